# Optimizing an MI355X kernel written in HIP

```python
import math
import jax, jax.numpy as jnp
from jax import lax
import numpy as np

D_MODEL = 1024
BATCH = 32
SEQ = 2048
DEPTH = 2

CONV_CH = 512
CONV_K = 31
DA_HEADS = 4
DA_SUB = 64
DA_QK = 2 * DA_SUB
DA_V = 128
ROT_DIM = DA_SUB // 4
ROPE_THETA = 500000.0
Q_BLOCK = 128
HG_HEADS = 4
HG_DK = 128
HG_DV = 128
HG_CHUNK = 32
MIX_WIDTH = 512
N_BRANCH = 3
N_GROUPS = 4
EXPERTS_PER_GROUP = 8
N_EXPERTS = N_GROUPS * EXPERTS_PER_GROUP
TOP_K = 2
D_EXPERT = 512
DN_ALPHA = (2 * DEPTH) ** 0.25
DN_BETA = (8 * DEPTH) ** -0.25
LN_EPS = 1e-5

SPLIT_SIZES = (
    2 * CONV_CH,
    DA_HEADS * DA_QK,
    DA_HEADS * DA_QK,
    DA_HEADS * DA_V,
    HG_HEADS * HG_DK,
    HG_HEADS * HG_DK,
    HG_HEADS * HG_DV,
    HG_HEADS * HG_DV,
    N_BRANCH * D_MODEL,
)
IN_COLS = sum(SPLIT_SIZES)
SPLIT_IDX = tuple(int(v) for v in np.cumsum(SPLIT_SIZES)[:-1])

kernel_name = "hybrid_conv_diffattn_hgrn2_hiermoe_deepnorm"


def layer_norm(x, g, b):
    xf = x.astype(jnp.float32)
    mu = jnp.mean(xf, -1, keepdims=True)
    var = jnp.mean(jnp.square(xf - mu), -1, keepdims=True)
    return ((xf - mu) * lax.rsqrt(var + LN_EPS)).astype(x.dtype) * g + b


def rms_norm(x, g):
    xf = x.astype(jnp.float32)
    return (xf * lax.rsqrt(jnp.mean(xf * xf, -1, keepdims=True) + LN_EPS)).astype(x.dtype) * g


def rotary_tables(positions, dtype):
    inv_freq = ROPE_THETA ** (-jnp.arange(0, ROT_DIM, 2, dtype=jnp.float32) / ROT_DIM)
    ang = positions.astype(jnp.float32)[..., None] * inv_freq
    return jnp.cos(ang).astype(dtype), jnp.sin(ang).astype(dtype)


def partial_rotary(t, cos, sin):
    half = ROT_DIM // 2
    t1, t2 = t[..., :half], t[..., half:ROT_DIM]
    c, s = cos[:, :, None, :], sin[:, :, None, :]
    return jnp.concatenate([t1 * c - t2 * s, t2 * c + t1 * s, t[..., ROT_DIM:]], -1)


def conformer_conv(a, conv_w, conv_b, ln_g, ln_b):
    u = a[..., :CONV_CH] * jax.nn.sigmoid(a[..., CONV_CH:])
    y = lax.conv_general_dilated(
        u, conv_w[:, None, :].astype(u.dtype), window_strides=(1,),
        padding=[(CONV_K - 1, 0)], dimension_numbers=("NWC", "WIO", "NWC"),
        feature_group_count=CONV_CH) + conv_b
    return jax.nn.silu(layer_norm(y, ln_g, ln_b))


def diff_attention(q, k, v, cos, sin, lam_params, norm_g, layer_idx):
    B, S, _ = q.shape
    q = partial_rotary(q.reshape(B, S, 2 * DA_HEADS, DA_SUB), cos, sin) * (DA_SUB ** -0.5)
    k = partial_rotary(k.reshape(B, S, 2 * DA_HEADS, DA_SUB), cos, sin)
    q = q.reshape(B, S, DA_HEADS, 2, DA_SUB)
    k = k.reshape(B, S, DA_HEADS, 2, DA_SUB)
    v = v.reshape(B, S, DA_HEADS, DA_V)
    lam_init = 0.8 - 0.6 * math.exp(-0.3 * layer_idx)
    lp = lam_params.astype(jnp.float32)
    lam = jnp.exp(jnp.sum(lp[0] * lp[1])) - jnp.exp(jnp.sum(lp[2] * lp[3])) + lam_init
    nb = S // Q_BLOCK
    qb = q.reshape(B, nb, Q_BLOCK, DA_HEADS, 2, DA_SUB).transpose(1, 0, 2, 3, 4, 5)
    key_pos = jnp.arange(S)

    def one_block(args):
        qi, i = args
        s = jnp.einsum("bqhpd,bkhpd->bhpqk", qi, k, preferred_element_type=jnp.float32)
        qpos = i * Q_BLOCK + jnp.arange(Q_BLOCK)
        s = jnp.where(key_pos[None, :] <= qpos[:, None], s, -jnp.inf)
        p = jax.nn.softmax(s, axis=-1)
        a = p[:, :, 0] - lam * p[:, :, 1]
        return jnp.einsum("bhqk,bkhd->bqhd", a.astype(v.dtype), v)

    o = lax.map(one_block, (qb, jnp.arange(nb)))
    o = o.transpose(1, 0, 2, 3, 4).reshape(B, S, DA_HEADS, DA_V)
    o = rms_norm(o, norm_g) * (1.0 - lam_init)
    return o.reshape(B, S, DA_HEADS * DA_V)


def hgrn2(q, f_logit, i_in, g, lb, norm_g):
    B, S, _ = q.shape
    C = HG_CHUNK
    nc = S // C
    qf = jax.nn.silu(q).astype(jnp.float32).reshape(B, S, HG_HEADS, HG_DK)
    lbf = lb.astype(jnp.float32)
    log_f = jnp.logaddexp(jnp.log(lbf), jnp.log1p(-lbf) + jax.nn.log_sigmoid(f_logit.astype(jnp.float32)))
    kf = -jnp.expm1(log_f)
    log_f = log_f.reshape(B, S, HG_HEADS, HG_DK)
    kf = kf.reshape(B, S, HG_HEADS, HG_DK)
    vf = i_in.astype(jnp.float32).reshape(B, S, HG_HEADS, HG_DV)

    def to_chunks(t):
        return t.reshape(B, nc, C, HG_HEADS, t.shape[-1]).transpose(1, 0, 3, 2, 4)

    bcum = jnp.cumsum(to_chunks(log_f), axis=-2)
    causal = jnp.tril(jnp.ones((C, C), dtype=bool))

    def step(state, xs):
        q_, k_, v_, b_ = xs
        o_inter = jnp.einsum("bhtc,bhcv->bhtv", q_ * jnp.exp(b_), state)
        diff = b_[:, :, :, None, :] - b_[:, :, None, :, :]
        decay = jnp.exp(jnp.where(causal[:, :, None], diff, -jnp.inf))
        att = jnp.einsum("bhtc,bhsc,bhtsc->bhts", q_, k_, decay)
        o_intra = jnp.einsum("bhts,bhsv->bhtv", att, v_)
        b_last = b_[:, :, -1:, :]
        k_dec = k_ * jnp.exp(b_last - b_)
        state = jnp.exp(b_last[:, :, 0, :])[..., None] * state + jnp.einsum("bhsc,bhsv->bhcv", k_dec, v_)
        return state, o_inter + o_intra

    s0 = jnp.zeros((B, HG_HEADS, HG_DK, HG_DV), jnp.float32)
    _, o = lax.scan(step, s0, (to_chunks(qf), to_chunks(kf), to_chunks(vf), bcum))
    o = o.transpose(1, 0, 3, 2, 4).reshape(B, S, HG_HEADS, HG_DV).astype(q.dtype)
    o = rms_norm(o, norm_g) * jax.nn.silu(g.reshape(B, S, HG_HEADS, HG_DV))
    return o.reshape(B, S, HG_HEADS * HG_DV)


def hier_moe(x, wg, bg, we, be, w1, w3, w2):
    B, S, D = x.shape
    t = x.reshape(-1, D)
    glog = (t @ wg).astype(jnp.float32) + bg
    gprob = jax.nn.softmax(glog, axis=-1)
    g_idx = jnp.argmax(glog, axis=-1)
    p_group = jnp.take_along_axis(gprob, g_idx[:, None], axis=-1)
    elog_all = jnp.einsum("td,gde->tge", t, we).astype(jnp.float32) + be
    elog = jnp.take_along_axis(elog_all, g_idx[:, None, None], axis=1)[:, 0]
    top_v, top_i = lax.top_k(elog, TOP_K)
    w_top = jax.nn.softmax(top_v, axis=-1) * p_group
    expert_id = g_idx[:, None] * EXPERTS_PER_GROUP + top_i
    comb = jnp.sum(jax.nn.one_hot(expert_id, N_EXPERTS, dtype=jnp.float32) * w_top[..., None], axis=1)
    comb = comb.astype(t.dtype)
    out = jnp.zeros_like(t)
    for e in range(N_EXPERTS):
        h = jax.nn.silu(t @ w1[e]) * (t @ w3[e])
        out = out + comb[:, e:e + 1] * (h @ w2[e])
    return out.reshape(B, S, D)


def setup_inputs(seed: int = 0) -> dict:
    key = jax.random.key(seed)
    ks = jax.random.split(key, 26)
    f32 = jnp.float32
    nrm = lambda k, shape, scale: jax.random.normal(k, shape, f32) * scale
    L, D = DEPTH, D_MODEL
    start = jax.random.randint(ks[1], (BATCH,), 0, 4096, dtype=jnp.int32)
    positions = (start[:, None] + jnp.arange(SEQ, dtype=jnp.int32)[None, :]).astype(jnp.int32)
    return {
        "x": jax.random.normal(ks[0], (BATCH, SEQ, D), f32),
        "positions": positions,
        "w_in": nrm(ks[2], (L, D, IN_COLS), D ** -0.5),
        "conv_w": nrm(ks[3], (L, CONV_K, CONV_CH), CONV_K ** -0.5),
        "conv_b": nrm(ks[4], (L, CONV_CH), 0.02),
        "conv_ln_g": 1.0 + nrm(ks[5], (L, CONV_CH), 0.02),
        "conv_ln_b": nrm(ks[6], (L, CONV_CH), 0.02),
        "da_lambda": nrm(ks[7], (L, 4, DA_SUB), 0.1),
        "da_norm_g": 1.0 + nrm(ks[8], (L, DA_V), 0.02),
        "hg_lb": nrm(ks[9], (L, HG_HEADS * HG_DK), 0.5),
        "hg_norm_g": 1.0 + nrm(ks[10], (L, HG_DV), 0.02),
        "w_branch": nrm(ks[11], (L, N_BRANCH, MIX_WIDTH, D), MIX_WIDTH ** -0.5),
        "b_gate": nrm(ks[12], (L, N_BRANCH, D), 0.02),
        "w_out": nrm(ks[13], (L, D, D), D ** -0.5 * DN_BETA),
        "ln1_g": 1.0 + nrm(ks[14], (L, D), 0.02),
        "ln1_b": nrm(ks[15], (L, D), 0.02),
        "router_group": nrm(ks[16], (L, D, N_GROUPS), D ** -0.5),
        "router_group_b": nrm(ks[17], (L, N_GROUPS), 0.01),
        "router_expert": nrm(ks[18], (L, N_GROUPS, D, EXPERTS_PER_GROUP), D ** -0.5),
        "router_expert_b": nrm(ks[19], (L, N_GROUPS, EXPERTS_PER_GROUP), 0.01),
        "exp_w1": nrm(ks[20], (L, N_EXPERTS, D, D_EXPERT), D ** -0.5),
        "exp_w3": nrm(ks[21], (L, N_EXPERTS, D, D_EXPERT), D ** -0.5),
        "exp_w2": nrm(ks[22], (L, N_EXPERTS, D_EXPERT, D), D_EXPERT ** -0.5 * DN_BETA),
        "ln2_g": 1.0 + nrm(ks[23], (L, D), 0.02),
        "ln2_b": nrm(ks[24], (L, D), 0.02),
    }


def reference(x, positions, w_in, conv_w, conv_b, conv_ln_g, conv_ln_b, da_lambda, da_norm_g,
              hg_lb, hg_norm_g, w_branch, b_gate, w_out, ln1_g, ln1_b, router_group,
              router_group_b, router_expert, router_expert_b, exp_w1, exp_w3, exp_w2,
              ln2_g, ln2_b):
    B, S, D = x.shape
    cos, sin = rotary_tables(positions, x.dtype)
    lb_tab = jnp.cumsum(jax.nn.softmax(hg_lb.astype(jnp.float32), axis=0), axis=0)
    lb_tab = lb_tab - lb_tab[0:1]
    for l in range(DEPTH):
        h = x @ w_in[l]
        a_in, q_a, k_a, v_a, q_h, f_h, i_h, g_h, gate_logits = jnp.split(h, SPLIT_IDX, axis=-1)
        y_a = conformer_conv(a_in, conv_w[l], conv_b[l], conv_ln_g[l], conv_ln_b[l])
        y_b = diff_attention(q_a, k_a, v_a, cos, sin, da_lambda[l], da_norm_g[l], l)
        y_c = hgrn2(q_h, f_h, i_h, g_h, lb_tab[l], hg_norm_g[l])
        ys = jnp.stack([y_a, y_b, y_c], axis=2)
        proj = jnp.einsum("bsnc,ncd->bsnd", ys, w_branch[l])
        gates = jax.nn.sigmoid(gate_logits.reshape(B, S, N_BRANCH, D) + b_gate[l])
        mix = jnp.sum(gates * proj, axis=2) @ w_out[l]
        x = layer_norm(DN_ALPHA * x + mix, ln1_g[l], ln1_b[l])
        moe = hier_moe(x, router_group[l], router_group_b[l], router_expert[l], router_expert_b[l],
                       exp_w1[l], exp_w3[l], exp_w2[l])
        x = layer_norm(DN_ALPHA * x + moe, ln2_g[l], ln2_b[l])
    return x
```

```cpp
#include <hip/hip_runtime.h>
#include <cstdio>
#include <cstdint>

#ifndef REP_P1
#define REP_P1 1
#endif
#ifndef REP_MIX
#define REP_MIX 1
#endif
#ifndef REP_P34
#define REP_P34 1
#endif
#ifndef REP_MOE
#define REP_MOE 1
#endif
#ifndef REP_P5
#define REP_P5 1
#endif
#ifndef REP_PRO
#define REP_PRO 1
#endif
#ifndef REP_LN
#define REP_LN 1
#endif
#ifndef ONE_LAUNCH
#define ONE_LAUNCH 1
#endif

#define GAS __attribute__((address_space(1)))
#define LAS __attribute__((address_space(3)))
typedef unsigned short bf16;
typedef float f32x4 __attribute__((ext_vector_type(4)));
typedef float f32x2 __attribute__((ext_vector_type(2)));
typedef unsigned u32x4 __attribute__((ext_vector_type(4)));
typedef unsigned u32x2 __attribute__((ext_vector_type(2)));

constexpr int D = 1024, NBATCH = 32, S = 2048, T = NBATCH * S, NL = 2;
constexpr int GB = 16, TG = GB * S, NG = NBATCH / GB;
constexpr int INC = 7680;
constexpr int NE = 32, DE = 512;
constexpr float ALPHA = 1.4142135623730951f, EPS = 1e-5f;
constexpr int NWAVES = 8, NTHR = 512;

constexpr size_t MiB = 1u << 20;
constexpr size_t WS_CTL = 0, CTL_ZERO_BYTES = 1 * MiB;
constexpr size_t WS_ROT = 1 * MiB;
constexpr size_t WS_LB = 5 * MiB;
constexpr size_t WS_RW = 6 * MiB;
constexpr size_t WS_WIN = 8 * MiB;
constexpr size_t WS_WBR = 38 * MiB;
constexpr size_t WS_WOUT = 44 * MiB;
constexpr size_t WS_W13 = 48 * MiB;
constexpr size_t WS_W2 = 176 * MiB;
constexpr size_t WS_XB = 240 * MiB;
constexpr size_t WS_U = 304 * MiB;
constexpr size_t WS_Q = 336 * MiB, WS_K = 368 * MiB, WS_V = 400 * MiB;
constexpr size_t WS_HQ = 432 * MiB, WS_HF = 464 * MiB, WS_HV = 496 * MiB, WS_HG = 528 * MiB;
constexpr size_t WS_GATE = 560 * MiB;
constexpr size_t WS_YA = 752 * MiB, WS_YB = 784 * MiB, WS_YC = 816 * MiB;
constexpr size_t WS_R = 848 * MiB;
constexpr size_t WS_TOK = 976 * MiB;
constexpr size_t WS_RT = 980 * MiB;
constexpr size_t WS_END = 982 * MiB;
constexpr size_t WS_M = WS_Q;
constexpr size_t WS_X1 = WS_YA;
constexpr size_t WS_HM = 304 * MiB;
constexpr size_t WS_OM = 376 * MiB;
constexpr size_t HSTRIDE = (size_t)TG * 512;
static_assert((WS_K - WS_Q) == HSTRIDE * 2 && (WS_HQ - WS_V) == HSTRIDE * 2 && (WS_HF - WS_HQ) == HSTRIDE * 2 && (WS_HV - WS_HF) == HSTRIDE * 2 && (WS_HG - WS_HV) == HSTRIDE * 2, "EpiInProj pointer arithmetic");
static_assert(WS_OM + (size_t)(2 * TG + 32 * 256) * 1024 * 2 <= WS_GATE && WS_HM + (size_t)(2 * TG + 32 * 256) * 512 * 2 <= WS_OM, "expert buffers overlay U..HF only");
constexpr int CW_BAR = 4096;
constexpr int CW_CNT = 16384;

__device__ __forceinline__ float bf2f(bf16 b) { return __uint_as_float(((unsigned)b) << 16); }
__device__ __forceinline__ unsigned f2bf(float f) { unsigned u = __float_as_uint(f); return (u + 0x7fffu + ((u >> 16) & 1u)) >> 16; }
__device__ __forceinline__ unsigned pk2(float lo, float hi) { unsigned r; asm volatile("v_cvt_pk_bf16_f32 %0, %1, %2" : "=v"(r) : "v"(lo), "v"(hi)); return r; }
__device__ __forceinline__ float lo16(unsigned w) { return __uint_as_float(w << 16); }
__device__ __forceinline__ float hi16(unsigned w) { return __uint_as_float(w & 0xffff0000u); }
#define DPP_ADD(v, ctrl) ((v) + __builtin_bit_cast(float, __builtin_amdgcn_update_dpp(0, __builtin_bit_cast(int, (v)), (ctrl), 0xF, 0xF, true)))
__device__ __forceinline__ float wave_sum(float v) {
    v = DPP_ADD(v, 0xB1);
    v = DPP_ADD(v, 0x4E);
    v = DPP_ADD(v, 0x141);
    v = DPP_ADD(v, 0x140);
    v = v + __builtin_bit_cast(float, __builtin_amdgcn_update_dpp(0, __builtin_bit_cast(int, v), 0x142, 0xA, 0xF, false));
    v = v + __builtin_bit_cast(float, __builtin_amdgcn_update_dpp(0, __builtin_bit_cast(int, v), 0x143, 0xC, 0xF, false));
    return __builtin_bit_cast(float, __builtin_amdgcn_readlane(__builtin_bit_cast(int, v), 63));
}
__device__ __forceinline__ float wave_max(float v) {
#pragma unroll
    for (int o = 1; o < 64; o <<= 1) v = fmaxf(v, __shfl_xor(v, o));
    return v;
}
__device__ __forceinline__ float sigmoidf_(float z) { return 1.f / (1.f + expf(-z)); }
__device__ __forceinline__ float siluf_(float z) { return z / (1.f + expf(-z)); }
__device__ __forceinline__ float hg_logf(float z, float lb) {
    if (z >= 0.f) { const float sn = 1.f / (1.f + expf(z)); return log1pf(-(1.f - lb) * sn); }
    const float ez = expf(z); return logf(lb + (1.f - lb) * (ez / (1.f + ez)));
}
#define LDS_WAIT() asm volatile("s_waitcnt lgkmcnt(0)" ::: "memory")

#define XB_TMO      128
#define XB_XCNT(j)  (256  + 64 * (j))
#define XB_XSUB(j)  (1280 + 64 * (j))
#define XB_XGEN(j)  (2304 + 64 * (j))
#define XB_TOP      3328
#define XB_TOPGEN   3392
#define XCD_BAR_WORDS 3456
#define XB_SPIN_CAP (1u << 22)
__device__ __forceinline__ unsigned xb_ld(unsigned* p)              { return __hip_atomic_load(p, __ATOMIC_RELAXED, __HIP_MEMORY_SCOPE_AGENT); }
__device__ __forceinline__ unsigned xb_add(unsigned* p, unsigned v) { return __hip_atomic_fetch_add(p, v, __ATOMIC_RELAXED, __HIP_MEMORY_SCOPE_AGENT); }
__device__ __forceinline__ unsigned xb_xcc_id() { return (unsigned)__builtin_amdgcn_s_getreg((3 << 11) | 20) & 0xFu; }
#define XB_SPIN(cond, bar) do { unsigned _sp = 0; while (cond) { __builtin_amdgcn_s_sleep(1); \
    if ((++_sp & 255u) == 0u) { if (xb_ld(&(bar)[XB_TMO])) break; if (_sp > XB_SPIN_CAP) { atomicAdd(&(bar)[XB_TMO], 1u); break; } } } } while (0)
struct XcdBarrier { unsigned* bar; unsigned x; volatile LAS unsigned* st; };
__device__ __forceinline__ XcdBarrier xcd_barrier_post(unsigned* bar, volatile LAS unsigned* st) {
    XcdBarrier b; b.bar = bar; b.x = (unsigned)__builtin_amdgcn_readfirstlane((int)xb_xcc_id()); b.st = st;
    if (threadIdx.x == 0) (void)xb_add(&bar[XB_XCNT(b.x)], 1u);
    return b;
}
__device__ __forceinline__ void xcd_barrier_complete(unsigned* bar, unsigned x, unsigned& nloc, unsigned& nx) {
    const unsigned G = gridDim.x * gridDim.y * gridDim.z;
    unsigned sum, cnt, mine, sp = 0u;
    for (;;) {
        sum = 0u; cnt = 0u; mine = 0u;
#pragma unroll
        for (unsigned j = 0; j < 16; ++j) { const unsigned c = xb_ld(&bar[XB_XCNT(j)]); sum += c; cnt += (c > 0u) ? 1u : 0u; mine = (j == x) ? c : mine; }
        if (sum == G) break;
        __builtin_amdgcn_s_sleep(1);
        if ((++sp & 255u) == 0u) { if (xb_ld(&bar[XB_TMO])) break; if (sp > XB_SPIN_CAP) { atomicAdd(&bar[XB_TMO], 1u); break; } }
    }
    nloc = mine > 0u ? mine : 1u; nx = cnt > 0u ? cnt : 1u;
}
__device__ __forceinline__ void xcd_barrier(const XcdBarrier& b_) {
    XcdBarrier b = b_;
    { unsigned long long bp = (unsigned long long)b_.bar; unsigned bx = b_.x; asm volatile("" : "+s"(bp), "+s"(bx)); b.bar = (unsigned*)(GAS unsigned*)bp; b.x = bx; }
    asm volatile("s_waitcnt vmcnt(0)" ::: "memory");
    __syncthreads();
    if (threadIdx.x == 0) {
        unsigned* bar = b.bar;
        __builtin_amdgcn_s_waitcnt(0);
        unsigned nloc = b.st[0], nx = b.st[1];
        if (nloc == 0u) { xcd_barrier_complete(bar, b.x, nloc, nx); b.st[0] = nloc; b.st[1] = nx; }
        const unsigned old = xb_add(&bar[XB_XSUB(b.x)], 1u);
        const unsigned gen = old / nloc;
        if (old + 1u == (gen + 1u) * nloc) {
            __builtin_amdgcn_fence(__ATOMIC_RELEASE, "agent");
            asm volatile("s_waitcnt vmcnt(0)" ::: "memory");
            const unsigned og = xb_add(&bar[XB_TOP], 1u);
            const unsigned tg = og / nx;
            if (og + 1u == (tg + 1u) * nx) xb_add(&bar[XB_TOPGEN], 1u);
            else XB_SPIN(xb_ld(&bar[XB_TOPGEN]) == tg, bar);
            __builtin_amdgcn_fence(__ATOMIC_ACQUIRE, "agent");
            xb_add(&bar[XB_XGEN(b.x)], 1u);
            asm volatile("s_waitcnt vmcnt(0)" ::: "memory");
        } else {
            XB_SPIN(xb_ld(&bar[XB_XGEN(b.x)]) == gen, bar);
            __builtin_amdgcn_fence(__ATOMIC_ACQUIRE, "agent");
            asm volatile("s_waitcnt vmcnt(0)" ::: "memory");
        }
    }
    __syncthreads();
}

constexpr int LDS_BYTES = 147456;
constexpr int MISC_OFF = 135168;
struct Args { const void* in[25]; float* out; unsigned char* ws; int g_lo, g_hi, l_lo, l_hi, ph_lo, ph_hi, prologue, pad; };
struct Frame { LAS unsigned char* lds; int tid, lane, wave; };
typedef const __attribute__((address_space(4))) Args* KArgs;
__device__ __forceinline__ KArgs kargs() { unsigned long long v = (unsigned long long)__builtin_amdgcn_kernarg_segment_ptr(); asm volatile("" : "+s"(v)); return (KArgs)v; }
#define KA_WS() KArgs ka = kargs(); unsigned char* ws = (unsigned char*)(GAS unsigned char*)ka->ws
#define KIN(i) ((const void*)(const GAS char*)ka->in[i])
#define KOUT() ((float*)(GAS float*)ka->out)
__device__ __forceinline__ Frame mkframe(LAS unsigned char* lds) { Frame F; int t = threadIdx.x; asm volatile("" : "+v"(t)); F.lds = lds; F.tid = t; F.lane = t & 63; F.wave = __builtin_amdgcn_readfirstlane(t >> 6); return F; }

namespace pg8 {
typedef short bf16x8 __attribute__((ext_vector_type(8)));
constexpr int BM = 256, BK = 64, HALF = 128, HTB = HALF * BK * 2, STAGE_BYTES = 8 * HTB, NXCD = 8, WGM = 8;
__host__ __device__ __forceinline__ int lds_byte(int r, int c) { const int st = (r >> 4) * 2 + (c >> 5), rr = r & 15, cc = c & 31, ob = rr * 64 + cc * 2; return st * 1024 + (ob ^ (((ob >> 9) & 1) << 5)); }
__host__ __device__ __forceinline__ void stage_rc(int b, int& R, int& C) { const int st = b / 1024, sb = b % 1024, swz = sb ^ (((sb >> 9) & 1) << 5); R = (st >> 1) * 16 + swz / 64; C = (st & 1) * 32 + (swz % 64) / 2; }
__host__ __device__ __forceinline__ int perm32(int rho) { const int n = rho >> 4, i = rho & 15; return 8 * (i >> 2) + 4 * n + (i & 3); }
struct Unit { int pm, pn, e, pos0, cnt; };
__device__ __forceinline__ int xcd_remap(int wgid, int nwg) { const int q = nwg / NXCD, r = nwg % NXCD, xcd = wgid % NXCD, off = wgid / NXCD; return (xcd < r ? xcd * (q + 1) : r * (q + 1) + (xcd - r) * q) + off; }
struct StaticOrder {
    int nM, nN, nwg, G, c;
    __device__ void init(int M, int N, int G_, int c_) { nM = M / BM; nN = N / BM; nwg = nM * nN; G = G_; c = c_; }
    __device__ bool next(int i, Unit& u) const {
        const long L = (long)i * G + c; if (L >= nwg) return false;
        const int wgid = xcd_remap((int)L, nwg);
        const int nig = WGM * nN, gid = wgid / nig, fm = gid * WGM, gsz = (nM - fm) < WGM ? (nM - fm) : WGM;
        u.pm = fm + ((wgid % nig) % gsz); u.pn = (wgid % nig) / gsz; u.e = 0; u.pos0 = 0; u.cnt = 0; return true;
    }
    __device__ __forceinline__ void a_ready(const Unit&) const {}
    __device__ __forceinline__ void done(const Unit&) const {}
};
template <int PART> struct SubOrder {
    StaticOrder so;
    __device__ void init(int M, int G_, int c_) { so.init(M, (PART == 0 ? 18 : 12) * BM, G_, c_); }
    __device__ bool next(int i, Unit& u) const { if (!so.next(i, u)) return false; u.pn = PART == 0 ? u.pn + 4 : (u.pn < 4 ? u.pn : u.pn + 18); return true; }
    __device__ __forceinline__ void a_ready(const Unit&) const {}
    __device__ __forceinline__ void done(const Unit&) const {}
};
struct MergeOrder {
    StaticOrder so;
    __device__ bool next(int i, Unit& u) const { if (!so.next(i / 3, u)) return false; u.e = i % 3; return true; }
    __device__ __forceinline__ void a_ready(const Unit&) const {}
    __device__ __forceinline__ void done(const Unit&) const {}
};
struct MoeOrder {
    const LAS int* tab; int G, c, NT;
    __device__ bool next(int i, Unit& u) const {
        const int np = __builtin_amdgcn_readfirstlane(tab[32]); const int nwg = np * NT;
        const long L = (long)i * G + c; if (L >= nwg) return false;
        const int wgid = xcd_remap((int)L, nwg);
        const int panel = wgid / NT; u.pn = wgid % NT;
        int e = 0;
#pragma unroll
        for (int s2 = 16; s2 >= 1; s2 >>= 1) { const int tv = __builtin_amdgcn_readfirstlane(tab[e + s2]); if (tv <= panel) e += s2; }
        u.e = e; u.pm = panel; u.pos0 = (panel - __builtin_amdgcn_readfirstlane(tab[e])) * 256; u.cnt = __builtin_amdgcn_readfirstlane(tab[33 + e]); return true;
    }
    __device__ __forceinline__ void a_ready(const Unit&) const {}
    __device__ __forceinline__ void done(const Unit&) const {}
};
__device__ __forceinline__ unsigned cvt_pk_bf16(float lo, float hi) { unsigned r; asm volatile("v_cvt_pk_bf16_f32 %0, %1, %2" : "=v"(r) : "v"(lo), "v"(hi)); return r; }

template <class Prob, class Epi, class Sched, bool ALIGN_EPI>
__device__ __forceinline__ void gemm_phase(LAS unsigned char* lds, const Prob& P, const Sched& S, const Epi& E) {
    int tid_ = threadIdx.x; asm volatile("" : "+v"(tid_));
    const int tid = tid_, wid = __builtin_amdgcn_readfirstlane(tid >> 6), lane = tid & 63, wr = wid >> 2, wc = wid & 3, fr = lane & 15, fq = lane >> 4;
    const int K = P.K, nt = K / BK;
    unsigned vA[2][2], voffB[2];
#pragma unroll
    for (int i = 0; i < 2; ++i) { int R, C; stage_rc(tid * 16 + i * 8192, R, C); const int Rb = (R & ~31) + perm32(R & 31);
        vA[0][i] = (unsigned)(R * K + C) * 2u; vA[1][i] = vA[0][i] + (unsigned)(HALF * K * 2); voffB[i] = (unsigned)(Rb * K + C) * 2u; }
    const size_t kstep = (size_t)(BK * 2);
    const size_t hstep = (size_t)HALF * K * 2;
    const unsigned ldsw = (unsigned)wid * 1024u;
    const int aoff = lds_byte(wr * 64 + fr, fq * 8), boff = lds_byte(wc * 32 + fr, fq * 8);
#define PG8_SA(b, h) (((b) * 2 + (h)) * HTB)
#define PG8_SB(b, h) ((4 + (b) * 2 + (h)) * HTB)
#define PG8_STAGE(bufoff, gbase, voff) do { _Pragma("unroll") for (int _i = 0; _i < 2; ++_i) \
        __builtin_amdgcn_global_load_lds((const unsigned*)((const char*)(gbase) + (voff)[_i]), (LAS unsigned*)(lds + (bufoff) + ldsw + _i * 8192), 16, 0, 0); } while (0)
#define PG8_LDA(dst, b, h) do { _Pragma("unroll") for (int m = 0; m < 4; ++m) _Pragma("unroll") for (int k = 0; k < 2; ++k) dst[m][k] = *(const LAS bf16x8*)(lds + PG8_SA(b, h) + aoff + m * 2048 + k * 1024); } while (0)
#define PG8_LDB(dst, b, h) do { _Pragma("unroll") for (int n = 0; n < 2; ++n) _Pragma("unroll") for (int k = 0; k < 2; ++k) dst[n][k] = *(const LAS bf16x8*)(lds + PG8_SB(b, h) + boff + n * 2048 + k * 1024); } while (0)
#define PG8_MMA(ai, bj, At, Bt) do { __builtin_amdgcn_s_setprio(1); _Pragma("unroll") for (int m = 0; m < 4; ++m) _Pragma("unroll") for (int n = 0; n < 2; ++n) _Pragma("unroll") for (int k = 0; k < 2; ++k) \
        acc[ai][bj][m][n] = __builtin_amdgcn_mfma_f32_16x16x32_bf16(Bt[n][k], At[m][k], acc[ai][bj][m][n], 0, 0, 0); __builtin_amdgcn_s_setprio(0); } while (0)
#define PG8_WAIT_V(n) asm volatile("s_waitcnt vmcnt(" #n ")" ::: "memory")
#define PG8_WAIT_L(n) asm volatile("s_waitcnt lgkmcnt(" #n ")" ::: "memory")
#define PG8_BAR __builtin_amdgcn_s_barrier()
#define PG8_SCHED __builtin_amdgcn_sched_barrier(0)
    Unit cur, nxt; int ui = 0;
    if (!S.next(0, cur)) return;
    f32x4 acc[2][2][4][2];
#pragma unroll
    for (int a = 0; a < 2; ++a)
#pragma unroll
        for (int b = 0; b < 2; ++b)
#pragma unroll
            for (int m = 0; m < 4; ++m)
#pragma unroll
                for (int n = 0; n < 2; ++n) acc[a][b][m][n] = (f32x4){0.f, 0.f, 0.f, 0.f};
    bf16x8 At[4][2], B0[2][2], B1[2][2];
    const char* cA = P.abase(cur); const char* cB = P.bbase(cur);
    if constexpr (Prob::GATHER) P.voff(cur, tid, vA);
    S.a_ready(cur);
    PG8_STAGE(PG8_SB(0, 0), cB, voffB); PG8_STAGE(PG8_SB(0, 1), cB + hstep, voffB); PG8_STAGE(PG8_SA(0, 0), cA, vA[0]); PG8_STAGE(PG8_SA(0, 1), cA, vA[1]);
    if (wr == 1) PG8_BAR;
    PG8_WAIT_V(2); PG8_BAR;
    PG8_STAGE(PG8_SB(1, 0), cB + kstep, voffB); PG8_STAGE(PG8_SA(1, 0), cA + kstep, vA[0]); PG8_STAGE(PG8_SB(1, 1), cB + hstep + kstep, voffB);
    PG8_WAIT_V(6); PG8_BAR;
    for (;;) {
        const bool has_next = S.next(ui + 1, nxt);
        const char* nA = has_next ? P.abase(nxt) : cA; const char* nB = has_next ? P.bbase(nxt) : cB;
        unsigned nv[2][2];
#pragma unroll
        for (int h = 0; h < 2; ++h)
#pragma unroll
            for (int i = 0; i < 2; ++i) nv[h][i] = vA[h][i];
        for (int t = 0; t < nt; t += 2) {
            const bool last = (t == nt - 2);
            if constexpr (Prob::GATHER) { if (t == nt - 4 && has_next) P.voff(nxt, tid, nv); }
            const char* a1 = cA + (size_t)(t + 1) * kstep;
            const char* a2 = last ? nA : cA + (size_t)(t + 2) * kstep; const char* b2 = last ? nB : cB + (size_t)(t + 2) * kstep;
            const char* a3 = a2 + kstep; const char* b3 = b2 + kstep;
            if (last && has_next) S.a_ready(nxt);
            unsigned w0[2], w1[2];
#pragma unroll
            for (int i = 0; i < 2; ++i) { if constexpr (Prob::GATHER) { w0[i] = last ? nv[0][i] : vA[0][i]; w1[i] = last ? nv[1][i] : vA[1][i]; } else { w0[i] = vA[0][i]; w1[i] = vA[1][i]; } }
            PG8_LDB(B0, 0, 0); PG8_LDB(B1, 0, 1); PG8_SCHED; PG8_LDA(At, 0, 0); PG8_STAGE(PG8_SA(1, 1), a1, vA[1]);
            PG8_WAIT_V(8); PG8_WAIT_L(0); PG8_BAR; PG8_MMA(0, 0, At, B0); PG8_MMA(0, 1, At, B1); PG8_BAR; PG8_SCHED;
            PG8_LDA(At, 0, 1); PG8_STAGE(PG8_SB(0, 0), b2, voffB); PG8_STAGE(PG8_SB(0, 1), b2 + hstep, voffB); PG8_STAGE(PG8_SA(0, 0), a2, w0);
            PG8_WAIT_V(8); PG8_WAIT_L(0); PG8_BAR; PG8_MMA(1, 0, At, B0); PG8_MMA(1, 1, At, B1); PG8_BAR; PG8_SCHED;
            PG8_LDB(B0, 1, 0); PG8_LDB(B1, 1, 1); PG8_SCHED; PG8_LDA(At, 1, 0); PG8_STAGE(PG8_SA(0, 1), a2, w1);
            PG8_WAIT_V(8); PG8_WAIT_L(0); PG8_BAR; PG8_MMA(0, 0, At, B0); PG8_MMA(0, 1, At, B1); PG8_BAR; PG8_SCHED;
            PG8_LDA(At, 1, 1); PG8_STAGE(PG8_SB(1, 0), b3, voffB); PG8_STAGE(PG8_SB(1, 1), b3 + hstep, voffB); PG8_STAGE(PG8_SA(1, 0), a3, w0);
            PG8_WAIT_V(8); PG8_WAIT_L(0); PG8_BAR; PG8_MMA(1, 0, At, B0); PG8_MMA(1, 1, At, B1); PG8_BAR; PG8_SCHED;
        }
        if constexpr (ALIGN_EPI) { if (wr == 0) PG8_BAR; }
        E(acc, cur, wr, wc, fr, fq); S.done(cur);
        if (!has_next) break;
        if (!(Epi::CARRY && nxt.e != 0))
#pragma unroll
        for (int a = 0; a < 2; ++a)
#pragma unroll
            for (int b = 0; b < 2; ++b)
#pragma unroll
                for (int m = 0; m < 4; ++m)
#pragma unroll
                    for (int n = 0; n < 2; ++n) acc[a][b][m][n] = (f32x4){0.f, 0.f, 0.f, 0.f};
        cur = nxt; cA = nA; cB = nB; ++ui;
        if constexpr (Prob::GATHER) {
#pragma unroll
            for (int h = 0; h < 2; ++h)
#pragma unroll
                for (int i = 0; i < 2; ++i) vA[h][i] = nv[h][i]; }
        if constexpr (ALIGN_EPI) { if (wr == 1) PG8_BAR; }
    }
    PG8_WAIT_V(0);
    if constexpr (!ALIGN_EPI) { if (wr == 0) PG8_BAR; }
    PG8_BAR;
#undef PG8_SA
#undef PG8_SB
#undef PG8_STAGE
#undef PG8_LDA
#undef PG8_LDB
#undef PG8_MMA
#undef PG8_WAIT_V
#undef PG8_WAIT_L
#undef PG8_BAR
#undef PG8_SCHED
}
struct ProbDense { static constexpr bool GATHER = false; const char* A; const char* Bt; int K;
    __device__ __forceinline__ const char* abase(const Unit& u) const { return A + (size_t)u.pm * 256 * K * 2; }
    __device__ __forceinline__ const char* bbase(const Unit& u) const { return Bt + (size_t)u.pn * 256 * K * 2; }
    __device__ __forceinline__ void voff(const Unit&, int, unsigned (&)[2][2]) const {} };
struct ProbMerge { static constexpr bool GATHER = false; const char* Y0; const char* Y1; const char* Y2; const char* W; int K;
    __device__ __forceinline__ const char* abase(const Unit& u) const { const char* y = u.e == 0 ? Y0 : (u.e == 1 ? Y1 : Y2); return y + (size_t)u.pm * 256 * K * 2; }
    __device__ __forceinline__ const char* bbase(const Unit& u) const { return W + ((size_t)u.e * 1024 + u.pn * 256) * K * 2; }
    __device__ __forceinline__ void voff(const Unit&, int, unsigned (&)[2][2]) const {} };
struct ProbMoe1 { static constexpr bool GATHER = true; const char* X1; const char* W; const int* TOK; int K;
    __device__ __forceinline__ const char* abase(const Unit&) const { return X1; }
    __device__ __forceinline__ const char* bbase(const Unit& u) const { return W + ((size_t)u.e * 1024 + u.pn * 256) * K * 2; }
    __device__ __forceinline__ void voff(const Unit& u, int tid, unsigned (&v)[2][2]) const {
#pragma unroll
        for (int i = 0; i < 2; ++i) { int R, C; stage_rc(tid * 16 + i * 8192, R, C);
#pragma unroll
            for (int h = 0; h < 2; ++h) { const int pos = u.pos0 + h * 128 + R; int tk = TOK[(size_t)u.e * TG + pos]; tk = pos < u.cnt ? tk : 0; v[h][i] = (unsigned)tk * (unsigned)(K * 2) + (unsigned)C * 2u; } } } };
struct ProbMoe2 { static constexpr bool GATHER = false; const char* HM; const char* W; int K;
    __device__ __forceinline__ const char* abase(const Unit& u) const { return HM + (size_t)u.pm * 256 * K * 2; }
    __device__ __forceinline__ const char* bbase(const Unit& u) const { return W + ((size_t)u.e * 1024 + u.pn * 256) * K * 2; }
    __device__ __forceinline__ void voff(const Unit&, int, unsigned (&)[2][2]) const {} };

__device__ __forceinline__ float fsig(float z) { return __builtin_amdgcn_rcpf(1.f + __expf(-z)); }
__device__ __forceinline__ float hg_logf_fast(float z, float lb) {
    const float t = __expf(-fabsf(z)), sg = t * __builtin_amdgcn_rcpf(1.f + t), w = (1.f - lb) * sg;
    return __logf(z >= 0.f ? 1.f - w : lb + w);
}
__device__ __forceinline__ void st8(bf16* p, const f32x4& a, const f32x4& b) { u32x4 w; w.x = cvt_pk_bf16(a[0], a[1]); w.y = cvt_pk_bf16(a[2], a[3]); w.z = cvt_pk_bf16(b[0], b[1]); w.w = cvt_pk_bf16(b[2], b[3]); *(u32x4*)p = w; }
struct EpiInProj {
    static constexpr bool PERM = true, CARRY = false;
    bf16 *U, *Q, *V, *GATE; const float* rot; const float* lbt; const float* bg;
    __device__ __forceinline__ void operator()(const f32x4 (&acc)[2][2][4][2], const Unit& u, int wr, int wc, int fr, int fq) const {
        const int pn = u.pn, rowb = u.pm * 256 + wr * 64 + fr, cl = wc * 32 + 8 * fq;
        if (pn < 4) {
#pragma unroll
            for (int ai = 0; ai < 2; ++ai)
#pragma unroll
                for (int m = 0; m < 4; ++m) { const int row = rowb + ai * 128 + m * 16; f32x4 o0, o1;
#pragma unroll
                    for (int j = 0; j < 4; ++j) { o0[j] = acc[ai][0][m][0][j] * fsig(acc[ai][1][m][0][j]); o1[j] = acc[ai][0][m][1][j] * fsig(acc[ai][1][m][1][j]); }
                    st8(U + (size_t)row * 512 + pn * 128 + cl, o0, o1); asm volatile("" ::: "memory"); }
        } else if (pn < 8) {
            const int which = pn - 4; bf16* dst = Q + (size_t)(which >> 1) * HSTRIDE; const float sc = (which >> 1) ? 1.f : 0.125f * 1.4426950408889634f; const int colb = (which & 1) * 256 + cl;
            const bool rotw = (wc & 1) == 0; const float sgn = fq == 0 ? -1.f : 1.f;
#pragma unroll
            for (int ai = 0; ai < 2; ++ai) {
                f32x4 cs[4][4];
#pragma unroll
                for (int m = 0; m < 4; ++m) { cs[m][0] = (f32x4){1.f, 1.f, 1.f, 1.f}; cs[m][1] = cs[m][0]; cs[m][2] = (f32x4){0.f, 0.f, 0.f, 0.f}; cs[m][3] = cs[m][2];
                    if (rotw && fq < 2) { const f32x4* rp = (const f32x4*)(rot + (size_t)(rowb + ai * 128 + m * 16) * 16); cs[m][0] = rp[0]; cs[m][1] = rp[1]; cs[m][2] = rp[2]; cs[m][3] = rp[3]; } }
#pragma unroll
                for (int m = 0; m < 4; ++m) { const int row = rowb + ai * 128 + m * 16;
                    const f32x4 c0 = cs[m][0], c1 = cs[m][1], s0 = cs[m][2] * sgn, s1 = cs[m][3] * sgn;
#pragma unroll
                    for (int bj = 0; bj < 2; ++bj) { f32x4 x0 = acc[ai][bj][m][0], x1 = acc[ai][bj][m][1];
                        if (rotw) { f32x4 p0, p1;
#pragma unroll
                            for (int j = 0; j < 4; ++j) { p0[j] = __shfl_xor(x0[j], 16); p1[j] = __shfl_xor(x1[j], 16); }
                            x0 = x0 * c0 + p0 * s0; x1 = x1 * c1 + p1 * s1; }
                        st8(dst + (size_t)row * 512 + colb + bj * 128, x0 * sc, x1 * sc); } }
                asm volatile("" ::: "memory"); }
        } else {
            int kind, ldc, colb; bf16* dst; bool seqc = false;
            if (pn < 18) { const int tq = (pn - 8) >> 1; seqc = tq >= 1; kind = tq == 0 ? 0 : (tq == 1 ? 1 : (tq == 2 ? 2 : (tq == 3 ? 0 : 1))); dst = V + (size_t)tq * HSTRIDE; ldc = 512; colb = ((pn - 8) & 1) * 256; }
            else { kind = 3; dst = GATE; ldc = 3072; colb = (pn - 18) * 256; }
            f32x4 aux[2][2];
#pragma unroll
            for (int bj = 0; bj < 2; ++bj)
#pragma unroll
                for (int n = 0; n < 2; ++n) aux[bj][n] = kind == 2 ? *(const f32x4*)(lbt + colb + bj * 128 + cl + 4 * n) : (kind == 3 ? *(const f32x4*)(bg + colb + bj * 128 + cl + 4 * n) : (f32x4){0.f, 0.f, 0.f, 0.f});
#pragma unroll
            for (int ai = 0; ai < 2; ++ai)
#pragma unroll
                for (int m = 0; m < 4; ++m) { const int row = rowb + ai * 128 + m * 16;
#pragma unroll
                    for (int bj = 0; bj < 2; ++bj) { f32x4 x[2] = {acc[ai][bj][m][0], acc[ai][bj][m][1]};
                        if (kind == 1) {
#pragma unroll
                            for (int n = 0; n < 2; ++n)
#pragma unroll
                                for (int j = 0; j < 4; ++j) x[n][j] = x[n][j] * fsig(x[n][j]);
                        } else if (kind == 2) {
#pragma unroll
                            for (int n = 0; n < 2; ++n)
#pragma unroll
                                for (int j = 0; j < 4; ++j) x[n][j] = hg_logf_fast(x[n][j], aux[bj][n][j]);
                        } else if (kind == 3) {
#pragma unroll
                            for (int n = 0; n < 2; ++n)
#pragma unroll
                                for (int j = 0; j < 4; ++j) x[n][j] = fsig(x[n][j] + aux[bj][n][j]);
                        }
                        const size_t di = seqc ? ((size_t)((row >> 11) * 4 + (colb >> 7) + bj) * 2048 + (row & 2047)) * 128 + cl : (size_t)row * ldc + colb + bj * 128 + cl;
                        st8(dst + di, x[0], x[1]); } asm volatile("" ::: "memory"); }
        }
    }
};
struct EpiMerge {
    static constexpr bool PERM = true, CARRY = true;
    const bf16* GATE; bf16* M;
    __device__ __forceinline__ void operator()(f32x4 (&acc)[2][2][4][2], const Unit& u, int wr, int wc, int fr, int fq) const {
        const int rowb = u.pm * 256 + wr * 64 + fr, cl = u.pn * 256 + wc * 32 + 8 * fq, n = u.e;
#pragma unroll
        for (int ai = 0; ai < 2; ++ai) {
            u32x4 g[4][2], h[4][2];
#pragma unroll
            for (int m = 0; m < 4; ++m)
#pragma unroll
                for (int bj = 0; bj < 2; ++bj) { const bf16* gp = GATE + (size_t)(rowb + ai * 128 + m * 16) * 3072 + n * 1024 + cl + bj * 128;
                    g[m][bj] = *(const u32x4*)gp; h[m][bj] = g[m][bj]; if (n < 2) h[m][bj] = *(const u32x4*)(gp + 1024); }
#pragma unroll
            for (int m = 0; m < 4; ++m)
#pragma unroll
                for (int bj = 0; bj < 2; ++bj) { const u32x4 gg = g[m][bj], hh = h[m][bj];
                    f32x4 s0 = (f32x4){lo16(gg.x), hi16(gg.x), lo16(gg.y), hi16(gg.y)}, s1 = (f32x4){lo16(gg.z), hi16(gg.z), lo16(gg.w), hi16(gg.w)};
                    if (n < 2) {
                        const f32x4 d0 = (f32x4){lo16(hh.x), hi16(hh.x), lo16(hh.y), hi16(hh.y)}, d1 = (f32x4){lo16(hh.z), hi16(hh.z), lo16(hh.w), hi16(hh.w)};
#pragma unroll
                        for (int j = 0; j < 4; ++j) { s0[j] *= __builtin_amdgcn_rcpf(fmaxf(d0[j], 1e-20f)); s1[j] *= __builtin_amdgcn_rcpf(fmaxf(d1[j], 1e-20f)); }
                        acc[ai][bj][m][0] = acc[ai][bj][m][0] * s0; acc[ai][bj][m][1] = acc[ai][bj][m][1] * s1;
                    } else st8(M + (size_t)(rowb + ai * 128 + m * 16) * D + cl + bj * 128, acc[ai][bj][m][0] * s0, acc[ai][bj][m][1] * s1); }
            asm volatile("" ::: "memory"); }
    }
};
struct EpiWout {
    static constexpr bool PERM = true, CARRY = false;
    const bf16* XB; float* R;
    __device__ __forceinline__ void operator()(const f32x4 (&acc)[2][2][4][2], const Unit& u, int wr, int wc, int fr, int fq) const {
        const int rowb = u.pm * 256 + wr * 64 + fr, cl = u.pn * 256 + wc * 32 + 8 * fq;
#pragma unroll
        for (int ai = 0; ai < 2; ++ai) {
            u32x4 g[4][2];
#pragma unroll
            for (int m = 0; m < 4; ++m)
#pragma unroll
                for (int bj = 0; bj < 2; ++bj) g[m][bj] = *(const u32x4*)(XB + (size_t)(rowb + ai * 128 + m * 16) * D + cl + bj * 128);
#pragma unroll
            for (int m = 0; m < 4; ++m)
#pragma unroll
                for (int bj = 0; bj < 2; ++bj) { const size_t o = (size_t)(rowb + ai * 128 + m * 16) * D + cl + bj * 128; const u32x4 gg = g[m][bj];
                    *(f32x4*)(R + o) = acc[ai][bj][m][0] + (f32x4){lo16(gg.x), hi16(gg.x), lo16(gg.y), hi16(gg.y)} * ALPHA;
                    *(f32x4*)(R + o + 4) = acc[ai][bj][m][1] + (f32x4){lo16(gg.z), hi16(gg.z), lo16(gg.w), hi16(gg.w)} * ALPHA; }
            asm volatile("" ::: "memory"); }
    }
};
struct EpiMoe1 {
    static constexpr bool PERM = true, CARRY = false;
    bf16* HM;
    __device__ __forceinline__ void operator()(const f32x4 (&acc)[2][2][4][2], const Unit& u, int wr, int wc, int fr, int fq) const {
        const int rowb = u.pm * 256 + wr * 64 + fr, cl = u.pn * 128 + wc * 32 + 8 * fq;
#pragma unroll
        for (int ai = 0; ai < 2; ++ai)
#pragma unroll
            for (int m = 0; m < 4; ++m) { const int row = rowb + ai * 128 + m * 16; f32x4 o0, o1;
#pragma unroll
                for (int j = 0; j < 4; ++j) { const float a = acc[ai][0][m][0][j], b = acc[ai][0][m][1][j]; o0[j] = a * fsig(a) * acc[ai][1][m][0][j]; o1[j] = b * fsig(b) * acc[ai][1][m][1][j]; }
                st8(HM + (size_t)row * DE + cl, o0, o1); }
    }
};
struct EpiMoe2 {
    static constexpr bool PERM = true, CARRY = false;
    bf16* OM;
    __device__ __forceinline__ void operator()(const f32x4 (&acc)[2][2][4][2], const Unit& u, int wr, int wc, int fr, int fq) const {
        const int rowb = u.pm * 256 + wr * 64 + fr, cl = u.pn * 256 + wc * 32 + 8 * fq;
#pragma unroll
        for (int ai = 0; ai < 2; ++ai)
#pragma unroll
            for (int m = 0; m < 4; ++m) { const int row = rowb + ai * 128 + m * 16;
#pragma unroll
                for (int bj = 0; bj < 2; ++bj) st8(OM + (size_t)row * D + cl + bj * 128, acc[ai][bj][m][0], acc[ai][bj][m][1]); }
    }
};
}

__device__ __forceinline__ void p_prologue(Frame& F_) {
    KA_WS();
    Frame F = mkframe(F_.lds);
    const int gt = blockIdx.x * NTHR + F.tid, NT = gridDim.x * NTHR;
    const int* pos = (const int*)KIN(1);
    float* rot = (float*)(ws + WS_ROT);
    for (int i = gt; i < T * 8; i += NT) {
        const int t = i >> 3, f = i & 7;
        const double invf[8] = {1.0, 0.19392274474868576, 0.03760603093086393, 0.007292664737217109, 0.001414213562373095, 0.0002742481756762073, 5.318295896944988e-05, 1.031338537721246e-05};
        double w = 1.0;
#pragma unroll
        for (int j = 0; j < 8; ++j) w = (f == j) ? invf[j] : w;
        const double ang = (double)pos[t] * w;
        const double n = rint(ang * 0.15915494309189535); const double r = (ang - n * 6.283185307179586) - n * 2.4492935982947064e-16;
        rot[t * 16 + f] = cosf((float)r); rot[t * 16 + 8 + f] = sinf((float)r);
    }
    { bf16* rw = (bf16*)(ws + WS_RW);
      for (int i = gt; i < 2 * 48 * 1024; i += NT) { const int l2 = i / (48 * 1024), j = (i / 1024) % 48, d = i & 1023; float w = 0.f;
          if (j < 4) w = ((const float*)KIN(16))[((size_t)l2 * D + d) * 4 + j];
          else if (j < 36) w = ((const float*)KIN(18))[(((size_t)l2 * 4 + ((j - 4) >> 3)) * D + d) * 8 + ((j - 4) & 7)];
          const unsigned hb = f2bf(w); const float hf = __uint_as_float(hb << 16);
          rw[((size_t)l2 * 2 + 0) * 48 * 1024 + j * 1024 + d] = (bf16)hb; rw[((size_t)l2 * 2 + 1) * 48 * 1024 + j * 1024 + d] = (bf16)f2bf(w - hf); } }
    float* lbt = (float*)(ws + WS_LB);
    const float* hg_lb = (const float*)KIN(9);
    for (int i = gt; i < 512; i += NT) { const float a0 = hg_lb[i], a1 = hg_lb[512 + i]; lbt[i] = 0.f; lbt[512 + i] = 1.f / (1.f + expf(a0 - a1)); }
    if (gt < 2) {
        const float* lp = (const float*)KIN(7) + gt * 256; float s1 = 0.f, s2 = 0.f;
        for (int i = 0; i < 64; ++i) { s1 += lp[i] * lp[64 + i]; s2 += lp[128 + i] * lp[192 + i]; }
        const float lam_init = gt == 0 ? 0.2f : 0.35550906759096934f;
        lbt[1024 + gt] = expf(s1) - expf(s2) + lam_init;
    }
}
__device__ __forceinline__ void p_xload(Frame& F_, int g) {
    KA_WS();
    Frame F = mkframe(F_.lds);
    const f32x4* x = (const f32x4*)((const float*)KIN(0) + (size_t)g * TG * D);
    u32x2* o = (u32x2*)((bf16*)(ws + WS_XB));
    for (size_t i = (size_t)blockIdx.x * NTHR + F.tid; i < (size_t)TG * D / 4; i += (size_t)gridDim.x * NTHR) { const f32x4 v = x[i]; u32x2 w; w.x = pk2(v.x, v.y); w.y = pk2(v.z, v.w); o[i] = w; }
}

__device__ __forceinline__ void p2_conv(Frame& F_, int l) {
    KA_WS();
    Frame F = mkframe(F_.lds);
    const float* cw = (const float*)KIN(3) + (size_t)l * 31 * 512; const float* cb = (const float*)KIN(4) + l * 512;
    const float* lg = (const float*)KIN(5) + l * 512; const float* lb = (const float*)KIN(6) + l * 512;
    const int c0 = F.lane * 8; const int per = TG / (gridDim.x * NWAVES);
    const int tbeg = (blockIdx.x * NWAVES + F.wave) * per;
    for (int t = tbeg; t < tbeg + per; ++t) {
        const int s = t & (S - 1);
        float acc[8];
        { const f32x4 b0 = *(const f32x4*)(cb + c0), b1 = *(const f32x4*)(cb + c0 + 4); acc[0] = b0.x; acc[1] = b0.y; acc[2] = b0.z; acc[3] = b0.w; acc[4] = b1.x; acc[5] = b1.y; acc[6] = b1.z; acc[7] = b1.w; }
        for (int j = 0; j < 31; ++j) {
            const int sj = s - 30 + j; if (sj < 0) continue;
            const u32x4 uv = *(const u32x4*)(((bf16*)(ws + WS_U)) + (size_t)(t - 30 + j) * 512 + c0);
            const f32x4 w0 = *(const f32x4*)(cw + j * 512 + c0), w1 = *(const f32x4*)(cw + j * 512 + c0 + 4);
            acc[0] += lo16(uv.x) * w0.x; acc[1] += hi16(uv.x) * w0.y; acc[2] += lo16(uv.y) * w0.z; acc[3] += hi16(uv.y) * w0.w;
            acc[4] += lo16(uv.z) * w1.x; acc[5] += hi16(uv.z) * w1.y; acc[6] += lo16(uv.w) * w1.z; acc[7] += hi16(uv.w) * w1.w;
        }
        float sm = 0.f;
#pragma unroll
        for (int i = 0; i < 8; ++i) sm += acc[i];
        const float mean = wave_sum(sm) * (1.f / 512.f); float sq = 0.f;
#pragma unroll
        for (int i = 0; i < 8; ++i) { acc[i] -= mean; sq += acc[i] * acc[i]; }
        const float rstd = __builtin_amdgcn_rsqf(wave_sum(sq) * (1.f / 512.f) + EPS);
        float y[8];
#pragma unroll
        for (int i = 0; i < 8; ++i) { const float z = acc[i] * rstd * lg[c0 + i] + lb[c0 + i]; y[i] = z * __builtin_amdgcn_rcpf(1.f + __expf(-z)); }
        u32x4 o; o.x = pk2(y[0], y[1]); o.y = pk2(y[2], y[3]); o.z = pk2(y[4], y[5]); o.w = pk2(y[6], y[7]);
        *(u32x4*)(((bf16*)(ws + WS_YA)) + (size_t)t * 512 + c0) = o;
    }
}

__device__ __forceinline__ void p2_conv_unit(Frame& F, unsigned char* ws, KArgs ka, int l, int cu) {
    const float* cw = (const float*)KIN(3) + (size_t)l * 31 * 512; const float* cb = (const float*)KIN(4) + l * 512;
    const float* lg = (const float*)KIN(5) + l * 512; const float* lb = (const float*)KIN(6) + l * 512;
    const bf16* __restrict__ U = (const bf16*)(ws + WS_U); bf16* __restrict__ YA = (bf16*)(ws + WS_YA);
    LAS float* Yt = (LAS float*)F.lds;
    const int lane = F.lane, wave = F.wave, hf = wave >> 2, c = 128 * (wave & 3) + 2 * lane;
    const int tb = cu * 64 + 32 * hf, sb = tb & (S - 1);
    f32x2 wt[31], uf[62];
#pragma unroll
    for (int j = 0; j < 31; ++j) wt[j] = *(const f32x2*)(cw + j * 512 + c);
#pragma unroll
    for (int k = 0; k < 62; ++k) { unsigned w = 0u; if (sb - 30 + k >= 0) w = *(const unsigned*)(U + (size_t)(tb - 30 + k) * 512 + c); uf[k] = (f32x2){lo16(w), hi16(w)}; }
    const f32x2 bias = *(const f32x2*)(cb + c);
    __syncthreads();
#pragma unroll
    for (int tt = 0; tt < 32; ++tt) { f32x2 acc = bias;
#pragma unroll
        for (int j = 0; j < 31; ++j) acc = acc + uf[tt + j] * wt[j];
        *(LAS f32x2*)(Yt + (32 * hf + tt) * 512 + c) = acc; }
    __syncthreads();
    const int c0 = lane * 8;
#pragma unroll 2
    for (int i = 0; i < 8; ++i) { const int tl = wave * 8 + i;
        const f32x4 a0 = *(const LAS f32x4*)(Yt + tl * 512 + c0), a1 = *(const LAS f32x4*)(Yt + tl * 512 + c0 + 4);
        float acc[8] = {a0.x, a0.y, a0.z, a0.w, a1.x, a1.y, a1.z, a1.w};
        float sm = 0.f;
#pragma unroll
        for (int q = 0; q < 8; ++q) sm += acc[q];
        const float mean = wave_sum(sm) * (1.f / 512.f); float sq = 0.f;
#pragma unroll
        for (int q = 0; q < 8; ++q) { acc[q] -= mean; sq += acc[q] * acc[q]; }
        const float rstd = __builtin_amdgcn_rsqf(wave_sum(sq) * (1.f / 512.f) + EPS);
        const f32x4 g0 = *(const f32x4*)(lg + c0), g1 = *(const f32x4*)(lg + c0 + 4), b0 = *(const f32x4*)(lb + c0), b1 = *(const f32x4*)(lb + c0 + 4);
        const float gg[8] = {g0.x, g0.y, g0.z, g0.w, g1.x, g1.y, g1.z, g1.w}, bb[8] = {b0.x, b0.y, b0.z, b0.w, b1.x, b1.y, b1.z, b1.w};
        float y[8];
#pragma unroll
        for (int q = 0; q < 8; ++q) { const float z = acc[q] * rstd * gg[q] + bb[q]; y[q] = z * __builtin_amdgcn_rcpf(1.f + __expf(-z)); }
        u32x4 o; o.x = pk2(y[0], y[1]); o.y = pk2(y[2], y[3]); o.z = pk2(y[4], y[5]); o.w = pk2(y[6], y[7]);
        *(u32x4*)(YA + (size_t)(cu * 64 + tl) * 512 + c0) = o;
    }
    __syncthreads();
}
#include <hip/hip_bf16.h>
#include <cmath>
namespace attn_body {
using bf16=__hip_bfloat16;
using bf16x8=__attribute__((ext_vector_type(8)))short;
using s16x4=__attribute__((ext_vector_type(4)))short;
using f32x16=__attribute__((ext_vector_type(16)))float;
using u32x4=__attribute__((ext_vector_type(4)))unsigned;
constexpr int SEQ=2048,D=64,DMI=512,DMO=1024;
constexpr int NW=8,QBLK=32,QB=QBLK*NW,KVBLK=64,NQB=SEQ/QB;
constexpr int ATTN_UNIT_ROWS=QB;
__device__ __forceinline__ int crow(int r,int hi){return (r&3)+8*(r>>2)+4*hi;}
#define SBAR() __builtin_amdgcn_sched_barrier(0)
__device__ __forceinline__ void cmask(f32x16&p0,f32x16&p1,int jb,int qrel,int hi){
  const float NEG=-INFINITY; int kb=64*jb+4*hi;
  #pragma unroll
  for(int r=0;r<16;++r){int kv=kb+(r&3)+8*(r>>2); if(kv>qrel)p0[r]=NEG; if(kv+32>qrel)p1[r]=NEG;}
}

constexpr int NSLOT=3, SLOTB=8192;
constexpr int LDS_K=0, LDS_V=NSLOT*SLOTB, LDS_WS=2*NSLOT*SLOTB, LDS_OST=LDS_WS+NW*64*4, LDS_BYTES=LDS_OST+NW*4096;
constexpr float C2=0.125f*1.4426950408889634f;
__device__ __forceinline__ void glds16(const void*gsrc,unsigned lds_dst){unsigned keep;
  asm volatile("s_mov_b32 %0, m0\n\ts_mov_b32 m0, %2\n\ts_nop 0\n\tglobal_load_lds_dwordx4 %1, off\n\ts_mov_b32 m0, %0":"=&s"(keep):"v"(gsrc),"s"(lds_dst):"memory");}
__device__ __forceinline__ float max3f(float a,float b,float c){float r;asm("v_max3_f32 %0, %1, %2, %3":"=v"(r):"v"(a),"v"(b),"v"(c));return r;}
__device__ __forceinline__ float max2f(float a,float b){float r;asm("v_max_f32_e32 %0, %1, %2":"=v"(r):"v"(a),"v"(b));return r;}
__device__ __forceinline__ float fadd_s(float a,float b){float r;asm("v_add_f32_e32 %0, %1, %2":"=v"(r):"v"(a),"v"(b));return r;}
__device__ __forceinline__ float fsub_s(float a,float b){float r;asm("v_sub_f32_e32 %0, %1, %2":"=v"(r):"v"(a),"v"(b));return r;}
typedef float f32x2_t __attribute__((ext_vector_type(2))); typedef __bf16 bf16x2_t __attribute__((ext_vector_type(2)));
__device__ __forceinline__ unsigned cvtpk_s(float lo,float hi){f32x2_t v={lo,hi};bf16x2_t b=__builtin_convertvector(v,bf16x2_t);return __builtin_bit_cast(unsigned,b);}
#define WAIT_BAR(N) asm volatile("s_waitcnt vmcnt(" #N ") lgkmcnt(0)\n\ts_barrier":::"memory")

__device__ __forceinline__ void qkt(f32x16&p0,f32x16&p1,const char*Kslot,const bf16x8*qr,const f32x16&negm,int r32,int hi){
  const char*kb=Kslot+hi*1024+r32*16;
  #pragma unroll
  for(int d0=0;d0<4;++d0){
    const bf16x8 b0=*reinterpret_cast<const bf16x8*>(kb+d0*2048);
    const bf16x8 b1=*reinterpret_cast<const bf16x8*>(kb+d0*2048+512);
    if(d0==0){p0=__builtin_amdgcn_mfma_f32_32x32x16_bf16(b0,qr[0],negm,0,0,0);p1=__builtin_amdgcn_mfma_f32_32x32x16_bf16(b1,qr[0],negm,0,0,0);}
    else{p0=__builtin_amdgcn_mfma_f32_32x32x16_bf16(b0,qr[d0],p0,0,0,0);p1=__builtin_amdgcn_mfma_f32_32x32x16_bf16(b1,qr[d0],p1,0,0,0);}}
}
typedef __attribute__((address_space(3))) const char* lds_cptr;
typedef short v4i16_t __attribute__((ext_vector_type(4)));
__device__ __forceinline__ void kload8(bf16x8*kf,lds_cptr kp){
  kf[0]=*(const __attribute__((address_space(3))) bf16x8*)(kp);      kf[1]=*(const __attribute__((address_space(3))) bf16x8*)(kp+512);
  kf[2]=*(const __attribute__((address_space(3))) bf16x8*)(kp+2048); kf[3]=*(const __attribute__((address_space(3))) bf16x8*)(kp+2560);
  kf[4]=*(const __attribute__((address_space(3))) bf16x8*)(kp+4096); kf[5]=*(const __attribute__((address_space(3))) bf16x8*)(kp+4608);
  kf[6]=*(const __attribute__((address_space(3))) bf16x8*)(kp+6144); kf[7]=*(const __attribute__((address_space(3))) bf16x8*)(kp+6656);
}
__device__ __forceinline__ void kload2(bf16x8*kf,lds_cptr kp,int j){ kf[2*j]=*(const __attribute__((address_space(3))) bf16x8*)(kp+j*2048); kf[2*j+1]=*(const __attribute__((address_space(3))) bf16x8*)(kp+j*2048+512); }
__device__ __forceinline__ s16x4 vtr(lds_cptr p){ return __builtin_bit_cast(s16x4,__builtin_amdgcn_ds_read_tr16_b64_v4i16((__attribute__((address_space(3))) v4i16_t*)p)); }
__device__ __forceinline__ float rowmax(const f32x16&p0,const f32x16&p1){
  float a=max3f(p0[0],p0[1],p1[0]),b=max3f(p0[2],p0[3],p1[1]);a=max3f(a,p1[2],p1[3]);
  #pragma unroll
  for(int r=4;r<16;r+=4){a=max3f(a,p0[r],p0[r+1]);b=max3f(b,p0[r+2],p0[r+3]);a=max3f(a,p1[r],p1[r+1]);b=max3f(b,p1[r+2],p1[r+3]);}
  const float m=max2f(a,b);
  auto rr=__builtin_amdgcn_permlane32_swap(__float_as_uint(m),__float_as_uint(m),false,false);
  return max2f(__uint_as_float(rr[0]),__uint_as_float(rr[1]));
}
__device__ __forceinline__ void pv(f32x16*o,int vb,bf16x8 pa0,bf16x8 pa1,bf16x8 pa2,bf16x8 pa3){
  #pragma unroll
  for(int d0=0;d0<2;++d0){s16x4 lo[4],hi[4];
    #pragma unroll
    for(int ks=0;ks<4;++ks){
      asm volatile("ds_read_b64_tr_b16 %0,%1 offset:%c2":"=&v"(lo[ks]):"v"(vb),"i"(d0*4096+ks*1024):"memory");
      asm volatile("ds_read_b64_tr_b16 %0,%1 offset:%c2":"=&v"(hi[ks]):"v"(vb),"i"(d0*4096+ks*1024+512):"memory");}
    asm volatile("s_waitcnt lgkmcnt(0)":::"memory");SBAR();
    #define PK(k) (bf16x8){lo[k][0],lo[k][1],lo[k][2],lo[k][3],hi[k][0],hi[k][1],hi[k][2],hi[k][3]}
    o[d0]=__builtin_amdgcn_mfma_f32_32x32x16_bf16(pa0,PK(0),o[d0],0,0,0);
    o[d0]=__builtin_amdgcn_mfma_f32_32x32x16_bf16(pa1,PK(1),o[d0],0,0,0);
    o[d0]=__builtin_amdgcn_mfma_f32_32x32x16_bf16(pa2,PK(2),o[d0],0,0,0);
    o[d0]=__builtin_amdgcn_mfma_f32_32x32x16_bf16(pa3,PK(3),o[d0],0,0,0);
    #undef PK
  }
}

#ifndef ATTN_STORE16
#define ATTN_STORE16(p,v) (*(u32x4*)(p)=(v))
#endif
template<int THRL> __device__ __forceinline__ void attn_unit(int qb,const bf16*Qb,const bf16*__restrict__ Kb,const bf16*__restrict__ Vb,bf16*Ob,char*shm){
  int tid_=threadIdx.x; asm volatile("":"+v"(tid_));
  const int tid=tid_,lane=tid&63,r32=lane&31,hi=lane>>5; const int wid=__builtin_amdgcn_readfirstlane(tid>>6);
  const int q0=qb*QB;
  const bf16*Qw=Qb+(long)(q0+wid*QBLK)*DMI;
  const bf16*Kh=Kb,*Vh=Vb;
  const unsigned lds0=(unsigned)(uintptr_t)shm;
  float*wsf=(float*)(shm+LDS_WS)+wid*64;
  const bf16*ksrc=Kh+(long)lane*DMI+wid*8;
  const bf16*vsrc=Vh+(long)(16*(wid&3)+(lane>>2))*DMI+(wid>>2)*32+(lane&3)*8;
  const unsigned kdst=lds0+LDS_K+wid*1024, vdst=lds0+LDS_V+wid*1024;
  #define DMA_K(t,slot) glds16(ksrc+(long)(t)*KVBLK*DMI,(unsigned)__builtin_amdgcn_readfirstlane(kdst+(slot)))
  #define DMA_V(t,slot) glds16(vsrc+(long)(t)*KVBLK*DMI,(unsigned)__builtin_amdgcn_readfirstlane(vdst+(slot)))
  const int vb0=(int)(lds0+LDS_V)+((lane>>4)&1)*32+(lane&3)*8+(4*hi+((lane&15)>>2))*64;
  const char*Kbase=shm+LDS_K; bf16x8 kf[8];
  const lds_cptr shm3=(lds_cptr)shm; const lds_cptr kp0=shm3+LDS_K+hi*1024+r32*16; const lds_cptr vp0=shm3+LDS_V+((lane>>4)&1)*32+(lane&3)*8+(4*hi+((lane&15)>>2))*64;
  const int NT=(q0+QB)/KVBLK;
  DMA_K(0,0);DMA_V(0,0);DMA_K(1,SLOTB);
  bf16x8 qr[4];
  #pragma unroll
  for(int d0=0;d0<4;++d0)qr[d0]=*reinterpret_cast<const bf16x8*>(&Qw[(long)r32*DMI+d0*16+hi*8]);
  float mhat=0.f,l_reg=0.f;f32x16 o[2];o[0]=f32x16{};o[1]=f32x16{};f32x16 negm=f32x16{};asm volatile("":"+v"(negm));
  const int qrel=wid*QBLK+r32;
  #define CMASK(P0,P1,t) do{int jb_=(t)-(NT-4); if(jb_>=0)cmask(P0,P1,jb_,qrel,hi);}while(0)
  bool resc=false;
  #define START(P0,P1) do{ const float rm=rowmax(P0,P1); resc=false; \
    { const float dl=rm; mhat=fadd_s(mhat,dl); \
      _Pragma("unroll") for(int r=0;r<16;++r){P0[r]=fsub_s(P0[r],dl);P1[r]=fsub_s(P1[r],dl);} \
      _Pragma("unroll") for(int r=0;r<16;++r)negm[r]=-mhat; asm volatile("":"+v"(negm)); } \
    _Pragma("unroll") for(int r=0;r<16;++r)P0[r]=__builtin_amdgcn_exp2f(P0[r]); }while(0)
  #define RESC() do{ if(resc){ asm volatile("s_waitcnt lgkmcnt(0)":::"memory"); \
      _Pragma("unroll") for(int d_=0;d_<2;++d_) _Pragma("unroll") for(int r=0;r<16;++r)o[d_][r]*=wsf[crow(r,hi)]; } }while(0)
  f32x16 pA0,pA1,pB0,pB1;
  int sl_prev=0,sl_cur=0,sl_next=SLOTB;
  #define ROT() do{sl_prev=sl_cur;sl_cur=sl_next;sl_next=(sl_next==(NSLOT-1)*SLOTB)?0:sl_next+SLOTB;}while(0)
  DMA_K(2,2*SLOTB);
  WAIT_BAR(3);
  qkt(pA0,pA1,Kbase,qr,negm,r32,hi);asm volatile("s_nop 15\n\ts_nop 7":"+v"(pA0),"+v"(pA1));CMASK(pA0,pA1,0);
  START(pA0,pA1);
  _Pragma("unroll") for(int r=0;r<16;++r)pA1[r]=__builtin_amdgcn_exp2f(pA1[r]);
  WAIT_BAR(0);
  DMA_K(3,0);DMA_V(1,SLOTB);
  ROT();
  kload8(kf,kp0+sl_cur);
  WAIT_BAR(2);
  s16x4 vlo[8],vhi[8]; u32x4 pw0,pw1,pw2,pw3;
  #define PKW(P,B) cvtpk_s(P[B],P[B+1])
  #define PAF(k) __builtin_bit_cast(bf16x8,pw##k)
  #define VFR(i) (bf16x8){vlo[i][0],vlo[i][1],vlo[i][2],vlo[i][3],vhi[i][0],vhi[i][1],vhi[i][2],vhi[i][3]}
  #define PIN(x) asm volatile("":"+v"(x))
  #define MX3(a,b,c) __builtin_fmaxf(__builtin_fmaxf((a),(b)),(c))
  #define GAPA(MF,A0,A1,A2,A3,W0,W1,PW) do{ MF; sacc+=A0; sacc+=A1; sacc+=A2; sacc+=A3; PIN(sacc); W0; W1; PIN(PW); SBAR(); }while(0)
  #define EX(v) __builtin_amdgcn_exp2f(v)
  #define GAPB(MF,X,B) do{ MF; X[B]=EX(X[B]); X[B+1]=EX(X[B+1]); X[B+2]=EX(X[B+2]); X[B+3]=EX(X[B+3]); PIN(X); SBAR(); }while(0)
  #define VRD(i) do{ vlo[i]=vtr(vp_+(((i)>>2)*4096+((i)&3)*1024)); vhi[i]=vtr(vp_+(((i)>>2)*4096+((i)&3)*1024+512)); }while(0)
  #define KRD(G,j) do{ if(G){ kload2(kf,kp0+sl_next,j); SBAR(); } }while(0)
  #define STEP(C0,C1,P0,P1,t,GK,GV,GL) do{ SBAR(); \
    const lds_cptr vp_=vp0+sl_prev; \
    VRD(0); SBAR(); float sacc=(P0[0]+P0[1]); \
    GAPA(C0=__builtin_amdgcn_mfma_f32_32x32x16_bf16(kf[0],qr[0],negm,0,0,0), P0[2],P0[3],P0[4],P0[5],     pw0[0]=PKW(P0,0), pw0[1]=PKW(P0,2), pw0); \
    VRD(4); SBAR(); GAPA(C1=__builtin_amdgcn_mfma_f32_32x32x16_bf16(kf[1],qr[0],negm,0,0,0), P0[6],P0[7],P0[8],P0[9],     pw0[2]=PKW(P0,4), pw0[3]=PKW(P0,6), pw0); \
    VRD(1); SBAR(); GAPA(C0=__builtin_amdgcn_mfma_f32_32x32x16_bf16(kf[2],qr[1],C0,0,0,0),   P0[10],P0[11],P0[12],P0[13], pw1[0]=PKW(P0,8), pw1[1]=PKW(P0,10), pw1); \
    VRD(5); SBAR(); GAPA(C1=__builtin_amdgcn_mfma_f32_32x32x16_bf16(kf[3],qr[1],C1,0,0,0),   P0[14],P0[15],P1[0],P1[1],   pw1[2]=PKW(P0,12),pw1[3]=PKW(P0,14), pw1); \
    VRD(2); SBAR(); GAPA(C0=__builtin_amdgcn_mfma_f32_32x32x16_bf16(kf[4],qr[2],C0,0,0,0),   P1[2],P1[3],P1[4],P1[5],     pw2[0]=PKW(P1,0), pw2[1]=PKW(P1,2), pw2); \
    VRD(6); SBAR(); GAPA(C1=__builtin_amdgcn_mfma_f32_32x32x16_bf16(kf[5],qr[2],C1,0,0,0),   P1[6],P1[7],P1[8],P1[9],     pw2[2]=PKW(P1,4), pw2[3]=PKW(P1,6), pw2); \
    VRD(3); SBAR(); GAPA(C0=__builtin_amdgcn_mfma_f32_32x32x16_bf16(kf[6],qr[3],C0,0,0,0),   P1[10],P1[11],P1[12],P1[13], pw3[0]=PKW(P1,8), pw3[1]=PKW(P1,10), pw3); \
    VRD(7); SBAR(); GAPA(C1=__builtin_amdgcn_mfma_f32_32x32x16_bf16(kf[7],qr[3],C1,0,0,0),   P1[14],P1[15],0.f,0.f,       pw3[2]=PKW(P1,12),pw3[3]=PKW(P1,14), pw3); \
    l_reg+=sacc; \
    if(GK){DMA_K((t)+3,sl_cur);} if(GV){DMA_V((t)+1,sl_next);} \
    CMASK(C0,C1,t); \
    { float a=MX3(C0[0],C0[1],C1[0]),b=MX3(C0[2],C0[3],C1[1]); a=MX3(a,C1[2],C1[3]); \
      _Pragma("unroll") for(int r=4;r<16;r+=4){a=MX3(a,C0[r],C0[r+1]);b=MX3(b,C0[r+2],C0[r+3]);a=MX3(a,C1[r],C1[r+1]);b=MX3(b,C1[r+2],C1[r+3]);} \
      float rm=__builtin_fmaxf(a,b); { auto rr=__builtin_amdgcn_permlane32_swap(__float_as_uint(rm),__float_as_uint(rm),false,false); rm=__builtin_fmaxf(__uint_as_float(rr[0]),__uint_as_float(rr[1])); } \
      resc=false; \
      if(__builtin_expect(__any(rm>(float)THRL),0)){ const float dl=__builtin_fmaxf(rm,0.f); mhat+=dl; \
        _Pragma("unroll") for(int r=0;r<16;++r){C0[r]-=dl;C1[r]-=dl;} \
        _Pragma("unroll") for(int r=0;r<16;++r)negm[r]=-mhat; asm volatile("":"+v"(negm)); \
        const float f=__builtin_amdgcn_exp2f(-dl); l_reg*=f; if(hi==0)wsf[r32]=f; resc=true; } } \
    SBAR(); \
    GAPB(o[0]=__builtin_amdgcn_mfma_f32_32x32x16_bf16(PAF(0),VFR(0),o[0],0,0,0), C0,0); \
    GAPB(o[1]=__builtin_amdgcn_mfma_f32_32x32x16_bf16(PAF(0),VFR(4),o[1],0,0,0), C0,4); \
    KRD(GL,0); GAPB(o[0]=__builtin_amdgcn_mfma_f32_32x32x16_bf16(PAF(1),VFR(1),o[0],0,0,0), C0,8); \
    KRD(GL,1); GAPB(o[1]=__builtin_amdgcn_mfma_f32_32x32x16_bf16(PAF(1),VFR(5),o[1],0,0,0), C0,12); \
    KRD(GL,2); GAPB(o[0]=__builtin_amdgcn_mfma_f32_32x32x16_bf16(PAF(2),VFR(2),o[0],0,0,0), C1,0); \
    KRD(GL,3); GAPB(o[1]=__builtin_amdgcn_mfma_f32_32x32x16_bf16(PAF(2),VFR(6),o[1],0,0,0), C1,4); \
    GAPB(o[0]=__builtin_amdgcn_mfma_f32_32x32x16_bf16(PAF(3),VFR(3),o[0],0,0,0), C1,8); \
    GAPB(o[1]=__builtin_amdgcn_mfma_f32_32x32x16_bf16(PAF(3),VFR(7),o[1],0,0,0), C1,12); \
    }while(0)
  int t=1;
  #undef CMASK
  #define CMASK(P0,P1,t) do{}while(0)
  for(;t+5<NT;t+=2){
    STEP(pB0,pB1,pA0,pA1,t,true,true,true);     WAIT_BAR(2); RESC(); ROT();
    STEP(pA0,pA1,pB0,pB1,t+1,true,true,true);   WAIT_BAR(2); RESC(); ROT();
  }
  #undef CMASK
  #define CMASK(P0,P1,t) do{int jb_=(t)-(NT-4); if(jb_>=0)cmask(P0,P1,jb_,qrel,hi);}while(0)
  #define ENDW(tt) do{ if((tt)+3<NT){WAIT_BAR(2);} else if((tt)+2<NT){WAIT_BAR(1);} else {WAIT_BAR(0);} }while(0)
  for(;t+1<NT;t+=2){
    STEP(pB0,pB1,pA0,pA1,t,(t+3<NT),(t+1<NT),(t+1<NT));       ENDW(t);   RESC(); ROT();
    STEP(pA0,pA1,pB0,pB1,t+1,(t+4<NT),(t+2<NT),(t+2<NT));     ENDW(t+1); RESC(); ROT();
  }
  STEP(pB0,pB1,pA0,pA1,NT-1,false,false,false); RESC();
  { float sacc=pB0[0]+pB0[1]; _Pragma("unroll") for(int r=2;r<16;++r)sacc+=pB0[r]; _Pragma("unroll") for(int r=0;r<16;++r)sacc+=pB1[r]; l_reg+=sacc;
    pw0=(u32x4){PKW(pB0,0),PKW(pB0,2),PKW(pB0,4),PKW(pB0,6)};pw1=(u32x4){PKW(pB0,8),PKW(pB0,10),PKW(pB0,12),PKW(pB0,14)};pw2=(u32x4){PKW(pB1,0),PKW(pB1,2),PKW(pB1,4),PKW(pB1,6)};pw3=(u32x4){PKW(pB1,8),PKW(pB1,10),PKW(pB1,12),PKW(pB1,14)};
    SBAR(); pv(o,vb0+sl_cur,PAF(0),PAF(1),PAF(2),PAF(3)); }
  #undef PKW
  #undef PAF
  #undef VFR
  #undef PIN
  #undef MX3
  #undef GAPA
  #undef GAPB
  #undef EX
  #undef VRD
  #undef KRD
  #undef STEP
  #undef ENDW
  {auto rr=__builtin_amdgcn_permlane32_swap(__float_as_uint(l_reg),__float_as_uint(l_reg),false,false);l_reg=__uint_as_float(rr[0])+__uint_as_float(rr[1]);}
  if(hi==0)wsf[32+r32]=l_reg;asm volatile("s_waitcnt lgkmcnt(0)":::"memory");
  float rli[16];
  #pragma unroll
  for(int r=0;r<16;++r)rli[r]=__builtin_amdgcn_rcpf(wsf[32+crow(r,hi)]);
  bf16*Ow=Ob+(long)(q0+wid*QBLK)*DMO;
  { bf16*stg=(bf16*)(shm+LDS_OST)+wid*2048;
    #pragma unroll
    for(int r=0;r<16;++r){const int orow=crow(r,hi);
      #pragma unroll
      for(int d0=0;d0<2;++d0)stg[orow*64+d0*32+r32]=__float2bfloat16(o[d0][r]*rli[r]);}
    asm volatile("s_waitcnt lgkmcnt(0)":::"memory");
    #pragma unroll
    for(int i=0;i<4;++i){const int row=i*8+(lane>>3),ch=lane&7; const u32x4 v=*(const u32x4*)(stg+row*64+ch*8); ATTN_STORE16(Ow+(long)row*DMO+ch*8,v);} }
  asm volatile("s_waitcnt lgkmcnt(0)\n\ts_barrier":::"memory");
  #undef DMA_K
  #undef DMA_V
  #undef CMASK
  #undef START
  #undef RESC
  #undef ROT
}
constexpr int ATTN_LDS_BYTES=LDS_BYTES;
#undef SBAR
#undef WAIT_BAR
}
extern __shared__ __attribute__((aligned(16))) unsigned char g_lds[];
constexpr size_t WS_OV = WS_R;
__device__ __forceinline__ void p2c_hgrn(Frame& F_, int l, int unit);
template <int PART> __device__ __forceinline__ void p1_part(Frame& F_, int g, int l, int G, int c);
constexpr int CW_P1B = 24576;
constexpr int CW_Q = 20480;
constexpr int NQ_ATT = GB * 16 * 8, NQ_CONV = TG / 64;
__device__ __forceinline__ void p2_mixers(Frame& F_, int g, int l, int rep) {
    if (blockIdx.x < GB * 4) p2c_hgrn(F_, l, blockIdx.x);
    else {
        p1_part<1>(F_, g, l, (int)gridDim.x - GB * 4, (int)blockIdx.x - GB * 4);
        KArgs ka2 = kargs(); unsigned* pdone = (unsigned*)((unsigned char*)(GAS unsigned char*)ka2->ws + WS_CTL) + CW_P1B + 64 * (g * 2 + l);
        asm volatile("s_waitcnt vmcnt(0)" ::: "memory"); __syncthreads();
        if (threadIdx.x == 0) { __builtin_amdgcn_fence(__ATOMIC_RELEASE, "agent"); asm volatile("s_waitcnt vmcnt(0)" ::: "memory"); (void)__hip_atomic_fetch_add(pdone, 1u, __ATOMIC_RELAXED, __HIP_MEMORY_SCOPE_AGENT); }
    }
    KA_WS();
    Frame F = mkframe(F_.lds);
    unsigned* qh = (unsigned*)(ws + WS_CTL) + CW_Q + 64 * ((g * 2 + l) * 4 + rep);
    volatile LAS int* qslot = (volatile LAS int*)(F.lds + MISC_OFF + 128);
    bool conv_ok = false;
    for (;;) {
        __syncthreads();
        if (F.tid == 0) qslot[0] = (int)__hip_atomic_fetch_add(qh, 1u, __ATOMIC_RELAXED, __HIP_MEMORY_SCOPE_AGENT);
        __syncthreads();
        const int u = __builtin_amdgcn_readfirstlane(qslot[0]);
        if (u >= NQ_ATT + NQ_CONV) break;
        if (u >= NQ_ATT && !conv_ok) {
            unsigned* pdone = (unsigned*)(ws + WS_CTL) + CW_P1B + 64 * (g * 2 + l);
            if (F.tid == 0) { unsigned sp = 0; while (__hip_atomic_load(pdone, __ATOMIC_RELAXED, __HIP_MEMORY_SCOPE_AGENT) < gridDim.x - GB * 4) { __builtin_amdgcn_s_sleep(4); if (++sp > (1u << 22)) break; }
                __builtin_amdgcn_fence(__ATOMIC_ACQUIRE, "agent"); asm volatile("s_waitcnt vmcnt(0)" ::: "memory"); }
            __syncthreads(); conv_ok = true;
        }
        if (u < NQ_ATT) {
            const int qb = 7 - u / (GB * 16), vhd = u % (GB * 16);
            const int bl = vhd >> 4, sh = (vhd >> 1) & 7, vh = vhd & 1;
            const attn_body::bf16* Qb = (const attn_body::bf16*)((bf16*)(ws + WS_Q) + (size_t)bl * S * 512 + sh * 64);
            const attn_body::bf16* Kb = (const attn_body::bf16*)((bf16*)(ws + WS_K) + (size_t)bl * S * 512 + sh * 64);
            const attn_body::bf16* Vb = (const attn_body::bf16*)((bf16*)(ws + WS_V) + (size_t)bl * S * 512 + (sh >> 1) * 128 + vh * 64);
            attn_body::bf16* Ob = (attn_body::bf16*)((bf16*)(ws + WS_OV) + (size_t)bl * S * 1024 + sh * 128 + vh * 64);
            attn_body::attn_unit<8>(qb, Qb, Kb, Vb, Ob, (char*)g_lds);
        } else { int ll = l; asm volatile("" : "+s"(ll)); p2_conv_unit(F, ws, ka, ll, u - NQ_ATT); }
    }
}
__device__ __forceinline__ void p2d_combine(Frame& F_, int l) {
    KA_WS();
    Frame F = mkframe(F_.lds);
    const float lam = ((const float*)(ws + WS_LB))[1024 + l]; const float lam_init = l == 0 ? 0.2f : 0.35550906759096934f;
    const float* ng = (const float*)KIN(8) + l * 128;
    const int lane = F.lane; const float g0 = ng[lane * 2] * (1.f - lam_init), g1 = ng[lane * 2 + 1] * (1.f - lam_init);
    const bf16* __restrict__ OV = (const bf16*)(ws + WS_OV); bf16* __restrict__ YB = (bf16*)(ws + WS_YB);
    const int per = TG / (gridDim.x * NWAVES);
    const int t0 = (blockIdx.x * NWAVES + F.wave) * per;
#pragma unroll 1
    for (int i = 0; i < per; i += 2) {
        unsigned a[2][8];
#pragma unroll
        for (int rr = 0; rr < 2; ++rr)
#pragma unroll
            for (int k = 0; k < 8; ++k) a[rr][k] = *(const unsigned*)(OV + (size_t)(t0 + i + rr) * 1024 + k * 128 + lane * 2);
#pragma unroll
        for (int rr = 0; rr < 2; ++rr)
#pragma unroll
            for (int h = 0; h < 4; ++h) { const unsigned a1 = a[rr][2 * h], a2 = a[rr][2 * h + 1];
                const float o0 = lo16(a1) - lam * lo16(a2), o1 = hi16(a1) - lam * hi16(a2);
                const float rr2 = __builtin_amdgcn_rsqf(wave_sum(o0 * o0 + o1 * o1) * (1.f / 128.f) + EPS);
                *(unsigned*)(YB + (size_t)(t0 + i + rr) * 512 + h * 128 + lane * 2) = pk2(o0 * rr2 * g0, o1 * rr2 * g1); }
    }
}

namespace hg {
typedef short bf16x8 __attribute__((ext_vector_type(8)));
typedef float f32x16 __attribute__((ext_vector_type(16)));
constexpr int ST = 272, STT = 80, RS = 264;
constexpr int O_Q1 = 0, O_KT = 8704, O_KTT = 17408, O_VT = 27648, O_D = 37888, OPS = 38400;
constexpr int L_O = 2 * OPS;
static_assert(L_O + 2 * 16384 <= MISC_OFF, "HGRN LDS map");
__device__ __forceinline__ void lbar() { asm volatile("s_waitcnt lgkmcnt(0)" ::: "memory"); __builtin_amdgcn_s_barrier(); asm volatile("" ::: "memory"); }
__device__ __forceinline__ bf16x8 pack8(const f32x16& x, int b) {
    u32x4 w; w.x = pg8::cvt_pk_bf16(x[b], x[b + 1]); w.y = pg8::cvt_pk_bf16(x[b + 2], x[b + 3]); w.z = pg8::cvt_pk_bf16(x[b + 4], x[b + 5]); w.w = pg8::cvt_pk_bf16(x[b + 6], x[b + 7]);
    return __builtin_bit_cast(bf16x8, w);
}
__device__ __forceinline__ bf16x8 ld2x8(const LAS unsigned char* p) {
    const u32x2 a = *(const LAS u32x2*)p, b = *(const LAS u32x2*)(p + 16); u32x4 w; w.x = a.x; w.y = a.y; w.z = b.x; w.w = b.y; return __builtin_bit_cast(bf16x8, w);
}
__device__ __forceinline__ float quad_bcast(float v, int which) {
    const int iv = __builtin_bit_cast(int, v); int r;
    if (which == 0) r = __builtin_amdgcn_update_dpp(0, iv, 0x00, 0xF, 0xF, true); else if (which == 1) r = __builtin_amdgcn_update_dpp(0, iv, 0x55, 0xF, 0xF, true);
    else if (which == 2) r = __builtin_amdgcn_update_dpp(0, iv, 0xAA, 0xF, 0xF, true); else r = __builtin_amdgcn_update_dpp(0, iv, 0xFF, 0xF, 0xF, true);
    return __builtin_bit_cast(float, r);
}
}
__device__ __forceinline__ void p2c_hgrn(Frame& F_, int l, int unit) {
    KA_WS();
    Frame F = mkframe(F_.lds);
    using namespace hg;
    const int bl = unit >> 2, h = unit & 3;
    LAS unsigned char* lds = F.lds;
    const int lane = F.lane, wave = F.wave, r32 = lane & 31, hi = lane >> 5;
    const size_t rb = ((size_t)(bl * 4 + h) * S) * 128;
    const size_t rbY = ((size_t)bl * S) * 512 + h * 128;
    const bf16* HQ = (const bf16*)(ws + WS_HQ) + rb; const bf16* HF = (const bf16*)(ws + WS_HF) + rb; const bf16* HV = (const bf16*)(ws + WS_HV) + rb; const bf16* HG = (const bf16*)(ws + WS_HG) + rb;
    bf16* YC = (bf16*)(ws + WS_YC) + rbY;
    const bool isP = wave >= 4;
    const int pw = wave & 3;
    __syncthreads();
    if (isP) {
        const float* ng = (const float*)KIN(10) + l * 128;
        const float n0 = ng[2 * lane], n1 = ng[2 * lane + 1];
        const int cpi = 16 * pw + (lane >> 2), tq = lane & 3;
        unsigned rawA[24], rawB[24], rawC[24]; unsigned gA[8], gB[8], gC[8];
#pragma unroll
        for (int k = 0; k < 24; ++k) { rawA[k] = 0u; rawB[k] = 0u; rawC[k] = 0u; }
#pragma unroll
        for (int k = 0; k < 8; ++k) { gA[k] = 0u; gB[k] = 0u; gC[k] = 0u; }
#define HG_LOAD(SET, n) do { _Pragma("unroll") for (int j = 0; j < 8; ++j) { const size_t go = (size_t)((n) * 32 + 8 * tq + j) * 128 + 2 * cpi; \
            SET[j] = *(const unsigned*)(HF + go); SET[8 + j] = *(const unsigned*)(HQ + go); SET[16 + j] = *(const unsigned*)(HV + go); } } while (0)
#define HG_GLOAD(GS, n) do { _Pragma("unroll") for (int jj = 0; jj < 8; ++jj) GS[jj] = *(const unsigned*)(HG + (size_t)((n) * 32 + 8 * pw + jj) * 128 + 2 * lane); } while (0)
        HG_LOAD(rawA, 0); HG_LOAD(rawB, 1); HG_LOAD(rawC, 2); HG_GLOAD(gA, 0);
#define HG_PITER(i, RS_, GU) do { \
            if ((i) + 1 <= 63) hg_prep(lds, RS_, (i) + 1, cpi, tq); \
            if ((i) + 4 <= 63) HG_LOAD(RS_, (i) + 4); \
            if ((i) >= 1 && (i) <= 64) hg_finish(lds, (i) - 1, pw, lane, n0, n1, GU); \
            if ((i) + 2 <= 63) HG_GLOAD(GU, (i) + 2); \
            lbar(); } while (0)
        auto hg_prep = [&](LAS unsigned char* lds_, const unsigned (&R_)[24], int n, int cpi_, int tq_) __attribute__((always_inline)) {
            LAS unsigned char* op = lds_ + (n & 1) * OPS;
            float p0[8], p1[8], l0[8], l1[8];
#pragma unroll
            for (int j = 0; j < 8; ++j) { const unsigned w = R_[j]; const float x0 = lo16(w) * 1.4426950408889634f, x1 = hi16(w) * 1.4426950408889634f;
                l0[j] = x0; l1[j] = x1; p0[j] = j ? p0[j - 1] + x0 : x0; p1[j] = j ? p1[j - 1] + x1 : x1; }
            float base0 = 0.f, base1 = 0.f, bl0 = 0.f, bl1 = 0.f;
#pragma unroll
            for (int q = 0; q < 4; ++q) { const float t0 = quad_bcast(p0[7], q), t1 = quad_bcast(p1[7], q); bl0 += t0; bl1 += t1; if (q < tq_) { base0 += t0; base1 += t1; } }
            unsigned ka[4], kb[4], va[4], vb4[4];
#pragma unroll
            for (int j = 0; j < 8; ++j) { const int t = 8 * tq_ + j;
                const float b0 = fmaxf(base0 + p0[j], -115.f), b1 = fmaxf(base1 + p1[j], -115.f);
                const float e0 = __builtin_amdgcn_exp2f(b0), e1 = __builtin_amdgcn_exp2f(b1), i0 = __builtin_amdgcn_exp2f(-b0), i1 = __builtin_amdgcn_exp2f(-b1);
                const float k0 = 1.f - __builtin_amdgcn_exp2f(l0[j]), k1 = 1.f - __builtin_amdgcn_exp2f(l1[j]);
                const unsigned qw = R_[8 + j], vw = R_[16 + j];
                const unsigned q1w = pg8::cvt_pk_bf16(lo16(qw) * e0, hi16(qw) * e1), ktw = pg8::cvt_pk_bf16(k0 * i0, k1 * i1);
                *(LAS unsigned*)(op + O_Q1 + t * ST + cpi_ * 4) = q1w; *(LAS unsigned*)(op + O_KT + t * ST + cpi_ * 4) = ktw;
                if (j & 1) { ka[j >> 1] |= ktw << 16; kb[j >> 1] |= ktw & 0xffff0000u; va[j >> 1] |= vw << 16; vb4[j >> 1] |= vw & 0xffff0000u; }
                else { ka[j >> 1] = ktw & 0xffffu; kb[j >> 1] = ktw >> 16; va[j >> 1] = vw & 0xffffu; vb4[j >> 1] = vw >> 16; } }
            *(LAS u32x4*)(op + O_KTT + (2 * cpi_) * STT + 16 * tq_) = (u32x4){ka[0], ka[1], ka[2], ka[3]}; *(LAS u32x4*)(op + O_KTT + (2 * cpi_ + 1) * STT + 16 * tq_) = (u32x4){kb[0], kb[1], kb[2], kb[3]};
            *(LAS u32x4*)(op + O_VT + (2 * cpi_) * STT + 16 * tq_) = (u32x4){va[0], va[1], va[2], va[3]}; *(LAS u32x4*)(op + O_VT + (2 * cpi_ + 1) * STT + 16 * tq_) = (u32x4){vb4[0], vb4[1], vb4[2], vb4[3]};
            if (tq_ == 3) *(LAS f32x2*)(op + O_D + cpi_ * 8) = (f32x2){__builtin_amdgcn_exp2f(fmaxf(bl0, -115.f)), __builtin_amdgcn_exp2f(fmaxf(bl1, -115.f))};
        };
        auto hg_finish = [&](LAS unsigned char* lds_, int j, int pw_, int lane_, float n0_, float n1_, const unsigned (&gt_)[8]) __attribute__((always_inline)) {
            LAS float* Ot = (LAS float*)(lds_ + L_O + (j & 1) * 16384);
            f32x2 ov[8];
#pragma unroll
            for (int jj = 0; jj < 8; ++jj) ov[jj] = *(const LAS f32x2*)(Ot + (8 * pw_ + jj) * 128 + 2 * lane_);
            asm volatile("s_waitcnt lgkmcnt(0)" ::: "memory");
#pragma unroll
            for (int jj = 0; jj < 8; ++jj) { const int t = 8 * pw_ + jj; const f32x2 o = ov[jj];
                const float rr = __builtin_amdgcn_rsqf(wave_sum(o.x * o.x + o.y * o.y) * (1.f / 128.f) + EPS);
                *(LAS unsigned*)((LAS unsigned char*)Ot + t * 512 + 4 * lane_) = pk2(o.x * rr * n0_ * lo16(gt_[jj]), o.y * rr * n1_ * hi16(gt_[jj])); }
        };
#pragma unroll 1
        for (int i = -1; i <= 62; i += 3) { HG_PITER(i, rawA, gB); HG_PITER(i + 1, rawB, gC); HG_PITER(i + 2, rawC, gA); }
        lbar();
#undef HG_PITER
#undef HG_LOAD
#undef HG_GLOAD
    } else {
        const int vb = pw;
        f32x16 Sacc[4];
#pragma unroll
        for (int cb = 0; cb < 4; ++cb)
#pragma unroll
            for (int r = 0; r < 16; ++r) Sacc[cb][r] = 0.f;
#pragma unroll 1
        for (int i = -1; i <= 65; ++i) {
            if (vb < 2 && i >= 2) {
                const LAS unsigned char* yt = lds + L_O + (i & 1) * 16384 + vb * 128;
#pragma unroll
                for (int k = 0; k < 4; ++k) { const int row = 8 * k + (lane >> 3), c16 = lane & 7;
                    *(u32x4*)(YC + (size_t)((i - 2) * 32 + row) * 512 + vb * 64 + c16 * 8) = *(const LAS u32x4*)(yt + row * 512 + c16 * 16); }
            }
            if (i >= 0 && i <= 63) {
                const LAS unsigned char* op = lds + (i & 1) * OPS;
                bf16x8 fk[8], fq[8], fp[8], fvp[2];
#pragma unroll
                for (int kc = 0; kc < 8; ++kc) { fk[kc] = *(const LAS bf16x8*)(op + O_KT + r32 * ST + (16 * kc + 8 * hi) * 2); fq[kc] = *(const LAS bf16x8*)(op + O_Q1 + r32 * ST + (16 * kc + 8 * hi) * 2); }
#pragma unroll
                for (int kc = 0; kc < 8; ++kc) fp[kc] = ld2x8(op + O_Q1 + r32 * ST + (16 * kc + 4 * hi) * 2);
#pragma unroll
                for (int ks = 0; ks < 2; ++ks) fvp[ks] = ld2x8(op + O_VT + (32 * vb + r32) * STT + (16 * ks + 4 * hi) * 2);
                asm volatile("s_waitcnt lgkmcnt(0)" ::: "memory"); __builtin_amdgcn_sched_barrier(0);
                f32x16 X, o;
#pragma unroll
                for (int r = 0; r < 16; ++r) { X[r] = 0.f; o[r] = 0.f; }
#pragma unroll
                for (int kc = 0; kc < 8; ++kc) { X = __builtin_amdgcn_mfma_f32_32x32x16_bf16(fk[kc], fq[kc], X, 0, 0, 0);
                    o = __builtin_amdgcn_mfma_f32_32x32x16_bf16(fp[kc], pack8(Sacc[kc >> 1], 8 * (kc & 1)), o, 0, 0, 0); }
                __builtin_amdgcn_sched_barrier(0);
                bf16x8 fkt[8], fvn[2];
#pragma unroll
                for (int ks = 0; ks < 2; ++ks) fvn[ks] = *(const LAS bf16x8*)(op + O_VT + (32 * vb + r32) * STT + (16 * ks + 8 * hi) * 2);
#pragma unroll
                for (int cb = 0; cb < 4; ++cb)
#pragma unroll
                    for (int ks = 0; ks < 2; ++ks) fkt[2 * cb + ks] = *(const LAS bf16x8*)(op + O_KTT + (32 * cb + r32) * STT + (16 * ks + 8 * hi) * 2);
#pragma unroll
                for (int r = 0; r < 16; ++r) { const int sidx = (r & 3) + 8 * (r >> 2) + 4 * hi; X[r] = sidx <= r32 ? X[r] : 0.f; }
#pragma unroll
                for (int ks = 0; ks < 2; ++ks) o = __builtin_amdgcn_mfma_f32_32x32x16_bf16(pack8(X, 8 * ks), fvp[ks], o, 0, 0, 0);
                asm volatile("s_waitcnt lgkmcnt(0)" ::: "memory"); __builtin_amdgcn_sched_barrier(0);
#pragma unroll
                for (int cb = 0; cb < 4; ++cb)
#pragma unroll
                    for (int ks = 0; ks < 2; ++ks) Sacc[cb] = __builtin_amdgcn_mfma_f32_32x32x16_bf16(fkt[2 * cb + ks], fvn[ks], Sacc[cb], 0, 0, 0);
                __builtin_amdgcn_sched_barrier(0);
                LAS float* Ot = (LAS float*)(lds + L_O + (i & 1) * 16384);
#pragma unroll
                for (int r = 0; r < 16; ++r) Ot[((r & 3) + 8 * (r >> 2) + 4 * hi) * 128 + 32 * vb + r32] = o[r];
#pragma unroll
                for (int cb = 0; cb < 4; ++cb)
#pragma unroll
                    for (int g4 = 0; g4 < 4; ++g4) { const f32x4 d = *(const LAS f32x4*)(op + O_D + (32 * cb + 8 * g4 + 4 * hi) * 4);
#pragma unroll
                        for (int j = 0; j < 4; ++j) Sacc[cb][4 * g4 + j] *= d[j]; }
            }
            lbar();
        }
    }
    __syncthreads();
}

__device__ __forceinline__ void np2_hgrn(Frame& F_, int l, int unit) {
    KA_WS();
    Frame F = mkframe(F_.lds);
    const int bl = unit >> 2, h = unit & 3;
    LAS float* Fs = (LAS float*)F.lds; LAS float* Ks = Fs + 4096; LAS float* Qs = Ks + 4096; LAS float* Vs = Qs + 4096; LAS float* Op = Vs + 4096;
    const float* ng = (const float*)KIN(10) + l * 128;
    const int tid = F.tid, lane = F.lane, wave = F.wave, cq = wave >> 1, v = (wave & 1) * 64 + lane;
    float Sr[32];
#pragma unroll
    for (int i = 0; i < 32; ++i) Sr[i] = 0.f;
    for (int blk = 0; blk < 64; ++blk) {
        const size_t t0 = (size_t)bl * S + blk * 32;
        __syncthreads();
        for (int i = tid; i < 4096; i += NTHR) { const int tt = i >> 7, c = i & 127; const size_t o = (t0 + tt) * 512 + h * 128 + c;
            const float lf = bf2f(((bf16*)(ws + WS_HF))[o]); Fs[i] = expf(lf); Ks[i] = -expm1f(lf); Qs[i] = bf2f(((bf16*)(ws + WS_HQ))[o]); Vs[i] = bf2f(((bf16*)(ws + WS_HV))[o]); }
        __syncthreads();
        for (int tt = 0; tt < 32; ++tt) {
            const float vv = Vs[tt * 128 + v]; float op = 0.f;
#pragma unroll
            for (int i4 = 0; i4 < 8; ++i4) {
                const f32x4 f4 = *(const LAS f32x4*)&Fs[tt * 128 + cq * 32 + i4 * 4], k4 = *(const LAS f32x4*)&Ks[tt * 128 + cq * 32 + i4 * 4], q4 = *(const LAS f32x4*)&Qs[tt * 128 + cq * 32 + i4 * 4];
                Sr[i4 * 4 + 0] = Sr[i4 * 4 + 0] * f4.x + k4.x * vv; op += q4.x * Sr[i4 * 4 + 0];
                Sr[i4 * 4 + 1] = Sr[i4 * 4 + 1] * f4.y + k4.y * vv; op += q4.y * Sr[i4 * 4 + 1];
                Sr[i4 * 4 + 2] = Sr[i4 * 4 + 2] * f4.z + k4.z * vv; op += q4.z * Sr[i4 * 4 + 2];
                Sr[i4 * 4 + 3] = Sr[i4 * 4 + 3] * f4.w + k4.w * vv; op += q4.w * Sr[i4 * 4 + 3];
            }
            Op[(tt * 4 + cq) * 128 + v] = op;
        }
        __syncthreads();
#pragma unroll
        for (int j = 0; j < 4; ++j) {
            const int tt = wave * 4 + j; float o0 = 0.f, o1 = 0.f;
#pragma unroll
            for (int c = 0; c < 4; ++c) { const f32x2 x = *(const LAS f32x2*)&Op[(tt * 4 + c) * 128 + lane * 2]; o0 += x.x; o1 += x.y; }
            const float r = __builtin_amdgcn_rsqf(wave_sum(o0 * o0 + o1 * o1) * (1.f / 128.f) + EPS);
            const size_t o = (t0 + tt) * 512 + h * 128 + lane * 2;
            const unsigned gw = *(const unsigned*)(((bf16*)(ws + WS_HG)) + o);
            *(unsigned*)(((bf16*)(ws + WS_YC)) + o) = pk2(o0 * r * ng[lane * 2] * lo16(gw), o1 * r * ng[lane * 2 + 1] * hi16(gw));
        }
    }
}

__device__ __forceinline__ void p5_ln_route(Frame& F_, int g, int l, int bank) {
    KA_WS();
    Frame F = mkframe(F_.lds);
    typedef short bf16x8 __attribute__((ext_vector_type(8)));
    const float* lg = (const float*)KIN(14) + l * D; const float* lb = (const float*)KIN(15) + l * D;
    const float* bgp = (const float*)KIN(17) + l * 4; const float* be = (const float*)KIN(19) + l * 32;
    unsigned* cnt = ((unsigned*)(ws + WS_CTL)) + CW_CNT + bank * 32;
    constexpr int XS = 2064;
    LAS unsigned char* XH = F.lds; LAS unsigned char* XL = F.lds + 16 * XS; LAS float* LG = (LAS float*)(F.lds + 32 * XS);
    LAS int* ent_e = (LAS int*)(F.lds + 32 * XS + 6144); LAS int* ent_pos = ent_e + 256; LAS float* ent_w = (LAS float*)(ent_pos + 256);
    const int lane = F.lane, wave = F.wave;
    constexpr int rows_per_wg = TG / 256;
    constexpr int NP = rows_per_wg / 16;
    const int row0 = blockIdx.x * rows_per_wg;
    const float* Rb = (const float*)(ws + WS_R); bf16* X1 = (bf16*)(ws + WS_X1);
    const int nb = wave % 3, kh = wave / 3;
    bf16x8 bh[16], blo[16];
    if (wave < 6) {
        const bf16* rw = (const bf16*)(ws + WS_RW) + (size_t)l * 2 * 48 * 1024 + (size_t)(16 * nb + (lane & 15)) * 1024 + 512 * kh + 8 * (lane >> 4);
#pragma unroll
        for (int ks = 0; ks < 16; ++ks) { bh[ks] = *(const bf16x8*)(rw + 32 * ks); blo[ks] = *(const bf16x8*)(rw + 48 * 1024 + 32 * ks); }
    }
    __syncthreads();
    f32x4 vin[2][4];
#pragma unroll
    for (int rr = 0; rr < 2; ++rr) { const f32x4* rp = (const f32x4*)(Rb + (size_t)(row0 + 2 * wave + rr) * D) + lane;
#pragma unroll
        for (int j = 0; j < 4; ++j) vin[rr][j] = rp[64 * j]; }
#pragma unroll 1
    for (int p = 0; p < NP; ++p) {
        f32x4 vnx[2][4];
#pragma unroll
        for (int rr = 0; rr < 2; ++rr) { const int tn = row0 + 16 * (p + 1 < NP ? p + 1 : p) + 2 * wave + rr; const f32x4* rp = (const f32x4*)(Rb + (size_t)tn * D) + lane;
#pragma unroll
            for (int j = 0; j < 4; ++j) vnx[rr][j] = rp[64 * j]; }
#pragma unroll
        for (int rr = 0; rr < 2; ++rr) {
            const int rl = 2 * wave + rr, t = row0 + 16 * p + rl;
            f32x4 v[4]; float sm = 0.f;
#pragma unroll
            for (int j = 0; j < 4; ++j) { v[j] = vin[rr][j]; sm += (v[j].x + v[j].y) + (v[j].z + v[j].w); }
            const float mean = wave_sum(sm) * (1.f / D); float s2 = 0.f;
#pragma unroll
            for (int j = 0; j < 4; ++j) { v[j] = v[j] - mean; s2 += (v[j].x * v[j].x + v[j].y * v[j].y) + (v[j].z * v[j].z + v[j].w * v[j].w); }
            const float rstd = __builtin_amdgcn_rsqf(wave_sum(s2) * (1.f / D) + EPS);
#pragma unroll
            for (int j = 0; j < 4; ++j) {
                const int d0 = lane * 4 + 256 * j; const f32x4 gg = *(const f32x4*)(lg + d0), bb = *(const f32x4*)(lb + d0);
                const f32x4 y = v[j] * rstd * gg + bb;
                const unsigned h0 = pk2(y.x, y.y), h1 = pk2(y.z, y.w);
                *(u32x2*)(X1 + (size_t)t * D + d0) = (u32x2){h0, h1};
                const unsigned l0 = pk2(y.x - lo16(h0), y.y - hi16(h0)), l1 = pk2(y.z - lo16(h1), y.w - hi16(h1));
                *(LAS u32x2*)(XH + rl * XS + d0 * 2) = (u32x2){h0, h1}; *(LAS u32x2*)(XL + rl * XS + d0 * 2) = (u32x2){l0, l1};
            }
        }
#pragma unroll
        for (int rr = 0; rr < 2; ++rr)
#pragma unroll
            for (int j = 0; j < 4; ++j) vin[rr][j] = vnx[rr][j];
        __syncthreads();
        if (wave < 6) {
            f32x4 acc = {0.f, 0.f, 0.f, 0.f};
            const LAS unsigned char* ah = XH + (lane & 15) * XS + (512 * kh + 8 * (lane >> 4)) * 2; const LAS unsigned char* al = XL + (lane & 15) * XS + (512 * kh + 8 * (lane >> 4)) * 2;
#pragma unroll
            for (int ks = 0; ks < 16; ++ks) { const bf16x8 xa = *(const LAS bf16x8*)(ah + 64 * ks), xb = *(const LAS bf16x8*)(al + 64 * ks);
                acc = __builtin_amdgcn_mfma_f32_16x16x32_bf16(xa, bh[ks], acc, 0, 0, 0); acc = __builtin_amdgcn_mfma_f32_16x16x32_bf16(xb, bh[ks], acc, 0, 0, 0); acc = __builtin_amdgcn_mfma_f32_16x16x32_bf16(xa, blo[ks], acc, 0, 0, 0); }
#pragma unroll
            for (int i = 0; i < 4; ++i) LG[(kh * 16 + 4 * (lane >> 4) + i) * 48 + 16 * nb + (lane & 15)] = acc[i];
        }
        __syncthreads();
        if (F.tid < 16) {
            const int rl = F.tid;
            const LAS float* L0 = LG + rl * 48; const LAS float* L1 = LG + (16 + rl) * 48;
            float gl4[4];
#pragma unroll
            for (int e = 0; e < 4; ++e) gl4[e] = L0[e] + L1[e] + bgp[e];
            int gi = 0; float gm = gl4[0];
#pragma unroll
            for (int e = 1; e < 4; ++e) if (gl4[e] > gm) { gm = gl4[e]; gi = e; }
            float gs = 0.f;
#pragma unroll
            for (int e = 0; e < 4; ++e) gs += __expf(gl4[e] - gm);
            const float pgroup = 1.f / gs;
            float el[8];
#pragma unroll
            for (int e = 0; e < 8; ++e) el[e] = L0[4 + 8 * gi + e] + L1[4 + 8 * gi + e] + be[gi * 8 + e];
            int i0 = 0; float v0 = el[0];
#pragma unroll
            for (int e = 1; e < 8; ++e) if (el[e] > v0) { v0 = el[e]; i0 = e; }
            int i1 = -1; float v1 = -INFINITY;
#pragma unroll
            for (int e = 0; e < 8; ++e) if (e != i0 && el[e] > v1) { v1 = el[e]; i1 = e; }
            const float ex = __expf(v1 - v0); const float p0 = 1.f / (1.f + ex), p1 = ex * p0;
            const int ri = 16 * p + rl;
            ent_e[ri * 2] = gi * 8 + i0; ent_e[ri * 2 + 1] = gi * 8 + i1; ent_w[ri * 2] = p0 * pgroup; ent_w[ri * 2 + 1] = p1 * pgroup;
        }
        __syncthreads();
    }
    if (F.tid < 32) {
        const int e = F.tid; int c = 0;
        for (int i = 0; i < rows_per_wg * 2; ++i) c += (ent_e[i] == e);
        unsigned base = 0; if (c) base = __hip_atomic_fetch_add(cnt + e, (unsigned)c, __ATOMIC_RELAXED, __HIP_MEMORY_SCOPE_AGENT);
        for (int i = 0; i < rows_per_wg * 2; ++i) if (ent_e[i] == e) { ent_pos[i] = (int)base; ((int*)(ws + WS_TOK))[(size_t)e * TG + base] = row0 + (i >> 1); ++base; }
    }
    __syncthreads();
    if (F.tid < rows_per_wg) { const int i = F.tid; unsigned* r = ((unsigned*)(ws + WS_RT)) + (size_t)(row0 + i) * 8;
        r[0] = (unsigned)ent_e[2 * i]; r[1] = (unsigned)ent_pos[2 * i]; r[2] = __float_as_uint(ent_w[2 * i]); r[3] = (unsigned)ent_e[2 * i + 1]; r[4] = (unsigned)ent_pos[2 * i + 1]; r[5] = __float_as_uint(ent_w[2 * i + 1]); }
    __syncthreads();
}

__device__ __forceinline__ void p8_ln2(Frame& F_, int g, int l) {
    KA_WS();
    Frame F = mkframe(F_.lds);
    const float* lg = (const float*)KIN(23) + l * D; const float* lb = (const float*)KIN(24) + l * D;
    const unsigned* cnt = ((unsigned*)(ws + WS_CTL)) + CW_CNT + (g * 2 + l) * 32;
    LAS int* offs = (LAS int*)F.lds;
    __syncthreads();
    if (F.tid == 0) { int off = 0; for (int e = 0; e < NE; ++e) { offs[e] = off; off += ((int)cnt[e] + 255) & ~255; } }
    __syncthreads();
    const int lane = F.lane;
    const bf16* __restrict__ X1 = (const bf16*)(ws + WS_X1); const bf16* __restrict__ OM = (const bf16*)(ws + WS_OM);
    const int per = TG / (gridDim.x * NWAVES);
    const int t0 = (blockIdx.x * NWAVES + F.wave) * per;
    int ms0 = 0, ms1 = 0; float mw0 = 0.f, mw1 = 0.f;
    if (lane < per) { const unsigned* r = ((const unsigned*)(ws + WS_RT)) + (size_t)(t0 + lane) * 8; const u32x4 ra = *(const u32x4*)r; const u32x2 rb2 = *(const u32x2*)(r + 4);
        ms0 = offs[ra.x] + (int)ra.y; mw0 = __uint_as_float(ra.z); ms1 = offs[ra.w] + (int)rb2.x; mw1 = __uint_as_float(rb2.y); }
#pragma unroll 1
    for (int i = 0; i < per; i += 2) {
        u32x2 xa[2][4], oa[2][4], ob[2][4]; float w0[2], w1[2];
#pragma unroll
        for (int rr = 0; rr < 2; ++rr) {
            const int s0 = __builtin_amdgcn_readlane(ms0, i + rr), s1 = __builtin_amdgcn_readlane(ms1, i + rr);
            w0[rr] = __builtin_bit_cast(float, __builtin_amdgcn_readlane(__builtin_bit_cast(int, mw0), i + rr)); w1[rr] = __builtin_bit_cast(float, __builtin_amdgcn_readlane(__builtin_bit_cast(int, mw1), i + rr));
#pragma unroll
            for (int j = 0; j < 4; ++j) { const int d0 = lane * 4 + 256 * j;
                xa[rr][j] = *(const u32x2*)(X1 + (size_t)(t0 + i + rr) * D + d0); oa[rr][j] = *(const u32x2*)(OM + (size_t)s0 * D + d0); ob[rr][j] = *(const u32x2*)(OM + (size_t)s1 * D + d0); }
        }
#pragma unroll
        for (int rr = 0; rr < 2; ++rr) {
            const int t = t0 + i + rr;
            f32x4 v[4]; float sm = 0.f;
#pragma unroll
            for (int j = 0; j < 4; ++j) {
                v[j].x = ALPHA * lo16(xa[rr][j].x) + w0[rr] * lo16(oa[rr][j].x) + w1[rr] * lo16(ob[rr][j].x); v[j].y = ALPHA * hi16(xa[rr][j].x) + w0[rr] * hi16(oa[rr][j].x) + w1[rr] * hi16(ob[rr][j].x);
                v[j].z = ALPHA * lo16(xa[rr][j].y) + w0[rr] * lo16(oa[rr][j].y) + w1[rr] * lo16(ob[rr][j].y); v[j].w = ALPHA * hi16(xa[rr][j].y) + w0[rr] * hi16(oa[rr][j].y) + w1[rr] * hi16(ob[rr][j].y);
                sm += (v[j].x + v[j].y) + (v[j].z + v[j].w);
            }
            const float mean = wave_sum(sm) * (1.f / D); float s2 = 0.f;
#pragma unroll
            for (int j = 0; j < 4; ++j) { v[j] = v[j] - mean; s2 += (v[j].x * v[j].x + v[j].y * v[j].y) + (v[j].z * v[j].z + v[j].w * v[j].w); }
            const float rstd = __builtin_amdgcn_rsqf(wave_sum(s2) * (1.f / D) + EPS);
#pragma unroll
            for (int j = 0; j < 4; ++j) {
                const int d0 = lane * 4 + 256 * j; const f32x4 gg = *(const f32x4*)(lg + d0), bb = *(const f32x4*)(lb + d0);
                const f32x4 y = v[j] * rstd * gg + bb;
                if (l == NL - 1) *(f32x4*)(KOUT() + ((size_t)g * TG + t) * D + d0) = y;
                else *(u32x2*)((bf16*)(ws + WS_XB) + (size_t)t * D + d0) = (u32x2){pk2(y.x, y.y), pk2(y.z, y.w)};
            }
        }
    }
}

struct RmId { int off; __device__ __forceinline__ int operator()(int n0) const { return off + n0; } };
struct RmGlu { __device__ __forceinline__ int operator()(int n0) const { if (n0 >= 1024) return n0; const int hi = n0 >= 512, c = n0 - hi * 512; return (c >> 7) * 256 + hi * 128 + (c & 127); } };
struct RmIl { int hi; __device__ __forceinline__ int operator()(int n0) const { return (n0 >> 7) * 256 + hi * 128 + (n0 & 127); } };
template <class RM>
__device__ __forceinline__ void transpose_item(const float* W, int K, int N, bf16* WT, RM rowmap, LAS float* scr, int item, int lane) {
    const int nblk = N / 32, kb = item / nblk, nb = item % nblk, k0 = 64 * kb, n0 = 32 * nb;
#pragma unroll 8
    for (int i = 0; i < 32; ++i) { const int kk = 2 * i + (lane >> 5); scr[kk * 33 + (lane & 31)] = W[(size_t)(k0 + kk) * N + n0 + (lane & 31)]; }
    LDS_WAIT();
    const int c = lane & 7; const int r0 = rowmap(n0);
#pragma unroll
    for (int j = 0; j < 4; ++j) { const int n = (lane >> 3) + 8 * j; const LAS float* sp = scr + (8 * c) * 33 + n;
        u32x4 o; o.x = pk2(sp[0 * 33], sp[1 * 33]); o.y = pk2(sp[2 * 33], sp[3 * 33]); o.z = pk2(sp[4 * 33], sp[5 * 33]); o.w = pk2(sp[6 * 33], sp[7 * 33]);
        *(u32x4*)(WT + (size_t)(r0 + n) * K + k0 + 8 * c) = o; }
    LDS_WAIT();
}
__device__ __forceinline__ void p_wprep(Frame& F_) {
    KA_WS();
    Frame F = mkframe(F_.lds);
    LAS float* scr = (LAS float*)(F.lds + F.wave * 16384);
    const int gw = blockIdx.x * NWAVES + F.wave, NGW = gridDim.x * NWAVES, lane = F.lane;
    bf16* WIN = (bf16*)(ws + WS_WIN); bf16* WBR = (bf16*)(ws + WS_WBR); bf16* WOUT = (bf16*)(ws + WS_WOUT); bf16* W13 = (bf16*)(ws + WS_W13); bf16* W2 = (bf16*)(ws + WS_W2);
    constexpr int I_IN = 16 * 240, I_BR = 8 * 32, I_OUT = 16 * 32, I_W1 = 16 * 16, I_W2 = 8 * 32;
    constexpr int N_IN = 2 * I_IN, N_BR = 6 * I_BR, N_OUT = 2 * I_OUT, N_W1 = 64 * I_W1, N_W2 = 64 * I_W2;
    constexpr int NITEMS = N_IN + N_BR + N_OUT + 2 * N_W1 + N_W2;
    for (int it = gw; it < NITEMS; it += NGW) {
        int r = it;
        if (r < N_IN) { const int l = r / I_IN; transpose_item((const float*)KIN(2) + (size_t)l * D * INC, D, INC, WIN + (size_t)l * INC * D, RmGlu(), scr, r % I_IN, lane); continue; } r -= N_IN;
        if (r < N_BR) { const int q = r / I_BR; transpose_item((const float*)KIN(11) + (size_t)q * 512 * D, 512, D, WBR + (size_t)q * D * 512, RmId{0}, scr, r % I_BR, lane); continue; } r -= N_BR;
        if (r < N_OUT) { const int l = r / I_OUT; transpose_item((const float*)KIN(13) + (size_t)l * D * D, D, D, WOUT + (size_t)l * D * D, RmId{0}, scr, r % I_OUT, lane); continue; } r -= N_OUT;
        if (r < N_W1) { const int q = r / I_W1; transpose_item((const float*)KIN(20) + (size_t)q * D * DE, D, DE, W13 + (size_t)q * 1024 * D, RmIl{0}, scr, r % I_W1, lane); continue; } r -= N_W1;
        if (r < N_W1) { const int q = r / I_W1; transpose_item((const float*)KIN(21) + (size_t)q * D * DE, D, DE, W13 + (size_t)q * 1024 * D, RmIl{1}, scr, r % I_W1, lane); continue; } r -= N_W1;
        { const int q = r / I_W2; transpose_item((const float*)KIN(22) + (size_t)q * DE * D, DE, D, W2 + (size_t)q * D * DE, RmId{0}, scr, r % I_W2, lane); }
    }
}

template <int PART> __device__ __forceinline__ void p1_part(Frame& F_, int g, int l, int G, int c) {
    KA_WS();
    Frame F = mkframe(F_.lds);
    pg8::ProbDense P{(const char*)((bf16*)(ws + WS_XB)), (const char*)(ws + WS_WIN) + (size_t)l * INC * D * 2, D};
    pg8::SubOrder<PART> S; S.init(TG, G, c);
    pg8::EpiInProj E{((bf16*)(ws + WS_U)), ((bf16*)(ws + WS_Q)), ((bf16*)(ws + WS_V)), ((bf16*)(ws + WS_GATE)), ((const float*)(ws + WS_ROT)) + (size_t)g * TG * 16, ((const float*)(ws + WS_LB)) + l * 512, (const float*)KIN(12) + (size_t)l * 3 * D};
    pg8::gemm_phase<pg8::ProbDense, pg8::EpiInProj, pg8::SubOrder<PART>, true>(F.lds, P, S, E);
}
__device__ __forceinline__ void p1_inproj(Frame& F_, int g, int l) {
    KA_WS();
    Frame F = mkframe(F_.lds);
    pg8::ProbDense P{(const char*)((bf16*)(ws + WS_XB)), (const char*)(ws + WS_WIN) + (size_t)l * INC * D * 2, D};
    pg8::StaticOrder S; S.init(TG, INC, gridDim.x, blockIdx.x);
    pg8::EpiInProj E{((bf16*)(ws + WS_U)), ((bf16*)(ws + WS_Q)), ((bf16*)(ws + WS_V)), ((bf16*)(ws + WS_GATE)), ((const float*)(ws + WS_ROT)) + (size_t)g * TG * 16, ((const float*)(ws + WS_LB)) + l * 512, (const float*)KIN(12) + (size_t)l * 3 * D};
    pg8::gemm_phase<pg8::ProbDense, pg8::EpiInProj, pg8::StaticOrder, true>(F.lds, P, S, E);
}
__device__ __forceinline__ void p3_merge(Frame& F_, int l) {
    KA_WS();
    Frame F = mkframe(F_.lds);
    pg8::ProbMerge P{(const char*)((bf16*)(ws + WS_YA)), (const char*)((bf16*)(ws + WS_YB)), (const char*)((bf16*)(ws + WS_YC)), (const char*)(ws + WS_WBR) + (size_t)l * 3 * D * 512 * 2, 512};
    pg8::MergeOrder S; S.so.init(TG, D, gridDim.x, blockIdx.x);
    pg8::EpiMerge E{((bf16*)(ws + WS_GATE)), ((bf16*)(ws + WS_M))};
    pg8::gemm_phase<pg8::ProbMerge, pg8::EpiMerge, pg8::MergeOrder, true>(F.lds, P, S, E);
}
__device__ __forceinline__ void p4_wout(Frame& F_, int l) {
    KA_WS();
    Frame F = mkframe(F_.lds);
    pg8::ProbDense P{(const char*)((bf16*)(ws + WS_M)), (const char*)(ws + WS_WOUT) + (size_t)l * D * D * 2, D};
    pg8::StaticOrder S; S.init(TG, D, gridDim.x, blockIdx.x);
    pg8::EpiWout E{((bf16*)(ws + WS_XB)), ((float*)(ws + WS_R))};
    pg8::gemm_phase<pg8::ProbDense, pg8::EpiWout, pg8::StaticOrder, true>(F.lds, P, S, E);
}
constexpr int TAB_OFF = MISC_OFF + 256;
__device__ __forceinline__ void moe_table(Frame& F_, int g, int l) {
    KA_WS();
    Frame F = mkframe(F_.lds);
    const unsigned* cnt = ((unsigned*)(ws + WS_CTL)) + CW_CNT + (g * 2 + l) * 32;
    LAS int* tab = (LAS int*)(F.lds + TAB_OFF);
    __syncthreads();
    if (F.tid < 64) {
        const int c = F.tid < 32 ? (int)cnt[F.tid] : 0; int sacc = (c + 255) >> 8;
#pragma unroll
        for (int o = 1; o < 32; o <<= 1) { const int t2 = __shfl_up(sacc, o); if (F.lane >= o) sacc += t2; }
        if (F.tid < 32) { tab[F.tid + 1] = sacc; tab[33 + F.tid] = c; }
        if (F.tid == 0) tab[0] = 0;
    }
    __syncthreads();
}
__device__ __forceinline__ void p6_moe1(Frame& F_, int g, int l) {
    KA_WS();
    Frame F = mkframe(F_.lds);
    moe_table(F, g, l);
    pg8::ProbMoe1 P{(const char*)((bf16*)(ws + WS_X1)), (const char*)(ws + WS_W13) + (size_t)l * NE * 1024 * D * 2, ((int*)(ws + WS_TOK)), D};
    pg8::MoeOrder S{(const LAS int*)(F.lds + TAB_OFF), (int)gridDim.x, (int)blockIdx.x, 4};
    pg8::EpiMoe1 E{((bf16*)(ws + WS_HM))};
    pg8::gemm_phase<pg8::ProbMoe1, pg8::EpiMoe1, pg8::MoeOrder, true>(F.lds, P, S, E);
}
__device__ __forceinline__ void p7_moe2(Frame& F_, int g, int l) {
    KA_WS();
    Frame F = mkframe(F_.lds);
    moe_table(F, g, l);
    pg8::ProbMoe2 P{(const char*)((bf16*)(ws + WS_HM)), (const char*)(ws + WS_W2) + (size_t)l * NE * D * DE * 2, DE};
    pg8::MoeOrder S{(const LAS int*)(F.lds + TAB_OFF), (int)gridDim.x, (int)blockIdx.x, 4};
    pg8::EpiMoe2 E{((bf16*)(ws + WS_OM))};
    pg8::gemm_phase<pg8::ProbMoe2, pg8::EpiMoe2, pg8::MoeOrder, true>(F.lds, P, S, E);
}

__device__ __forceinline__ void frame_init(Frame& F, unsigned char* lds_raw) {
    F.lds = (LAS unsigned char*)lds_raw; F.tid = threadIdx.x; F.lane = F.tid & 63; F.wave = __builtin_amdgcn_readfirstlane(F.tid >> 6);
}
__global__ void __launch_bounds__(NTHR, 2) fwd_all(Args a) {
    extern __shared__ __attribute__((aligned(16))) unsigned char lds_raw[];
    Frame F; frame_init(F, lds_raw);
    volatile LAS unsigned* MISC = (volatile LAS unsigned*)(F.lds + MISC_OFF);
    if (F.tid < 64) MISC[F.tid] = 0u;
    __syncthreads();
    XcdBarrier bar = xcd_barrier_post((unsigned*)(a.ws + WS_CTL) + CW_BAR, MISC + 8);
    p_prologue(F);
#pragma unroll 1
    for (int rep = 0; rep < REP_PRO; ++rep) p_wprep(F);
    xcd_barrier(bar);
    for (int g = 0; g < NG; ++g) {
        p_xload(F, g); xcd_barrier(bar);
        for (int l = 0; l < NL; ++l) {
#pragma unroll 1
            for (int rep = 0; rep < REP_P1; ++rep) { p1_part<0>(F, g, l, (int)gridDim.x, (int)blockIdx.x); xcd_barrier(bar); }
#pragma unroll 1
            for (int rep = 0; rep < REP_MIX; ++rep) { p2_mixers(F, g, l, rep); xcd_barrier(bar); p2d_combine(F, l); xcd_barrier(bar); }
#pragma unroll 1
            for (int rep = 0; rep < REP_P34; ++rep) { p3_merge(F, l); xcd_barrier(bar); p4_wout(F, l); xcd_barrier(bar); }
#pragma unroll 1
            for (int rep = 0; rep < REP_P5; ++rep) { p5_ln_route(F, g, l, rep == REP_P5 - 1 ? g * 2 + l : 8 + (g * 2 + l) * 2 + rep); xcd_barrier(bar); }
#pragma unroll 1
            for (int rep = 0; rep < REP_MOE; ++rep) { p6_moe1(F, g, l); xcd_barrier(bar); p7_moe2(F, g, l); xcd_barrier(bar); }
#pragma unroll 1
            for (int rep = 0; rep < REP_LN; ++rep) { p8_ln2(F, g, l); xcd_barrier(bar); }
        }
    }
}

extern "C" void kernel_launch(void* const* d_in, const int* in_sizes, int n_in, void* d_out, int out_size, void* d_ws, size_t ws_size, hipStream_t stream) {
    static int grid = 0;
    if (grid == 0) {
        if (n_in != 25 || out_size != T * D || ws_size < WS_END) { fprintf(stderr, "kernel_launch: unexpected shapes (n_in %d out %d ws %zu)\n", n_in, out_size, ws_size); grid = -1; return; }
        int dev = 0, cus = 0;
        if (hipGetDevice(&dev) != hipSuccess || hipDeviceGetAttribute(&cus, hipDeviceAttributeMultiprocessorCount, dev) != hipSuccess) { grid = -1; return; }
        (void)hipGetLastError();
        grid = cus;
        if (grid != 256) { fprintf(stderr, "kernel_launch: built for 256 CUs, got %d\n", cus); grid = -1; return; }
    }
    if (grid < 0) return;
    (void)hipMemsetAsync((char*)d_ws + WS_CTL, 0, CTL_ZERO_BYTES, stream);
    Args a{};
    for (int i = 0; i < 25; ++i) a.in[i] = d_in[i];
    a.out = (float*)d_out; a.ws = (unsigned char*)d_ws;
    { static bool attr = false; if (!attr) { (void)hipFuncSetAttribute((const void*)fwd_all, hipFuncAttributeMaxDynamicSharedMemorySize, LDS_BYTES); attr = true; }
      hipLaunchKernelGGL(fwd_all, dim3(grid), dim3(NTHR), LDS_BYTES, stream, a);}

}
```

```cpp
#include <hip/hip_runtime.h>
#include <cstdio>
#include <cstdint>

#ifndef REP_P1
#define REP_P1 1
#endif
#ifndef REP_MIX
#define REP_MIX 1
#endif
#ifndef REP_P34
#define REP_P34 1
#endif
#ifndef REP_MOE
#define REP_MOE 1
#endif
#ifndef REP_P5
#define REP_P5 1
#endif
#ifndef REP_PRO
#define REP_PRO 1
#endif
#ifndef REP_LN
#define REP_LN 1
#endif
#ifndef ONE_LAUNCH
#define ONE_LAUNCH 1
#endif

#define GAS __attribute__((address_space(1)))
#define LAS __attribute__((address_space(3)))
typedef unsigned short bf16;
typedef float f32x4 __attribute__((ext_vector_type(4)));
typedef float f32x2 __attribute__((ext_vector_type(2)));
typedef unsigned u32x4 __attribute__((ext_vector_type(4)));
typedef unsigned u32x2 __attribute__((ext_vector_type(2)));

constexpr int D = 1024, NBATCH = 32, S = 2048, T = NBATCH * S, NL = 2;
constexpr int GB = 16, TG = GB * S, NG = NBATCH / GB;
constexpr int INC = 7680;
constexpr int NE = 32, DE = 512;
constexpr float ALPHA = 1.4142135623730951f, EPS = 1e-5f;
constexpr int NWAVES = 8, NTHR = 512;

constexpr size_t MiB = 1u << 20;
constexpr size_t WS_CTL = 0, CTL_ZERO_BYTES = 1 * MiB;
constexpr size_t WS_ROT = 1 * MiB;
constexpr size_t WS_LB = 5 * MiB;
constexpr size_t WS_RW = 6 * MiB;
constexpr size_t WS_WIN = 8 * MiB;
constexpr size_t WS_WBR = 38 * MiB;
constexpr size_t WS_WOUT = 44 * MiB;
constexpr size_t WS_W13 = 48 * MiB;
constexpr size_t WS_W2 = 176 * MiB;
constexpr size_t WS_XB = 240 * MiB;
constexpr size_t WS_U = 304 * MiB;
constexpr size_t WS_Q = 336 * MiB, WS_K = 368 * MiB, WS_V = 400 * MiB;
constexpr size_t WS_HQ = 432 * MiB, WS_HF = 464 * MiB, WS_HV = 496 * MiB, WS_HG = 528 * MiB;
constexpr size_t WS_GATE = 560 * MiB;
constexpr size_t WS_YA = 752 * MiB, WS_YB = 784 * MiB, WS_YC = 816 * MiB;
constexpr size_t WS_R = 848 * MiB;
constexpr size_t WS_TOK = 976 * MiB;
constexpr size_t WS_RT = 980 * MiB;
constexpr size_t WS_END = 982 * MiB;
constexpr size_t WS_M = WS_Q;
constexpr size_t WS_X1 = WS_YA;
constexpr size_t WS_HM = 304 * MiB;
constexpr size_t WS_OM = 376 * MiB;
constexpr size_t HSTRIDE = (size_t)TG * 512;
static_assert((WS_K - WS_Q) == HSTRIDE * 2 && (WS_HQ - WS_V) == HSTRIDE * 2 && (WS_HF - WS_HQ) == HSTRIDE * 2 && (WS_HV - WS_HF) == HSTRIDE * 2 && (WS_HG - WS_HV) == HSTRIDE * 2, "EpiInProj pointer arithmetic");
static_assert(WS_OM + (size_t)(2 * TG + 32 * 256) * 1024 * 2 <= WS_GATE && WS_HM + (size_t)(2 * TG + 32 * 256) * 512 * 2 <= WS_OM, "expert buffers overlay U..HF only");
constexpr int CW_BAR = 4096;
constexpr int CW_CNT = 16384;

__device__ __forceinline__ float bf2f(bf16 b) { return __uint_as_float(((unsigned)b) << 16); }
__device__ __forceinline__ unsigned f2bf(float f) { unsigned u = __float_as_uint(f); return (u + 0x7fffu + ((u >> 16) & 1u)) >> 16; }
__device__ __forceinline__ unsigned pk2(float lo, float hi) { unsigned r; asm volatile("v_cvt_pk_bf16_f32 %0, %1, %2" : "=v"(r) : "v"(lo), "v"(hi)); return r; }
__device__ __forceinline__ float lo16(unsigned w) { return __uint_as_float(w << 16); }
__device__ __forceinline__ float hi16(unsigned w) { return __uint_as_float(w & 0xffff0000u); }
#define DPP_ADD(v, ctrl) ((v) + __builtin_bit_cast(float, __builtin_amdgcn_update_dpp(0, __builtin_bit_cast(int, (v)), (ctrl), 0xF, 0xF, true)))
__device__ __forceinline__ float wave_sum(float v) {
    v = DPP_ADD(v, 0xB1);
    v = DPP_ADD(v, 0x4E);
    v = DPP_ADD(v, 0x141);
    v = DPP_ADD(v, 0x140);
    v = v + __builtin_bit_cast(float, __builtin_amdgcn_update_dpp(0, __builtin_bit_cast(int, v), 0x142, 0xA, 0xF, false));
    v = v + __builtin_bit_cast(float, __builtin_amdgcn_update_dpp(0, __builtin_bit_cast(int, v), 0x143, 0xC, 0xF, false));
    return __builtin_bit_cast(float, __builtin_amdgcn_readlane(__builtin_bit_cast(int, v), 63));
}
__device__ __forceinline__ float wave_max(float v) {
#pragma unroll
    for (int o = 1; o < 64; o <<= 1) v = fmaxf(v, __shfl_xor(v, o));
    return v;
}
__device__ __forceinline__ float sigmoidf_(float z) { return 1.f / (1.f + expf(-z)); }
__device__ __forceinline__ float siluf_(float z) { return z / (1.f + expf(-z)); }
__device__ __forceinline__ float hg_logf(float z, float lb) {
    if (z >= 0.f) { const float sn = 1.f / (1.f + expf(z)); return log1pf(-(1.f - lb) * sn); }
    const float ez = expf(z); return logf(lb + (1.f - lb) * (ez / (1.f + ez)));
}
#define LDS_WAIT() asm volatile("s_waitcnt lgkmcnt(0)" ::: "memory")

#define XB_TMO      128
#define XB_XCNT(j)  (256  + 64 * (j))
#define XB_XSUB(j)  (1280 + 64 * (j))
#define XB_XGEN(j)  (2304 + 64 * (j))
#define XB_TOP      3328
#define XB_TOPGEN   3392
#define XCD_BAR_WORDS 3456
#define XB_SPIN_CAP (1u << 22)
__device__ __forceinline__ unsigned xb_ld(unsigned* p)              { return __hip_atomic_load(p, __ATOMIC_RELAXED, __HIP_MEMORY_SCOPE_AGENT); }
__device__ __forceinline__ unsigned xb_add(unsigned* p, unsigned v) { return __hip_atomic_fetch_add(p, v, __ATOMIC_RELAXED, __HIP_MEMORY_SCOPE_AGENT); }
__device__ __forceinline__ unsigned xb_xcc_id() { return (unsigned)__builtin_amdgcn_s_getreg((3 << 11) | 20) & 0xFu; }
#define XB_SPIN(cond, bar) do { unsigned _sp = 0; while (cond) { __builtin_amdgcn_s_sleep(1); \
    if ((++_sp & 255u) == 0u) { if (xb_ld(&(bar)[XB_TMO])) break; if (_sp > XB_SPIN_CAP) { atomicAdd(&(bar)[XB_TMO], 1u); break; } } } } while (0)
struct XcdBarrier { unsigned* bar; unsigned x; volatile LAS unsigned* st; };
__device__ __forceinline__ XcdBarrier xcd_barrier_post(unsigned* bar, volatile LAS unsigned* st) {
    XcdBarrier b; b.bar = bar; b.x = (unsigned)__builtin_amdgcn_readfirstlane((int)xb_xcc_id()); b.st = st;
    if (threadIdx.x == 0) (void)xb_add(&bar[XB_XCNT(b.x)], 1u);
    return b;
}
__device__ __forceinline__ void xcd_barrier_complete(unsigned* bar, unsigned x, unsigned& nloc, unsigned& nx) {
    const unsigned G = gridDim.x * gridDim.y * gridDim.z;
    unsigned sum, cnt, mine, sp = 0u;
    for (;;) {
        sum = 0u; cnt = 0u; mine = 0u;
#pragma unroll
        for (unsigned j = 0; j < 16; ++j) { const unsigned c = xb_ld(&bar[XB_XCNT(j)]); sum += c; cnt += (c > 0u) ? 1u : 0u; mine = (j == x) ? c : mine; }
        if (sum == G) break;
        __builtin_amdgcn_s_sleep(1);
        if ((++sp & 255u) == 0u) { if (xb_ld(&bar[XB_TMO])) break; if (sp > XB_SPIN_CAP) { atomicAdd(&bar[XB_TMO], 1u); break; } }
    }
    nloc = mine > 0u ? mine : 1u; nx = cnt > 0u ? cnt : 1u;
}
__device__ __forceinline__ void xcd_barrier(const XcdBarrier& b_) {
    XcdBarrier b = b_;
    { unsigned long long bp = (unsigned long long)b_.bar; unsigned bx = b_.x; asm volatile("" : "+s"(bp), "+s"(bx)); b.bar = (unsigned*)(GAS unsigned*)bp; b.x = bx; }
    asm volatile("s_waitcnt vmcnt(0)" ::: "memory");
    __syncthreads();
    if (threadIdx.x == 0) {
        unsigned* bar = b.bar;
        __builtin_amdgcn_s_waitcnt(0);
        unsigned nloc = b.st[0], nx = b.st[1];
        if (nloc == 0u) { xcd_barrier_complete(bar, b.x, nloc, nx); b.st[0] = nloc; b.st[1] = nx; }
        const unsigned old = xb_add(&bar[XB_XSUB(b.x)], 1u);
        const unsigned gen = old / nloc;
        if (old + 1u == (gen + 1u) * nloc) {
            __builtin_amdgcn_fence(__ATOMIC_RELEASE, "agent");
            asm volatile("s_waitcnt vmcnt(0)" ::: "memory");
            const unsigned og = xb_add(&bar[XB_TOP], 1u);
            const unsigned tg = og / nx;
            if (og + 1u == (tg + 1u) * nx) xb_add(&bar[XB_TOPGEN], 1u);
            else XB_SPIN(xb_ld(&bar[XB_TOPGEN]) == tg, bar);
            __builtin_amdgcn_fence(__ATOMIC_ACQUIRE, "agent");
            xb_add(&bar[XB_XGEN(b.x)], 1u);
            asm volatile("s_waitcnt vmcnt(0)" ::: "memory");
        } else {
            XB_SPIN(xb_ld(&bar[XB_XGEN(b.x)]) == gen, bar);
            __builtin_amdgcn_fence(__ATOMIC_ACQUIRE, "agent");
            asm volatile("s_waitcnt vmcnt(0)" ::: "memory");
        }
    }
    __syncthreads();
}

constexpr int LDS_BYTES = 147456;
constexpr int MISC_OFF = 135168;
struct Args { const void* in[25]; float* out; unsigned char* ws; int g_lo, g_hi, l_lo, l_hi, ph_lo, ph_hi, prologue, pad; };
struct Frame { LAS unsigned char* lds; int tid, lane, wave; };
typedef const __attribute__((address_space(4))) Args* KArgs;
__device__ __forceinline__ KArgs kargs() { unsigned long long v = (unsigned long long)__builtin_amdgcn_kernarg_segment_ptr(); asm volatile("" : "+s"(v)); return (KArgs)v; }
#define KA_WS() KArgs ka = kargs(); unsigned char* ws = (unsigned char*)(GAS unsigned char*)ka->ws
#define KIN(i) ((const void*)(const GAS char*)ka->in[i])
#define KOUT() ((float*)(GAS float*)ka->out)
__device__ __forceinline__ Frame mkframe(LAS unsigned char* lds) { Frame F; int t = threadIdx.x; asm volatile("" : "+v"(t)); F.lds = lds; F.tid = t; F.lane = t & 63; F.wave = __builtin_amdgcn_readfirstlane(t >> 6); return F; }

namespace pg8 {
typedef short bf16x8 __attribute__((ext_vector_type(8)));
constexpr int BM = 256, BK = 64, HALF = 128, HTB = HALF * BK * 2, STAGE_BYTES = 8 * HTB, NXCD = 8, WGM = 8;
__host__ __device__ __forceinline__ int lds_byte(int r, int c) { const int st = (r >> 4) * 2 + (c >> 5), rr = r & 15, cc = c & 31, ob = rr * 64 + cc * 2; return st * 1024 + (ob ^ (((ob >> 9) & 1) << 5)); }
__host__ __device__ __forceinline__ void stage_rc(int b, int& R, int& C) { const int st = b / 1024, sb = b % 1024, swz = sb ^ (((sb >> 9) & 1) << 5); R = (st >> 1) * 16 + swz / 64; C = (st & 1) * 32 + (swz % 64) / 2; }
__host__ __device__ __forceinline__ int perm32(int rho) { const int n = rho >> 4, i = rho & 15; return 8 * (i >> 2) + 4 * n + (i & 3); }
struct Unit { int pm, pn, e, pos0, cnt; };
__device__ __forceinline__ int xcd_remap(int wgid, int nwg) { const int q = nwg / NXCD, r = nwg % NXCD, xcd = wgid % NXCD, off = wgid / NXCD; return (xcd < r ? xcd * (q + 1) : r * (q + 1) + (xcd - r) * q) + off; }
struct StaticOrder {
    int nM, nN, nwg, G, c;
    __device__ void init(int M, int N, int G_, int c_) { nM = M / BM; nN = N / BM; nwg = nM * nN; G = G_; c = c_; }
    __device__ bool next(int i, Unit& u) const {
        const long L = (long)i * G + c; if (L >= nwg) return false;
        const int wgid = xcd_remap((int)L, nwg);
        const int nig = WGM * nN, gid = wgid / nig, fm = gid * WGM, gsz = (nM - fm) < WGM ? (nM - fm) : WGM;
        u.pm = fm + ((wgid % nig) % gsz); u.pn = (wgid % nig) / gsz; u.e = 0; u.pos0 = 0; u.cnt = 0; return true;
    }
    __device__ __forceinline__ void a_ready(const Unit&) const {}
    __device__ __forceinline__ void done(const Unit&) const {}
};
template <int PART> struct SubOrder {
    StaticOrder so;
    __device__ void init(int M, int G_, int c_) { so.init(M, (PART == 0 ? 18 : 12) * BM, G_, c_); }
    __device__ bool next(int i, Unit& u) const { if (!so.next(i, u)) return false; u.pn = PART == 0 ? u.pn + 4 : (u.pn < 4 ? u.pn : u.pn + 18); return true; }
    __device__ __forceinline__ void a_ready(const Unit&) const {}
    __device__ __forceinline__ void done(const Unit&) const {}
};
struct MergeOrder {
    StaticOrder so;
    __device__ bool next(int i, Unit& u) const { if (!so.next(i / 3, u)) return false; u.e = i % 3; return true; }
    __device__ __forceinline__ void a_ready(const Unit&) const {}
    __device__ __forceinline__ void done(const Unit&) const {}
};
struct MoeOrder {
    const LAS int* tab; int G, c, NT;
    __device__ bool next(int i, Unit& u) const {
        const int np = __builtin_amdgcn_readfirstlane(tab[32]); const int nwg = np * NT;
        const long L = (long)i * G + c; if (L >= nwg) return false;
        const int wgid = xcd_remap((int)L, nwg);
        const int panel = wgid / NT; u.pn = wgid % NT;
        int e = 0;
#pragma unroll
        for (int s2 = 16; s2 >= 1; s2 >>= 1) { const int tv = __builtin_amdgcn_readfirstlane(tab[e + s2]); if (tv <= panel) e += s2; }
        u.e = e; u.pm = panel; u.pos0 = (panel - __builtin_amdgcn_readfirstlane(tab[e])) * 256; u.cnt = __builtin_amdgcn_readfirstlane(tab[33 + e]); return true;
    }
    __device__ __forceinline__ void a_ready(const Unit&) const {}
    __device__ __forceinline__ void done(const Unit&) const {}
};
__device__ __forceinline__ unsigned cvt_pk_bf16(float lo, float hi) { unsigned r; asm volatile("v_cvt_pk_bf16_f32 %0, %1, %2" : "=v"(r) : "v"(lo), "v"(hi)); return r; }

template <class Prob, class Epi, class Sched, bool ALIGN_EPI>
__device__ __forceinline__ void gemm_phase(LAS unsigned char* lds, const Prob& P, const Sched& S, const Epi& E) {
    int tid_ = threadIdx.x; asm volatile("" : "+v"(tid_));
    const int tid = tid_, wid = __builtin_amdgcn_readfirstlane(tid >> 6), lane = tid & 63, wr = wid >> 2, wc = wid & 3, fr = lane & 15, fq = lane >> 4;
    const int K = P.K, nt = K / BK;
    unsigned vA[2][2], voffB[2];
#pragma unroll
    for (int i = 0; i < 2; ++i) { int R, C; stage_rc(tid * 16 + i * 8192, R, C); const int Rb = (R & ~31) + perm32(R & 31);
        vA[0][i] = (unsigned)(R * K + C) * 2u; vA[1][i] = vA[0][i] + (unsigned)(HALF * K * 2); voffB[i] = (unsigned)(Rb * K + C) * 2u; }
    const size_t kstep = (size_t)(BK * 2);
    const size_t hstep = (size_t)HALF * K * 2;
    const unsigned ldsw = (unsigned)wid * 1024u;
    const int aoff = lds_byte(wr * 64 + fr, fq * 8), boff = lds_byte(wc * 32 + fr, fq * 8);
#define PG8_SA(b, h) (((b) * 2 + (h)) * HTB)
#define PG8_SB(b, h) ((4 + (b) * 2 + (h)) * HTB)
#define PG8_STAGE(bufoff, gbase, voff) do { _Pragma("unroll") for (int _i = 0; _i < 2; ++_i) \
        __builtin_amdgcn_global_load_lds((const unsigned*)((const char*)(gbase) + (voff)[_i]), (LAS unsigned*)(lds + (bufoff) + ldsw + _i * 8192), 16, 0, 0); } while (0)
#define PG8_LDA(dst, b, h) do { _Pragma("unroll") for (int m = 0; m < 4; ++m) _Pragma("unroll") for (int k = 0; k < 2; ++k) dst[m][k] = *(const LAS bf16x8*)(lds + PG8_SA(b, h) + aoff + m * 2048 + k * 1024); } while (0)
#define PG8_LDB(dst, b, h) do { _Pragma("unroll") for (int n = 0; n < 2; ++n) _Pragma("unroll") for (int k = 0; k < 2; ++k) dst[n][k] = *(const LAS bf16x8*)(lds + PG8_SB(b, h) + boff + n * 2048 + k * 1024); } while (0)
#define PG8_MMA(ai, bj, At, Bt) do { __builtin_amdgcn_s_setprio(1); _Pragma("unroll") for (int m = 0; m < 4; ++m) _Pragma("unroll") for (int n = 0; n < 2; ++n) _Pragma("unroll") for (int k = 0; k < 2; ++k) \
        acc[ai][bj][m][n] = __builtin_amdgcn_mfma_f32_16x16x32_bf16(Bt[n][k], At[m][k], acc[ai][bj][m][n], 0, 0, 0); __builtin_amdgcn_s_setprio(0); } while (0)
#define PG8_WAIT_V(n) asm volatile("s_waitcnt vmcnt(" #n ")" ::: "memory")
#define PG8_WAIT_L(n) asm volatile("s_waitcnt lgkmcnt(" #n ")" ::: "memory")
#define PG8_BAR __builtin_amdgcn_s_barrier()
#define PG8_SCHED __builtin_amdgcn_sched_barrier(0)
    Unit cur, nxt; int ui = 0;
    if (!S.next(0, cur)) return;
    f32x4 acc[2][2][4][2];
#pragma unroll
    for (int a = 0; a < 2; ++a)
#pragma unroll
        for (int b = 0; b < 2; ++b)
#pragma unroll
            for (int m = 0; m < 4; ++m)
#pragma unroll
                for (int n = 0; n < 2; ++n) acc[a][b][m][n] = (f32x4){0.f, 0.f, 0.f, 0.f};
    bf16x8 At[4][2], B0[2][2], B1[2][2];
    const char* cA = P.abase(cur); const char* cB = P.bbase(cur);
    if constexpr (Prob::GATHER) P.voff(cur, tid, vA);
    S.a_ready(cur);
    PG8_STAGE(PG8_SB(0, 0), cB, voffB); PG8_STAGE(PG8_SB(0, 1), cB + hstep, voffB); PG8_STAGE(PG8_SA(0, 0), cA, vA[0]); PG8_STAGE(PG8_SA(0, 1), cA, vA[1]);
    if (wr == 1) PG8_BAR;
    PG8_WAIT_V(2); PG8_BAR;
    PG8_STAGE(PG8_SB(1, 0), cB + kstep, voffB); PG8_STAGE(PG8_SA(1, 0), cA + kstep, vA[0]); PG8_STAGE(PG8_SB(1, 1), cB + hstep + kstep, voffB);
    PG8_WAIT_V(6); PG8_BAR;
    for (;;) {
        const bool has_next = S.next(ui + 1, nxt);
        const char* nA = has_next ? P.abase(nxt) : cA; const char* nB = has_next ? P.bbase(nxt) : cB;
        unsigned nv[2][2];
#pragma unroll
        for (int h = 0; h < 2; ++h)
#pragma unroll
            for (int i = 0; i < 2; ++i) nv[h][i] = vA[h][i];
        for (int t = 0; t < nt; t += 2) {
            const bool last = (t == nt - 2);
            if constexpr (Prob::GATHER) { if (t == nt - 4 && has_next) P.voff(nxt, tid, nv); }
            const char* a1 = cA + (size_t)(t + 1) * kstep;
            const char* a2 = last ? nA : cA + (size_t)(t + 2) * kstep; const char* b2 = last ? nB : cB + (size_t)(t + 2) * kstep;
            const char* a3 = a2 + kstep; const char* b3 = b2 + kstep;
            if (last && has_next) S.a_ready(nxt);
            unsigned w0[2], w1[2];
#pragma unroll
            for (int i = 0; i < 2; ++i) { if constexpr (Prob::GATHER) { w0[i] = last ? nv[0][i] : vA[0][i]; w1[i] = last ? nv[1][i] : vA[1][i]; } else { w0[i] = vA[0][i]; w1[i] = vA[1][i]; } }
            PG8_LDB(B0, 0, 0); PG8_LDB(B1, 0, 1); PG8_SCHED; PG8_LDA(At, 0, 0); PG8_STAGE(PG8_SA(1, 1), a1, vA[1]);
            PG8_WAIT_V(8); PG8_WAIT_L(0); PG8_BAR; PG8_MMA(0, 0, At, B0); PG8_MMA(0, 1, At, B1); PG8_BAR; PG8_SCHED;
            PG8_LDA(At, 0, 1); PG8_STAGE(PG8_SB(0, 0), b2, voffB); PG8_STAGE(PG8_SB(0, 1), b2 + hstep, voffB); PG8_STAGE(PG8_SA(0, 0), a2, w0);
            PG8_WAIT_V(8); PG8_WAIT_L(0); PG8_BAR; PG8_MMA(1, 0, At, B0); PG8_MMA(1, 1, At, B1); PG8_BAR; PG8_SCHED;
            PG8_LDB(B0, 1, 0); PG8_LDB(B1, 1, 1); PG8_SCHED; PG8_LDA(At, 1, 0); PG8_STAGE(PG8_SA(0, 1), a2, w1);
            PG8_WAIT_V(8); PG8_WAIT_L(0); PG8_BAR; PG8_MMA(0, 0, At, B0); PG8_MMA(0, 1, At, B1); PG8_BAR; PG8_SCHED;
            PG8_LDA(At, 1, 1); PG8_STAGE(PG8_SB(1, 0), b3, voffB); PG8_STAGE(PG8_SB(1, 1), b3 + hstep, voffB); PG8_STAGE(PG8_SA(1, 0), a3, w0);
            PG8_WAIT_V(8); PG8_WAIT_L(0); PG8_BAR; PG8_MMA(1, 0, At, B0); PG8_MMA(1, 1, At, B1); PG8_BAR; PG8_SCHED;
        }
        if constexpr (ALIGN_EPI) { if (wr == 0) PG8_BAR; }
        E(acc, cur, wr, wc, fr, fq); S.done(cur);
        if (!has_next) break;
        if (!(Epi::CARRY && nxt.e != 0))
#pragma unroll
        for (int a = 0; a < 2; ++a)
#pragma unroll
            for (int b = 0; b < 2; ++b)
#pragma unroll
                for (int m = 0; m < 4; ++m)
#pragma unroll
                    for (int n = 0; n < 2; ++n) acc[a][b][m][n] = (f32x4){0.f, 0.f, 0.f, 0.f};
        cur = nxt; cA = nA; cB = nB; ++ui;
        if constexpr (Prob::GATHER) {
#pragma unroll
            for (int h = 0; h < 2; ++h)
#pragma unroll
                for (int i = 0; i < 2; ++i) vA[h][i] = nv[h][i]; }
        if constexpr (ALIGN_EPI) { if (wr == 1) PG8_BAR; }
    }
    PG8_WAIT_V(0);
    if constexpr (!ALIGN_EPI) { if (wr == 0) PG8_BAR; }
    PG8_BAR;
#undef PG8_SA
#undef PG8_SB
#undef PG8_STAGE
#undef PG8_LDA
#undef PG8_LDB
#undef PG8_MMA
#undef PG8_WAIT_V
#undef PG8_WAIT_L
#undef PG8_BAR
#undef PG8_SCHED
}
struct ProbDense { static constexpr bool GATHER = false; const char* A; const char* Bt; int K;
    __device__ __forceinline__ const char* abase(const Unit& u) const { return A + (size_t)u.pm * 256 * K * 2; }
    __device__ __forceinline__ const char* bbase(const Unit& u) const { return Bt + (size_t)u.pn * 256 * K * 2; }
    __device__ __forceinline__ void voff(const Unit&, int, unsigned (&)[2][2]) const {} };
struct ProbMerge { static constexpr bool GATHER = false; const char* Y0; const char* Y1; const char* Y2; const char* W; int K;
    __device__ __forceinline__ const char* abase(const Unit& u) const { const char* y = u.e == 0 ? Y0 : (u.e == 1 ? Y1 : Y2); return y + (size_t)u.pm * 256 * K * 2; }
    __device__ __forceinline__ const char* bbase(const Unit& u) const { return W + ((size_t)u.e * 1024 + u.pn * 256) * K * 2; }
    __device__ __forceinline__ void voff(const Unit&, int, unsigned (&)[2][2]) const {} };
struct ProbMoe1 { static constexpr bool GATHER = true; const char* X1; const char* W; const int* TOK; int K;
    __device__ __forceinline__ const char* abase(const Unit&) const { return X1; }
    __device__ __forceinline__ const char* bbase(const Unit& u) const { return W + ((size_t)u.e * 1024 + u.pn * 256) * K * 2; }
    __device__ __forceinline__ void voff(const Unit& u, int tid, unsigned (&v)[2][2]) const {
#pragma unroll
        for (int i = 0; i < 2; ++i) { int R, C; stage_rc(tid * 16 + i * 8192, R, C);
#pragma unroll
            for (int h = 0; h < 2; ++h) { const int pos = u.pos0 + h * 128 + R; int tk = TOK[(size_t)u.e * TG + pos]; tk = pos < u.cnt ? tk : 0; v[h][i] = (unsigned)tk * (unsigned)(K * 2) + (unsigned)C * 2u; } } } };
struct ProbMoe2 { static constexpr bool GATHER = false; const char* HM; const char* W; int K;
    __device__ __forceinline__ const char* abase(const Unit& u) const { return HM + (size_t)u.pm * 256 * K * 2; }
    __device__ __forceinline__ const char* bbase(const Unit& u) const { return W + ((size_t)u.e * 1024 + u.pn * 256) * K * 2; }
    __device__ __forceinline__ void voff(const Unit&, int, unsigned (&)[2][2]) const {} };

__device__ __forceinline__ float fsig(float z) { return __builtin_amdgcn_rcpf(1.f + __expf(-z)); }
__device__ __forceinline__ float hg_logf_fast(float z, float lb) {
    const float t = __expf(-fabsf(z)), sg = t * __builtin_amdgcn_rcpf(1.f + t), w = (1.f - lb) * sg;
    return __logf(z >= 0.f ? 1.f - w : lb + w);
}
__device__ __forceinline__ void st8(bf16* p, const f32x4& a, const f32x4& b) { u32x4 w; w.x = cvt_pk_bf16(a[0], a[1]); w.y = cvt_pk_bf16(a[2], a[3]); w.z = cvt_pk_bf16(b[0], b[1]); w.w = cvt_pk_bf16(b[2], b[3]); *(u32x4*)p = w; }
struct EpiInProj {
    static constexpr bool PERM = true, CARRY = false;
    bf16 *U, *Q, *V, *GATE; const float* rot; const float* lbt; const float* bg;
    __device__ __forceinline__ void operator()(const f32x4 (&acc)[2][2][4][2], const Unit& u, int wr, int wc, int fr, int fq) const {
        const int pn = u.pn, rowb = u.pm * 256 + wr * 64 + fr, cl = wc * 32 + 8 * fq;
        if (pn < 4) {
#pragma unroll
            for (int ai = 0; ai < 2; ++ai)
#pragma unroll
                for (int m = 0; m < 4; ++m) { const int row = rowb + ai * 128 + m * 16; f32x4 o0, o1;
#pragma unroll
                    for (int j = 0; j < 4; ++j) { o0[j] = acc[ai][0][m][0][j] * fsig(acc[ai][1][m][0][j]); o1[j] = acc[ai][0][m][1][j] * fsig(acc[ai][1][m][1][j]); }
                    st8(U + (size_t)row * 512 + pn * 128 + cl, o0, o1); asm volatile("" ::: "memory"); }
        } else if (pn < 8) {
            const int which = pn - 4; bf16* dst = Q + (size_t)(which >> 1) * HSTRIDE; const float sc = (which >> 1) ? 1.f : 0.125f * 1.4426950408889634f; const int colb = (which & 1) * 256 + cl;
            const bool rotw = (wc & 1) == 0; const float sgn = fq == 0 ? -1.f : 1.f;
#pragma unroll
            for (int ai = 0; ai < 2; ++ai) {
                f32x4 cs[4][4];
#pragma unroll
                for (int m = 0; m < 4; ++m) { cs[m][0] = (f32x4){1.f, 1.f, 1.f, 1.f}; cs[m][1] = cs[m][0]; cs[m][2] = (f32x4){0.f, 0.f, 0.f, 0.f}; cs[m][3] = cs[m][2];
                    if (rotw && fq < 2) { const f32x4* rp = (const f32x4*)(rot + (size_t)(rowb + ai * 128 + m * 16) * 16); cs[m][0] = rp[0]; cs[m][1] = rp[1]; cs[m][2] = rp[2]; cs[m][3] = rp[3]; } }
#pragma unroll
                for (int m = 0; m < 4; ++m) { const int row = rowb + ai * 128 + m * 16;
                    const f32x4 c0 = cs[m][0], c1 = cs[m][1], s0 = cs[m][2] * sgn, s1 = cs[m][3] * sgn;
#pragma unroll
                    for (int bj = 0; bj < 2; ++bj) { f32x4 x0 = acc[ai][bj][m][0], x1 = acc[ai][bj][m][1];
                        if (rotw) { f32x4 p0, p1;
#pragma unroll
                            for (int j = 0; j < 4; ++j) { p0[j] = __shfl_xor(x0[j], 16); p1[j] = __shfl_xor(x1[j], 16); }
                            x0 = x0 * c0 + p0 * s0; x1 = x1 * c1 + p1 * s1; }
                        st8(dst + (size_t)row * 512 + colb + bj * 128, x0 * sc, x1 * sc); } }
                asm volatile("" ::: "memory"); }
        } else {
            int kind, ldc, colb; bf16* dst; bool seqc = false;
            if (pn < 18) { const int tq = (pn - 8) >> 1; seqc = tq >= 1; kind = tq == 0 ? 0 : (tq == 1 ? 1 : (tq == 2 ? 2 : (tq == 3 ? 0 : 1))); dst = V + (size_t)tq * HSTRIDE; ldc = 512; colb = ((pn - 8) & 1) * 256; }
            else { kind = 3; dst = GATE; ldc = 3072; colb = (pn - 18) * 256; }
            f32x4 aux[2][2];
#pragma unroll
            for (int bj = 0; bj < 2; ++bj)
#pragma unroll
                for (int n = 0; n < 2; ++n) aux[bj][n] = kind == 2 ? *(const f32x4*)(lbt + colb + bj * 128 + cl + 4 * n) : (kind == 3 ? *(const f32x4*)(bg + colb + bj * 128 + cl + 4 * n) : (f32x4){0.f, 0.f, 0.f, 0.f});
#pragma unroll
            for (int ai = 0; ai < 2; ++ai)
#pragma unroll
                for (int m = 0; m < 4; ++m) { const int row = rowb + ai * 128 + m * 16;
#pragma unroll
                    for (int bj = 0; bj < 2; ++bj) { f32x4 x[2] = {acc[ai][bj][m][0], acc[ai][bj][m][1]};
                        if (kind == 1) {
#pragma unroll
                            for (int n = 0; n < 2; ++n)
#pragma unroll
                                for (int j = 0; j < 4; ++j) x[n][j] = x[n][j] * fsig(x[n][j]);
                        } else if (kind == 2) {
#pragma unroll
                            for (int n = 0; n < 2; ++n)
#pragma unroll
                                for (int j = 0; j < 4; ++j) x[n][j] = hg_logf_fast(x[n][j], aux[bj][n][j]);
                        } else if (kind == 3) {
#pragma unroll
                            for (int n = 0; n < 2; ++n)
#pragma unroll
                                for (int j = 0; j < 4; ++j) x[n][j] = fsig(x[n][j] + aux[bj][n][j]);
                        }
                        const size_t di = seqc ? ((size_t)((row >> 11) * 4 + (colb >> 7) + bj) * 2048 + (row & 2047)) * 128 + cl : (size_t)row * ldc + colb + bj * 128 + cl;
                        st8(dst + di, x[0], x[1]); } asm volatile("" ::: "memory"); }
        }
    }
};
struct EpiMerge {
    static constexpr bool PERM = true, CARRY = true;
    const bf16* GATE; bf16* M;
    __device__ __forceinline__ void operator()(f32x4 (&acc)[2][2][4][2], const Unit& u, int wr, int wc, int fr, int fq) const {
        const int rowb = u.pm * 256 + wr * 64 + fr, cl = u.pn * 256 + wc * 32 + 8 * fq, n = u.e;
#pragma unroll
        for (int ai = 0; ai < 2; ++ai) {
            u32x4 g[4][2], h[4][2];
#pragma unroll
            for (int m = 0; m < 4; ++m)
#pragma unroll
                for (int bj = 0; bj < 2; ++bj) { const bf16* gp = GATE + (size_t)(rowb + ai * 128 + m * 16) * 3072 + n * 1024 + cl + bj * 128;
                    g[m][bj] = *(const u32x4*)gp; h[m][bj] = g[m][bj]; if (n < 2) h[m][bj] = *(const u32x4*)(gp + 1024); }
#pragma unroll
            for (int m = 0; m < 4; ++m)
#pragma unroll
                for (int bj = 0; bj < 2; ++bj) { const u32x4 gg = g[m][bj], hh = h[m][bj];
                    f32x4 s0 = (f32x4){lo16(gg.x), hi16(gg.x), lo16(gg.y), hi16(gg.y)}, s1 = (f32x4){lo16(gg.z), hi16(gg.z), lo16(gg.w), hi16(gg.w)};
                    if (n < 2) {
                        const f32x4 d0 = (f32x4){lo16(hh.x), hi16(hh.x), lo16(hh.y), hi16(hh.y)}, d1 = (f32x4){lo16(hh.z), hi16(hh.z), lo16(hh.w), hi16(hh.w)};
#pragma unroll
                        for (int j = 0; j < 4; ++j) { s0[j] *= __builtin_amdgcn_rcpf(fmaxf(d0[j], 1e-20f)); s1[j] *= __builtin_amdgcn_rcpf(fmaxf(d1[j], 1e-20f)); }
                        acc[ai][bj][m][0] = acc[ai][bj][m][0] * s0; acc[ai][bj][m][1] = acc[ai][bj][m][1] * s1;
                    } else st8(M + (size_t)(rowb + ai * 128 + m * 16) * D + cl + bj * 128, acc[ai][bj][m][0] * s0, acc[ai][bj][m][1] * s1); }
            asm volatile("" ::: "memory"); }
    }
};
struct EpiWout {
    static constexpr bool PERM = true, CARRY = false;
    const bf16* XB; bf16* R;
    __device__ __forceinline__ void operator()(const f32x4 (&acc)[2][2][4][2], const Unit& u, int wr, int wc, int fr, int fq) const {
        const int rowb = u.pm * 256 + wr * 64 + fr, cl = u.pn * 256 + wc * 32 + 8 * fq;
#pragma unroll
        for (int ai = 0; ai < 2; ++ai) {
            u32x4 g[4][2];
#pragma unroll
            for (int m = 0; m < 4; ++m)
#pragma unroll
                for (int bj = 0; bj < 2; ++bj) g[m][bj] = *(const u32x4*)(XB + (size_t)(rowb + ai * 128 + m * 16) * D + cl + bj * 128);
#pragma unroll
            for (int m = 0; m < 4; ++m)
#pragma unroll
                for (int bj = 0; bj < 2; ++bj) { const size_t o = (size_t)(rowb + ai * 128 + m * 16) * D + cl + bj * 128; const u32x4 gg = g[m][bj];
                    st8(R + o, acc[ai][bj][m][0] + (f32x4){lo16(gg.x), hi16(gg.x), lo16(gg.y), hi16(gg.y)} * ALPHA, acc[ai][bj][m][1] + (f32x4){lo16(gg.z), hi16(gg.z), lo16(gg.w), hi16(gg.w)} * ALPHA); }
            asm volatile("" ::: "memory"); }
    }
};
struct EpiMoe1 {
    static constexpr bool PERM = true, CARRY = false;
    bf16* HM;
    __device__ __forceinline__ void operator()(const f32x4 (&acc)[2][2][4][2], const Unit& u, int wr, int wc, int fr, int fq) const {
        const int rowb = u.pm * 256 + wr * 64 + fr, cl = u.pn * 128 + wc * 32 + 8 * fq;
#pragma unroll
        for (int ai = 0; ai < 2; ++ai)
#pragma unroll
            for (int m = 0; m < 4; ++m) { const int row = rowb + ai * 128 + m * 16; f32x4 o0, o1;
#pragma unroll
                for (int j = 0; j < 4; ++j) { const float a = acc[ai][0][m][0][j], b = acc[ai][0][m][1][j]; o0[j] = a * fsig(a) * acc[ai][1][m][0][j]; o1[j] = b * fsig(b) * acc[ai][1][m][1][j]; }
                st8(HM + (size_t)row * DE + cl, o0, o1); }
    }
};
struct EpiMoe2 {
    static constexpr bool PERM = true, CARRY = false;
    bf16* OM;
    __device__ __forceinline__ void operator()(const f32x4 (&acc)[2][2][4][2], const Unit& u, int wr, int wc, int fr, int fq) const {
        const int rowb = u.pm * 256 + wr * 64 + fr, cl = u.pn * 256 + wc * 32 + 8 * fq;
#pragma unroll
        for (int ai = 0; ai < 2; ++ai)
#pragma unroll
            for (int m = 0; m < 4; ++m) { const int row = rowb + ai * 128 + m * 16;
#pragma unroll
                for (int bj = 0; bj < 2; ++bj) st8(OM + (size_t)row * D + cl + bj * 128, acc[ai][bj][m][0], acc[ai][bj][m][1]); }
    }
};
}

__device__ __forceinline__ void p_prologue(Frame& F_) {
    KA_WS();
    Frame F = mkframe(F_.lds);
    const int gt = blockIdx.x * NTHR + F.tid, NT = gridDim.x * NTHR;
    const int* pos = (const int*)KIN(1);
    float* rot = (float*)(ws + WS_ROT);
    for (int i = gt; i < T * 8; i += NT) {
        const int t = i >> 3, f = i & 7;
        const double invf[8] = {1.0, 0.19392274474868576, 0.03760603093086393, 0.007292664737217109, 0.001414213562373095, 0.0002742481756762073, 5.318295896944988e-05, 1.031338537721246e-05};
        double w = 1.0;
#pragma unroll
        for (int j = 0; j < 8; ++j) w = (f == j) ? invf[j] : w;
        const double ang = (double)pos[t] * w;
        const double n = rint(ang * 0.15915494309189535); const double r = (ang - n * 6.283185307179586) - n * 2.4492935982947064e-16;
        rot[t * 16 + f] = cosf((float)r); rot[t * 16 + 8 + f] = sinf((float)r);
    }
    { bf16* rw = (bf16*)(ws + WS_RW);
      for (int i = gt; i < 2 * 48 * 1024; i += NT) { const int l2 = i / (48 * 1024), j = (i / 1024) % 48, d = i & 1023; float w = 0.f;
          if (j < 4) w = ((const float*)KIN(16))[((size_t)l2 * D + d) * 4 + j];
          else if (j < 36) w = ((const float*)KIN(18))[(((size_t)l2 * 4 + ((j - 4) >> 3)) * D + d) * 8 + ((j - 4) & 7)];
          const unsigned hb = f2bf(w); const float hf = __uint_as_float(hb << 16);
          rw[((size_t)l2 * 2 + 0) * 48 * 1024 + j * 1024 + d] = (bf16)hb; rw[((size_t)l2 * 2 + 1) * 48 * 1024 + j * 1024 + d] = (bf16)f2bf(w - hf); } }
    float* lbt = (float*)(ws + WS_LB);
    const float* hg_lb = (const float*)KIN(9);
    for (int i = gt; i < 512; i += NT) { const float a0 = hg_lb[i], a1 = hg_lb[512 + i]; lbt[i] = 0.f; lbt[512 + i] = 1.f / (1.f + expf(a0 - a1)); }
    if (gt < 2) {
        const float* lp = (const float*)KIN(7) + gt * 256; float s1 = 0.f, s2 = 0.f;
        for (int i = 0; i < 64; ++i) { s1 += lp[i] * lp[64 + i]; s2 += lp[128 + i] * lp[192 + i]; }
        const float lam_init = gt == 0 ? 0.2f : 0.35550906759096934f;
        lbt[1024 + gt] = expf(s1) - expf(s2) + lam_init;
    }
}
__device__ __forceinline__ void p_xload(Frame& F_, int g) {
    KA_WS();
    Frame F = mkframe(F_.lds);
    const f32x4* x = (const f32x4*)((const float*)KIN(0) + (size_t)g * TG * D);
    u32x2* o = (u32x2*)((bf16*)(ws + WS_XB));
    for (size_t i = (size_t)blockIdx.x * NTHR + F.tid; i < (size_t)TG * D / 4; i += (size_t)gridDim.x * NTHR) { const f32x4 v = x[i]; u32x2 w; w.x = pk2(v.x, v.y); w.y = pk2(v.z, v.w); o[i] = w; }
}

__device__ __forceinline__ void p2_conv(Frame& F_, int l) {
    KA_WS();
    Frame F = mkframe(F_.lds);
    const float* cw = (const float*)KIN(3) + (size_t)l * 31 * 512; const float* cb = (const float*)KIN(4) + l * 512;
    const float* lg = (const float*)KIN(5) + l * 512; const float* lb = (const float*)KIN(6) + l * 512;
    const int c0 = F.lane * 8; const int per = TG / (gridDim.x * NWAVES);
    const int tbeg = (blockIdx.x * NWAVES + F.wave) * per;
    for (int t = tbeg; t < tbeg + per; ++t) {
        const int s = t & (S - 1);
        float acc[8];
        { const f32x4 b0 = *(const f32x4*)(cb + c0), b1 = *(const f32x4*)(cb + c0 + 4); acc[0] = b0.x; acc[1] = b0.y; acc[2] = b0.z; acc[3] = b0.w; acc[4] = b1.x; acc[5] = b1.y; acc[6] = b1.z; acc[7] = b1.w; }
        for (int j = 0; j < 31; ++j) {
            const int sj = s - 30 + j; if (sj < 0) continue;
            const u32x4 uv = *(const u32x4*)(((bf16*)(ws + WS_U)) + (size_t)(t - 30 + j) * 512 + c0);
            const f32x4 w0 = *(const f32x4*)(cw + j * 512 + c0), w1 = *(const f32x4*)(cw + j * 512 + c0 + 4);
            acc[0] += lo16(uv.x) * w0.x; acc[1] += hi16(uv.x) * w0.y; acc[2] += lo16(uv.y) * w0.z; acc[3] += hi16(uv.y) * w0.w;
            acc[4] += lo16(uv.z) * w1.x; acc[5] += hi16(uv.z) * w1.y; acc[6] += lo16(uv.w) * w1.z; acc[7] += hi16(uv.w) * w1.w;
        }
        float sm = 0.f;
#pragma unroll
        for (int i = 0; i < 8; ++i) sm += acc[i];
        const float mean = wave_sum(sm) * (1.f / 512.f); float sq = 0.f;
#pragma unroll
        for (int i = 0; i < 8; ++i) { acc[i] -= mean; sq += acc[i] * acc[i]; }
        const float rstd = __builtin_amdgcn_rsqf(wave_sum(sq) * (1.f / 512.f) + EPS);
        float y[8];
#pragma unroll
        for (int i = 0; i < 8; ++i) { const float z = acc[i] * rstd * lg[c0 + i] + lb[c0 + i]; y[i] = z * __builtin_amdgcn_rcpf(1.f + __expf(-z)); }
        u32x4 o; o.x = pk2(y[0], y[1]); o.y = pk2(y[2], y[3]); o.z = pk2(y[4], y[5]); o.w = pk2(y[6], y[7]);
        *(u32x4*)(((bf16*)(ws + WS_YA)) + (size_t)t * 512 + c0) = o;
    }
}

__device__ __forceinline__ void p2_conv_unit(Frame& F, unsigned char* ws, KArgs ka, int l, int cu) {
    const float* cw = (const float*)KIN(3) + (size_t)l * 31 * 512; const float* cb = (const float*)KIN(4) + l * 512;
    const float* lg = (const float*)KIN(5) + l * 512; const float* lb = (const float*)KIN(6) + l * 512;
    const bf16* __restrict__ U = (const bf16*)(ws + WS_U); bf16* __restrict__ YA = (bf16*)(ws + WS_YA);
    LAS float* Yt = (LAS float*)F.lds;
    const int lane = F.lane, wave = F.wave, hf = wave >> 2, c = 128 * (wave & 3) + 2 * lane;
    const int tb = cu * 64 + 32 * hf, sb = tb & (S - 1);
    f32x2 wt[31], uf[62];
#pragma unroll
    for (int j = 0; j < 31; ++j) wt[j] = *(const f32x2*)(cw + j * 512 + c);
#pragma unroll
    for (int k = 0; k < 62; ++k) { unsigned w = 0u; if (sb - 30 + k >= 0) w = *(const unsigned*)(U + (size_t)(tb - 30 + k) * 512 + c); uf[k] = (f32x2){lo16(w), hi16(w)}; }
    const f32x2 bias = *(const f32x2*)(cb + c);
    __syncthreads();
#pragma unroll
    for (int tt = 0; tt < 32; ++tt) { f32x2 acc = bias;
#pragma unroll
        for (int j = 0; j < 31; ++j) acc = acc + uf[tt + j] * wt[j];
        *(LAS f32x2*)(Yt + (32 * hf + tt) * 512 + c) = acc; }
    __syncthreads();
    const int c0 = lane * 8;
#pragma unroll 2
    for (int i = 0; i < 8; ++i) { const int tl = wave * 8 + i;
        const f32x4 a0 = *(const LAS f32x4*)(Yt + tl * 512 + c0), a1 = *(const LAS f32x4*)(Yt + tl * 512 + c0 + 4);
        float acc[8] = {a0.x, a0.y, a0.z, a0.w, a1.x, a1.y, a1.z, a1.w};
        float sm = 0.f;
#pragma unroll
        for (int q = 0; q < 8; ++q) sm += acc[q];
        const float mean = wave_sum(sm) * (1.f / 512.f); float sq = 0.f;
#pragma unroll
        for (int q = 0; q < 8; ++q) { acc[q] -= mean; sq += acc[q] * acc[q]; }
        const float rstd = __builtin_amdgcn_rsqf(wave_sum(sq) * (1.f / 512.f) + EPS);
        const f32x4 g0 = *(const f32x4*)(lg + c0), g1 = *(const f32x4*)(lg + c0 + 4), b0 = *(const f32x4*)(lb + c0), b1 = *(const f32x4*)(lb + c0 + 4);
        const float gg[8] = {g0.x, g0.y, g0.z, g0.w, g1.x, g1.y, g1.z, g1.w}, bb[8] = {b0.x, b0.y, b0.z, b0.w, b1.x, b1.y, b1.z, b1.w};
        float y[8];
#pragma unroll
        for (int q = 0; q < 8; ++q) { const float z = acc[q] * rstd * gg[q] + bb[q]; y[q] = z * __builtin_amdgcn_rcpf(1.f + __expf(-z)); }
        u32x4 o; o.x = pk2(y[0], y[1]); o.y = pk2(y[2], y[3]); o.z = pk2(y[4], y[5]); o.w = pk2(y[6], y[7]);
        *(u32x4*)(YA + (size_t)(cu * 64 + tl) * 512 + c0) = o;
    }
    __syncthreads();
}
#include <hip/hip_bf16.h>
#include <cmath>
namespace attn_body {
using bf16=__hip_bfloat16;
using bf16x8=__attribute__((ext_vector_type(8)))short;
using s16x4=__attribute__((ext_vector_type(4)))short;
using f32x16=__attribute__((ext_vector_type(16)))float;
using u32x4=__attribute__((ext_vector_type(4)))unsigned;
constexpr int SEQ=2048,D=64,DMI=512,DMO=1024;
constexpr int NW=8,QBLK=32,QB=QBLK*NW,KVBLK=64,NQB=SEQ/QB;
constexpr int ATTN_UNIT_ROWS=QB;
__device__ __forceinline__ int crow(int r,int hi){return (r&3)+8*(r>>2)+4*hi;}
#define SBAR() __builtin_amdgcn_sched_barrier(0)
__device__ __forceinline__ void cmask(f32x16&p0,f32x16&p1,int jb,int qrel,int hi){
  const float NEG=-INFINITY; int kb=64*jb+4*hi;
  #pragma unroll
  for(int r=0;r<16;++r){int kv=kb+(r&3)+8*(r>>2); if(kv>qrel)p0[r]=NEG; if(kv+32>qrel)p1[r]=NEG;}
}

constexpr int NSLOT=3, SLOTB=8192;
constexpr int LDS_K=0, LDS_V=NSLOT*SLOTB, LDS_WS=2*NSLOT*SLOTB, LDS_OST=LDS_WS+NW*64*4, LDS_BYTES=LDS_OST+NW*4096;
constexpr float C2=0.125f*1.4426950408889634f;
__device__ __forceinline__ void glds16(const void*gsrc,unsigned lds_dst){unsigned keep;
  asm volatile("s_mov_b32 %0, m0\n\ts_mov_b32 m0, %2\n\ts_nop 0\n\tglobal_load_lds_dwordx4 %1, off\n\ts_mov_b32 m0, %0":"=&s"(keep):"v"(gsrc),"s"(lds_dst):"memory");}
__device__ __forceinline__ float max3f(float a,float b,float c){float r;asm("v_max3_f32 %0, %1, %2, %3":"=v"(r):"v"(a),"v"(b),"v"(c));return r;}
__device__ __forceinline__ float max2f(float a,float b){float r;asm("v_max_f32_e32 %0, %1, %2":"=v"(r):"v"(a),"v"(b));return r;}
__device__ __forceinline__ float fadd_s(float a,float b){float r;asm("v_add_f32_e32 %0, %1, %2":"=v"(r):"v"(a),"v"(b));return r;}
__device__ __forceinline__ float fsub_s(float a,float b){float r;asm("v_sub_f32_e32 %0, %1, %2":"=v"(r):"v"(a),"v"(b));return r;}
typedef float f32x2_t __attribute__((ext_vector_type(2))); typedef __bf16 bf16x2_t __attribute__((ext_vector_type(2)));
__device__ __forceinline__ unsigned cvtpk_s(float lo,float hi){f32x2_t v={lo,hi};bf16x2_t b=__builtin_convertvector(v,bf16x2_t);return __builtin_bit_cast(unsigned,b);}
#define WAIT_BAR(N) asm volatile("s_waitcnt vmcnt(" #N ") lgkmcnt(0)\n\ts_barrier":::"memory")

__device__ __forceinline__ void qkt(f32x16&p0,f32x16&p1,const char*Kslot,const bf16x8*qr,const f32x16&negm,int r32,int hi){
  const char*kb=Kslot+hi*1024+r32*16;
  #pragma unroll
  for(int d0=0;d0<4;++d0){
    const bf16x8 b0=*reinterpret_cast<const bf16x8*>(kb+d0*2048);
    const bf16x8 b1=*reinterpret_cast<const bf16x8*>(kb+d0*2048+512);
    if(d0==0){p0=__builtin_amdgcn_mfma_f32_32x32x16_bf16(b0,qr[0],negm,0,0,0);p1=__builtin_amdgcn_mfma_f32_32x32x16_bf16(b1,qr[0],negm,0,0,0);}
    else{p0=__builtin_amdgcn_mfma_f32_32x32x16_bf16(b0,qr[d0],p0,0,0,0);p1=__builtin_amdgcn_mfma_f32_32x32x16_bf16(b1,qr[d0],p1,0,0,0);}}
}
typedef __attribute__((address_space(3))) const char* lds_cptr;
typedef short v4i16_t __attribute__((ext_vector_type(4)));
__device__ __forceinline__ void kload8(bf16x8*kf,lds_cptr kp){
  kf[0]=*(const __attribute__((address_space(3))) bf16x8*)(kp);      kf[1]=*(const __attribute__((address_space(3))) bf16x8*)(kp+512);
  kf[2]=*(const __attribute__((address_space(3))) bf16x8*)(kp+2048); kf[3]=*(const __attribute__((address_space(3))) bf16x8*)(kp+2560);
  kf[4]=*(const __attribute__((address_space(3))) bf16x8*)(kp+4096); kf[5]=*(const __attribute__((address_space(3))) bf16x8*)(kp+4608);
  kf[6]=*(const __attribute__((address_space(3))) bf16x8*)(kp+6144); kf[7]=*(const __attribute__((address_space(3))) bf16x8*)(kp+6656);
}
__device__ __forceinline__ void kload2(bf16x8*kf,lds_cptr kp,int j){ kf[2*j]=*(const __attribute__((address_space(3))) bf16x8*)(kp+j*2048); kf[2*j+1]=*(const __attribute__((address_space(3))) bf16x8*)(kp+j*2048+512); }
__device__ __forceinline__ s16x4 vtr(lds_cptr p){ return __builtin_bit_cast(s16x4,__builtin_amdgcn_ds_read_tr16_b64_v4i16((__attribute__((address_space(3))) v4i16_t*)p)); }
__device__ __forceinline__ float rowmax(const f32x16&p0,const f32x16&p1){
  float a=max3f(p0[0],p0[1],p1[0]),b=max3f(p0[2],p0[3],p1[1]);a=max3f(a,p1[2],p1[3]);
  #pragma unroll
  for(int r=4;r<16;r+=4){a=max3f(a,p0[r],p0[r+1]);b=max3f(b,p0[r+2],p0[r+3]);a=max3f(a,p1[r],p1[r+1]);b=max3f(b,p1[r+2],p1[r+3]);}
  const float m=max2f(a,b);
  auto rr=__builtin_amdgcn_permlane32_swap(__float_as_uint(m),__float_as_uint(m),false,false);
  return max2f(__uint_as_float(rr[0]),__uint_as_float(rr[1]));
}
__device__ __forceinline__ void pv(f32x16*o,int vb,bf16x8 pa0,bf16x8 pa1,bf16x8 pa2,bf16x8 pa3){
  #pragma unroll
  for(int d0=0;d0<2;++d0){s16x4 lo[4],hi[4];
    #pragma unroll
    for(int ks=0;ks<4;++ks){
      asm volatile("ds_read_b64_tr_b16 %0,%1 offset:%c2":"=&v"(lo[ks]):"v"(vb),"i"(d0*4096+ks*1024):"memory");
      asm volatile("ds_read_b64_tr_b16 %0,%1 offset:%c2":"=&v"(hi[ks]):"v"(vb),"i"(d0*4096+ks*1024+512):"memory");}
    asm volatile("s_waitcnt lgkmcnt(0)":::"memory");SBAR();
    #define PK(k) (bf16x8){lo[k][0],lo[k][1],lo[k][2],lo[k][3],hi[k][0],hi[k][1],hi[k][2],hi[k][3]}
    o[d0]=__builtin_amdgcn_mfma_f32_32x32x16_bf16(pa0,PK(0),o[d0],0,0,0);
    o[d0]=__builtin_amdgcn_mfma_f32_32x32x16_bf16(pa1,PK(1),o[d0],0,0,0);
    o[d0]=__builtin_amdgcn_mfma_f32_32x32x16_bf16(pa2,PK(2),o[d0],0,0,0);
    o[d0]=__builtin_amdgcn_mfma_f32_32x32x16_bf16(pa3,PK(3),o[d0],0,0,0);
    #undef PK
  }
}

#ifndef ATTN_STORE16
#define ATTN_STORE16(p,v) (*(u32x4*)(p)=(v))
#endif
template<int THRL> __device__ __forceinline__ void attn_unit(int qb,const bf16*Qb,const bf16*__restrict__ Kb,const bf16*__restrict__ Vb,bf16*Ob,char*shm){
  int tid_=threadIdx.x; asm volatile("":"+v"(tid_));
  const int tid=tid_,lane=tid&63,r32=lane&31,hi=lane>>5; const int wid=__builtin_amdgcn_readfirstlane(tid>>6);
  const int q0=qb*QB;
  const bf16*Qw=Qb+(long)(q0+wid*QBLK)*DMI;
  const bf16*Kh=Kb,*Vh=Vb;
  const unsigned lds0=(unsigned)(uintptr_t)shm;
  float*wsf=(float*)(shm+LDS_WS)+wid*64;
  const bf16*ksrc=Kh+(long)lane*DMI+wid*8;
  const bf16*vsrc=Vh+(long)(16*(wid&3)+(lane>>2))*DMI+(wid>>2)*32+(lane&3)*8;
  const unsigned kdst=lds0+LDS_K+wid*1024, vdst=lds0+LDS_V+wid*1024;
  #define DMA_K(t,slot) glds16(ksrc+(long)(t)*KVBLK*DMI,(unsigned)__builtin_amdgcn_readfirstlane(kdst+(slot)))
  #define DMA_V(t,slot) glds16(vsrc+(long)(t)*KVBLK*DMI,(unsigned)__builtin_amdgcn_readfirstlane(vdst+(slot)))
  const int vb0=(int)(lds0+LDS_V)+((lane>>4)&1)*32+(lane&3)*8+(4*hi+((lane&15)>>2))*64;
  const char*Kbase=shm+LDS_K; bf16x8 kf[8];
  const lds_cptr shm3=(lds_cptr)shm; const lds_cptr kp0=shm3+LDS_K+hi*1024+r32*16; const lds_cptr vp0=shm3+LDS_V+((lane>>4)&1)*32+(lane&3)*8+(4*hi+((lane&15)>>2))*64;
  const int NT=(q0+QB)/KVBLK;
  DMA_K(0,0);DMA_V(0,0);DMA_K(1,SLOTB);
  bf16x8 qr[4];
  #pragma unroll
  for(int d0=0;d0<4;++d0)qr[d0]=*reinterpret_cast<const bf16x8*>(&Qw[(long)r32*DMI+d0*16+hi*8]);
  float mhat=0.f,l_reg=0.f;f32x16 o[2];o[0]=f32x16{};o[1]=f32x16{};f32x16 negm=f32x16{};asm volatile("":"+v"(negm));
  const int qrel=wid*QBLK+r32;
  #define CMASK(P0,P1,t) do{int jb_=(t)-(NT-4); if(jb_>=0)cmask(P0,P1,jb_,qrel,hi);}while(0)
  bool resc=false;
  #define START(P0,P1) do{ const float rm=rowmax(P0,P1); resc=false; \
    { const float dl=rm; mhat=fadd_s(mhat,dl); \
      _Pragma("unroll") for(int r=0;r<16;++r){P0[r]=fsub_s(P0[r],dl);P1[r]=fsub_s(P1[r],dl);} \
      _Pragma("unroll") for(int r=0;r<16;++r)negm[r]=-mhat; asm volatile("":"+v"(negm)); } \
    _Pragma("unroll") for(int r=0;r<16;++r)P0[r]=__builtin_amdgcn_exp2f(P0[r]); }while(0)
  #define RESC() do{ if(resc){ asm volatile("s_waitcnt lgkmcnt(0)":::"memory"); \
      _Pragma("unroll") for(int d_=0;d_<2;++d_) _Pragma("unroll") for(int r=0;r<16;++r)o[d_][r]*=wsf[crow(r,hi)]; } }while(0)
  f32x16 pA0,pA1,pB0,pB1;
  int sl_prev=0,sl_cur=0,sl_next=SLOTB;
  #define ROT() do{sl_prev=sl_cur;sl_cur=sl_next;sl_next=(sl_next==(NSLOT-1)*SLOTB)?0:sl_next+SLOTB;}while(0)
  DMA_K(2,2*SLOTB);
  WAIT_BAR(3);
  qkt(pA0,pA1,Kbase,qr,negm,r32,hi);asm volatile("s_nop 15\n\ts_nop 7":"+v"(pA0),"+v"(pA1));CMASK(pA0,pA1,0);
  START(pA0,pA1);
  _Pragma("unroll") for(int r=0;r<16;++r)pA1[r]=__builtin_amdgcn_exp2f(pA1[r]);
  WAIT_BAR(0);
  DMA_K(3,0);DMA_V(1,SLOTB);
  ROT();
  kload8(kf,kp0+sl_cur);
  WAIT_BAR(2);
  s16x4 vlo[8],vhi[8]; u32x4 pw0,pw1,pw2,pw3;
  #define PKW(P,B) cvtpk_s(P[B],P[B+1])
  #define PAF(k) __builtin_bit_cast(bf16x8,pw##k)
  #define VFR(i) (bf16x8){vlo[i][0],vlo[i][1],vlo[i][2],vlo[i][3],vhi[i][0],vhi[i][1],vhi[i][2],vhi[i][3]}
  #define PIN(x) asm volatile("":"+v"(x))
  #define MX3(a,b,c) __builtin_fmaxf(__builtin_fmaxf((a),(b)),(c))
  #define GAPA(MF,A0,A1,A2,A3,W0,W1,PW) do{ MF; sacc+=A0; sacc+=A1; sacc+=A2; sacc+=A3; PIN(sacc); W0; W1; PIN(PW); SBAR(); }while(0)
  #define EX(v) __builtin_amdgcn_exp2f(v)
  #define GAPB(MF,X,B) do{ MF; X[B]=EX(X[B]); X[B+1]=EX(X[B+1]); X[B+2]=EX(X[B+2]); X[B+3]=EX(X[B+3]); PIN(X); SBAR(); }while(0)
  #define VRD(i) do{ vlo[i]=vtr(vp_+(((i)>>2)*4096+((i)&3)*1024)); vhi[i]=vtr(vp_+(((i)>>2)*4096+((i)&3)*1024+512)); }while(0)
  #define KRD(G,j) do{ if(G){ kload2(kf,kp0+sl_next,j); SBAR(); } }while(0)
  #define STEP(C0,C1,P0,P1,t,GK,GV,GL) do{ SBAR(); \
    const lds_cptr vp_=vp0+sl_prev; \
    VRD(0); SBAR(); float sacc=(P0[0]+P0[1]); \
    GAPA(C0=__builtin_amdgcn_mfma_f32_32x32x16_bf16(kf[0],qr[0],negm,0,0,0), P0[2],P0[3],P0[4],P0[5],     pw0[0]=PKW(P0,0), pw0[1]=PKW(P0,2), pw0); \
    VRD(4); SBAR(); GAPA(C1=__builtin_amdgcn_mfma_f32_32x32x16_bf16(kf[1],qr[0],negm,0,0,0), P0[6],P0[7],P0[8],P0[9],     pw0[2]=PKW(P0,4), pw0[3]=PKW(P0,6), pw0); \
    VRD(1); SBAR(); GAPA(C0=__builtin_amdgcn_mfma_f32_32x32x16_bf16(kf[2],qr[1],C0,0,0,0),   P0[10],P0[11],P0[12],P0[13], pw1[0]=PKW(P0,8), pw1[1]=PKW(P0,10), pw1); \
    VRD(5); SBAR(); GAPA(C1=__builtin_amdgcn_mfma_f32_32x32x16_bf16(kf[3],qr[1],C1,0,0,0),   P0[14],P0[15],P1[0],P1[1],   pw1[2]=PKW(P0,12),pw1[3]=PKW(P0,14), pw1); \
    VRD(2); SBAR(); GAPA(C0=__builtin_amdgcn_mfma_f32_32x32x16_bf16(kf[4],qr[2],C0,0,0,0),   P1[2],P1[3],P1[4],P1[5],     pw2[0]=PKW(P1,0), pw2[1]=PKW(P1,2), pw2); \
    VRD(6); SBAR(); GAPA(C1=__builtin_amdgcn_mfma_f32_32x32x16_bf16(kf[5],qr[2],C1,0,0,0),   P1[6],P1[7],P1[8],P1[9],     pw2[2]=PKW(P1,4), pw2[3]=PKW(P1,6), pw2); \
    VRD(3); SBAR(); GAPA(C0=__builtin_amdgcn_mfma_f32_32x32x16_bf16(kf[6],qr[3],C0,0,0,0),   P1[10],P1[11],P1[12],P1[13], pw3[0]=PKW(P1,8), pw3[1]=PKW(P1,10), pw3); \
    VRD(7); SBAR(); GAPA(C1=__builtin_amdgcn_mfma_f32_32x32x16_bf16(kf[7],qr[3],C1,0,0,0),   P1[14],P1[15],0.f,0.f,       pw3[2]=PKW(P1,12),pw3[3]=PKW(P1,14), pw3); \
    l_reg+=sacc; \
    if(GK){DMA_K((t)+3,sl_cur);} if(GV){DMA_V((t)+1,sl_next);} \
    CMASK(C0,C1,t); \
    { float a=MX3(C0[0],C0[1],C1[0]),b=MX3(C0[2],C0[3],C1[1]); a=MX3(a,C1[2],C1[3]); \
      _Pragma("unroll") for(int r=4;r<16;r+=4){a=MX3(a,C0[r],C0[r+1]);b=MX3(b,C0[r+2],C0[r+3]);a=MX3(a,C1[r],C1[r+1]);b=MX3(b,C1[r+2],C1[r+3]);} \
      float rm=__builtin_fmaxf(a,b); { auto rr=__builtin_amdgcn_permlane32_swap(__float_as_uint(rm),__float_as_uint(rm),false,false); rm=__builtin_fmaxf(__uint_as_float(rr[0]),__uint_as_float(rr[1])); } \
      resc=false; \
      if(__builtin_expect(__any(rm>(float)THRL),0)){ const float dl=__builtin_fmaxf(rm,0.f); mhat+=dl; \
        _Pragma("unroll") for(int r=0;r<16;++r){C0[r]-=dl;C1[r]-=dl;} \
        _Pragma("unroll") for(int r=0;r<16;++r)negm[r]=-mhat; asm volatile("":"+v"(negm)); \
        const float f=__builtin_amdgcn_exp2f(-dl); l_reg*=f; if(hi==0)wsf[r32]=f; resc=true; } } \
    SBAR(); \
    GAPB(o[0]=__builtin_amdgcn_mfma_f32_32x32x16_bf16(PAF(0),VFR(0),o[0],0,0,0), C0,0); \
    GAPB(o[1]=__builtin_amdgcn_mfma_f32_32x32x16_bf16(PAF(0),VFR(4),o[1],0,0,0), C0,4); \
    KRD(GL,0); GAPB(o[0]=__builtin_amdgcn_mfma_f32_32x32x16_bf16(PAF(1),VFR(1),o[0],0,0,0), C0,8); \
    KRD(GL,1); GAPB(o[1]=__builtin_amdgcn_mfma_f32_32x32x16_bf16(PAF(1),VFR(5),o[1],0,0,0), C0,12); \
    KRD(GL,2); GAPB(o[0]=__builtin_amdgcn_mfma_f32_32x32x16_bf16(PAF(2),VFR(2),o[0],0,0,0), C1,0); \
    KRD(GL,3); GAPB(o[1]=__builtin_amdgcn_mfma_f32_32x32x16_bf16(PAF(2),VFR(6),o[1],0,0,0), C1,4); \
    GAPB(o[0]=__builtin_amdgcn_mfma_f32_32x32x16_bf16(PAF(3),VFR(3),o[0],0,0,0), C1,8); \
    GAPB(o[1]=__builtin_amdgcn_mfma_f32_32x32x16_bf16(PAF(3),VFR(7),o[1],0,0,0), C1,12); \
    }while(0)
  int t=1;
  #undef CMASK
  #define CMASK(P0,P1,t) do{}while(0)
  for(;t+5<NT;t+=2){
    STEP(pB0,pB1,pA0,pA1,t,true,true,true);     WAIT_BAR(2); RESC(); ROT();
    STEP(pA0,pA1,pB0,pB1,t+1,true,true,true);   WAIT_BAR(2); RESC(); ROT();
  }
  #undef CMASK
  #define CMASK(P0,P1,t) do{int jb_=(t)-(NT-4); if(jb_>=0)cmask(P0,P1,jb_,qrel,hi);}while(0)
  #define ENDW(tt) do{ if((tt)+3<NT){WAIT_BAR(2);} else if((tt)+2<NT){WAIT_BAR(1);} else {WAIT_BAR(0);} }while(0)
  for(;t+1<NT;t+=2){
    STEP(pB0,pB1,pA0,pA1,t,(t+3<NT),(t+1<NT),(t+1<NT));       ENDW(t);   RESC(); ROT();
    STEP(pA0,pA1,pB0,pB1,t+1,(t+4<NT),(t+2<NT),(t+2<NT));     ENDW(t+1); RESC(); ROT();
  }
  STEP(pB0,pB1,pA0,pA1,NT-1,false,false,false); RESC();
  { float sacc=pB0[0]+pB0[1]; _Pragma("unroll") for(int r=2;r<16;++r)sacc+=pB0[r]; _Pragma("unroll") for(int r=0;r<16;++r)sacc+=pB1[r]; l_reg+=sacc;
    pw0=(u32x4){PKW(pB0,0),PKW(pB0,2),PKW(pB0,4),PKW(pB0,6)};pw1=(u32x4){PKW(pB0,8),PKW(pB0,10),PKW(pB0,12),PKW(pB0,14)};pw2=(u32x4){PKW(pB1,0),PKW(pB1,2),PKW(pB1,4),PKW(pB1,6)};pw3=(u32x4){PKW(pB1,8),PKW(pB1,10),PKW(pB1,12),PKW(pB1,14)};
    SBAR(); pv(o,vb0+sl_cur,PAF(0),PAF(1),PAF(2),PAF(3)); }
  #undef PKW
  #undef PAF
  #undef VFR
  #undef PIN
  #undef MX3
  #undef GAPA
  #undef GAPB
  #undef EX
  #undef VRD
  #undef KRD
  #undef STEP
  #undef ENDW
  {auto rr=__builtin_amdgcn_permlane32_swap(__float_as_uint(l_reg),__float_as_uint(l_reg),false,false);l_reg=__uint_as_float(rr[0])+__uint_as_float(rr[1]);}
  if(hi==0)wsf[32+r32]=l_reg;asm volatile("s_waitcnt lgkmcnt(0)":::"memory");
  float rli[16];
  #pragma unroll
  for(int r=0;r<16;++r)rli[r]=__builtin_amdgcn_rcpf(wsf[32+crow(r,hi)]);
  bf16*Ow=Ob+(long)(q0+wid*QBLK)*DMO;
  { bf16*stg=(bf16*)(shm+LDS_OST)+wid*2048;
    #pragma unroll
    for(int r=0;r<16;++r){const int orow=crow(r,hi);
      #pragma unroll
      for(int d0=0;d0<2;++d0)stg[orow*64+d0*32+r32]=__float2bfloat16(o[d0][r]*rli[r]);}
    asm volatile("s_waitcnt lgkmcnt(0)":::"memory");
    #pragma unroll
    for(int i=0;i<4;++i){const int row=i*8+(lane>>3),ch=lane&7; const u32x4 v=*(const u32x4*)(stg+row*64+ch*8); ATTN_STORE16(Ow+(long)row*DMO+ch*8,v);} }
  asm volatile("s_waitcnt lgkmcnt(0)\n\ts_barrier":::"memory");
  #undef DMA_K
  #undef DMA_V
  #undef CMASK
  #undef START
  #undef RESC
  #undef ROT
}
constexpr int ATTN_LDS_BYTES=LDS_BYTES;
#undef SBAR
#undef WAIT_BAR
}
extern __shared__ __attribute__((aligned(16))) unsigned char g_lds[];
constexpr size_t WS_OV = WS_R;
__device__ __forceinline__ void p2c_hgrn(Frame& F_, int l, int unit);
template <int PART> __device__ __forceinline__ void p1_part(Frame& F_, int g, int l, int G, int c);
constexpr int CW_P1B = 24576;
constexpr int CW_Q = 20480;
constexpr int NQ_ATT = GB * 16 * 8, NQ_CONV = TG / 64;
__device__ __forceinline__ void p2_mixers(Frame& F_, int g, int l, int rep) {
    if (blockIdx.x < GB * 4) p2c_hgrn(F_, l, blockIdx.x);
    else {
        p1_part<1>(F_, g, l, (int)gridDim.x - GB * 4, (int)blockIdx.x - GB * 4);
        KArgs ka2 = kargs(); unsigned* pdone = (unsigned*)((unsigned char*)(GAS unsigned char*)ka2->ws + WS_CTL) + CW_P1B + 64 * (g * 2 + l);
        asm volatile("s_waitcnt vmcnt(0)" ::: "memory"); __syncthreads();
        if (threadIdx.x == 0) { __builtin_amdgcn_fence(__ATOMIC_RELEASE, "agent"); asm volatile("s_waitcnt vmcnt(0)" ::: "memory"); (void)__hip_atomic_fetch_add(pdone, 1u, __ATOMIC_RELAXED, __HIP_MEMORY_SCOPE_AGENT); }
    }
    KA_WS();
    Frame F = mkframe(F_.lds);
    const int xq = (int)(xb_xcc_id() & 7u);
    volatile LAS int* qslot = (volatile LAS int*)(F.lds + MISC_OFF + 128);
    bool conv_ok = false;
    constexpr int NQX = (NQ_ATT + NQ_CONV) / 8;
    unsigned* qbase = (unsigned*)(ws + WS_CTL) + CW_Q + 64 * ((g * 2 + l) * 8);
    int xcur = xq;
    for (;;) {
        __syncthreads();
        if (F.tid == 0) qslot[0] = (int)__hip_atomic_fetch_add(qbase + 64 * xcur, 1u, __ATOMIC_RELAXED, __HIP_MEMORY_SCOPE_AGENT);
        __syncthreads();
        int u = __builtin_amdgcn_readfirstlane(qslot[0]);
        if (u >= NQX) {
            __syncthreads();
            if (F.tid < 8) { const unsigned hd = __hip_atomic_load(qbase + 64 * F.tid, __ATOMIC_RELAXED, __HIP_MEMORY_SCOPE_AGENT); const unsigned long long m = __ballot(hd < (unsigned)NQX);
                if (F.tid == 0) qslot[1] = m ? (int)__builtin_ctzll(m) : -1; }
            __syncthreads();
            const int nx = __builtin_amdgcn_readfirstlane(qslot[1]);
            if (nx < 0) break;
            xcur = nx; continue;
        }
        const int xu = xcur;
        if (u >= NQ_ATT / 8 && !conv_ok) {
            unsigned* pdone = (unsigned*)(ws + WS_CTL) + CW_P1B + 64 * (g * 2 + l);
            if (F.tid == 0) { unsigned sp = 0; while (__hip_atomic_load(pdone, __ATOMIC_RELAXED, __HIP_MEMORY_SCOPE_AGENT) < gridDim.x - GB * 4) { __builtin_amdgcn_s_sleep(4); if (++sp > (1u << 22)) break; }
                __builtin_amdgcn_fence(__ATOMIC_ACQUIRE, "agent"); asm volatile("s_waitcnt vmcnt(0)" ::: "memory"); }
            __syncthreads(); conv_ok = true;
        }
        if (u < NQ_ATT / 8) {
            const int qb = 7 - u / (GB * 2), vhd = (u % (GB * 2)) * 8 + xu;
            const int bl = vhd >> 4, sh = (vhd >> 1) & 7, vh = vhd & 1;
            const attn_body::bf16* Qb = (const attn_body::bf16*)((bf16*)(ws + WS_Q) + (size_t)bl * S * 512 + sh * 64);
            const attn_body::bf16* Kb = (const attn_body::bf16*)((bf16*)(ws + WS_K) + (size_t)bl * S * 512 + sh * 64);
            const attn_body::bf16* Vb = (const attn_body::bf16*)((bf16*)(ws + WS_V) + (size_t)bl * S * 512 + (sh >> 1) * 128 + vh * 64);
            attn_body::bf16* Ob = (attn_body::bf16*)((bf16*)(ws + WS_OV) + (size_t)bl * S * 1024 + sh * 128 + vh * 64);
            attn_body::attn_unit<8>(qb, Qb, Kb, Vb, Ob, (char*)g_lds);
        } else { int ll = l; asm volatile("" : "+s"(ll)); p2_conv_unit(F, ws, ka, ll, (u - NQ_ATT / 8) * 8 + xu); }
    }
}
__device__ __forceinline__ void p2d_combine(Frame& F_, int l) {
    KA_WS();
    Frame F = mkframe(F_.lds);
    const float lam = ((const float*)(ws + WS_LB))[1024 + l]; const float lam_init = l == 0 ? 0.2f : 0.35550906759096934f;
    const float* ng = (const float*)KIN(8) + l * 128;
    const int lane = F.lane; const float g0 = ng[lane * 2] * (1.f - lam_init), g1 = ng[lane * 2 + 1] * (1.f - lam_init);
    const bf16* __restrict__ OV = (const bf16*)(ws + WS_OV); bf16* __restrict__ YB = (bf16*)(ws + WS_YB);
    const int per = TG / (gridDim.x * NWAVES);
    const int t0 = (blockIdx.x * NWAVES + F.wave) * per;
#pragma unroll 1
    for (int i = 0; i < per; i += 2) {
        unsigned a[2][8];
#pragma unroll
        for (int rr = 0; rr < 2; ++rr)
#pragma unroll
            for (int k = 0; k < 8; ++k) a[rr][k] = *(const unsigned*)(OV + (size_t)(t0 + i + rr) * 1024 + k * 128 + lane * 2);
#pragma unroll
        for (int rr = 0; rr < 2; ++rr)
#pragma unroll
            for (int h = 0; h < 4; ++h) { const unsigned a1 = a[rr][2 * h], a2 = a[rr][2 * h + 1];
                const float o0 = lo16(a1) - lam * lo16(a2), o1 = hi16(a1) - lam * hi16(a2);
                const float rr2 = __builtin_amdgcn_rsqf(wave_sum(o0 * o0 + o1 * o1) * (1.f / 128.f) + EPS);
                *(unsigned*)(YB + (size_t)(t0 + i + rr) * 512 + h * 128 + lane * 2) = pk2(o0 * rr2 * g0, o1 * rr2 * g1); }
    }
}

namespace hg {
typedef short bf16x8 __attribute__((ext_vector_type(8)));
typedef float f32x16 __attribute__((ext_vector_type(16)));
constexpr int ST = 272, STT = 80, RS = 264;
constexpr int O_Q1 = 0, O_KT = 8704, O_KTT = 17408, O_VT = 27648, O_D = 37888, OPS = 38400;
constexpr int L_O = 2 * OPS;
static_assert(L_O + 2 * 16384 <= MISC_OFF, "HGRN LDS map");
__device__ __forceinline__ void lbar() { asm volatile("s_waitcnt lgkmcnt(0)" ::: "memory"); __builtin_amdgcn_s_barrier(); asm volatile("" ::: "memory"); }
__device__ __forceinline__ bf16x8 pack8(const f32x16& x, int b) {
    u32x4 w; w.x = pg8::cvt_pk_bf16(x[b], x[b + 1]); w.y = pg8::cvt_pk_bf16(x[b + 2], x[b + 3]); w.z = pg8::cvt_pk_bf16(x[b + 4], x[b + 5]); w.w = pg8::cvt_pk_bf16(x[b + 6], x[b + 7]);
    return __builtin_bit_cast(bf16x8, w);
}
__device__ __forceinline__ bf16x8 ld2x8(const LAS unsigned char* p) {
    const u32x2 a = *(const LAS u32x2*)p, b = *(const LAS u32x2*)(p + 16); u32x4 w; w.x = a.x; w.y = a.y; w.z = b.x; w.w = b.y; return __builtin_bit_cast(bf16x8, w);
}
__device__ __forceinline__ float quad_bcast(float v, int which) {
    const int iv = __builtin_bit_cast(int, v); int r;
    if (which == 0) r = __builtin_amdgcn_update_dpp(0, iv, 0x00, 0xF, 0xF, true); else if (which == 1) r = __builtin_amdgcn_update_dpp(0, iv, 0x55, 0xF, 0xF, true);
    else if (which == 2) r = __builtin_amdgcn_update_dpp(0, iv, 0xAA, 0xF, 0xF, true); else r = __builtin_amdgcn_update_dpp(0, iv, 0xFF, 0xF, 0xF, true);
    return __builtin_bit_cast(float, r);
}
}
__device__ __forceinline__ void p2c_hgrn(Frame& F_, int l, int unit) {
    KA_WS();
    Frame F = mkframe(F_.lds);
    using namespace hg;
    const int bl = unit >> 2, h = unit & 3;
    LAS unsigned char* lds = F.lds;
    const int lane = F.lane, wave = F.wave, r32 = lane & 31, hi = lane >> 5;
    const size_t rb = ((size_t)(bl * 4 + h) * S) * 128;
    const size_t rbY = ((size_t)bl * S) * 512 + h * 128;
    const bf16* HQ = (const bf16*)(ws + WS_HQ) + rb; const bf16* HF = (const bf16*)(ws + WS_HF) + rb; const bf16* HV = (const bf16*)(ws + WS_HV) + rb; const bf16* HG = (const bf16*)(ws + WS_HG) + rb;
    bf16* YC = (bf16*)(ws + WS_YC) + rbY;
    const bool isP = wave >= 4;
    const int pw = wave & 3;
    __syncthreads();
    if (isP) {
        const float* ng = (const float*)KIN(10) + l * 128;
        const float n0 = ng[2 * lane], n1 = ng[2 * lane + 1];
        const int cpi = 16 * pw + (lane >> 2), tq = lane & 3;
        unsigned rawA[24], rawB[24], rawC[24]; unsigned gA[8], gB[8], gC[8];
#pragma unroll
        for (int k = 0; k < 24; ++k) { rawA[k] = 0u; rawB[k] = 0u; rawC[k] = 0u; }
#pragma unroll
        for (int k = 0; k < 8; ++k) { gA[k] = 0u; gB[k] = 0u; gC[k] = 0u; }
#define HG_LOAD(SET, n) do { _Pragma("unroll") for (int j = 0; j < 8; ++j) { const size_t go = (size_t)((n) * 32 + 8 * tq + j) * 128 + 2 * cpi; \
            SET[j] = *(const unsigned*)(HF + go); SET[8 + j] = *(const unsigned*)(HQ + go); SET[16 + j] = *(const unsigned*)(HV + go); } } while (0)
#define HG_GLOAD(GS, n) do { _Pragma("unroll") for (int jj = 0; jj < 8; ++jj) GS[jj] = *(const unsigned*)(HG + (size_t)((n) * 32 + 8 * pw + jj) * 128 + 2 * lane); } while (0)
        HG_LOAD(rawA, 0); HG_LOAD(rawB, 1); HG_LOAD(rawC, 2); HG_GLOAD(gA, 0);
#define HG_PITER(i, RS_, GU) do { \
            if ((i) + 1 <= 63) hg_prep(lds, RS_, (i) + 1, cpi, tq); \
            if ((i) + 4 <= 63) HG_LOAD(RS_, (i) + 4); \
            if ((i) >= 1 && (i) <= 64) hg_finish(lds, (i) - 1, pw, lane, n0, n1, GU); \
            if ((i) + 2 <= 63) HG_GLOAD(GU, (i) + 2); \
            lbar(); } while (0)
        auto hg_prep = [&](LAS unsigned char* lds_, const unsigned (&R_)[24], int n, int cpi_, int tq_) __attribute__((always_inline)) {
            LAS unsigned char* op = lds_ + (n & 1) * OPS;
            float p0[8], p1[8], l0[8], l1[8];
#pragma unroll
            for (int j = 0; j < 8; ++j) { const unsigned w = R_[j]; const float x0 = lo16(w) * 1.4426950408889634f, x1 = hi16(w) * 1.4426950408889634f;
                l0[j] = x0; l1[j] = x1; p0[j] = j ? p0[j - 1] + x0 : x0; p1[j] = j ? p1[j - 1] + x1 : x1; }
            float base0 = 0.f, base1 = 0.f, bl0 = 0.f, bl1 = 0.f;
#pragma unroll
            for (int q = 0; q < 4; ++q) { const float t0 = quad_bcast(p0[7], q), t1 = quad_bcast(p1[7], q); bl0 += t0; bl1 += t1; if (q < tq_) { base0 += t0; base1 += t1; } }
            unsigned ka[4], kb[4], va[4], vb4[4];
#pragma unroll
            for (int j = 0; j < 8; ++j) { const int t = 8 * tq_ + j;
                const float b0 = fmaxf(base0 + p0[j], -115.f), b1 = fmaxf(base1 + p1[j], -115.f);
                const float e0 = __builtin_amdgcn_exp2f(b0), e1 = __builtin_amdgcn_exp2f(b1), i0 = __builtin_amdgcn_exp2f(-b0), i1 = __builtin_amdgcn_exp2f(-b1);
                const float k0 = 1.f - __builtin_amdgcn_exp2f(l0[j]), k1 = 1.f - __builtin_amdgcn_exp2f(l1[j]);
                const unsigned qw = R_[8 + j], vw = R_[16 + j];
                const unsigned q1w = pg8::cvt_pk_bf16(lo16(qw) * e0, hi16(qw) * e1), ktw = pg8::cvt_pk_bf16(k0 * i0, k1 * i1);
                *(LAS unsigned*)(op + O_Q1 + t * ST + cpi_ * 4) = q1w; *(LAS unsigned*)(op + O_KT + t * ST + cpi_ * 4) = ktw;
                if (j & 1) { ka[j >> 1] |= ktw << 16; kb[j >> 1] |= ktw & 0xffff0000u; va[j >> 1] |= vw << 16; vb4[j >> 1] |= vw & 0xffff0000u; }
                else { ka[j >> 1] = ktw & 0xffffu; kb[j >> 1] = ktw >> 16; va[j >> 1] = vw & 0xffffu; vb4[j >> 1] = vw >> 16; } }
            *(LAS u32x4*)(op + O_KTT + (2 * cpi_) * STT + 16 * tq_) = (u32x4){ka[0], ka[1], ka[2], ka[3]}; *(LAS u32x4*)(op + O_KTT + (2 * cpi_ + 1) * STT + 16 * tq_) = (u32x4){kb[0], kb[1], kb[2], kb[3]};
            *(LAS u32x4*)(op + O_VT + (2 * cpi_) * STT + 16 * tq_) = (u32x4){va[0], va[1], va[2], va[3]}; *(LAS u32x4*)(op + O_VT + (2 * cpi_ + 1) * STT + 16 * tq_) = (u32x4){vb4[0], vb4[1], vb4[2], vb4[3]};
            if (tq_ == 3) *(LAS f32x2*)(op + O_D + cpi_ * 8) = (f32x2){__builtin_amdgcn_exp2f(fmaxf(bl0, -115.f)), __builtin_amdgcn_exp2f(fmaxf(bl1, -115.f))};
        };
        auto hg_finish = [&](LAS unsigned char* lds_, int j, int pw_, int lane_, float n0_, float n1_, const unsigned (&gt_)[8]) __attribute__((always_inline)) {
            LAS float* Ot = (LAS float*)(lds_ + L_O + (j & 1) * 16384);
            f32x2 ov[8];
#pragma unroll
            for (int jj = 0; jj < 8; ++jj) ov[jj] = *(const LAS f32x2*)(Ot + (8 * pw_ + jj) * 128 + 2 * lane_);
            asm volatile("s_waitcnt lgkmcnt(0)" ::: "memory");
#pragma unroll
            for (int jj = 0; jj < 8; ++jj) { const int t = 8 * pw_ + jj; const f32x2 o = ov[jj];
                const float rr = __builtin_amdgcn_rsqf(wave_sum(o.x * o.x + o.y * o.y) * (1.f / 128.f) + EPS);
                *(LAS unsigned*)((LAS unsigned char*)Ot + t * 512 + 4 * lane_) = pk2(o.x * rr * n0_ * lo16(gt_[jj]), o.y * rr * n1_ * hi16(gt_[jj])); }
        };
#pragma unroll 1
        for (int i = -1; i <= 62; i += 3) { HG_PITER(i, rawA, gB); HG_PITER(i + 1, rawB, gC); HG_PITER(i + 2, rawC, gA); }
        lbar();
#undef HG_PITER
#undef HG_LOAD
#undef HG_GLOAD
    } else {
        const int vb = pw;
        f32x16 Sacc[4];
#pragma unroll
        for (int cb = 0; cb < 4; ++cb)
#pragma unroll
            for (int r = 0; r < 16; ++r) Sacc[cb][r] = 0.f;
#pragma unroll 1
        for (int i = -1; i <= 65; ++i) {
            if (vb < 2 && i >= 2) {
                const LAS unsigned char* yt = lds + L_O + (i & 1) * 16384 + vb * 128;
#pragma unroll
                for (int k = 0; k < 4; ++k) { const int row = 8 * k + (lane >> 3), c16 = lane & 7;
                    *(u32x4*)(YC + (size_t)((i - 2) * 32 + row) * 512 + vb * 64 + c16 * 8) = *(const LAS u32x4*)(yt + row * 512 + c16 * 16); }
            }
            if (i >= 0 && i <= 63) {
                const LAS unsigned char* op = lds + (i & 1) * OPS;
                bf16x8 fk[8], fq[8], fp[8], fvp[2];
#pragma unroll
                for (int kc = 0; kc < 8; ++kc) { fk[kc] = *(const LAS bf16x8*)(op + O_KT + r32 * ST + (16 * kc + 8 * hi) * 2); fq[kc] = *(const LAS bf16x8*)(op + O_Q1 + r32 * ST + (16 * kc + 8 * hi) * 2); }
#pragma unroll
                for (int kc = 0; kc < 8; ++kc) fp[kc] = ld2x8(op + O_Q1 + r32 * ST + (16 * kc + 4 * hi) * 2);
#pragma unroll
                for (int ks = 0; ks < 2; ++ks) fvp[ks] = ld2x8(op + O_VT + (32 * vb + r32) * STT + (16 * ks + 4 * hi) * 2);
                asm volatile("s_waitcnt lgkmcnt(0)" ::: "memory"); __builtin_amdgcn_sched_barrier(0);
                f32x16 X, o;
#pragma unroll
                for (int r = 0; r < 16; ++r) { X[r] = 0.f; o[r] = 0.f; }
#pragma unroll
                for (int kc = 0; kc < 8; ++kc) { X = __builtin_amdgcn_mfma_f32_32x32x16_bf16(fk[kc], fq[kc], X, 0, 0, 0);
                    o = __builtin_amdgcn_mfma_f32_32x32x16_bf16(fp[kc], pack8(Sacc[kc >> 1], 8 * (kc & 1)), o, 0, 0, 0); }
                __builtin_amdgcn_sched_barrier(0);
                bf16x8 fkt[8], fvn[2];
#pragma unroll
                for (int ks = 0; ks < 2; ++ks) fvn[ks] = *(const LAS bf16x8*)(op + O_VT + (32 * vb + r32) * STT + (16 * ks + 8 * hi) * 2);
#pragma unroll
                for (int cb = 0; cb < 4; ++cb)
#pragma unroll
                    for (int ks = 0; ks < 2; ++ks) fkt[2 * cb + ks] = *(const LAS bf16x8*)(op + O_KTT + (32 * cb + r32) * STT + (16 * ks + 8 * hi) * 2);
#pragma unroll
                for (int r = 0; r < 16; ++r) { const int sidx = (r & 3) + 8 * (r >> 2) + 4 * hi; X[r] = sidx <= r32 ? X[r] : 0.f; }
#pragma unroll
                for (int ks = 0; ks < 2; ++ks) o = __builtin_amdgcn_mfma_f32_32x32x16_bf16(pack8(X, 8 * ks), fvp[ks], o, 0, 0, 0);
                asm volatile("s_waitcnt lgkmcnt(0)" ::: "memory"); __builtin_amdgcn_sched_barrier(0);
#pragma unroll
                for (int cb = 0; cb < 4; ++cb)
#pragma unroll
                    for (int ks = 0; ks < 2; ++ks) Sacc[cb] = __builtin_amdgcn_mfma_f32_32x32x16_bf16(fkt[2 * cb + ks], fvn[ks], Sacc[cb], 0, 0, 0);
                __builtin_amdgcn_sched_barrier(0);
                LAS float* Ot = (LAS float*)(lds + L_O + (i & 1) * 16384);
#pragma unroll
                for (int r = 0; r < 16; ++r) Ot[((r & 3) + 8 * (r >> 2) + 4 * hi) * 128 + 32 * vb + r32] = o[r];
#pragma unroll
                for (int cb = 0; cb < 4; ++cb)
#pragma unroll
                    for (int g4 = 0; g4 < 4; ++g4) { const f32x4 d = *(const LAS f32x4*)(op + O_D + (32 * cb + 8 * g4 + 4 * hi) * 4);
#pragma unroll
                        for (int j = 0; j < 4; ++j) Sacc[cb][4 * g4 + j] *= d[j]; }
            }
            lbar();
        }
    }
    __syncthreads();
}

__device__ __forceinline__ void np2_hgrn(Frame& F_, int l, int unit) {
    KA_WS();
    Frame F = mkframe(F_.lds);
    const int bl = unit >> 2, h = unit & 3;
    LAS float* Fs = (LAS float*)F.lds; LAS float* Ks = Fs + 4096; LAS float* Qs = Ks + 4096; LAS float* Vs = Qs + 4096; LAS float* Op = Vs + 4096;
    const float* ng = (const float*)KIN(10) + l * 128;
    const int tid = F.tid, lane = F.lane, wave = F.wave, cq = wave >> 1, v = (wave & 1) * 64 + lane;
    float Sr[32];
#pragma unroll
    for (int i = 0; i < 32; ++i) Sr[i] = 0.f;
    for (int blk = 0; blk < 64; ++blk) {
        const size_t t0 = (size_t)bl * S + blk * 32;
        __syncthreads();
        for (int i = tid; i < 4096; i += NTHR) { const int tt = i >> 7, c = i & 127; const size_t o = (t0 + tt) * 512 + h * 128 + c;
            const float lf = bf2f(((bf16*)(ws + WS_HF))[o]); Fs[i] = expf(lf); Ks[i] = -expm1f(lf); Qs[i] = bf2f(((bf16*)(ws + WS_HQ))[o]); Vs[i] = bf2f(((bf16*)(ws + WS_HV))[o]); }
        __syncthreads();
        for (int tt = 0; tt < 32; ++tt) {
            const float vv = Vs[tt * 128 + v]; float op = 0.f;
#pragma unroll
            for (int i4 = 0; i4 < 8; ++i4) {
                const f32x4 f4 = *(const LAS f32x4*)&Fs[tt * 128 + cq * 32 + i4 * 4], k4 = *(const LAS f32x4*)&Ks[tt * 128 + cq * 32 + i4 * 4], q4 = *(const LAS f32x4*)&Qs[tt * 128 + cq * 32 + i4 * 4];
                Sr[i4 * 4 + 0] = Sr[i4 * 4 + 0] * f4.x + k4.x * vv; op += q4.x * Sr[i4 * 4 + 0];
                Sr[i4 * 4 + 1] = Sr[i4 * 4 + 1] * f4.y + k4.y * vv; op += q4.y * Sr[i4 * 4 + 1];
                Sr[i4 * 4 + 2] = Sr[i4 * 4 + 2] * f4.z + k4.z * vv; op += q4.z * Sr[i4 * 4 + 2];
                Sr[i4 * 4 + 3] = Sr[i4 * 4 + 3] * f4.w + k4.w * vv; op += q4.w * Sr[i4 * 4 + 3];
            }
            Op[(tt * 4 + cq) * 128 + v] = op;
        }
        __syncthreads();
#pragma unroll
        for (int j = 0; j < 4; ++j) {
            const int tt = wave * 4 + j; float o0 = 0.f, o1 = 0.f;
#pragma unroll
            for (int c = 0; c < 4; ++c) { const f32x2 x = *(const LAS f32x2*)&Op[(tt * 4 + c) * 128 + lane * 2]; o0 += x.x; o1 += x.y; }
            const float r = __builtin_amdgcn_rsqf(wave_sum(o0 * o0 + o1 * o1) * (1.f / 128.f) + EPS);
            const size_t o = (t0 + tt) * 512 + h * 128 + lane * 2;
            const unsigned gw = *(const unsigned*)(((bf16*)(ws + WS_HG)) + o);
            *(unsigned*)(((bf16*)(ws + WS_YC)) + o) = pk2(o0 * r * ng[lane * 2] * lo16(gw), o1 * r * ng[lane * 2 + 1] * hi16(gw));
        }
    }
}

__device__ __forceinline__ void p5_ln_route(Frame& F_, int g, int l, int bank) {
    KA_WS();
    Frame F = mkframe(F_.lds);
    typedef short bf16x8 __attribute__((ext_vector_type(8)));
    const float* lg = (const float*)KIN(14) + l * D; const float* lb = (const float*)KIN(15) + l * D;
    const float* bgp = (const float*)KIN(17) + l * 4; const float* be = (const float*)KIN(19) + l * 32;
    unsigned* cnt = ((unsigned*)(ws + WS_CTL)) + CW_CNT + bank * 32;
    constexpr int XS = 2064;
    LAS unsigned char* XH = F.lds; LAS unsigned char* XL = F.lds + 16 * XS; LAS float* LG = (LAS float*)(F.lds + 32 * XS);
    LAS int* ent_e = (LAS int*)(F.lds + 32 * XS + 6144); LAS int* ent_pos = ent_e + 256; LAS float* ent_w = (LAS float*)(ent_pos + 256);
    const int lane = F.lane, wave = F.wave;
    constexpr int rows_per_wg = TG / 256;
    constexpr int NP = rows_per_wg / 16;
    const int row0 = blockIdx.x * rows_per_wg;
    const bf16* Rb = (const bf16*)(ws + WS_R); bf16* X1 = (bf16*)(ws + WS_X1);
    const int nb = wave % 3, kh = wave / 3;
    bf16x8 bh[16], blo[16];
    if (wave < 6) {
        const bf16* rw = (const bf16*)(ws + WS_RW) + (size_t)l * 2 * 48 * 1024 + (size_t)(16 * nb + (lane & 15)) * 1024 + 512 * kh + 8 * (lane >> 4);
#pragma unroll
        for (int ks = 0; ks < 16; ++ks) { bh[ks] = *(const bf16x8*)(rw + 32 * ks); blo[ks] = *(const bf16x8*)(rw + 48 * 1024 + 32 * ks); }
    }
    __syncthreads();
    f32x4 vin[2][4];
#pragma unroll
    for (int rr = 0; rr < 2; ++rr) { const u32x2* rp = (const u32x2*)(Rb + (size_t)(row0 + 2 * wave + rr) * D) + lane;
#pragma unroll
        for (int j = 0; j < 4; ++j) { const u32x2 w = rp[64 * j]; vin[rr][j] = (f32x4){lo16(w.x), hi16(w.x), lo16(w.y), hi16(w.y)}; } }
#pragma unroll 1
    for (int p = 0; p < NP; ++p) {
        f32x4 vnx[2][4];
#pragma unroll
        for (int rr = 0; rr < 2; ++rr) { const int tn = row0 + 16 * (p + 1 < NP ? p + 1 : p) + 2 * wave + rr; const u32x2* rp = (const u32x2*)(Rb + (size_t)tn * D) + lane;
#pragma unroll
            for (int j = 0; j < 4; ++j) { const u32x2 w = rp[64 * j]; vnx[rr][j] = (f32x4){lo16(w.x), hi16(w.x), lo16(w.y), hi16(w.y)}; } }
#pragma unroll
        for (int rr = 0; rr < 2; ++rr) {
            const int rl = 2 * wave + rr, t = row0 + 16 * p + rl;
            f32x4 v[4]; float sm = 0.f;
#pragma unroll
            for (int j = 0; j < 4; ++j) { v[j] = vin[rr][j]; sm += (v[j].x + v[j].y) + (v[j].z + v[j].w); }
            const float mean = wave_sum(sm) * (1.f / D); float s2 = 0.f;
#pragma unroll
            for (int j = 0; j < 4; ++j) { v[j] = v[j] - mean; s2 += (v[j].x * v[j].x + v[j].y * v[j].y) + (v[j].z * v[j].z + v[j].w * v[j].w); }
            const float rstd = __builtin_amdgcn_rsqf(wave_sum(s2) * (1.f / D) + EPS);
#pragma unroll
            for (int j = 0; j < 4; ++j) {
                const int d0 = lane * 4 + 256 * j; const f32x4 gg = *(const f32x4*)(lg + d0), bb = *(const f32x4*)(lb + d0);
                const f32x4 y = v[j] * rstd * gg + bb;
                const unsigned h0 = pk2(y.x, y.y), h1 = pk2(y.z, y.w);
                *(u32x2*)(X1 + (size_t)t * D + d0) = (u32x2){h0, h1};
                const unsigned l0 = pk2(y.x - lo16(h0), y.y - hi16(h0)), l1 = pk2(y.z - lo16(h1), y.w - hi16(h1));
                *(LAS u32x2*)(XH + rl * XS + d0 * 2) = (u32x2){h0, h1}; *(LAS u32x2*)(XL + rl * XS + d0 * 2) = (u32x2){l0, l1};
            }
        }
#pragma unroll
        for (int rr = 0; rr < 2; ++rr)
#pragma unroll
            for (int j = 0; j < 4; ++j) vin[rr][j] = vnx[rr][j];
        __syncthreads();
        if (wave < 6) {
            f32x4 acc = {0.f, 0.f, 0.f, 0.f};
            const LAS unsigned char* ah = XH + (lane & 15) * XS + (512 * kh + 8 * (lane >> 4)) * 2; const LAS unsigned char* al = XL + (lane & 15) * XS + (512 * kh + 8 * (lane >> 4)) * 2;
#pragma unroll
            for (int ks = 0; ks < 16; ++ks) { const bf16x8 xa = *(const LAS bf16x8*)(ah + 64 * ks), xb = *(const LAS bf16x8*)(al + 64 * ks);
                acc = __builtin_amdgcn_mfma_f32_16x16x32_bf16(xa, bh[ks], acc, 0, 0, 0); acc = __builtin_amdgcn_mfma_f32_16x16x32_bf16(xb, bh[ks], acc, 0, 0, 0); acc = __builtin_amdgcn_mfma_f32_16x16x32_bf16(xa, blo[ks], acc, 0, 0, 0); }
#pragma unroll
            for (int i = 0; i < 4; ++i) LG[(kh * 16 + 4 * (lane >> 4) + i) * 48 + 16 * nb + (lane & 15)] = acc[i];
        }
        __syncthreads();
        if (F.tid < 16) {
            const int rl = F.tid;
            const LAS float* L0 = LG + rl * 48; const LAS float* L1 = LG + (16 + rl) * 48;
            float gl4[4];
#pragma unroll
            for (int e = 0; e < 4; ++e) gl4[e] = L0[e] + L1[e] + bgp[e];
            int gi = 0; float gm = gl4[0];
#pragma unroll
            for (int e = 1; e < 4; ++e) if (gl4[e] > gm) { gm = gl4[e]; gi = e; }
            float gs = 0.f;
#pragma unroll
            for (int e = 0; e < 4; ++e) gs += __expf(gl4[e] - gm);
            const float pgroup = 1.f / gs;
            float el[8];
#pragma unroll
            for (int e = 0; e < 8; ++e) el[e] = L0[4 + 8 * gi + e] + L1[4 + 8 * gi + e] + be[gi * 8 + e];
            int i0 = 0; float v0 = el[0];
#pragma unroll
            for (int e = 1; e < 8; ++e) if (el[e] > v0) { v0 = el[e]; i0 = e; }
            int i1 = -1; float v1 = -INFINITY;
#pragma unroll
            for (int e = 0; e < 8; ++e) if (e != i0 && el[e] > v1) { v1 = el[e]; i1 = e; }
            const float ex = __expf(v1 - v0); const float p0 = 1.f / (1.f + ex), p1 = ex * p0;
            const int ri = 16 * p + rl;
            ent_e[ri * 2] = gi * 8 + i0; ent_e[ri * 2 + 1] = gi * 8 + i1; ent_w[ri * 2] = p0 * pgroup; ent_w[ri * 2 + 1] = p1 * pgroup;
        }
        __syncthreads();
    }
    if (F.tid < 32) {
        const int e = F.tid; int c = 0;
        for (int i = 0; i < rows_per_wg * 2; ++i) c += (ent_e[i] == e);
        unsigned base = 0; if (c) base = __hip_atomic_fetch_add(cnt + e, (unsigned)c, __ATOMIC_RELAXED, __HIP_MEMORY_SCOPE_AGENT);
        for (int i = 0; i < rows_per_wg * 2; ++i) if (ent_e[i] == e) { ent_pos[i] = (int)base; ((int*)(ws + WS_TOK))[(size_t)e * TG + base] = row0 + (i >> 1); ++base; }
    }
    __syncthreads();
    if (F.tid < rows_per_wg) { const int i = F.tid; unsigned* r = ((unsigned*)(ws + WS_RT)) + (size_t)(row0 + i) * 8;
        r[0] = (unsigned)ent_e[2 * i]; r[1] = (unsigned)ent_pos[2 * i]; r[2] = __float_as_uint(ent_w[2 * i]); r[3] = (unsigned)ent_e[2 * i + 1]; r[4] = (unsigned)ent_pos[2 * i + 1]; r[5] = __float_as_uint(ent_w[2 * i + 1]); }
    __syncthreads();
}

__device__ __forceinline__ void p8_ln2(Frame& F_, int g, int l) {
    KA_WS();
    Frame F = mkframe(F_.lds);
    const float* lg = (const float*)KIN(23) + l * D; const float* lb = (const float*)KIN(24) + l * D;
    const unsigned* cnt = ((unsigned*)(ws + WS_CTL)) + CW_CNT + (g * 2 + l) * 32;
    LAS int* offs = (LAS int*)F.lds;
    __syncthreads();
    if (F.tid == 0) { int off = 0; for (int e = 0; e < NE; ++e) { offs[e] = off; off += ((int)cnt[e] + 255) & ~255; } }
    __syncthreads();
    const int lane = F.lane;
    const bf16* __restrict__ X1 = (const bf16*)(ws + WS_X1); const bf16* __restrict__ OM = (const bf16*)(ws + WS_OM);
    const int per = TG / (gridDim.x * NWAVES);
    const int t0 = (blockIdx.x * NWAVES + F.wave) * per;
    int ms0 = 0, ms1 = 0; float mw0 = 0.f, mw1 = 0.f;
    if (lane < per) { const unsigned* r = ((const unsigned*)(ws + WS_RT)) + (size_t)(t0 + lane) * 8; const u32x4 ra = *(const u32x4*)r; const u32x2 rb2 = *(const u32x2*)(r + 4);
        ms0 = offs[ra.x] + (int)ra.y; mw0 = __uint_as_float(ra.z); ms1 = offs[ra.w] + (int)rb2.x; mw1 = __uint_as_float(rb2.y); }
#pragma unroll 1
    for (int i = 0; i < per; i += 2) {
        u32x2 xa[2][4], oa[2][4], ob[2][4]; float w0[2], w1[2];
#pragma unroll
        for (int rr = 0; rr < 2; ++rr) {
            const int s0 = __builtin_amdgcn_readlane(ms0, i + rr), s1 = __builtin_amdgcn_readlane(ms1, i + rr);
            w0[rr] = __builtin_bit_cast(float, __builtin_amdgcn_readlane(__builtin_bit_cast(int, mw0), i + rr)); w1[rr] = __builtin_bit_cast(float, __builtin_amdgcn_readlane(__builtin_bit_cast(int, mw1), i + rr));
#pragma unroll
            for (int j = 0; j < 4; ++j) { const int d0 = lane * 4 + 256 * j;
                xa[rr][j] = *(const u32x2*)(X1 + (size_t)(t0 + i + rr) * D + d0); oa[rr][j] = *(const u32x2*)(OM + (size_t)s0 * D + d0); ob[rr][j] = *(const u32x2*)(OM + (size_t)s1 * D + d0); }
        }
#pragma unroll
        for (int rr = 0; rr < 2; ++rr) {
            const int t = t0 + i + rr;
            f32x4 v[4]; float sm = 0.f;
#pragma unroll
            for (int j = 0; j < 4; ++j) {
                v[j].x = ALPHA * lo16(xa[rr][j].x) + w0[rr] * lo16(oa[rr][j].x) + w1[rr] * lo16(ob[rr][j].x); v[j].y = ALPHA * hi16(xa[rr][j].x) + w0[rr] * hi16(oa[rr][j].x) + w1[rr] * hi16(ob[rr][j].x);
                v[j].z = ALPHA * lo16(xa[rr][j].y) + w0[rr] * lo16(oa[rr][j].y) + w1[rr] * lo16(ob[rr][j].y); v[j].w = ALPHA * hi16(xa[rr][j].y) + w0[rr] * hi16(oa[rr][j].y) + w1[rr] * hi16(ob[rr][j].y);
                sm += (v[j].x + v[j].y) + (v[j].z + v[j].w);
            }
            const float mean = wave_sum(sm) * (1.f / D); float s2 = 0.f;
#pragma unroll
            for (int j = 0; j < 4; ++j) { v[j] = v[j] - mean; s2 += (v[j].x * v[j].x + v[j].y * v[j].y) + (v[j].z * v[j].z + v[j].w * v[j].w); }
            const float rstd = __builtin_amdgcn_rsqf(wave_sum(s2) * (1.f / D) + EPS);
#pragma unroll
            for (int j = 0; j < 4; ++j) {
                const int d0 = lane * 4 + 256 * j; const f32x4 gg = *(const f32x4*)(lg + d0), bb = *(const f32x4*)(lb + d0);
                const f32x4 y = v[j] * rstd * gg + bb;
                if (l == NL - 1) *(f32x4*)(KOUT() + ((size_t)g * TG + t) * D + d0) = y;
                else *(u32x2*)((bf16*)(ws + WS_XB) + (size_t)t * D + d0) = (u32x2){pk2(y.x, y.y), pk2(y.z, y.w)};
            }
        }
    }
}

struct RmId { int off; __device__ __forceinline__ int operator()(int n0) const { return off + n0; } };
struct RmGlu { __device__ __forceinline__ int operator()(int n0) const { if (n0 >= 1024) return n0; const int hi = n0 >= 512, c = n0 - hi * 512; return (c >> 7) * 256 + hi * 128 + (c & 127); } };
struct RmIl { int hi; __device__ __forceinline__ int operator()(int n0) const { return (n0 >> 7) * 256 + hi * 128 + (n0 & 127); } };
template <class RM>
__device__ __forceinline__ void transpose_item(const float* W, int K, int N, bf16* WT, RM rowmap, LAS float* scr, int item, int lane) {
    const int nblk = N / 32, kb = item / nblk, nb = item % nblk, k0 = 64 * kb, n0 = 32 * nb;
#pragma unroll 8
    for (int i = 0; i < 32; ++i) { const int kk = 2 * i + (lane >> 5); scr[kk * 33 + (lane & 31)] = W[(size_t)(k0 + kk) * N + n0 + (lane & 31)]; }
    LDS_WAIT();
    const int c = lane & 7; const int r0 = rowmap(n0);
#pragma unroll
    for (int j = 0; j < 4; ++j) { const int n = (lane >> 3) + 8 * j; const LAS float* sp = scr + (8 * c) * 33 + n;
        u32x4 o; o.x = pk2(sp[0 * 33], sp[1 * 33]); o.y = pk2(sp[2 * 33], sp[3 * 33]); o.z = pk2(sp[4 * 33], sp[5 * 33]); o.w = pk2(sp[6 * 33], sp[7 * 33]);
        *(u32x4*)(WT + (size_t)(r0 + n) * K + k0 + 8 * c) = o; }
    LDS_WAIT();
}
__device__ __forceinline__ void p_wprep(Frame& F_) {
    KA_WS();
    Frame F = mkframe(F_.lds);
    LAS float* scr = (LAS float*)(F.lds + F.wave * 16384);
    const int gw = blockIdx.x * NWAVES + F.wave, NGW = gridDim.x * NWAVES, lane = F.lane;
    bf16* WIN = (bf16*)(ws + WS_WIN); bf16* WBR = (bf16*)(ws + WS_WBR); bf16* WOUT = (bf16*)(ws + WS_WOUT); bf16* W13 = (bf16*)(ws + WS_W13); bf16* W2 = (bf16*)(ws + WS_W2);
    constexpr int I_IN = 16 * 240, I_BR = 8 * 32, I_OUT = 16 * 32, I_W1 = 16 * 16, I_W2 = 8 * 32;
    constexpr int N_IN = 2 * I_IN, N_BR = 6 * I_BR, N_OUT = 2 * I_OUT, N_W1 = 64 * I_W1, N_W2 = 64 * I_W2;
    constexpr int NITEMS = N_IN + N_BR + N_OUT + 2 * N_W1 + N_W2;
    for (int it = gw; it < NITEMS; it += NGW) {
        int r = it;
        if (r < N_IN) { const int l = r / I_IN; transpose_item((const float*)KIN(2) + (size_t)l * D * INC, D, INC, WIN + (size_t)l * INC * D, RmGlu(), scr, r % I_IN, lane); continue; } r -= N_IN;
        if (r < N_BR) { const int q = r / I_BR; transpose_item((const float*)KIN(11) + (size_t)q * 512 * D, 512, D, WBR + (size_t)q * D * 512, RmId{0}, scr, r % I_BR, lane); continue; } r -= N_BR;
        if (r < N_OUT) { const int l = r / I_OUT; transpose_item((const float*)KIN(13) + (size_t)l * D * D, D, D, WOUT + (size_t)l * D * D, RmId{0}, scr, r % I_OUT, lane); continue; } r -= N_OUT;
        if (r < N_W1) { const int q = r / I_W1; transpose_item((const float*)KIN(20) + (size_t)q * D * DE, D, DE, W13 + (size_t)q * 1024 * D, RmIl{0}, scr, r % I_W1, lane); continue; } r -= N_W1;
        if (r < N_W1) { const int q = r / I_W1; transpose_item((const float*)KIN(21) + (size_t)q * D * DE, D, DE, W13 + (size_t)q * 1024 * D, RmIl{1}, scr, r % I_W1, lane); continue; } r -= N_W1;
        { const int q = r / I_W2; transpose_item((const float*)KIN(22) + (size_t)q * DE * D, DE, D, W2 + (size_t)q * D * DE, RmId{0}, scr, r % I_W2, lane); }
    }
}

template <int PART> __device__ __forceinline__ void p1_part(Frame& F_, int g, int l, int G, int c) {
    KA_WS();
    Frame F = mkframe(F_.lds);
    pg8::ProbDense P{(const char*)((bf16*)(ws + WS_XB)), (const char*)(ws + WS_WIN) + (size_t)l * INC * D * 2, D};
    pg8::SubOrder<PART> S; S.init(TG, G, c);
    pg8::EpiInProj E{((bf16*)(ws + WS_U)), ((bf16*)(ws + WS_Q)), ((bf16*)(ws + WS_V)), ((bf16*)(ws + WS_GATE)), ((const float*)(ws + WS_ROT)) + (size_t)g * TG * 16, ((const float*)(ws + WS_LB)) + l * 512, (const float*)KIN(12) + (size_t)l * 3 * D};
    pg8::gemm_phase<pg8::ProbDense, pg8::EpiInProj, pg8::SubOrder<PART>, true>(F.lds, P, S, E);
}
__device__ __forceinline__ void p1_inproj(Frame& F_, int g, int l) {
    KA_WS();
    Frame F = mkframe(F_.lds);
    pg8::ProbDense P{(const char*)((bf16*)(ws + WS_XB)), (const char*)(ws + WS_WIN) + (size_t)l * INC * D * 2, D};
    pg8::StaticOrder S; S.init(TG, INC, gridDim.x, blockIdx.x);
    pg8::EpiInProj E{((bf16*)(ws + WS_U)), ((bf16*)(ws + WS_Q)), ((bf16*)(ws + WS_V)), ((bf16*)(ws + WS_GATE)), ((const float*)(ws + WS_ROT)) + (size_t)g * TG * 16, ((const float*)(ws + WS_LB)) + l * 512, (const float*)KIN(12) + (size_t)l * 3 * D};
    pg8::gemm_phase<pg8::ProbDense, pg8::EpiInProj, pg8::StaticOrder, true>(F.lds, P, S, E);
}
__device__ __forceinline__ void p3_merge(Frame& F_, int l) {
    KA_WS();
    Frame F = mkframe(F_.lds);
    pg8::ProbMerge P{(const char*)((bf16*)(ws + WS_YA)), (const char*)((bf16*)(ws + WS_YB)), (const char*)((bf16*)(ws + WS_YC)), (const char*)(ws + WS_WBR) + (size_t)l * 3 * D * 512 * 2, 512};
    pg8::MergeOrder S; S.so.init(TG, D, gridDim.x, blockIdx.x);
    pg8::EpiMerge E{((bf16*)(ws + WS_GATE)), ((bf16*)(ws + WS_M))};
    pg8::gemm_phase<pg8::ProbMerge, pg8::EpiMerge, pg8::MergeOrder, true>(F.lds, P, S, E);
}
__device__ __forceinline__ void p4_wout(Frame& F_, int l) {
    KA_WS();
    Frame F = mkframe(F_.lds);
    pg8::ProbDense P{(const char*)((bf16*)(ws + WS_M)), (const char*)(ws + WS_WOUT) + (size_t)l * D * D * 2, D};
    pg8::StaticOrder S; S.init(TG, D, gridDim.x, blockIdx.x);
    pg8::EpiWout E{((bf16*)(ws + WS_XB)), ((bf16*)(ws + WS_R))};
    pg8::gemm_phase<pg8::ProbDense, pg8::EpiWout, pg8::StaticOrder, true>(F.lds, P, S, E);
}
constexpr int TAB_OFF = MISC_OFF + 256;
__device__ __forceinline__ void moe_table(Frame& F_, int g, int l) {
    KA_WS();
    Frame F = mkframe(F_.lds);
    const unsigned* cnt = ((unsigned*)(ws + WS_CTL)) + CW_CNT + (g * 2 + l) * 32;
    LAS int* tab = (LAS int*)(F.lds + TAB_OFF);
    __syncthreads();
    if (F.tid < 64) {
        const int c = F.tid < 32 ? (int)cnt[F.tid] : 0; int sacc = (c + 255) >> 8;
#pragma unroll
        for (int o = 1; o < 32; o <<= 1) { const int t2 = __shfl_up(sacc, o); if (F.lane >= o) sacc += t2; }
        if (F.tid < 32) { tab[F.tid + 1] = sacc; tab[33 + F.tid] = c; }
        if (F.tid == 0) tab[0] = 0;
    }
    __syncthreads();
}
__device__ __forceinline__ void p6_moe1(Frame& F_, int g, int l) {
    KA_WS();
    Frame F = mkframe(F_.lds);
    moe_table(F, g, l);
    pg8::ProbMoe1 P{(const char*)((bf16*)(ws + WS_X1)), (const char*)(ws + WS_W13) + (size_t)l * NE * 1024 * D * 2, ((int*)(ws + WS_TOK)), D};
    pg8::MoeOrder S{(const LAS int*)(F.lds + TAB_OFF), (int)gridDim.x, (int)blockIdx.x, 4};
    pg8::EpiMoe1 E{((bf16*)(ws + WS_HM))};
    pg8::gemm_phase<pg8::ProbMoe1, pg8::EpiMoe1, pg8::MoeOrder, true>(F.lds, P, S, E);
}
__device__ __forceinline__ void p7_moe2(Frame& F_, int g, int l) {
    KA_WS();
    Frame F = mkframe(F_.lds);
    moe_table(F, g, l);
    pg8::ProbMoe2 P{(const char*)((bf16*)(ws + WS_HM)), (const char*)(ws + WS_W2) + (size_t)l * NE * D * DE * 2, DE};
    pg8::MoeOrder S{(const LAS int*)(F.lds + TAB_OFF), (int)gridDim.x, (int)blockIdx.x, 4};
    pg8::EpiMoe2 E{((bf16*)(ws + WS_OM))};
    pg8::gemm_phase<pg8::ProbMoe2, pg8::EpiMoe2, pg8::MoeOrder, true>(F.lds, P, S, E);
}

__device__ __forceinline__ void frame_init(Frame& F, unsigned char* lds_raw) {
    F.lds = (LAS unsigned char*)lds_raw; F.tid = threadIdx.x; F.lane = F.tid & 63; F.wave = __builtin_amdgcn_readfirstlane(F.tid >> 6);
}
__global__ void __launch_bounds__(NTHR, 2) fwd_all(Args a) {
    extern __shared__ __attribute__((aligned(16))) unsigned char lds_raw[];
    Frame F; frame_init(F, lds_raw);
    volatile LAS unsigned* MISC = (volatile LAS unsigned*)(F.lds + MISC_OFF);
    if (F.tid < 64) MISC[F.tid] = 0u;
    __syncthreads();
    XcdBarrier bar = xcd_barrier_post((unsigned*)(a.ws + WS_CTL) + CW_BAR, MISC + 8);
    p_prologue(F);
#pragma unroll 1
    for (int rep = 0; rep < REP_PRO; ++rep) p_wprep(F);
    xcd_barrier(bar);
    for (int g = 0; g < NG; ++g) {
        p_xload(F, g); xcd_barrier(bar);
        for (int l = 0; l < NL; ++l) {
#pragma unroll 1
            for (int rep = 0; rep < REP_P1; ++rep) { p1_part<0>(F, g, l, (int)gridDim.x, (int)blockIdx.x); xcd_barrier(bar); }
#pragma unroll 1
            for (int rep = 0; rep < REP_MIX; ++rep) { p2_mixers(F, g, l, rep); xcd_barrier(bar); p2d_combine(F, l); xcd_barrier(bar); }
#pragma unroll 1
            for (int rep = 0; rep < REP_P34; ++rep) { p3_merge(F, l); xcd_barrier(bar); p4_wout(F, l); xcd_barrier(bar); }
#pragma unroll 1
            for (int rep = 0; rep < REP_P5; ++rep) { p5_ln_route(F, g, l, rep == REP_P5 - 1 ? g * 2 + l : 8 + (g * 2 + l) * 2 + rep); xcd_barrier(bar); }
#pragma unroll 1
            for (int rep = 0; rep < REP_MOE; ++rep) { p6_moe1(F, g, l); xcd_barrier(bar); p7_moe2(F, g, l); xcd_barrier(bar); }
#pragma unroll 1
            for (int rep = 0; rep < REP_LN; ++rep) { p8_ln2(F, g, l); xcd_barrier(bar); }
        }
    }
}

extern "C" void kernel_launch(void* const* d_in, const int* in_sizes, int n_in, void* d_out, int out_size, void* d_ws, size_t ws_size, hipStream_t stream) {
    static int grid = 0;
    if (grid == 0) {
        if (n_in != 25 || out_size != T * D || ws_size < WS_END) { fprintf(stderr, "kernel_launch: unexpected shapes (n_in %d out %d ws %zu)\n", n_in, out_size, ws_size); grid = -1; return; }
        int dev = 0, cus = 0;
        if (hipGetDevice(&dev) != hipSuccess || hipDeviceGetAttribute(&cus, hipDeviceAttributeMultiprocessorCount, dev) != hipSuccess) { grid = -1; return; }
        (void)hipGetLastError();
        grid = cus;
        if (grid != 256) { fprintf(stderr, "kernel_launch: built for 256 CUs, got %d\n", cus); grid = -1; return; }
    }
    if (grid < 0) return;
    (void)hipMemsetAsync((char*)d_ws + WS_CTL, 0, CTL_ZERO_BYTES, stream);
    Args a{};
    for (int i = 0; i < 25; ++i) a.in[i] = d_in[i];
    a.out = (float*)d_out; a.ws = (unsigned char*)d_ws;
    { static bool attr = false; if (!attr) { (void)hipFuncSetAttribute((const void*)fwd_all, hipFuncAttributeMaxDynamicSharedMemorySize, LDS_BYTES); attr = true; }
      hipLaunchKernelGGL(fwd_all, dim3(grid), dim3(NTHR), LDS_BYTES, stream, a);}

}
```

```cpp
#include <hip/hip_runtime.h>
#include <cstdio>
#include <cstdint>

#ifndef ONE_LAUNCH
#define ONE_LAUNCH 1
#endif

#define GAS __attribute__((address_space(1)))
#define LAS __attribute__((address_space(3)))
typedef unsigned short bf16;
typedef float f32x4 __attribute__((ext_vector_type(4)));
typedef float f32x2 __attribute__((ext_vector_type(2)));
typedef unsigned u32x4 __attribute__((ext_vector_type(4)));
typedef unsigned u32x2 __attribute__((ext_vector_type(2)));

constexpr int D = 1024, NBATCH = 32, S = 2048, T = NBATCH * S, NL = 2;
constexpr int GB = 16, TG = GB * S, NG = NBATCH / GB;
constexpr int INC = 7680;
constexpr int NE = 32, DE = 512;
constexpr float ALPHA = 1.4142135623730951f, EPS = 1e-5f;
constexpr int NWAVES = 8, NTHR = 512;

constexpr size_t MiB = 1u << 20;
constexpr size_t WS_CTL = 0, CTL_ZERO_BYTES = 1 * MiB;
constexpr size_t WS_ROT = 1 * MiB;
constexpr size_t WS_LB = 5 * MiB;
constexpr size_t WS_RW = 6 * MiB;
constexpr size_t WS_WIN = 8 * MiB;
constexpr size_t WS_WBR = 38 * MiB;
constexpr size_t WS_WOUT = 44 * MiB;
constexpr size_t WS_W13 = 48 * MiB;
constexpr size_t WS_W2 = 176 * MiB;
constexpr size_t WS_XB = 240 * MiB;
constexpr size_t WS_U = 304 * MiB;
constexpr size_t WS_Q = 336 * MiB, WS_K = 368 * MiB, WS_V = 400 * MiB;
constexpr size_t WS_HQ = 432 * MiB, WS_HF = 464 * MiB, WS_HV = 496 * MiB, WS_HG = 528 * MiB;
constexpr size_t WS_GATE = 560 * MiB;
constexpr size_t WS_YA = 752 * MiB, WS_YB = 784 * MiB, WS_YC = 816 * MiB;
constexpr size_t WS_R = 848 * MiB;
constexpr size_t WS_TOK = 976 * MiB;
constexpr size_t WS_RT = 980 * MiB;
constexpr size_t WS_END = 982 * MiB;
constexpr size_t WS_M = WS_Q;
constexpr size_t WS_X1 = WS_YA;
constexpr size_t WS_HM = 304 * MiB;
constexpr size_t WS_OM = 376 * MiB;
constexpr size_t HSTRIDE = (size_t)TG * 512;
static_assert((WS_K - WS_Q) == HSTRIDE * 2 && (WS_HQ - WS_V) == HSTRIDE * 2 && (WS_HF - WS_HQ) == HSTRIDE * 2 && (WS_HV - WS_HF) == HSTRIDE * 2 && (WS_HG - WS_HV) == HSTRIDE * 2, "EpiInProj pointer arithmetic");
static_assert(WS_OM + (size_t)(2 * TG + 32 * 256) * 1024 * 2 <= WS_GATE && WS_HM + (size_t)(2 * TG + 32 * 256) * 512 * 2 <= WS_OM, "expert buffers overlay U..HF only");
constexpr int CW_BAR = 4096;
constexpr int CW_CNT = 16384;

__device__ __forceinline__ float bf2f(bf16 b) { return __uint_as_float(((unsigned)b) << 16); }
__device__ __forceinline__ unsigned f2bf(float f) { unsigned u = __float_as_uint(f); return (u + 0x7fffu + ((u >> 16) & 1u)) >> 16; }
__device__ __forceinline__ unsigned pk2(float lo, float hi) { unsigned r; asm volatile("v_cvt_pk_bf16_f32 %0, %1, %2" : "=v"(r) : "v"(lo), "v"(hi)); return r; }
__device__ __forceinline__ float lo16(unsigned w) { return __uint_as_float(w << 16); }
__device__ __forceinline__ float hi16(unsigned w) { return __uint_as_float(w & 0xffff0000u); }
#define DPP_ADD(v, ctrl) ((v) + __builtin_bit_cast(float, __builtin_amdgcn_update_dpp(0, __builtin_bit_cast(int, (v)), (ctrl), 0xF, 0xF, true)))
__device__ __forceinline__ float wave_sum(float v) {
    v = DPP_ADD(v, 0xB1);
    v = DPP_ADD(v, 0x4E);
    v = DPP_ADD(v, 0x141);
    v = DPP_ADD(v, 0x140);
    v = v + __builtin_bit_cast(float, __builtin_amdgcn_update_dpp(0, __builtin_bit_cast(int, v), 0x142, 0xA, 0xF, false));
    v = v + __builtin_bit_cast(float, __builtin_amdgcn_update_dpp(0, __builtin_bit_cast(int, v), 0x143, 0xC, 0xF, false));
    return __builtin_bit_cast(float, __builtin_amdgcn_readlane(__builtin_bit_cast(int, v), 63));
}
__device__ __forceinline__ float wave_max(float v) {
#pragma unroll
    for (int o = 1; o < 64; o <<= 1) v = fmaxf(v, __shfl_xor(v, o));
    return v;
}
__device__ __forceinline__ float sigmoidf_(float z) { return 1.f / (1.f + expf(-z)); }
__device__ __forceinline__ float siluf_(float z) { return z / (1.f + expf(-z)); }
__device__ __forceinline__ float hg_logf(float z, float lb) {
    if (z >= 0.f) { const float sn = 1.f / (1.f + expf(z)); return log1pf(-(1.f - lb) * sn); }
    const float ez = expf(z); return logf(lb + (1.f - lb) * (ez / (1.f + ez)));
}
#define LDS_WAIT() asm volatile("s_waitcnt lgkmcnt(0)" ::: "memory")

#define XB_TMO      128
#define XB_XCNT(j)  (256  + 64 * (j))
#define XB_XSUB(j)  (1280 + 64 * (j))
#define XB_XGEN(j)  (2304 + 64 * (j))
#define XB_TOP      3328
#define XB_TOPGEN   3392
#define XCD_BAR_WORDS 3456
#define XB_SPIN_CAP (1u << 22)
__device__ __forceinline__ unsigned xb_ld(unsigned* p)              { return __hip_atomic_load(p, __ATOMIC_RELAXED, __HIP_MEMORY_SCOPE_AGENT); }
__device__ __forceinline__ unsigned xb_add(unsigned* p, unsigned v) { return __hip_atomic_fetch_add(p, v, __ATOMIC_RELAXED, __HIP_MEMORY_SCOPE_AGENT); }
__device__ __forceinline__ unsigned xb_xcc_id() { return (unsigned)__builtin_amdgcn_s_getreg((3 << 11) | 20) & 0xFu; }
#define XB_SPIN(cond, bar) do { unsigned _sp = 0; while (cond) { __builtin_amdgcn_s_sleep(1); \
    if ((++_sp & 255u) == 0u) { if (xb_ld(&(bar)[XB_TMO])) break; if (_sp > XB_SPIN_CAP) { atomicAdd(&(bar)[XB_TMO], 1u); break; } } } } while (0)
struct XcdBarrier { unsigned* bar; unsigned x; volatile LAS unsigned* st; };
__device__ __forceinline__ XcdBarrier xcd_barrier_post(unsigned* bar, volatile LAS unsigned* st) {
    XcdBarrier b; b.bar = bar; b.x = (unsigned)__builtin_amdgcn_readfirstlane((int)xb_xcc_id()); b.st = st;
    if (threadIdx.x == 0) (void)xb_add(&bar[XB_XCNT(b.x)], 1u);
    return b;
}
__device__ __forceinline__ void xcd_barrier_complete(unsigned* bar, unsigned x, unsigned& nloc, unsigned& nx) {
    const unsigned G = gridDim.x * gridDim.y * gridDim.z;
    unsigned sum, cnt, mine, sp = 0u;
    for (;;) {
        sum = 0u; cnt = 0u; mine = 0u;
#pragma unroll
        for (unsigned j = 0; j < 16; ++j) { const unsigned c = xb_ld(&bar[XB_XCNT(j)]); sum += c; cnt += (c > 0u) ? 1u : 0u; mine = (j == x) ? c : mine; }
        if (sum == G) break;
        __builtin_amdgcn_s_sleep(1);
        if ((++sp & 255u) == 0u) { if (xb_ld(&bar[XB_TMO])) break; if (sp > XB_SPIN_CAP) { atomicAdd(&bar[XB_TMO], 1u); break; } }
    }
    nloc = mine > 0u ? mine : 1u; nx = cnt > 0u ? cnt : 1u;
}
__device__ __forceinline__ void xcd_barrier(const XcdBarrier& b_) {
    XcdBarrier b = b_;
    { unsigned long long bp = (unsigned long long)b_.bar; unsigned bx = b_.x; asm volatile("" : "+s"(bp), "+s"(bx)); b.bar = (unsigned*)(GAS unsigned*)bp; b.x = bx; }
    asm volatile("s_waitcnt vmcnt(0)" ::: "memory");
    __syncthreads();
    if (threadIdx.x == 0) {
        unsigned* bar = b.bar;
        __builtin_amdgcn_s_waitcnt(0);
        unsigned nloc = b.st[0], nx = b.st[1];
        if (nloc == 0u) { xcd_barrier_complete(bar, b.x, nloc, nx); b.st[0] = nloc; b.st[1] = nx; }
        const unsigned old = xb_add(&bar[XB_XSUB(b.x)], 1u);
        const unsigned gen = old / nloc;
        if (old + 1u == (gen + 1u) * nloc) {
            __builtin_amdgcn_fence(__ATOMIC_RELEASE, "agent");
            asm volatile("s_waitcnt vmcnt(0)" ::: "memory");
            const unsigned og = xb_add(&bar[XB_TOP], 1u);
            const unsigned tg = og / nx;
            if (og + 1u == (tg + 1u) * nx) xb_add(&bar[XB_TOPGEN], 1u);
            else XB_SPIN(xb_ld(&bar[XB_TOPGEN]) == tg, bar);
            __builtin_amdgcn_fence(__ATOMIC_ACQUIRE, "agent");
            xb_add(&bar[XB_XGEN(b.x)], 1u);
            asm volatile("s_waitcnt vmcnt(0)" ::: "memory");
        } else {
            XB_SPIN(xb_ld(&bar[XB_XGEN(b.x)]) == gen, bar);
            __builtin_amdgcn_fence(__ATOMIC_ACQUIRE, "agent");
            asm volatile("s_waitcnt vmcnt(0)" ::: "memory");
        }
    }
    __syncthreads();
}

constexpr int LDS_BYTES = 147456;
constexpr int MISC_OFF = 135168;
struct Args { const void* in[25]; float* out; unsigned char* ws; int g_lo, g_hi, l_lo, l_hi, ph_lo, ph_hi, prologue, pad; };
struct Frame { LAS unsigned char* lds; int tid, lane, wave; };
typedef const __attribute__((address_space(4))) Args* KArgs;
__device__ __forceinline__ KArgs kargs() { unsigned long long v = (unsigned long long)__builtin_amdgcn_kernarg_segment_ptr(); asm volatile("" : "+s"(v)); return (KArgs)v; }
#define KA_WS() KArgs ka = kargs(); unsigned char* ws = (unsigned char*)(GAS unsigned char*)ka->ws
#define KIN(i) ((const void*)(const GAS char*)ka->in[i])
#define KOUT() ((float*)(GAS float*)ka->out)
__device__ __forceinline__ Frame mkframe(LAS unsigned char* lds) { Frame F; int t = threadIdx.x; asm volatile("" : "+v"(t)); F.lds = lds; F.tid = t; F.lane = t & 63; F.wave = __builtin_amdgcn_readfirstlane(t >> 6); return F; }

namespace pg8 {
typedef short bf16x8 __attribute__((ext_vector_type(8)));
constexpr int BM = 256, BK = 64, HALF = 128, HTB = HALF * BK * 2, STAGE_BYTES = 8 * HTB, NXCD = 8, WGM = 8;
__host__ __device__ __forceinline__ int lds_byte(int r, int c) { const int st = (r >> 4) * 2 + (c >> 5), rr = r & 15, cc = c & 31, ob = rr * 64 + cc * 2; return st * 1024 + (ob ^ (((ob >> 9) & 1) << 5)); }
__host__ __device__ __forceinline__ void stage_rc(int b, int& R, int& C) { const int st = b / 1024, sb = b % 1024, swz = sb ^ (((sb >> 9) & 1) << 5); R = (st >> 1) * 16 + swz / 64; C = (st & 1) * 32 + (swz % 64) / 2; }
__host__ __device__ __forceinline__ int perm32(int rho) { const int n = rho >> 4, i = rho & 15; return 8 * (i >> 2) + 4 * n + (i & 3); }
struct Unit { int pm, pn, e, pos0, cnt; };
__device__ __forceinline__ int xcd_remap(int wgid, int nwg) { const int q = nwg / NXCD, r = nwg % NXCD, xcd = wgid % NXCD, off = wgid / NXCD; return (xcd < r ? xcd * (q + 1) : r * (q + 1) + (xcd - r) * q) + off; }
struct StaticOrder {
    int nM, nN, nwg, G, c;
    __device__ void init(int M, int N, int G_, int c_) { nM = M / BM; nN = N / BM; nwg = nM * nN; G = G_; c = c_; }
    __device__ bool next(int i, Unit& u) const {
        const long L = (long)i * G + c; if (L >= nwg) return false;
        const int wgid = xcd_remap((int)L, nwg);
        const int nig = WGM * nN, gid = wgid / nig, fm = gid * WGM, gsz = (nM - fm) < WGM ? (nM - fm) : WGM;
        u.pm = fm + ((wgid % nig) % gsz); u.pn = (wgid % nig) / gsz; u.e = 0; u.pos0 = 0; u.cnt = 0; return true;
    }
    __device__ __forceinline__ void a_ready(const Unit&) const {}
    __device__ __forceinline__ void done(const Unit&) const {}
};
template <int PART> struct SubOrder {
    StaticOrder so;
    __device__ void init(int M, int G_, int c_) { so.init(M, (PART == 0 ? 18 : 12) * BM, G_, c_); }
    __device__ bool next(int i, Unit& u) const { if (!so.next(i, u)) return false; u.pn = PART == 0 ? u.pn + 4 : (u.pn < 4 ? u.pn : u.pn + 18); return true; }
    __device__ __forceinline__ void a_ready(const Unit&) const {}
    __device__ __forceinline__ void done(const Unit&) const {}
};
struct MergeOrder {
    StaticOrder so;
    __device__ bool next(int i, Unit& u) const { if (!so.next(i / 3, u)) return false; u.e = i % 3; return true; }
    __device__ __forceinline__ void a_ready(const Unit&) const {}
    __device__ __forceinline__ void done(const Unit&) const {}
};
struct MoeOrder {
    const LAS int* tab; int G, c, NT;
    __device__ bool next(int i, Unit& u) const {
        const int np = __builtin_amdgcn_readfirstlane(tab[32]); const int nwg = np * NT;
        const long L = (long)i * G + c; if (L >= nwg) return false;
        const int wgid = xcd_remap((int)L, nwg);
        const int panel = wgid / NT; u.pn = wgid % NT;
        int e = 0;
#pragma unroll
        for (int s2 = 16; s2 >= 1; s2 >>= 1) { const int tv = __builtin_amdgcn_readfirstlane(tab[e + s2]); if (tv <= panel) e += s2; }
        u.e = e; u.pm = panel; u.pos0 = (panel - __builtin_amdgcn_readfirstlane(tab[e])) * 256; u.cnt = __builtin_amdgcn_readfirstlane(tab[33 + e]); return true;
    }
    __device__ __forceinline__ void a_ready(const Unit&) const {}
    __device__ __forceinline__ void done(const Unit&) const {}
};
__device__ __forceinline__ unsigned cvt_pk_bf16(float lo, float hi) { unsigned r; asm volatile("v_cvt_pk_bf16_f32 %0, %1, %2" : "=v"(r) : "v"(lo), "v"(hi)); return r; }

template <class Prob, class Epi, class Sched, bool ALIGN_EPI>
__device__ __forceinline__ void gemm_phase(LAS unsigned char* lds, const Prob& P, const Sched& S, const Epi& E) {
    int tid_ = threadIdx.x; asm volatile("" : "+v"(tid_));
    const int tid = tid_, wid = __builtin_amdgcn_readfirstlane(tid >> 6), lane = tid & 63, wr = wid >> 2, wc = wid & 3, fr = lane & 15, fq = lane >> 4;
    const int K = P.K, nt = K / BK;
    unsigned vA[2][2], voffB[2];
#pragma unroll
    for (int i = 0; i < 2; ++i) { int R, C; stage_rc(tid * 16 + i * 8192, R, C); const int Rb = (R & ~31) + perm32(R & 31);
        vA[0][i] = (unsigned)(R * K + C) * 2u; vA[1][i] = vA[0][i] + (unsigned)(HALF * K * 2); voffB[i] = (unsigned)(Rb * K + C) * 2u; }
    const size_t kstep = (size_t)(BK * 2);
    const size_t hstep = (size_t)HALF * K * 2;
    const unsigned ldsw = (unsigned)wid * 1024u;
    const int aoff = lds_byte(wr * 64 + fr, fq * 8), boff = lds_byte(wc * 32 + fr, fq * 8);
#define PG8_SA(b, h) (((b) * 2 + (h)) * HTB)
#define PG8_SB(b, h) ((4 + (b) * 2 + (h)) * HTB)
#define PG8_STAGE(bufoff, gbase, voff) do { _Pragma("unroll") for (int _i = 0; _i < 2; ++_i) \
        __builtin_amdgcn_global_load_lds((const unsigned*)((const char*)(gbase) + (voff)[_i]), (LAS unsigned*)(lds + (bufoff) + ldsw + _i * 8192), 16, 0, 0); } while (0)
#define PG8_LDA(dst, b, h) do { _Pragma("unroll") for (int m = 0; m < 4; ++m) _Pragma("unroll") for (int k = 0; k < 2; ++k) dst[m][k] = *(const LAS bf16x8*)(lds + PG8_SA(b, h) + aoff + m * 2048 + k * 1024); } while (0)
#define PG8_LDB(dst, b, h) do { _Pragma("unroll") for (int n = 0; n < 2; ++n) _Pragma("unroll") for (int k = 0; k < 2; ++k) dst[n][k] = *(const LAS bf16x8*)(lds + PG8_SB(b, h) + boff + n * 2048 + k * 1024); } while (0)
#define PG8_MMA(ai, bj, At, Bt) do { __builtin_amdgcn_s_setprio(1); _Pragma("unroll") for (int m = 0; m < 4; ++m) _Pragma("unroll") for (int n = 0; n < 2; ++n) _Pragma("unroll") for (int k = 0; k < 2; ++k) \
        acc[ai][bj][m][n] = __builtin_amdgcn_mfma_f32_16x16x32_bf16(Bt[n][k], At[m][k], acc[ai][bj][m][n], 0, 0, 0); __builtin_amdgcn_s_setprio(0); } while (0)
#define PG8_WAIT_V(n) asm volatile("s_waitcnt vmcnt(" #n ")" ::: "memory")
#define PG8_WAIT_L(n) asm volatile("s_waitcnt lgkmcnt(" #n ")" ::: "memory")
#define PG8_BAR __builtin_amdgcn_s_barrier()
#define PG8_SCHED __builtin_amdgcn_sched_barrier(0)
    Unit cur, nxt; int ui = 0;
    if (!S.next(0, cur)) return;
    f32x4 acc[2][2][4][2];
#pragma unroll
    for (int a = 0; a < 2; ++a)
#pragma unroll
        for (int b = 0; b < 2; ++b)
#pragma unroll
            for (int m = 0; m < 4; ++m)
#pragma unroll
                for (int n = 0; n < 2; ++n) acc[a][b][m][n] = (f32x4){0.f, 0.f, 0.f, 0.f};
    bf16x8 At[4][2], B0[2][2], B1[2][2];
    const char* cA = P.abase(cur); const char* cB = P.bbase(cur);
    if constexpr (Prob::GATHER) P.voff(cur, tid, vA);
    S.a_ready(cur);
    PG8_STAGE(PG8_SB(0, 0), cB, voffB); PG8_STAGE(PG8_SB(0, 1), cB + hstep, voffB); PG8_STAGE(PG8_SA(0, 0), cA, vA[0]); PG8_STAGE(PG8_SA(0, 1), cA, vA[1]);
    if (wr == 1) PG8_BAR;
    PG8_WAIT_V(2); PG8_BAR;
    PG8_STAGE(PG8_SB(1, 0), cB + kstep, voffB); PG8_STAGE(PG8_SA(1, 0), cA + kstep, vA[0]); PG8_STAGE(PG8_SB(1, 1), cB + hstep + kstep, voffB);
    PG8_WAIT_V(6); PG8_BAR;
    for (;;) {
        const bool has_next = S.next(ui + 1, nxt);
        const char* nA = has_next ? P.abase(nxt) : cA; const char* nB = has_next ? P.bbase(nxt) : cB;
        unsigned nv[2][2];
#pragma unroll
        for (int h = 0; h < 2; ++h)
#pragma unroll
            for (int i = 0; i < 2; ++i) nv[h][i] = vA[h][i];
        for (int t = 0; t < nt; t += 2) {
            const bool last = (t == nt - 2);
            if constexpr (Prob::GATHER) { if (t == nt - 4 && has_next) P.voff(nxt, tid, nv); }
            const char* a1 = cA + (size_t)(t + 1) * kstep;
            const char* a2 = last ? nA : cA + (size_t)(t + 2) * kstep; const char* b2 = last ? nB : cB + (size_t)(t + 2) * kstep;
            const char* a3 = a2 + kstep; const char* b3 = b2 + kstep;
            if (last && has_next) S.a_ready(nxt);
            unsigned w0[2], w1[2];
#pragma unroll
            for (int i = 0; i < 2; ++i) { if constexpr (Prob::GATHER) { w0[i] = last ? nv[0][i] : vA[0][i]; w1[i] = last ? nv[1][i] : vA[1][i]; } else { w0[i] = vA[0][i]; w1[i] = vA[1][i]; } }
            PG8_LDB(B0, 0, 0); PG8_LDB(B1, 0, 1); PG8_SCHED; PG8_LDA(At, 0, 0); PG8_STAGE(PG8_SA(1, 1), a1, vA[1]);
            PG8_WAIT_V(8); PG8_WAIT_L(0); PG8_BAR; PG8_MMA(0, 0, At, B0); PG8_MMA(0, 1, At, B1); PG8_BAR; PG8_SCHED;
            PG8_LDA(At, 0, 1); PG8_STAGE(PG8_SB(0, 0), b2, voffB); PG8_STAGE(PG8_SB(0, 1), b2 + hstep, voffB); PG8_STAGE(PG8_SA(0, 0), a2, w0);
            PG8_WAIT_V(8); PG8_WAIT_L(0); PG8_BAR; PG8_MMA(1, 0, At, B0); PG8_MMA(1, 1, At, B1); PG8_BAR; PG8_SCHED;
            PG8_LDB(B0, 1, 0); PG8_LDB(B1, 1, 1); PG8_SCHED; PG8_LDA(At, 1, 0); PG8_STAGE(PG8_SA(0, 1), a2, w1);
            PG8_WAIT_V(8); PG8_WAIT_L(0); PG8_BAR; PG8_MMA(0, 0, At, B0); PG8_MMA(0, 1, At, B1); PG8_BAR; PG8_SCHED;
            PG8_LDA(At, 1, 1); PG8_STAGE(PG8_SB(1, 0), b3, voffB); PG8_STAGE(PG8_SB(1, 1), b3 + hstep, voffB); PG8_STAGE(PG8_SA(1, 0), a3, w0);
            PG8_WAIT_V(8); PG8_WAIT_L(0); PG8_BAR; PG8_MMA(1, 0, At, B0); PG8_MMA(1, 1, At, B1); PG8_BAR; PG8_SCHED;
        }
        if constexpr (ALIGN_EPI) { if (wr == 0) PG8_BAR; }
        E(acc, cur, wr, wc, fr, fq); S.done(cur);
        if (!has_next) break;
        if (!(Epi::CARRY && nxt.e != 0))
#pragma unroll
        for (int a = 0; a < 2; ++a)
#pragma unroll
            for (int b = 0; b < 2; ++b)
#pragma unroll
                for (int m = 0; m < 4; ++m)
#pragma unroll
                    for (int n = 0; n < 2; ++n) acc[a][b][m][n] = (f32x4){0.f, 0.f, 0.f, 0.f};
        cur = nxt; cA = nA; cB = nB; ++ui;
        if constexpr (Prob::GATHER) {
#pragma unroll
            for (int h = 0; h < 2; ++h)
#pragma unroll
                for (int i = 0; i < 2; ++i) vA[h][i] = nv[h][i]; }
        if constexpr (ALIGN_EPI) { if (wr == 1) PG8_BAR; }
    }
    PG8_WAIT_V(0);
    if constexpr (!ALIGN_EPI) { if (wr == 0) PG8_BAR; }
    PG8_BAR;
#undef PG8_SA
#undef PG8_SB
#undef PG8_STAGE
#undef PG8_LDA
#undef PG8_LDB
#undef PG8_MMA
#undef PG8_WAIT_V
#undef PG8_WAIT_L
#undef PG8_BAR
#undef PG8_SCHED
}
struct ProbDense { static constexpr bool GATHER = false; const char* A; const char* Bt; int K;
    __device__ __forceinline__ const char* abase(const Unit& u) const { return A + (size_t)u.pm * 256 * K * 2; }
    __device__ __forceinline__ const char* bbase(const Unit& u) const { return Bt + (size_t)u.pn * 256 * K * 2; }
    __device__ __forceinline__ void voff(const Unit&, int, unsigned (&)[2][2]) const {} };
struct ProbMerge { static constexpr bool GATHER = false; const char* Y0; const char* Y1; const char* Y2; const char* W; int K;
    __device__ __forceinline__ const char* abase(const Unit& u) const { const char* y = u.e == 0 ? Y0 : (u.e == 1 ? Y1 : Y2); return y + (size_t)u.pm * 256 * K * 2; }
    __device__ __forceinline__ const char* bbase(const Unit& u) const { return W + ((size_t)u.e * 1024 + u.pn * 256) * K * 2; }
    __device__ __forceinline__ void voff(const Unit&, int, unsigned (&)[2][2]) const {} };
struct ProbMoe1 { static constexpr bool GATHER = true; const char* X1; const char* W; const int* TOK; int K;
    __device__ __forceinline__ const char* abase(const Unit&) const { return X1; }
    __device__ __forceinline__ const char* bbase(const Unit& u) const { return W + ((size_t)u.e * 1024 + u.pn * 256) * K * 2; }
    __device__ __forceinline__ void voff(const Unit& u, int tid, unsigned (&v)[2][2]) const {
#pragma unroll
        for (int i = 0; i < 2; ++i) { int R, C; stage_rc(tid * 16 + i * 8192, R, C);
#pragma unroll
            for (int h = 0; h < 2; ++h) { const int pos = u.pos0 + h * 128 + R; int tk = TOK[(size_t)u.e * TG + pos]; tk = pos < u.cnt ? tk : 0; v[h][i] = (unsigned)tk * (unsigned)(K * 2) + (unsigned)C * 2u; } } } };
struct ProbMoe2 { static constexpr bool GATHER = false; const char* HM; const char* W; int K;
    __device__ __forceinline__ const char* abase(const Unit& u) const { return HM + (size_t)u.pm * 256 * K * 2; }
    __device__ __forceinline__ const char* bbase(const Unit& u) const { return W + ((size_t)u.e * 1024 + u.pn * 256) * K * 2; }
    __device__ __forceinline__ void voff(const Unit&, int, unsigned (&)[2][2]) const {} };

__device__ __forceinline__ float fsig(float z) { return __builtin_amdgcn_rcpf(1.f + __expf(-z)); }
__device__ __forceinline__ float hg_logf_fast(float z, float lb) {
    const float t = __expf(-fabsf(z)), sg = t * __builtin_amdgcn_rcpf(1.f + t), w = (1.f - lb) * sg;
    return __logf(z >= 0.f ? 1.f - w : lb + w);
}
__device__ __forceinline__ void st8(bf16* p, const f32x4& a, const f32x4& b) { u32x4 w; w.x = cvt_pk_bf16(a[0], a[1]); w.y = cvt_pk_bf16(a[2], a[3]); w.z = cvt_pk_bf16(b[0], b[1]); w.w = cvt_pk_bf16(b[2], b[3]); *(u32x4*)p = w; }
struct EpiInProj {
    static constexpr bool PERM = true, CARRY = false;
    bf16 *U, *Q, *V, *GATE; const float* rot; const float* lbt; const float* bg;
    __device__ __forceinline__ void operator()(const f32x4 (&acc)[2][2][4][2], const Unit& u, int wr, int wc, int fr, int fq) const {
        const int pn = u.pn, rowb = u.pm * 256 + wr * 64 + fr, cl = wc * 32 + 8 * fq;
        if (pn < 4) {
#pragma unroll
            for (int ai = 0; ai < 2; ++ai)
#pragma unroll
                for (int m = 0; m < 4; ++m) { const int row = rowb + ai * 128 + m * 16; f32x4 o0, o1;
#pragma unroll
                    for (int j = 0; j < 4; ++j) { o0[j] = acc[ai][0][m][0][j] * fsig(acc[ai][1][m][0][j]); o1[j] = acc[ai][0][m][1][j] * fsig(acc[ai][1][m][1][j]); }
                    st8(U + (size_t)row * 512 + pn * 128 + cl, o0, o1); asm volatile("" ::: "memory"); }
        } else if (pn < 8) {
            const int which = pn - 4; bf16* dst = Q + (size_t)(which >> 1) * HSTRIDE; const float sc = (which >> 1) ? 1.f : 0.125f * 1.4426950408889634f; const int colb = (which & 1) * 256 + cl;
            const bool rotw = (wc & 1) == 0; const float sgn = fq == 0 ? -1.f : 1.f;
#pragma unroll
            for (int ai = 0; ai < 2; ++ai) {
                f32x4 cs[4][4];
#pragma unroll
                for (int m = 0; m < 4; ++m) { cs[m][0] = (f32x4){1.f, 1.f, 1.f, 1.f}; cs[m][1] = cs[m][0]; cs[m][2] = (f32x4){0.f, 0.f, 0.f, 0.f}; cs[m][3] = cs[m][2];
                    if (rotw && fq < 2) { const f32x4* rp = (const f32x4*)(rot + (size_t)(rowb + ai * 128 + m * 16) * 16); cs[m][0] = rp[0]; cs[m][1] = rp[1]; cs[m][2] = rp[2]; cs[m][3] = rp[3]; } }
#pragma unroll
                for (int m = 0; m < 4; ++m) { const int row = rowb + ai * 128 + m * 16;
                    const f32x4 c0 = cs[m][0], c1 = cs[m][1], s0 = cs[m][2] * sgn, s1 = cs[m][3] * sgn;
#pragma unroll
                    for (int bj = 0; bj < 2; ++bj) { f32x4 x0 = acc[ai][bj][m][0], x1 = acc[ai][bj][m][1];
                        if (rotw) { f32x4 p0, p1;
#pragma unroll
                            for (int j = 0; j < 4; ++j) { p0[j] = __shfl_xor(x0[j], 16); p1[j] = __shfl_xor(x1[j], 16); }
                            x0 = x0 * c0 + p0 * s0; x1 = x1 * c1 + p1 * s1; }
                        st8(dst + (size_t)row * 512 + colb + bj * 128, x0 * sc, x1 * sc); } }
                asm volatile("" ::: "memory"); }
        } else {
            int kind, ldc, colb; bf16* dst; bool seqc = false;
            if (pn < 18) { const int tq = (pn - 8) >> 1; seqc = tq >= 1; kind = tq == 0 ? 0 : (tq == 1 ? 1 : (tq == 2 ? 2 : (tq == 3 ? 0 : 1))); dst = V + (size_t)tq * HSTRIDE; ldc = 512; colb = ((pn - 8) & 1) * 256; }
            else { kind = 3; dst = GATE; ldc = 3072; colb = (pn - 18) * 256; }
            f32x4 aux[2][2];
#pragma unroll
            for (int bj = 0; bj < 2; ++bj)
#pragma unroll
                for (int n = 0; n < 2; ++n) aux[bj][n] = kind == 2 ? *(const f32x4*)(lbt + colb + bj * 128 + cl + 4 * n) : (kind == 3 ? *(const f32x4*)(bg + colb + bj * 128 + cl + 4 * n) : (f32x4){0.f, 0.f, 0.f, 0.f});
#pragma unroll
            for (int ai = 0; ai < 2; ++ai)
#pragma unroll
                for (int m = 0; m < 4; ++m) { const int row = rowb + ai * 128 + m * 16;
#pragma unroll
                    for (int bj = 0; bj < 2; ++bj) { f32x4 x[2] = {acc[ai][bj][m][0], acc[ai][bj][m][1]};
                        if (kind == 1) {
#pragma unroll
                            for (int n = 0; n < 2; ++n)
#pragma unroll
                                for (int j = 0; j < 4; ++j) x[n][j] = x[n][j] * fsig(x[n][j]);
                        } else if (kind == 2) {
#pragma unroll
                            for (int n = 0; n < 2; ++n)
#pragma unroll
                                for (int j = 0; j < 4; ++j) x[n][j] = hg_logf_fast(x[n][j], aux[bj][n][j]);
                        } else if (kind == 3) {
#pragma unroll
                            for (int n = 0; n < 2; ++n)
#pragma unroll
                                for (int j = 0; j < 4; ++j) x[n][j] = fsig(x[n][j] + aux[bj][n][j]);
                        }
                        const size_t di = seqc ? ((size_t)((row >> 11) * 4 + (colb >> 7) + bj) * 2048 + (row & 2047)) * 128 + cl : (size_t)row * ldc + colb + bj * 128 + cl;
                        st8(dst + di, x[0], x[1]); } asm volatile("" ::: "memory"); }
        }
    }
};
struct EpiMerge {
    static constexpr bool PERM = true, CARRY = true;
    const bf16* GATE; bf16* M;
    __device__ __forceinline__ void operator()(f32x4 (&acc)[2][2][4][2], const Unit& u, int wr, int wc, int fr, int fq) const {
        const int rowb = u.pm * 256 + wr * 64 + fr, cl = u.pn * 256 + wc * 32 + 8 * fq, n = u.e;
#pragma unroll
        for (int ai = 0; ai < 2; ++ai) {
            u32x4 g[4][2], h[4][2];
#pragma unroll
            for (int m = 0; m < 4; ++m)
#pragma unroll
                for (int bj = 0; bj < 2; ++bj) { const bf16* gp = GATE + (size_t)(rowb + ai * 128 + m * 16) * 3072 + n * 1024 + cl + bj * 128;
                    g[m][bj] = *(const u32x4*)gp; h[m][bj] = g[m][bj]; if (n < 2) h[m][bj] = *(const u32x4*)(gp + 1024); }
#pragma unroll
            for (int m = 0; m < 4; ++m)
#pragma unroll
                for (int bj = 0; bj < 2; ++bj) { const u32x4 gg = g[m][bj], hh = h[m][bj];
                    f32x4 s0 = (f32x4){lo16(gg.x), hi16(gg.x), lo16(gg.y), hi16(gg.y)}, s1 = (f32x4){lo16(gg.z), hi16(gg.z), lo16(gg.w), hi16(gg.w)};
                    if (n < 2) {
                        const f32x4 d0 = (f32x4){lo16(hh.x), hi16(hh.x), lo16(hh.y), hi16(hh.y)}, d1 = (f32x4){lo16(hh.z), hi16(hh.z), lo16(hh.w), hi16(hh.w)};
#pragma unroll
                        for (int j = 0; j < 4; ++j) { s0[j] *= __builtin_amdgcn_rcpf(fmaxf(d0[j], 1e-20f)); s1[j] *= __builtin_amdgcn_rcpf(fmaxf(d1[j], 1e-20f)); }
                        acc[ai][bj][m][0] = acc[ai][bj][m][0] * s0; acc[ai][bj][m][1] = acc[ai][bj][m][1] * s1;
                    } else st8(M + (size_t)(rowb + ai * 128 + m * 16) * D + cl + bj * 128, acc[ai][bj][m][0] * s0, acc[ai][bj][m][1] * s1); }
            asm volatile("" ::: "memory"); }
    }
};
struct EpiWout {
    static constexpr bool PERM = true, CARRY = false;
    const bf16* XB; bf16* R;
    __device__ __forceinline__ void operator()(const f32x4 (&acc)[2][2][4][2], const Unit& u, int wr, int wc, int fr, int fq) const {
        const int rowb = u.pm * 256 + wr * 64 + fr, cl = u.pn * 256 + wc * 32 + 8 * fq;
#pragma unroll
        for (int ai = 0; ai < 2; ++ai) {
            u32x4 g[4][2];
#pragma unroll
            for (int m = 0; m < 4; ++m)
#pragma unroll
                for (int bj = 0; bj < 2; ++bj) g[m][bj] = *(const u32x4*)(XB + (size_t)(rowb + ai * 128 + m * 16) * D + cl + bj * 128);
#pragma unroll
            for (int m = 0; m < 4; ++m)
#pragma unroll
                for (int bj = 0; bj < 2; ++bj) { const size_t o = (size_t)(rowb + ai * 128 + m * 16) * D + cl + bj * 128; const u32x4 gg = g[m][bj];
                    st8(R + o, acc[ai][bj][m][0] + (f32x4){lo16(gg.x), hi16(gg.x), lo16(gg.y), hi16(gg.y)} * ALPHA, acc[ai][bj][m][1] + (f32x4){lo16(gg.z), hi16(gg.z), lo16(gg.w), hi16(gg.w)} * ALPHA); }
            asm volatile("" ::: "memory"); }
    }
};
struct EpiMoe1 {
    static constexpr bool PERM = true, CARRY = false;
    bf16* HM;
    __device__ __forceinline__ void operator()(const f32x4 (&acc)[2][2][4][2], const Unit& u, int wr, int wc, int fr, int fq) const {
        const int rowb = u.pm * 256 + wr * 64 + fr, cl = u.pn * 128 + wc * 32 + 8 * fq;
#pragma unroll
        for (int ai = 0; ai < 2; ++ai)
#pragma unroll
            for (int m = 0; m < 4; ++m) { const int row = rowb + ai * 128 + m * 16; f32x4 o0, o1;
#pragma unroll
                for (int j = 0; j < 4; ++j) { const float a = acc[ai][0][m][0][j], b = acc[ai][0][m][1][j]; o0[j] = a * fsig(a) * acc[ai][1][m][0][j]; o1[j] = b * fsig(b) * acc[ai][1][m][1][j]; }
                st8(HM + (size_t)row * DE + cl, o0, o1); }
    }
};
struct EpiMoe2 {
    static constexpr bool PERM = true, CARRY = false;
    bf16* OM;
    __device__ __forceinline__ void operator()(const f32x4 (&acc)[2][2][4][2], const Unit& u, int wr, int wc, int fr, int fq) const {
        const int rowb = u.pm * 256 + wr * 64 + fr, cl = u.pn * 256 + wc * 32 + 8 * fq;
#pragma unroll
        for (int ai = 0; ai < 2; ++ai)
#pragma unroll
            for (int m = 0; m < 4; ++m) { const int row = rowb + ai * 128 + m * 16;
#pragma unroll
                for (int bj = 0; bj < 2; ++bj) st8(OM + (size_t)row * D + cl + bj * 128, acc[ai][bj][m][0], acc[ai][bj][m][1]); }
    }
};
}

__device__ __forceinline__ void p_prologue(Frame& F_) {
    KA_WS();
    Frame F = mkframe(F_.lds);
    const int gt = blockIdx.x * NTHR + F.tid, NT = gridDim.x * NTHR;
    const int* pos = (const int*)KIN(1);
    float* rot = (float*)(ws + WS_ROT);
    for (int i = gt; i < T * 8; i += NT) {
        const int t = i >> 3, f = i & 7;
        const double invf[8] = {1.0, 0.19392274474868576, 0.03760603093086393, 0.007292664737217109, 0.001414213562373095, 0.0002742481756762073, 5.318295896944988e-05, 1.031338537721246e-05};
        double w = 1.0;
#pragma unroll
        for (int j = 0; j < 8; ++j) w = (f == j) ? invf[j] : w;
        const double ang = (double)pos[t] * w;
        const double n = rint(ang * 0.15915494309189535); const double r = (ang - n * 6.283185307179586) - n * 2.4492935982947064e-16;
        rot[t * 16 + f] = cosf((float)r); rot[t * 16 + 8 + f] = sinf((float)r);
    }
    { bf16* rw = (bf16*)(ws + WS_RW);
      for (int i = gt; i < 2 * 48 * 1024; i += NT) { const int l2 = i / (48 * 1024), j = (i / 1024) % 48, d = i & 1023; float w = 0.f;
          if (j < 4) w = ((const float*)KIN(16))[((size_t)l2 * D + d) * 4 + j];
          else if (j < 36) w = ((const float*)KIN(18))[(((size_t)l2 * 4 + ((j - 4) >> 3)) * D + d) * 8 + ((j - 4) & 7)];
          const unsigned hb = f2bf(w); const float hf = __uint_as_float(hb << 16);
          rw[((size_t)l2 * 2 + 0) * 48 * 1024 + j * 1024 + d] = (bf16)hb; rw[((size_t)l2 * 2 + 1) * 48 * 1024 + j * 1024 + d] = (bf16)f2bf(w - hf); } }
    float* lbt = (float*)(ws + WS_LB);
    const float* hg_lb = (const float*)KIN(9);
    for (int i = gt; i < 512; i += NT) { const float a0 = hg_lb[i], a1 = hg_lb[512 + i]; lbt[i] = 0.f; lbt[512 + i] = 1.f / (1.f + expf(a0 - a1)); }
    if (gt < 2) {
        const float* lp = (const float*)KIN(7) + gt * 256; float s1 = 0.f, s2 = 0.f;
        for (int i = 0; i < 64; ++i) { s1 += lp[i] * lp[64 + i]; s2 += lp[128 + i] * lp[192 + i]; }
        const float lam_init = gt == 0 ? 0.2f : 0.35550906759096934f;
        lbt[1024 + gt] = expf(s1) - expf(s2) + lam_init;
    }
}
__device__ __forceinline__ void p_xload(Frame& F_, int g) {
    KA_WS();
    Frame F = mkframe(F_.lds);
    const f32x4* x = (const f32x4*)((const float*)KIN(0) + (size_t)g * TG * D);
    u32x2* o = (u32x2*)((bf16*)(ws + WS_XB));
    for (size_t i = (size_t)blockIdx.x * NTHR + F.tid; i < (size_t)TG * D / 4; i += (size_t)gridDim.x * NTHR) { const f32x4 v = x[i]; u32x2 w; w.x = pk2(v.x, v.y); w.y = pk2(v.z, v.w); o[i] = w; }
}

__device__ __forceinline__ void p2_conv_unit(Frame& F, unsigned char* ws, KArgs ka, int l, int cu) {
    const float* cw = (const float*)KIN(3) + (size_t)l * 31 * 512; const float* cb = (const float*)KIN(4) + l * 512;
    const float* lg = (const float*)KIN(5) + l * 512; const float* lb = (const float*)KIN(6) + l * 512;
    const bf16* __restrict__ U = (const bf16*)(ws + WS_U); bf16* __restrict__ YA = (bf16*)(ws + WS_YA);
    LAS float* Yt = (LAS float*)F.lds;
    const int lane = F.lane, wave = F.wave, hf = wave >> 2, c = 128 * (wave & 3) + 2 * lane;
    const int tb = cu * 64 + 32 * hf, sb = tb & (S - 1);
    f32x2 wt[31], uf[62];
#pragma unroll
    for (int j = 0; j < 31; ++j) wt[j] = *(const f32x2*)(cw + j * 512 + c);
#pragma unroll
    for (int k = 0; k < 62; ++k) { unsigned w = 0u; if (sb - 30 + k >= 0) w = *(const unsigned*)(U + (size_t)(tb - 30 + k) * 512 + c); uf[k] = (f32x2){lo16(w), hi16(w)}; }
    const f32x2 bias = *(const f32x2*)(cb + c);
    __syncthreads();
#pragma unroll
    for (int tt = 0; tt < 32; ++tt) { f32x2 acc = bias;
#pragma unroll
        for (int j = 0; j < 31; ++j) acc = acc + uf[tt + j] * wt[j];
        *(LAS f32x2*)(Yt + (32 * hf + tt) * 512 + c) = acc; }
    __syncthreads();
    const int c0 = lane * 8;
#pragma unroll 2
    for (int i = 0; i < 8; ++i) { const int tl = wave * 8 + i;
        const f32x4 a0 = *(const LAS f32x4*)(Yt + tl * 512 + c0), a1 = *(const LAS f32x4*)(Yt + tl * 512 + c0 + 4);
        float acc[8] = {a0.x, a0.y, a0.z, a0.w, a1.x, a1.y, a1.z, a1.w};
        float sm = 0.f;
#pragma unroll
        for (int q = 0; q < 8; ++q) sm += acc[q];
        const float mean = wave_sum(sm) * (1.f / 512.f); float sq = 0.f;
#pragma unroll
        for (int q = 0; q < 8; ++q) { acc[q] -= mean; sq += acc[q] * acc[q]; }
        const float rstd = __builtin_amdgcn_rsqf(wave_sum(sq) * (1.f / 512.f) + EPS);
        const f32x4 g0 = *(const f32x4*)(lg + c0), g1 = *(const f32x4*)(lg + c0 + 4), b0 = *(const f32x4*)(lb + c0), b1 = *(const f32x4*)(lb + c0 + 4);
        const float gg[8] = {g0.x, g0.y, g0.z, g0.w, g1.x, g1.y, g1.z, g1.w}, bb[8] = {b0.x, b0.y, b0.z, b0.w, b1.x, b1.y, b1.z, b1.w};
        float y[8];
#pragma unroll
        for (int q = 0; q < 8; ++q) { const float z = acc[q] * rstd * gg[q] + bb[q]; y[q] = z * __builtin_amdgcn_rcpf(1.f + __expf(-z)); }
        u32x4 o; o.x = pk2(y[0], y[1]); o.y = pk2(y[2], y[3]); o.z = pk2(y[4], y[5]); o.w = pk2(y[6], y[7]);
        *(u32x4*)(YA + (size_t)(cu * 64 + tl) * 512 + c0) = o;
    }
    __syncthreads();
}
#include <hip/hip_bf16.h>
#include <cmath>
namespace attn_body {
using bf16=__hip_bfloat16;
using bf16x8=__attribute__((ext_vector_type(8)))short;
using s16x4=__attribute__((ext_vector_type(4)))short;
using f32x16=__attribute__((ext_vector_type(16)))float;
using u32x4=__attribute__((ext_vector_type(4)))unsigned;
constexpr int SEQ=2048,D=64,DMI=512,DMO=1024;
constexpr int NW=8,QBLK=32,QB=QBLK*NW,KVBLK=64,NQB=SEQ/QB;
constexpr int ATTN_UNIT_ROWS=QB;
__device__ __forceinline__ int crow(int r,int hi){return (r&3)+8*(r>>2)+4*hi;}
#define SBAR() __builtin_amdgcn_sched_barrier(0)
__device__ __forceinline__ void cmask(f32x16&p0,f32x16&p1,int jb,int qrel,int hi){
  const float NEG=-INFINITY; int kb=64*jb+4*hi;
  #pragma unroll
  for(int r=0;r<16;++r){int kv=kb+(r&3)+8*(r>>2); if(kv>qrel)p0[r]=NEG; if(kv+32>qrel)p1[r]=NEG;}
}

constexpr int NSLOT=3, SLOTB=8192;
constexpr int LDS_K=0, LDS_V=NSLOT*SLOTB, LDS_WS=2*NSLOT*SLOTB, LDS_OST=LDS_WS+NW*64*4, LDS_BYTES=LDS_OST+NW*4096;
constexpr float C2=0.125f*1.4426950408889634f;
__device__ __forceinline__ void glds16(const void*gsrc,unsigned lds_dst){unsigned keep;
  asm volatile("s_mov_b32 %0, m0\n\ts_mov_b32 m0, %2\n\ts_nop 0\n\tglobal_load_lds_dwordx4 %1, off\n\ts_mov_b32 m0, %0":"=&s"(keep):"v"(gsrc),"s"(lds_dst):"memory");}
__device__ __forceinline__ float max3f(float a,float b,float c){float r;asm("v_max3_f32 %0, %1, %2, %3":"=v"(r):"v"(a),"v"(b),"v"(c));return r;}
__device__ __forceinline__ float max2f(float a,float b){float r;asm("v_max_f32_e32 %0, %1, %2":"=v"(r):"v"(a),"v"(b));return r;}
__device__ __forceinline__ float fadd_s(float a,float b){float r;asm("v_add_f32_e32 %0, %1, %2":"=v"(r):"v"(a),"v"(b));return r;}
__device__ __forceinline__ float fsub_s(float a,float b){float r;asm("v_sub_f32_e32 %0, %1, %2":"=v"(r):"v"(a),"v"(b));return r;}
typedef float f32x2_t __attribute__((ext_vector_type(2))); typedef __bf16 bf16x2_t __attribute__((ext_vector_type(2)));
__device__ __forceinline__ unsigned cvtpk_s(float lo,float hi){f32x2_t v={lo,hi};bf16x2_t b=__builtin_convertvector(v,bf16x2_t);return __builtin_bit_cast(unsigned,b);}
#define WAIT_BAR(N) asm volatile("s_waitcnt vmcnt(" #N ") lgkmcnt(0)\n\ts_barrier":::"memory")

__device__ __forceinline__ void qkt(f32x16&p0,f32x16&p1,const char*Kslot,const bf16x8*qr,const f32x16&negm,int r32,int hi){
  const char*kb=Kslot+hi*1024+r32*16;
  #pragma unroll
  for(int d0=0;d0<4;++d0){
    const bf16x8 b0=*reinterpret_cast<const bf16x8*>(kb+d0*2048);
    const bf16x8 b1=*reinterpret_cast<const bf16x8*>(kb+d0*2048+512);
    if(d0==0){p0=__builtin_amdgcn_mfma_f32_32x32x16_bf16(b0,qr[0],negm,0,0,0);p1=__builtin_amdgcn_mfma_f32_32x32x16_bf16(b1,qr[0],negm,0,0,0);}
    else{p0=__builtin_amdgcn_mfma_f32_32x32x16_bf16(b0,qr[d0],p0,0,0,0);p1=__builtin_amdgcn_mfma_f32_32x32x16_bf16(b1,qr[d0],p1,0,0,0);}}
}
typedef __attribute__((address_space(3))) const char* lds_cptr;
typedef short v4i16_t __attribute__((ext_vector_type(4)));
__device__ __forceinline__ void kload8(bf16x8*kf,lds_cptr kp){
  kf[0]=*(const __attribute__((address_space(3))) bf16x8*)(kp);      kf[1]=*(const __attribute__((address_space(3))) bf16x8*)(kp+512);
  kf[2]=*(const __attribute__((address_space(3))) bf16x8*)(kp+2048); kf[3]=*(const __attribute__((address_space(3))) bf16x8*)(kp+2560);
  kf[4]=*(const __attribute__((address_space(3))) bf16x8*)(kp+4096); kf[5]=*(const __attribute__((address_space(3))) bf16x8*)(kp+4608);
  kf[6]=*(const __attribute__((address_space(3))) bf16x8*)(kp+6144); kf[7]=*(const __attribute__((address_space(3))) bf16x8*)(kp+6656);
}
__device__ __forceinline__ void kload2(bf16x8*kf,lds_cptr kp,int j){ kf[2*j]=*(const __attribute__((address_space(3))) bf16x8*)(kp+j*2048); kf[2*j+1]=*(const __attribute__((address_space(3))) bf16x8*)(kp+j*2048+512); }
__device__ __forceinline__ s16x4 vtr(lds_cptr p){ return __builtin_bit_cast(s16x4,__builtin_amdgcn_ds_read_tr16_b64_v4i16((__attribute__((address_space(3))) v4i16_t*)p)); }
__device__ __forceinline__ float rowmax(const f32x16&p0,const f32x16&p1){
  float a=max3f(p0[0],p0[1],p1[0]),b=max3f(p0[2],p0[3],p1[1]);a=max3f(a,p1[2],p1[3]);
  #pragma unroll
  for(int r=4;r<16;r+=4){a=max3f(a,p0[r],p0[r+1]);b=max3f(b,p0[r+2],p0[r+3]);a=max3f(a,p1[r],p1[r+1]);b=max3f(b,p1[r+2],p1[r+3]);}
  const float m=max2f(a,b);
  auto rr=__builtin_amdgcn_permlane32_swap(__float_as_uint(m),__float_as_uint(m),false,false);
  return max2f(__uint_as_float(rr[0]),__uint_as_float(rr[1]));
}
__device__ __forceinline__ void pv(f32x16*o,int vb,bf16x8 pa0,bf16x8 pa1,bf16x8 pa2,bf16x8 pa3){
  #pragma unroll
  for(int d0=0;d0<2;++d0){s16x4 lo[4],hi[4];
    #pragma unroll
    for(int ks=0;ks<4;++ks){
      asm volatile("ds_read_b64_tr_b16 %0,%1 offset:%c2":"=&v"(lo[ks]):"v"(vb),"i"(d0*4096+ks*1024):"memory");
      asm volatile("ds_read_b64_tr_b16 %0,%1 offset:%c2":"=&v"(hi[ks]):"v"(vb),"i"(d0*4096+ks*1024+512):"memory");}
    asm volatile("s_waitcnt lgkmcnt(0)":::"memory");SBAR();
    #define PK(k) (bf16x8){lo[k][0],lo[k][1],lo[k][2],lo[k][3],hi[k][0],hi[k][1],hi[k][2],hi[k][3]}
    o[d0]=__builtin_amdgcn_mfma_f32_32x32x16_bf16(pa0,PK(0),o[d0],0,0,0);
    o[d0]=__builtin_amdgcn_mfma_f32_32x32x16_bf16(pa1,PK(1),o[d0],0,0,0);
    o[d0]=__builtin_amdgcn_mfma_f32_32x32x16_bf16(pa2,PK(2),o[d0],0,0,0);
    o[d0]=__builtin_amdgcn_mfma_f32_32x32x16_bf16(pa3,PK(3),o[d0],0,0,0);
    #undef PK
  }
}

#ifndef ATTN_STORE16
#define ATTN_STORE16(p,v) (*(u32x4*)(p)=(v))
#endif
template<int THRL> __device__ __forceinline__ void attn_unit(int qb,const bf16*Qb,const bf16*__restrict__ Kb,const bf16*__restrict__ Vb,bf16*Ob,char*shm){
  int tid_=threadIdx.x; asm volatile("":"+v"(tid_));
  const int tid=tid_,lane=tid&63,r32=lane&31,hi=lane>>5; const int wid=__builtin_amdgcn_readfirstlane(tid>>6);
  const int q0=qb*QB;
  const bf16*Qw=Qb+(long)(q0+wid*QBLK)*DMI;
  const bf16*Kh=Kb,*Vh=Vb;
  const unsigned lds0=(unsigned)(uintptr_t)shm;
  float*wsf=(float*)(shm+LDS_WS)+wid*64;
  const bf16*ksrc=Kh+(long)lane*DMI+wid*8;
  const bf16*vsrc=Vh+(long)(16*(wid&3)+(lane>>2))*DMI+(wid>>2)*32+(lane&3)*8;
  const unsigned kdst=lds0+LDS_K+wid*1024, vdst=lds0+LDS_V+wid*1024;
  #define DMA_K(t,slot) glds16(ksrc+(long)(t)*KVBLK*DMI,(unsigned)__builtin_amdgcn_readfirstlane(kdst+(slot)))
  #define DMA_V(t,slot) glds16(vsrc+(long)(t)*KVBLK*DMI,(unsigned)__builtin_amdgcn_readfirstlane(vdst+(slot)))
  const int vb0=(int)(lds0+LDS_V)+((lane>>4)&1)*32+(lane&3)*8+(4*hi+((lane&15)>>2))*64;
  const char*Kbase=shm+LDS_K; bf16x8 kf[8];
  const lds_cptr shm3=(lds_cptr)shm; const lds_cptr kp0=shm3+LDS_K+hi*1024+r32*16; const lds_cptr vp0=shm3+LDS_V+((lane>>4)&1)*32+(lane&3)*8+(4*hi+((lane&15)>>2))*64;
  const int NT=(q0+QB)/KVBLK;
  DMA_K(0,0);DMA_V(0,0);DMA_K(1,SLOTB);
  bf16x8 qr[4];
  #pragma unroll
  for(int d0=0;d0<4;++d0)qr[d0]=*reinterpret_cast<const bf16x8*>(&Qw[(long)r32*DMI+d0*16+hi*8]);
  float mhat=0.f,l_reg=0.f;f32x16 o[2];o[0]=f32x16{};o[1]=f32x16{};f32x16 negm=f32x16{};asm volatile("":"+v"(negm));
  const int qrel=wid*QBLK+r32;
  #define CMASK(P0,P1,t) do{int jb_=(t)-(NT-4); if(jb_>=0)cmask(P0,P1,jb_,qrel,hi);}while(0)
  bool resc=false;
  #define START(P0,P1) do{ const float rm=rowmax(P0,P1); resc=false; \
    { const float dl=rm; mhat=fadd_s(mhat,dl); \
      _Pragma("unroll") for(int r=0;r<16;++r){P0[r]=fsub_s(P0[r],dl);P1[r]=fsub_s(P1[r],dl);} \
      _Pragma("unroll") for(int r=0;r<16;++r)negm[r]=-mhat; asm volatile("":"+v"(negm)); } \
    _Pragma("unroll") for(int r=0;r<16;++r)P0[r]=__builtin_amdgcn_exp2f(P0[r]); }while(0)
  #define RESC() do{ if(resc){ asm volatile("s_waitcnt lgkmcnt(0)":::"memory"); \
      _Pragma("unroll") for(int d_=0;d_<2;++d_) _Pragma("unroll") for(int r=0;r<16;++r)o[d_][r]*=wsf[crow(r,hi)]; } }while(0)
  f32x16 pA0,pA1,pB0,pB1;
  int sl_prev=0,sl_cur=0,sl_next=SLOTB;
  #define ROT() do{sl_prev=sl_cur;sl_cur=sl_next;sl_next=(sl_next==(NSLOT-1)*SLOTB)?0:sl_next+SLOTB;}while(0)
  DMA_K(2,2*SLOTB);
  WAIT_BAR(3);
  qkt(pA0,pA1,Kbase,qr,negm,r32,hi);asm volatile("s_nop 15\n\ts_nop 7":"+v"(pA0),"+v"(pA1));CMASK(pA0,pA1,0);
  START(pA0,pA1);
  _Pragma("unroll") for(int r=0;r<16;++r)pA1[r]=__builtin_amdgcn_exp2f(pA1[r]);
  WAIT_BAR(0);
  DMA_K(3,0);DMA_V(1,SLOTB);
  ROT();
  kload8(kf,kp0+sl_cur);
  WAIT_BAR(2);
  s16x4 vlo[8],vhi[8]; u32x4 pw0,pw1,pw2,pw3;
  #define PKW(P,B) cvtpk_s(P[B],P[B+1])
  #define PAF(k) __builtin_bit_cast(bf16x8,pw##k)
  #define VFR(i) (bf16x8){vlo[i][0],vlo[i][1],vlo[i][2],vlo[i][3],vhi[i][0],vhi[i][1],vhi[i][2],vhi[i][3]}
  #define PIN(x) asm volatile("":"+v"(x))
  #define MX3(a,b,c) __builtin_fmaxf(__builtin_fmaxf((a),(b)),(c))
  #define GAPA(MF,A0,A1,A2,A3,W0,W1,PW) do{ MF; sacc+=A0; sacc+=A1; sacc+=A2; sacc+=A3; PIN(sacc); W0; W1; PIN(PW); SBAR(); }while(0)
  #define EX(v) __builtin_amdgcn_exp2f(v)
  #define GAPB(MF,X,B) do{ MF; X[B]=EX(X[B]); X[B+1]=EX(X[B+1]); X[B+2]=EX(X[B+2]); X[B+3]=EX(X[B+3]); PIN(X); SBAR(); }while(0)
  #define VRD(i) do{ vlo[i]=vtr(vp_+(((i)>>2)*4096+((i)&3)*1024)); vhi[i]=vtr(vp_+(((i)>>2)*4096+((i)&3)*1024+512)); }while(0)
  #define KRD(G,j) do{ if(G){ kload2(kf,kp0+sl_next,j); SBAR(); } }while(0)
  #define STEP(C0,C1,P0,P1,t,GK,GV,GL) do{ SBAR(); \
    const lds_cptr vp_=vp0+sl_prev; \
    VRD(0); SBAR(); float sacc=(P0[0]+P0[1]); \
    GAPA(C0=__builtin_amdgcn_mfma_f32_32x32x16_bf16(kf[0],qr[0],negm,0,0,0), P0[2],P0[3],P0[4],P0[5],     pw0[0]=PKW(P0,0), pw0[1]=PKW(P0,2), pw0); \
    VRD(4); SBAR(); GAPA(C1=__builtin_amdgcn_mfma_f32_32x32x16_bf16(kf[1],qr[0],negm,0,0,0), P0[6],P0[7],P0[8],P0[9],     pw0[2]=PKW(P0,4), pw0[3]=PKW(P0,6), pw0); \
    VRD(1); SBAR(); GAPA(C0=__builtin_amdgcn_mfma_f32_32x32x16_bf16(kf[2],qr[1],C0,0,0,0),   P0[10],P0[11],P0[12],P0[13], pw1[0]=PKW(P0,8), pw1[1]=PKW(P0,10), pw1); \
    VRD(5); SBAR(); GAPA(C1=__builtin_amdgcn_mfma_f32_32x32x16_bf16(kf[3],qr[1],C1,0,0,0),   P0[14],P0[15],P1[0],P1[1],   pw1[2]=PKW(P0,12),pw1[3]=PKW(P0,14), pw1); \
    VRD(2); SBAR(); GAPA(C0=__builtin_amdgcn_mfma_f32_32x32x16_bf16(kf[4],qr[2],C0,0,0,0),   P1[2],P1[3],P1[4],P1[5],     pw2[0]=PKW(P1,0), pw2[1]=PKW(P1,2), pw2); \
    VRD(6); SBAR(); GAPA(C1=__builtin_amdgcn_mfma_f32_32x32x16_bf16(kf[5],qr[2],C1,0,0,0),   P1[6],P1[7],P1[8],P1[9],     pw2[2]=PKW(P1,4), pw2[3]=PKW(P1,6), pw2); \
    VRD(3); SBAR(); GAPA(C0=__builtin_amdgcn_mfma_f32_32x32x16_bf16(kf[6],qr[3],C0,0,0,0),   P1[10],P1[11],P1[12],P1[13], pw3[0]=PKW(P1,8), pw3[1]=PKW(P1,10), pw3); \
    VRD(7); SBAR(); GAPA(C1=__builtin_amdgcn_mfma_f32_32x32x16_bf16(kf[7],qr[3],C1,0,0,0),   P1[14],P1[15],0.f,0.f,       pw3[2]=PKW(P1,12),pw3[3]=PKW(P1,14), pw3); \
    l_reg+=sacc; \
    if(GK){DMA_K((t)+3,sl_cur);} if(GV){DMA_V((t)+1,sl_next);} \
    CMASK(C0,C1,t); \
    { float a=MX3(C0[0],C0[1],C1[0]),b=MX3(C0[2],C0[3],C1[1]); a=MX3(a,C1[2],C1[3]); \
      _Pragma("unroll") for(int r=4;r<16;r+=4){a=MX3(a,C0[r],C0[r+1]);b=MX3(b,C0[r+2],C0[r+3]);a=MX3(a,C1[r],C1[r+1]);b=MX3(b,C1[r+2],C1[r+3]);} \
      float rm=__builtin_fmaxf(a,b); { auto rr=__builtin_amdgcn_permlane32_swap(__float_as_uint(rm),__float_as_uint(rm),false,false); rm=__builtin_fmaxf(__uint_as_float(rr[0]),__uint_as_float(rr[1])); } \
      resc=false; \
      if(__builtin_expect(__any(rm>(float)THRL),0)){ const float dl=__builtin_fmaxf(rm,0.f); mhat+=dl; \
        _Pragma("unroll") for(int r=0;r<16;++r){C0[r]-=dl;C1[r]-=dl;} \
        _Pragma("unroll") for(int r=0;r<16;++r)negm[r]=-mhat; asm volatile("":"+v"(negm)); \
        const float f=__builtin_amdgcn_exp2f(-dl); l_reg*=f; if(hi==0)wsf[r32]=f; resc=true; } } \
    SBAR(); \
    GAPB(o[0]=__builtin_amdgcn_mfma_f32_32x32x16_bf16(PAF(0),VFR(0),o[0],0,0,0), C0,0); \
    GAPB(o[1]=__builtin_amdgcn_mfma_f32_32x32x16_bf16(PAF(0),VFR(4),o[1],0,0,0), C0,4); \
    KRD(GL,0); GAPB(o[0]=__builtin_amdgcn_mfma_f32_32x32x16_bf16(PAF(1),VFR(1),o[0],0,0,0), C0,8); \
    KRD(GL,1); GAPB(o[1]=__builtin_amdgcn_mfma_f32_32x32x16_bf16(PAF(1),VFR(5),o[1],0,0,0), C0,12); \
    KRD(GL,2); GAPB(o[0]=__builtin_amdgcn_mfma_f32_32x32x16_bf16(PAF(2),VFR(2),o[0],0,0,0), C1,0); \
    KRD(GL,3); GAPB(o[1]=__builtin_amdgcn_mfma_f32_32x32x16_bf16(PAF(2),VFR(6),o[1],0,0,0), C1,4); \
    GAPB(o[0]=__builtin_amdgcn_mfma_f32_32x32x16_bf16(PAF(3),VFR(3),o[0],0,0,0), C1,8); \
    GAPB(o[1]=__builtin_amdgcn_mfma_f32_32x32x16_bf16(PAF(3),VFR(7),o[1],0,0,0), C1,12); \
    }while(0)
  int t=1;
  #undef CMASK
  #define CMASK(P0,P1,t) do{}while(0)
  for(;t+5<NT;t+=2){
    STEP(pB0,pB1,pA0,pA1,t,true,true,true);     WAIT_BAR(2); RESC(); ROT();
    STEP(pA0,pA1,pB0,pB1,t+1,true,true,true);   WAIT_BAR(2); RESC(); ROT();
  }
  #undef CMASK
  #define CMASK(P0,P1,t) do{int jb_=(t)-(NT-4); if(jb_>=0)cmask(P0,P1,jb_,qrel,hi);}while(0)
  #define ENDW(tt) do{ if((tt)+3<NT){WAIT_BAR(2);} else if((tt)+2<NT){WAIT_BAR(1);} else {WAIT_BAR(0);} }while(0)
  for(;t+1<NT;t+=2){
    STEP(pB0,pB1,pA0,pA1,t,(t+3<NT),(t+1<NT),(t+1<NT));       ENDW(t);   RESC(); ROT();
    STEP(pA0,pA1,pB0,pB1,t+1,(t+4<NT),(t+2<NT),(t+2<NT));     ENDW(t+1); RESC(); ROT();
  }
  STEP(pB0,pB1,pA0,pA1,NT-1,false,false,false); RESC();
  { float sacc=pB0[0]+pB0[1]; _Pragma("unroll") for(int r=2;r<16;++r)sacc+=pB0[r]; _Pragma("unroll") for(int r=0;r<16;++r)sacc+=pB1[r]; l_reg+=sacc;
    pw0=(u32x4){PKW(pB0,0),PKW(pB0,2),PKW(pB0,4),PKW(pB0,6)};pw1=(u32x4){PKW(pB0,8),PKW(pB0,10),PKW(pB0,12),PKW(pB0,14)};pw2=(u32x4){PKW(pB1,0),PKW(pB1,2),PKW(pB1,4),PKW(pB1,6)};pw3=(u32x4){PKW(pB1,8),PKW(pB1,10),PKW(pB1,12),PKW(pB1,14)};
    SBAR(); pv(o,vb0+sl_cur,PAF(0),PAF(1),PAF(2),PAF(3)); }
  #undef PKW
  #undef PAF
  #undef VFR
  #undef PIN
  #undef MX3
  #undef GAPA
  #undef GAPB
  #undef EX
  #undef VRD
  #undef KRD
  #undef STEP
  #undef ENDW
  {auto rr=__builtin_amdgcn_permlane32_swap(__float_as_uint(l_reg),__float_as_uint(l_reg),false,false);l_reg=__uint_as_float(rr[0])+__uint_as_float(rr[1]);}
  if(hi==0)wsf[32+r32]=l_reg;asm volatile("s_waitcnt lgkmcnt(0)":::"memory");
  float rli[16];
  #pragma unroll
  for(int r=0;r<16;++r)rli[r]=__builtin_amdgcn_rcpf(wsf[32+crow(r,hi)]);
  bf16*Ow=Ob+(long)(q0+wid*QBLK)*DMO;
  { bf16*stg=(bf16*)(shm+LDS_OST)+wid*2048;
    #pragma unroll
    for(int r=0;r<16;++r){const int orow=crow(r,hi);
      #pragma unroll
      for(int d0=0;d0<2;++d0)stg[orow*64+d0*32+r32]=__float2bfloat16(o[d0][r]*rli[r]);}
    asm volatile("s_waitcnt lgkmcnt(0)":::"memory");
    #pragma unroll
    for(int i=0;i<4;++i){const int row=i*8+(lane>>3),ch=lane&7; const u32x4 v=*(const u32x4*)(stg+row*64+ch*8); ATTN_STORE16(Ow+(long)row*DMO+ch*8,v);} }
  asm volatile("s_waitcnt lgkmcnt(0)\n\ts_barrier":::"memory");
  #undef DMA_K
  #undef DMA_V
  #undef CMASK
  #undef START
  #undef RESC
  #undef ROT
}
constexpr int ATTN_LDS_BYTES=LDS_BYTES;
#undef SBAR
#undef WAIT_BAR
}
extern __shared__ __attribute__((aligned(16))) unsigned char g_lds[];
constexpr size_t WS_OV = WS_R;
__device__ __forceinline__ void p2c_hgrn(Frame& F_, int l, int unit);
template <int PART> __device__ __forceinline__ void p1_part(Frame& F_, int g, int l, int G, int c);
constexpr int CW_P1B = 24576;
constexpr int CW_Q = 20480;
constexpr int NQ_ATT = GB * 16 * 8, NQ_CONV = TG / 64;
__device__ __forceinline__ void p2_mixers(Frame& F_, int g, int l, int rep) {
    if (blockIdx.x < GB * 4) p2c_hgrn(F_, l, blockIdx.x);
    else {
        p1_part<1>(F_, g, l, (int)gridDim.x - GB * 4, (int)blockIdx.x - GB * 4);
        KArgs ka2 = kargs(); unsigned* pdone = (unsigned*)((unsigned char*)(GAS unsigned char*)ka2->ws + WS_CTL) + CW_P1B + 64 * (g * 2 + l);
        asm volatile("s_waitcnt vmcnt(0)" ::: "memory"); __syncthreads();
        if (threadIdx.x == 0) { __builtin_amdgcn_fence(__ATOMIC_RELEASE, "agent"); asm volatile("s_waitcnt vmcnt(0)" ::: "memory"); (void)__hip_atomic_fetch_add(pdone, 1u, __ATOMIC_RELAXED, __HIP_MEMORY_SCOPE_AGENT); }
    }
    KA_WS();
    Frame F = mkframe(F_.lds);
    const int xq = (int)(xb_xcc_id() & 7u);
    volatile LAS int* qslot = (volatile LAS int*)(F.lds + MISC_OFF + 128);
    bool conv_ok = false;
    constexpr int NQX = (NQ_ATT + NQ_CONV) / 8;
    unsigned* qbase = (unsigned*)(ws + WS_CTL) + CW_Q + 64 * ((g * 2 + l) * 8);
    int xcur = xq;
    for (;;) {
        __syncthreads();
        if (F.tid == 0) qslot[0] = (int)__hip_atomic_fetch_add(qbase + 64 * xcur, 1u, __ATOMIC_RELAXED, __HIP_MEMORY_SCOPE_AGENT);
        __syncthreads();
        int u = __builtin_amdgcn_readfirstlane(qslot[0]);
        if (u >= NQX) {
            __syncthreads();
            if (F.tid < 8) { const unsigned hd = __hip_atomic_load(qbase + 64 * F.tid, __ATOMIC_RELAXED, __HIP_MEMORY_SCOPE_AGENT); const unsigned long long m = __ballot(hd < (unsigned)NQX);
                if (F.tid == 0) qslot[1] = m ? (int)__builtin_ctzll(m) : -1; }
            __syncthreads();
            const int nx = __builtin_amdgcn_readfirstlane(qslot[1]);
            if (nx < 0) break;
            xcur = nx; continue;
        }
        const int xu = xcur;
        if (u >= NQ_ATT / 8 && !conv_ok) {
            unsigned* pdone = (unsigned*)(ws + WS_CTL) + CW_P1B + 64 * (g * 2 + l);
            if (F.tid == 0) { unsigned sp = 0; while (__hip_atomic_load(pdone, __ATOMIC_RELAXED, __HIP_MEMORY_SCOPE_AGENT) < gridDim.x - GB * 4) { __builtin_amdgcn_s_sleep(4); if (++sp > (1u << 22)) break; }
                __builtin_amdgcn_fence(__ATOMIC_ACQUIRE, "agent"); asm volatile("s_waitcnt vmcnt(0)" ::: "memory"); }
            __syncthreads(); conv_ok = true;
        }
        if (u < NQ_ATT / 8) {
            const int qb = 7 - u / (GB * 2), vhd = (u % (GB * 2)) * 8 + xu;
            const int bl = vhd >> 4, sh = (vhd >> 1) & 7, vh = vhd & 1;
            const attn_body::bf16* Qb = (const attn_body::bf16*)((bf16*)(ws + WS_Q) + (size_t)bl * S * 512 + sh * 64);
            const attn_body::bf16* Kb = (const attn_body::bf16*)((bf16*)(ws + WS_K) + (size_t)bl * S * 512 + sh * 64);
            const attn_body::bf16* Vb = (const attn_body::bf16*)((bf16*)(ws + WS_V) + (size_t)bl * S * 512 + (sh >> 1) * 128 + vh * 64);
            attn_body::bf16* Ob = (attn_body::bf16*)((bf16*)(ws + WS_OV) + (size_t)bl * S * 1024 + sh * 128 + vh * 64);
            attn_body::attn_unit<8>(qb, Qb, Kb, Vb, Ob, (char*)g_lds);
        } else { int ll = l; asm volatile("" : "+s"(ll)); p2_conv_unit(F, ws, ka, ll, (u - NQ_ATT / 8) * 8 + xu); }
    }
}
__device__ __forceinline__ void p2d_combine(Frame& F_, int l) {
    KA_WS();
    Frame F = mkframe(F_.lds);
    const float lam = ((const float*)(ws + WS_LB))[1024 + l]; const float lam_init = l == 0 ? 0.2f : 0.35550906759096934f;
    const float* ng = (const float*)KIN(8) + l * 128;
    const int lane = F.lane; const float g0 = ng[lane * 2] * (1.f - lam_init), g1 = ng[lane * 2 + 1] * (1.f - lam_init);
    const bf16* __restrict__ OV = (const bf16*)(ws + WS_OV); bf16* __restrict__ YB = (bf16*)(ws + WS_YB);
    const int per = TG / (gridDim.x * NWAVES);
    const int t0 = (blockIdx.x * NWAVES + F.wave) * per;
#pragma unroll 1
    for (int i = 0; i < per; i += 2) {
        unsigned a[2][8];
#pragma unroll
        for (int rr = 0; rr < 2; ++rr)
#pragma unroll
            for (int k = 0; k < 8; ++k) a[rr][k] = *(const unsigned*)(OV + (size_t)(t0 + i + rr) * 1024 + k * 128 + lane * 2);
#pragma unroll
        for (int rr = 0; rr < 2; ++rr)
#pragma unroll
            for (int h = 0; h < 4; ++h) { const unsigned a1 = a[rr][2 * h], a2 = a[rr][2 * h + 1];
                const float o0 = lo16(a1) - lam * lo16(a2), o1 = hi16(a1) - lam * hi16(a2);
                const float rr2 = __builtin_amdgcn_rsqf(wave_sum(o0 * o0 + o1 * o1) * (1.f / 128.f) + EPS);
                *(unsigned*)(YB + (size_t)(t0 + i + rr) * 512 + h * 128 + lane * 2) = pk2(o0 * rr2 * g0, o1 * rr2 * g1); }
    }
}

namespace hg {
typedef short bf16x8 __attribute__((ext_vector_type(8)));
typedef float f32x16 __attribute__((ext_vector_type(16)));
constexpr int ST = 272, STT = 80, RS = 264;
constexpr int O_Q1 = 0, O_KT = 8704, O_KTT = 17408, O_VT = 27648, O_D = 37888, OPS = 38400;
constexpr int L_O = 2 * OPS;
static_assert(L_O + 2 * 16384 <= MISC_OFF, "HGRN LDS map");
__device__ __forceinline__ void lbar() { asm volatile("s_waitcnt lgkmcnt(0)" ::: "memory"); __builtin_amdgcn_s_barrier(); asm volatile("" ::: "memory"); }
__device__ __forceinline__ bf16x8 pack8(const f32x16& x, int b) {
    u32x4 w; w.x = pg8::cvt_pk_bf16(x[b], x[b + 1]); w.y = pg8::cvt_pk_bf16(x[b + 2], x[b + 3]); w.z = pg8::cvt_pk_bf16(x[b + 4], x[b + 5]); w.w = pg8::cvt_pk_bf16(x[b + 6], x[b + 7]);
    return __builtin_bit_cast(bf16x8, w);
}
__device__ __forceinline__ bf16x8 ld2x8(const LAS unsigned char* p) {
    const u32x2 a = *(const LAS u32x2*)p, b = *(const LAS u32x2*)(p + 16); u32x4 w; w.x = a.x; w.y = a.y; w.z = b.x; w.w = b.y; return __builtin_bit_cast(bf16x8, w);
}
__device__ __forceinline__ float quad_bcast(float v, int which) {
    const int iv = __builtin_bit_cast(int, v); int r;
    if (which == 0) r = __builtin_amdgcn_update_dpp(0, iv, 0x00, 0xF, 0xF, true); else if (which == 1) r = __builtin_amdgcn_update_dpp(0, iv, 0x55, 0xF, 0xF, true);
    else if (which == 2) r = __builtin_amdgcn_update_dpp(0, iv, 0xAA, 0xF, 0xF, true); else r = __builtin_amdgcn_update_dpp(0, iv, 0xFF, 0xF, 0xF, true);
    return __builtin_bit_cast(float, r);
}
}
__device__ __forceinline__ void p2c_hgrn(Frame& F_, int l, int unit) {
    KA_WS();
    Frame F = mkframe(F_.lds);
    using namespace hg;
    const int bl = unit >> 2, h = unit & 3;
    LAS unsigned char* lds = F.lds;
    const int lane = F.lane, wave = F.wave, r32 = lane & 31, hi = lane >> 5;
    const size_t rb = ((size_t)(bl * 4 + h) * S) * 128;
    const size_t rbY = ((size_t)bl * S) * 512 + h * 128;
    const bf16* HQ = (const bf16*)(ws + WS_HQ) + rb; const bf16* HF = (const bf16*)(ws + WS_HF) + rb; const bf16* HV = (const bf16*)(ws + WS_HV) + rb; const bf16* HG = (const bf16*)(ws + WS_HG) + rb;
    bf16* YC = (bf16*)(ws + WS_YC) + rbY;
    const bool isP = wave >= 4;
    const int pw = wave & 3;
    __syncthreads();
    if (isP) {
        const float* ng = (const float*)KIN(10) + l * 128;
        const float n0 = ng[2 * lane], n1 = ng[2 * lane + 1];
        const int cpi = 16 * pw + (lane >> 2), tq = lane & 3;
        unsigned rawA[24], rawB[24], rawC[24]; unsigned gA[8], gB[8], gC[8];
#pragma unroll
        for (int k = 0; k < 24; ++k) { rawA[k] = 0u; rawB[k] = 0u; rawC[k] = 0u; }
#pragma unroll
        for (int k = 0; k < 8; ++k) { gA[k] = 0u; gB[k] = 0u; gC[k] = 0u; }
#define HG_LOAD(SET, n) do { _Pragma("unroll") for (int j = 0; j < 8; ++j) { const size_t go = (size_t)((n) * 32 + 8 * tq + j) * 128 + 2 * cpi; \
            SET[j] = *(const unsigned*)(HF + go); SET[8 + j] = *(const unsigned*)(HQ + go); SET[16 + j] = *(const unsigned*)(HV + go); } } while (0)
#define HG_GLOAD(GS, n) do { _Pragma("unroll") for (int jj = 0; jj < 8; ++jj) GS[jj] = *(const unsigned*)(HG + (size_t)((n) * 32 + 8 * pw + jj) * 128 + 2 * lane); } while (0)
        HG_LOAD(rawA, 0); HG_LOAD(rawB, 1); HG_LOAD(rawC, 2); HG_GLOAD(gA, 0);
#define HG_PITER(i, RS_, GU) do { \
            if ((i) + 1 <= 63) hg_prep(lds, RS_, (i) + 1, cpi, tq); \
            if ((i) + 4 <= 63) HG_LOAD(RS_, (i) + 4); \
            if ((i) >= 1 && (i) <= 64) hg_finish(lds, (i) - 1, pw, lane, n0, n1, GU); \
            if ((i) + 2 <= 63) HG_GLOAD(GU, (i) + 2); \
            lbar(); } while (0)
        auto hg_prep = [&](LAS unsigned char* lds_, const unsigned (&R_)[24], int n, int cpi_, int tq_) __attribute__((always_inline)) {
            LAS unsigned char* op = lds_ + (n & 1) * OPS;
            float p0[8], p1[8], l0[8], l1[8];
#pragma unroll
            for (int j = 0; j < 8; ++j) { const unsigned w = R_[j]; const float x0 = lo16(w) * 1.4426950408889634f, x1 = hi16(w) * 1.4426950408889634f;
                l0[j] = x0; l1[j] = x1; p0[j] = j ? p0[j - 1] + x0 : x0; p1[j] = j ? p1[j - 1] + x1 : x1; }
            float base0 = 0.f, base1 = 0.f, bl0 = 0.f, bl1 = 0.f;
#pragma unroll
            for (int q = 0; q < 4; ++q) { const float t0 = quad_bcast(p0[7], q), t1 = quad_bcast(p1[7], q); bl0 += t0; bl1 += t1; if (q < tq_) { base0 += t0; base1 += t1; } }
            unsigned ka[4], kb[4], va[4], vb4[4];
#pragma unroll
            for (int j = 0; j < 8; ++j) { const int t = 8 * tq_ + j;
                const float b0 = fmaxf(base0 + p0[j], -115.f), b1 = fmaxf(base1 + p1[j], -115.f);
                const float e0 = __builtin_amdgcn_exp2f(b0), e1 = __builtin_amdgcn_exp2f(b1), i0 = __builtin_amdgcn_exp2f(-b0), i1 = __builtin_amdgcn_exp2f(-b1);
                const float k0 = 1.f - __builtin_amdgcn_exp2f(l0[j]), k1 = 1.f - __builtin_amdgcn_exp2f(l1[j]);
                const unsigned qw = R_[8 + j], vw = R_[16 + j];
                const unsigned q1w = pg8::cvt_pk_bf16(lo16(qw) * e0, hi16(qw) * e1), ktw = pg8::cvt_pk_bf16(k0 * i0, k1 * i1);
                *(LAS unsigned*)(op + O_Q1 + t * ST + cpi_ * 4) = q1w; *(LAS unsigned*)(op + O_KT + t * ST + cpi_ * 4) = ktw;
                if (j & 1) { ka[j >> 1] |= ktw << 16; kb[j >> 1] |= ktw & 0xffff0000u; va[j >> 1] |= vw << 16; vb4[j >> 1] |= vw & 0xffff0000u; }
                else { ka[j >> 1] = ktw & 0xffffu; kb[j >> 1] = ktw >> 16; va[j >> 1] = vw & 0xffffu; vb4[j >> 1] = vw >> 16; } }
            *(LAS u32x4*)(op + O_KTT + (2 * cpi_) * STT + 16 * tq_) = (u32x4){ka[0], ka[1], ka[2], ka[3]}; *(LAS u32x4*)(op + O_KTT + (2 * cpi_ + 1) * STT + 16 * tq_) = (u32x4){kb[0], kb[1], kb[2], kb[3]};
            *(LAS u32x4*)(op + O_VT + (2 * cpi_) * STT + 16 * tq_) = (u32x4){va[0], va[1], va[2], va[3]}; *(LAS u32x4*)(op + O_VT + (2 * cpi_ + 1) * STT + 16 * tq_) = (u32x4){vb4[0], vb4[1], vb4[2], vb4[3]};
            if (tq_ == 3) *(LAS f32x2*)(op + O_D + cpi_ * 8) = (f32x2){__builtin_amdgcn_exp2f(fmaxf(bl0, -115.f)), __builtin_amdgcn_exp2f(fmaxf(bl1, -115.f))};
        };
        auto hg_finish = [&](LAS unsigned char* lds_, int j, int pw_, int lane_, float n0_, float n1_, const unsigned (&gt_)[8]) __attribute__((always_inline)) {
            LAS float* Ot = (LAS float*)(lds_ + L_O + (j & 1) * 16384);
            f32x2 ov[8];
#pragma unroll
            for (int jj = 0; jj < 8; ++jj) ov[jj] = *(const LAS f32x2*)(Ot + (8 * pw_ + jj) * 128 + 2 * lane_);
            asm volatile("s_waitcnt lgkmcnt(0)" ::: "memory");
#pragma unroll
            for (int jj = 0; jj < 8; ++jj) { const int t = 8 * pw_ + jj; const f32x2 o = ov[jj];
                const float rr = __builtin_amdgcn_rsqf(wave_sum(o.x * o.x + o.y * o.y) * (1.f / 128.f) + EPS);
                *(LAS unsigned*)((LAS unsigned char*)Ot + t * 512 + 4 * lane_) = pk2(o.x * rr * n0_ * lo16(gt_[jj]), o.y * rr * n1_ * hi16(gt_[jj])); }
        };
#pragma unroll 1
        for (int i = -1; i <= 62; i += 3) { HG_PITER(i, rawA, gB); HG_PITER(i + 1, rawB, gC); HG_PITER(i + 2, rawC, gA); }
        lbar();
#undef HG_PITER
#undef HG_LOAD
#undef HG_GLOAD
    } else {
        const int vb = pw;
        f32x16 Sacc[4];
#pragma unroll
        for (int cb = 0; cb < 4; ++cb)
#pragma unroll
            for (int r = 0; r < 16; ++r) Sacc[cb][r] = 0.f;
#pragma unroll 1
        for (int i = -1; i <= 65; ++i) {
            if (vb < 2 && i >= 2) {
                const LAS unsigned char* yt = lds + L_O + (i & 1) * 16384 + vb * 128;
#pragma unroll
                for (int k = 0; k < 4; ++k) { const int row = 8 * k + (lane >> 3), c16 = lane & 7;
                    *(u32x4*)(YC + (size_t)((i - 2) * 32 + row) * 512 + vb * 64 + c16 * 8) = *(const LAS u32x4*)(yt + row * 512 + c16 * 16); }
            }
            if (i >= 0 && i <= 63) {
                const LAS unsigned char* op = lds + (i & 1) * OPS;
                bf16x8 fk[8], fq[8], fp[8], fvp[2];
#pragma unroll
                for (int kc = 0; kc < 8; ++kc) { fk[kc] = *(const LAS bf16x8*)(op + O_KT + r32 * ST + (16 * kc + 8 * hi) * 2); fq[kc] = *(const LAS bf16x8*)(op + O_Q1 + r32 * ST + (16 * kc + 8 * hi) * 2); }
#pragma unroll
                for (int kc = 0; kc < 8; ++kc) fp[kc] = ld2x8(op + O_Q1 + r32 * ST + (16 * kc + 4 * hi) * 2);
#pragma unroll
                for (int ks = 0; ks < 2; ++ks) fvp[ks] = ld2x8(op + O_VT + (32 * vb + r32) * STT + (16 * ks + 4 * hi) * 2);
                asm volatile("s_waitcnt lgkmcnt(0)" ::: "memory"); __builtin_amdgcn_sched_barrier(0);
                f32x16 X, o;
#pragma unroll
                for (int r = 0; r < 16; ++r) { X[r] = 0.f; o[r] = 0.f; }
#pragma unroll
                for (int kc = 0; kc < 8; ++kc) { X = __builtin_amdgcn_mfma_f32_32x32x16_bf16(fk[kc], fq[kc], X, 0, 0, 0);
                    o = __builtin_amdgcn_mfma_f32_32x32x16_bf16(fp[kc], pack8(Sacc[kc >> 1], 8 * (kc & 1)), o, 0, 0, 0); }
                __builtin_amdgcn_sched_barrier(0);
                bf16x8 fkt[8], fvn[2];
#pragma unroll
                for (int ks = 0; ks < 2; ++ks) fvn[ks] = *(const LAS bf16x8*)(op + O_VT + (32 * vb + r32) * STT + (16 * ks + 8 * hi) * 2);
#pragma unroll
                for (int cb = 0; cb < 4; ++cb)
#pragma unroll
                    for (int ks = 0; ks < 2; ++ks) fkt[2 * cb + ks] = *(const LAS bf16x8*)(op + O_KTT + (32 * cb + r32) * STT + (16 * ks + 8 * hi) * 2);
#pragma unroll
                for (int r = 0; r < 16; ++r) { const int sidx = (r & 3) + 8 * (r >> 2) + 4 * hi; X[r] = sidx <= r32 ? X[r] : 0.f; }
#pragma unroll
                for (int ks = 0; ks < 2; ++ks) o = __builtin_amdgcn_mfma_f32_32x32x16_bf16(pack8(X, 8 * ks), fvp[ks], o, 0, 0, 0);
                asm volatile("s_waitcnt lgkmcnt(0)" ::: "memory"); __builtin_amdgcn_sched_barrier(0);
#pragma unroll
                for (int cb = 0; cb < 4; ++cb)
#pragma unroll
                    for (int ks = 0; ks < 2; ++ks) Sacc[cb] = __builtin_amdgcn_mfma_f32_32x32x16_bf16(fkt[2 * cb + ks], fvn[ks], Sacc[cb], 0, 0, 0);
                __builtin_amdgcn_sched_barrier(0);
                LAS float* Ot = (LAS float*)(lds + L_O + (i & 1) * 16384);
#pragma unroll
                for (int r = 0; r < 16; ++r) Ot[((r & 3) + 8 * (r >> 2) + 4 * hi) * 128 + 32 * vb + r32] = o[r];
#pragma unroll
                for (int cb = 0; cb < 4; ++cb)
#pragma unroll
                    for (int g4 = 0; g4 < 4; ++g4) { const f32x4 d = *(const LAS f32x4*)(op + O_D + (32 * cb + 8 * g4 + 4 * hi) * 4);
#pragma unroll
                        for (int j = 0; j < 4; ++j) Sacc[cb][4 * g4 + j] *= d[j]; }
            }
            lbar();
        }
    }
    __syncthreads();
}

__device__ __forceinline__ void p5_ln_route(Frame& F_, int g, int l, int bank) {
    KA_WS();
    Frame F = mkframe(F_.lds);
    typedef short bf16x8 __attribute__((ext_vector_type(8)));
    const float* lg = (const float*)KIN(14) + l * D; const float* lb = (const float*)KIN(15) + l * D;
    const float* bgp = (const float*)KIN(17) + l * 4; const float* be = (const float*)KIN(19) + l * 32;
    unsigned* cnt = ((unsigned*)(ws + WS_CTL)) + CW_CNT + bank * 32;
    constexpr int XS = 2064;
    LAS unsigned char* XH = F.lds; LAS unsigned char* XL = F.lds + 16 * XS; LAS float* LG = (LAS float*)(F.lds + 32 * XS);
    LAS int* ent_e = (LAS int*)(F.lds + 32 * XS + 6144); LAS int* ent_pos = ent_e + 256; LAS float* ent_w = (LAS float*)(ent_pos + 256);
    const int lane = F.lane, wave = F.wave;
    constexpr int rows_per_wg = TG / 256;
    constexpr int NP = rows_per_wg / 16;
    const int row0 = blockIdx.x * rows_per_wg;
    const bf16* Rb = (const bf16*)(ws + WS_R); bf16* X1 = (bf16*)(ws + WS_X1);
    const int nb = wave % 3, kh = wave / 3;
    bf16x8 bh[16], blo[16];
    if (wave < 6) {
        const bf16* rw = (const bf16*)(ws + WS_RW) + (size_t)l * 2 * 48 * 1024 + (size_t)(16 * nb + (lane & 15)) * 1024 + 512 * kh + 8 * (lane >> 4);
#pragma unroll
        for (int ks = 0; ks < 16; ++ks) { bh[ks] = *(const bf16x8*)(rw + 32 * ks); blo[ks] = *(const bf16x8*)(rw + 48 * 1024 + 32 * ks); }
    }
    __syncthreads();
    f32x4 vin[2][4];
#pragma unroll
    for (int rr = 0; rr < 2; ++rr) { const u32x2* rp = (const u32x2*)(Rb + (size_t)(row0 + 2 * wave + rr) * D) + lane;
#pragma unroll
        for (int j = 0; j < 4; ++j) { const u32x2 w = rp[64 * j]; vin[rr][j] = (f32x4){lo16(w.x), hi16(w.x), lo16(w.y), hi16(w.y)}; } }
#pragma unroll 1
    for (int p = 0; p < NP; ++p) {
        f32x4 vnx[2][4];
#pragma unroll
        for (int rr = 0; rr < 2; ++rr) { const int tn = row0 + 16 * (p + 1 < NP ? p + 1 : p) + 2 * wave + rr; const u32x2* rp = (const u32x2*)(Rb + (size_t)tn * D) + lane;
#pragma unroll
            for (int j = 0; j < 4; ++j) { const u32x2 w = rp[64 * j]; vnx[rr][j] = (f32x4){lo16(w.x), hi16(w.x), lo16(w.y), hi16(w.y)}; } }
#pragma unroll
        for (int rr = 0; rr < 2; ++rr) {
            const int rl = 2 * wave + rr, t = row0 + 16 * p + rl;
            f32x4 v[4]; float sm = 0.f;
#pragma unroll
            for (int j = 0; j < 4; ++j) { v[j] = vin[rr][j]; sm += (v[j].x + v[j].y) + (v[j].z + v[j].w); }
            const float mean = wave_sum(sm) * (1.f / D); float s2 = 0.f;
#pragma unroll
            for (int j = 0; j < 4; ++j) { v[j] = v[j] - mean; s2 += (v[j].x * v[j].x + v[j].y * v[j].y) + (v[j].z * v[j].z + v[j].w * v[j].w); }
            const float rstd = __builtin_amdgcn_rsqf(wave_sum(s2) * (1.f / D) + EPS);
#pragma unroll
            for (int j = 0; j < 4; ++j) {
                const int d0 = lane * 4 + 256 * j; const f32x4 gg = *(const f32x4*)(lg + d0), bb = *(const f32x4*)(lb + d0);
                const f32x4 y = v[j] * rstd * gg + bb;
                const unsigned h0 = pk2(y.x, y.y), h1 = pk2(y.z, y.w);
                *(u32x2*)(X1 + (size_t)t * D + d0) = (u32x2){h0, h1};
                const unsigned l0 = pk2(y.x - lo16(h0), y.y - hi16(h0)), l1 = pk2(y.z - lo16(h1), y.w - hi16(h1));
                *(LAS u32x2*)(XH + rl * XS + d0 * 2) = (u32x2){h0, h1}; *(LAS u32x2*)(XL + rl * XS + d0 * 2) = (u32x2){l0, l1};
            }
        }
#pragma unroll
        for (int rr = 0; rr < 2; ++rr)
#pragma unroll
            for (int j = 0; j < 4; ++j) vin[rr][j] = vnx[rr][j];
        __syncthreads();
        if (wave < 6) {
            f32x4 acc = {0.f, 0.f, 0.f, 0.f};
            const LAS unsigned char* ah = XH + (lane & 15) * XS + (512 * kh + 8 * (lane >> 4)) * 2; const LAS unsigned char* al = XL + (lane & 15) * XS + (512 * kh + 8 * (lane >> 4)) * 2;
#pragma unroll
            for (int ks = 0; ks < 16; ++ks) { const bf16x8 xa = *(const LAS bf16x8*)(ah + 64 * ks), xb = *(const LAS bf16x8*)(al + 64 * ks);
                acc = __builtin_amdgcn_mfma_f32_16x16x32_bf16(xa, bh[ks], acc, 0, 0, 0); acc = __builtin_amdgcn_mfma_f32_16x16x32_bf16(xb, bh[ks], acc, 0, 0, 0); acc = __builtin_amdgcn_mfma_f32_16x16x32_bf16(xa, blo[ks], acc, 0, 0, 0); }
#pragma unroll
            for (int i = 0; i < 4; ++i) LG[(kh * 16 + 4 * (lane >> 4) + i) * 48 + 16 * nb + (lane & 15)] = acc[i];
        }
        __syncthreads();
        if (F.tid < 16) {
            const int rl = F.tid;
            const LAS float* L0 = LG + rl * 48; const LAS float* L1 = LG + (16 + rl) * 48;
            float gl4[4];
#pragma unroll
            for (int e = 0; e < 4; ++e) gl4[e] = L0[e] + L1[e] + bgp[e];
            int gi = 0; float gm = gl4[0];
#pragma unroll
            for (int e = 1; e < 4; ++e) if (gl4[e] > gm) { gm = gl4[e]; gi = e; }
            float gs = 0.f;
#pragma unroll
            for (int e = 0; e < 4; ++e) gs += __expf(gl4[e] - gm);
            const float pgroup = 1.f / gs;
            float el[8];
#pragma unroll
            for (int e = 0; e < 8; ++e) el[e] = L0[4 + 8 * gi + e] + L1[4 + 8 * gi + e] + be[gi * 8 + e];
            int i0 = 0; float v0 = el[0];
#pragma unroll
            for (int e = 1; e < 8; ++e) if (el[e] > v0) { v0 = el[e]; i0 = e; }
            int i1 = -1; float v1 = -INFINITY;
#pragma unroll
            for (int e = 0; e < 8; ++e) if (e != i0 && el[e] > v1) { v1 = el[e]; i1 = e; }
            const float ex = __expf(v1 - v0); const float p0 = 1.f / (1.f + ex), p1 = ex * p0;
            const int ri = 16 * p + rl;
            ent_e[ri * 2] = gi * 8 + i0; ent_e[ri * 2 + 1] = gi * 8 + i1; ent_w[ri * 2] = p0 * pgroup; ent_w[ri * 2 + 1] = p1 * pgroup;
        }
        __syncthreads();
    }
    if (F.tid < 32) {
        const int e = F.tid; int c = 0;
        for (int i = 0; i < rows_per_wg * 2; ++i) c += (ent_e[i] == e);
        unsigned base = 0; if (c) base = __hip_atomic_fetch_add(cnt + e, (unsigned)c, __ATOMIC_RELAXED, __HIP_MEMORY_SCOPE_AGENT);
        for (int i = 0; i < rows_per_wg * 2; ++i) if (ent_e[i] == e) { ent_pos[i] = (int)base; ((int*)(ws + WS_TOK))[(size_t)e * TG + base] = row0 + (i >> 1); ++base; }
    }
    __syncthreads();
    if (F.tid < rows_per_wg) { const int i = F.tid; unsigned* r = ((unsigned*)(ws + WS_RT)) + (size_t)(row0 + i) * 8;
        r[0] = (unsigned)ent_e[2 * i]; r[1] = (unsigned)ent_pos[2 * i]; r[2] = __float_as_uint(ent_w[2 * i]); r[3] = (unsigned)ent_e[2 * i + 1]; r[4] = (unsigned)ent_pos[2 * i + 1]; r[5] = __float_as_uint(ent_w[2 * i + 1]); }
    __syncthreads();
}

__device__ __forceinline__ void p8_ln2(Frame& F_, int g, int l) {
    KA_WS();
    Frame F = mkframe(F_.lds);
    const float* lg = (const float*)KIN(23) + l * D; const float* lb = (const float*)KIN(24) + l * D;
    const unsigned* cnt = ((unsigned*)(ws + WS_CTL)) + CW_CNT + (g * 2 + l) * 32;
    LAS int* offs = (LAS int*)F.lds;
    __syncthreads();
    if (F.tid == 0) { int off = 0; for (int e = 0; e < NE; ++e) { offs[e] = off; off += ((int)cnt[e] + 255) & ~255; } }
    __syncthreads();
    const int lane = F.lane;
    const bf16* __restrict__ X1 = (const bf16*)(ws + WS_X1); const bf16* __restrict__ OM = (const bf16*)(ws + WS_OM);
    const int per = TG / (gridDim.x * NWAVES);
    const int t0 = (blockIdx.x * NWAVES + F.wave) * per;
    int ms0 = 0, ms1 = 0; float mw0 = 0.f, mw1 = 0.f;
    if (lane < per) { const unsigned* r = ((const unsigned*)(ws + WS_RT)) + (size_t)(t0 + lane) * 8; const u32x4 ra = *(const u32x4*)r; const u32x2 rb2 = *(const u32x2*)(r + 4);
        ms0 = offs[ra.x] + (int)ra.y; mw0 = __uint_as_float(ra.z); ms1 = offs[ra.w] + (int)rb2.x; mw1 = __uint_as_float(rb2.y); }
#pragma unroll 1
    for (int i = 0; i < per; i += 2) {
        u32x2 xa[2][4], oa[2][4], ob[2][4]; float w0[2], w1[2];
#pragma unroll
        for (int rr = 0; rr < 2; ++rr) {
            const int s0 = __builtin_amdgcn_readlane(ms0, i + rr), s1 = __builtin_amdgcn_readlane(ms1, i + rr);
            w0[rr] = __builtin_bit_cast(float, __builtin_amdgcn_readlane(__builtin_bit_cast(int, mw0), i + rr)); w1[rr] = __builtin_bit_cast(float, __builtin_amdgcn_readlane(__builtin_bit_cast(int, mw1), i + rr));
#pragma unroll
            for (int j = 0; j < 4; ++j) { const int d0 = lane * 4 + 256 * j;
                xa[rr][j] = *(const u32x2*)(X1 + (size_t)(t0 + i + rr) * D + d0); oa[rr][j] = *(const u32x2*)(OM + (size_t)s0 * D + d0); ob[rr][j] = *(const u32x2*)(OM + (size_t)s1 * D + d0); }
        }
#pragma unroll
        for (int rr = 0; rr < 2; ++rr) {
            const int t = t0 + i + rr;
            f32x4 v[4]; float sm = 0.f;
#pragma unroll
            for (int j = 0; j < 4; ++j) {
                v[j].x = ALPHA * lo16(xa[rr][j].x) + w0[rr] * lo16(oa[rr][j].x) + w1[rr] * lo16(ob[rr][j].x); v[j].y = ALPHA * hi16(xa[rr][j].x) + w0[rr] * hi16(oa[rr][j].x) + w1[rr] * hi16(ob[rr][j].x);
                v[j].z = ALPHA * lo16(xa[rr][j].y) + w0[rr] * lo16(oa[rr][j].y) + w1[rr] * lo16(ob[rr][j].y); v[j].w = ALPHA * hi16(xa[rr][j].y) + w0[rr] * hi16(oa[rr][j].y) + w1[rr] * hi16(ob[rr][j].y);
                sm += (v[j].x + v[j].y) + (v[j].z + v[j].w);
            }
            const float mean = wave_sum(sm) * (1.f / D); float s2 = 0.f;
#pragma unroll
            for (int j = 0; j < 4; ++j) { v[j] = v[j] - mean; s2 += (v[j].x * v[j].x + v[j].y * v[j].y) + (v[j].z * v[j].z + v[j].w * v[j].w); }
            const float rstd = __builtin_amdgcn_rsqf(wave_sum(s2) * (1.f / D) + EPS);
#pragma unroll
            for (int j = 0; j < 4; ++j) {
                const int d0 = lane * 4 + 256 * j; const f32x4 gg = *(const f32x4*)(lg + d0), bb = *(const f32x4*)(lb + d0);
                const f32x4 y = v[j] * rstd * gg + bb;
                if (l == NL - 1) *(f32x4*)(KOUT() + ((size_t)g * TG + t) * D + d0) = y;
                else *(u32x2*)((bf16*)(ws + WS_XB) + (size_t)t * D + d0) = (u32x2){pk2(y.x, y.y), pk2(y.z, y.w)};
            }
        }
    }
}

struct RmId { int off; __device__ __forceinline__ int operator()(int n0) const { return off + n0; } };
struct RmGlu { __device__ __forceinline__ int operator()(int n0) const { if (n0 >= 1024) return n0; const int hi = n0 >= 512, c = n0 - hi * 512; return (c >> 7) * 256 + hi * 128 + (c & 127); } };
struct RmIl { int hi; __device__ __forceinline__ int operator()(int n0) const { return (n0 >> 7) * 256 + hi * 128 + (n0 & 127); } };
template <class RM>
__device__ __forceinline__ void transpose_item(const float* W, int K, int N, bf16* WT, RM rowmap, LAS float* scr, int item, int lane) {
    const int nblk = N / 32, kb = item / nblk, nb = item % nblk, k0 = 64 * kb, n0 = 32 * nb;
#pragma unroll 8
    for (int i = 0; i < 32; ++i) { const int kk = 2 * i + (lane >> 5); scr[kk * 33 + (lane & 31)] = W[(size_t)(k0 + kk) * N + n0 + (lane & 31)]; }
    LDS_WAIT();
    const int c = lane & 7; const int r0 = rowmap(n0);
#pragma unroll
    for (int j = 0; j < 4; ++j) { const int n = (lane >> 3) + 8 * j; const LAS float* sp = scr + (8 * c) * 33 + n;
        u32x4 o; o.x = pk2(sp[0 * 33], sp[1 * 33]); o.y = pk2(sp[2 * 33], sp[3 * 33]); o.z = pk2(sp[4 * 33], sp[5 * 33]); o.w = pk2(sp[6 * 33], sp[7 * 33]);
        *(u32x4*)(WT + (size_t)(r0 + n) * K + k0 + 8 * c) = o; }
    LDS_WAIT();
}
__device__ __forceinline__ void p_wprep(Frame& F_) {
    KA_WS();
    Frame F = mkframe(F_.lds);
    LAS float* scr = (LAS float*)(F.lds + F.wave * 16384);
    const int gw = blockIdx.x * NWAVES + F.wave, NGW = gridDim.x * NWAVES, lane = F.lane;
    bf16* WIN = (bf16*)(ws + WS_WIN); bf16* WBR = (bf16*)(ws + WS_WBR); bf16* WOUT = (bf16*)(ws + WS_WOUT); bf16* W13 = (bf16*)(ws + WS_W13); bf16* W2 = (bf16*)(ws + WS_W2);
    constexpr int I_IN = 16 * 240, I_BR = 8 * 32, I_OUT = 16 * 32, I_W1 = 16 * 16, I_W2 = 8 * 32;
    constexpr int N_IN = 2 * I_IN, N_BR = 6 * I_BR, N_OUT = 2 * I_OUT, N_W1 = 64 * I_W1, N_W2 = 64 * I_W2;
    constexpr int NITEMS = N_IN + N_BR + N_OUT + 2 * N_W1 + N_W2;
    for (int it = gw; it < NITEMS; it += NGW) {
        int r = it;
        if (r < N_IN) { const int l = r / I_IN; transpose_item((const float*)KIN(2) + (size_t)l * D * INC, D, INC, WIN + (size_t)l * INC * D, RmGlu(), scr, r % I_IN, lane); continue; } r -= N_IN;
        if (r < N_BR) { const int q = r / I_BR; transpose_item((const float*)KIN(11) + (size_t)q * 512 * D, 512, D, WBR + (size_t)q * D * 512, RmId{0}, scr, r % I_BR, lane); continue; } r -= N_BR;
        if (r < N_OUT) { const int l = r / I_OUT; transpose_item((const float*)KIN(13) + (size_t)l * D * D, D, D, WOUT + (size_t)l * D * D, RmId{0}, scr, r % I_OUT, lane); continue; } r -= N_OUT;
        if (r < N_W1) { const int q = r / I_W1; transpose_item((const float*)KIN(20) + (size_t)q * D * DE, D, DE, W13 + (size_t)q * 1024 * D, RmIl{0}, scr, r % I_W1, lane); continue; } r -= N_W1;
        if (r < N_W1) { const int q = r / I_W1; transpose_item((const float*)KIN(21) + (size_t)q * D * DE, D, DE, W13 + (size_t)q * 1024 * D, RmIl{1}, scr, r % I_W1, lane); continue; } r -= N_W1;
        { const int q = r / I_W2; transpose_item((const float*)KIN(22) + (size_t)q * DE * D, DE, D, W2 + (size_t)q * D * DE, RmId{0}, scr, r % I_W2, lane); }
    }
}

template <int PART> __device__ __forceinline__ void p1_part(Frame& F_, int g, int l, int G, int c) {
    KA_WS();
    Frame F = mkframe(F_.lds);
    pg8::ProbDense P{(const char*)((bf16*)(ws + WS_XB)), (const char*)(ws + WS_WIN) + (size_t)l * INC * D * 2, D};
    pg8::SubOrder<PART> S; S.init(TG, G, c);
    pg8::EpiInProj E{((bf16*)(ws + WS_U)), ((bf16*)(ws + WS_Q)), ((bf16*)(ws + WS_V)), ((bf16*)(ws + WS_GATE)), ((const float*)(ws + WS_ROT)) + (size_t)g * TG * 16, ((const float*)(ws + WS_LB)) + l * 512, (const float*)KIN(12) + (size_t)l * 3 * D};
    pg8::gemm_phase<pg8::ProbDense, pg8::EpiInProj, pg8::SubOrder<PART>, true>(F.lds, P, S, E);
}
__device__ __forceinline__ void p3_merge(Frame& F_, int l) {
    KA_WS();
    Frame F = mkframe(F_.lds);
    pg8::ProbMerge P{(const char*)((bf16*)(ws + WS_YA)), (const char*)((bf16*)(ws + WS_YB)), (const char*)((bf16*)(ws + WS_YC)), (const char*)(ws + WS_WBR) + (size_t)l * 3 * D * 512 * 2, 512};
    pg8::MergeOrder S; S.so.init(TG, D, gridDim.x, blockIdx.x);
    pg8::EpiMerge E{((bf16*)(ws + WS_GATE)), ((bf16*)(ws + WS_M))};
    pg8::gemm_phase<pg8::ProbMerge, pg8::EpiMerge, pg8::MergeOrder, true>(F.lds, P, S, E);
}
__device__ __forceinline__ void p4_wout(Frame& F_, int l) {
    KA_WS();
    Frame F = mkframe(F_.lds);
    pg8::ProbDense P{(const char*)((bf16*)(ws + WS_M)), (const char*)(ws + WS_WOUT) + (size_t)l * D * D * 2, D};
    pg8::StaticOrder S; S.init(TG, D, gridDim.x, blockIdx.x);
    pg8::EpiWout E{((bf16*)(ws + WS_XB)), ((bf16*)(ws + WS_R))};
    pg8::gemm_phase<pg8::ProbDense, pg8::EpiWout, pg8::StaticOrder, true>(F.lds, P, S, E);
}
constexpr int TAB_OFF = MISC_OFF + 256;
__device__ __forceinline__ void moe_table(Frame& F_, int g, int l) {
    KA_WS();
    Frame F = mkframe(F_.lds);
    const unsigned* cnt = ((unsigned*)(ws + WS_CTL)) + CW_CNT + (g * 2 + l) * 32;
    LAS int* tab = (LAS int*)(F.lds + TAB_OFF);
    __syncthreads();
    if (F.tid < 64) {
        const int c = F.tid < 32 ? (int)cnt[F.tid] : 0; int sacc = (c + 255) >> 8;
#pragma unroll
        for (int o = 1; o < 32; o <<= 1) { const int t2 = __shfl_up(sacc, o); if (F.lane >= o) sacc += t2; }
        if (F.tid < 32) { tab[F.tid + 1] = sacc; tab[33 + F.tid] = c; }
        if (F.tid == 0) tab[0] = 0;
    }
    __syncthreads();
}
__device__ __forceinline__ void p6_moe1(Frame& F_, int g, int l) {
    KA_WS();
    Frame F = mkframe(F_.lds);
    moe_table(F, g, l);
    pg8::ProbMoe1 P{(const char*)((bf16*)(ws + WS_X1)), (const char*)(ws + WS_W13) + (size_t)l * NE * 1024 * D * 2, ((int*)(ws + WS_TOK)), D};
    pg8::MoeOrder S{(const LAS int*)(F.lds + TAB_OFF), (int)gridDim.x, (int)blockIdx.x, 4};
    pg8::EpiMoe1 E{((bf16*)(ws + WS_HM))};
    pg8::gemm_phase<pg8::ProbMoe1, pg8::EpiMoe1, pg8::MoeOrder, true>(F.lds, P, S, E);
}
__device__ __forceinline__ void p7_moe2(Frame& F_, int g, int l) {
    KA_WS();
    Frame F = mkframe(F_.lds);
    moe_table(F, g, l);
    pg8::ProbMoe2 P{(const char*)((bf16*)(ws + WS_HM)), (const char*)(ws + WS_W2) + (size_t)l * NE * D * DE * 2, DE};
    pg8::MoeOrder S{(const LAS int*)(F.lds + TAB_OFF), (int)gridDim.x, (int)blockIdx.x, 4};
    pg8::EpiMoe2 E{((bf16*)(ws + WS_OM))};
    pg8::gemm_phase<pg8::ProbMoe2, pg8::EpiMoe2, pg8::MoeOrder, true>(F.lds, P, S, E);
}

__device__ __forceinline__ void frame_init(Frame& F, unsigned char* lds_raw) {
    F.lds = (LAS unsigned char*)lds_raw; F.tid = threadIdx.x; F.lane = F.tid & 63; F.wave = __builtin_amdgcn_readfirstlane(F.tid >> 6);
}
__global__ void __launch_bounds__(NTHR, 2) fwd_all(Args a) {
    extern __shared__ __attribute__((aligned(16))) unsigned char lds_raw[];
    Frame F; frame_init(F, lds_raw);
    volatile LAS unsigned* MISC = (volatile LAS unsigned*)(F.lds + MISC_OFF);
    if (F.tid < 64) MISC[F.tid] = 0u;
    __syncthreads();
    XcdBarrier bar = xcd_barrier_post((unsigned*)(a.ws + WS_CTL) + CW_BAR, MISC + 8);
    p_prologue(F); p_wprep(F); p_xload(F, 0);
    xcd_barrier(bar);
    for (int g = 0; g < NG; ++g) {
        for (int l = 0; l < NL; ++l) {
            p1_part<0>(F, g, l, (int)gridDim.x, (int)blockIdx.x); xcd_barrier(bar);
            p2_mixers(F, g, l, 0); xcd_barrier(bar);
            p2d_combine(F, l); xcd_barrier(bar);
            p3_merge(F, l); xcd_barrier(bar);
            p4_wout(F, l); xcd_barrier(bar);
            p5_ln_route(F, g, l, g * 2 + l); xcd_barrier(bar);
            p6_moe1(F, g, l); xcd_barrier(bar);
            p7_moe2(F, g, l); xcd_barrier(bar);
            p8_ln2(F, g, l);
            if (l == NL - 1 && g + 1 < NG) p_xload(F, g + 1);
            xcd_barrier(bar);
        }
    }
}

extern "C" void kernel_launch(void* const* d_in, const int* in_sizes, int n_in, void* d_out, int out_size, void* d_ws, size_t ws_size, hipStream_t stream) {
    static int grid = 0;
    if (grid == 0) {
        if (n_in != 25 || out_size != T * D || ws_size < WS_END) { fprintf(stderr, "kernel_launch: unexpected shapes (n_in %d out %d ws %zu)\n", n_in, out_size, ws_size); grid = -1; return; }
        int dev = 0, cus = 0;
        if (hipGetDevice(&dev) != hipSuccess || hipDeviceGetAttribute(&cus, hipDeviceAttributeMultiprocessorCount, dev) != hipSuccess) { grid = -1; return; }
        (void)hipGetLastError();
        grid = cus;
        if (grid != 256) { fprintf(stderr, "kernel_launch: built for 256 CUs, got %d\n", cus); grid = -1; return; }
    }
    if (grid < 0) return;
    (void)hipMemsetAsync((char*)d_ws + WS_CTL, 0, CTL_ZERO_BYTES, stream);
    Args a{};
    for (int i = 0; i < 25; ++i) a.in[i] = d_in[i];
    a.out = (float*)d_out; a.ws = (unsigned char*)d_ws;
    { static bool attr = false; if (!attr) { (void)hipFuncSetAttribute((const void*)fwd_all, hipFuncAttributeMaxDynamicSharedMemorySize, LDS_BYTES); attr = true; }
      hipLaunchKernelGGL(fwd_all, dim3(grid), dim3(NTHR), LDS_BYTES, stream, a);}

}
```

```cpp
#include <hip/hip_runtime.h>
#include <cstdio>
#include <cstdint>

#ifndef ONE_LAUNCH
#define ONE_LAUNCH 1
#endif

#define GAS __attribute__((address_space(1)))
#define LAS __attribute__((address_space(3)))
typedef unsigned short bf16;
typedef float f32x4 __attribute__((ext_vector_type(4)));
typedef float f32x2 __attribute__((ext_vector_type(2)));
typedef unsigned u32x4 __attribute__((ext_vector_type(4)));
typedef unsigned u32x2 __attribute__((ext_vector_type(2)));

constexpr int D = 1024, NBATCH = 32, S = 2048, T = NBATCH * S, NL = 2;
constexpr int GB = 16, TG = GB * S, NG = NBATCH / GB;
constexpr int INC = 7680;
constexpr int NE = 32, DE = 512;
constexpr float ALPHA = 1.4142135623730951f, EPS = 1e-5f;
constexpr int NWAVES = 8, NTHR = 512;

constexpr size_t MiB = 1u << 20;
constexpr size_t WS_CTL = 0, CTL_ZERO_BYTES = 1 * MiB;
constexpr size_t WS_ROT = 1 * MiB;
constexpr size_t WS_LB = 5 * MiB;
constexpr size_t WS_RW = 6 * MiB;
constexpr size_t WS_WIN = 8 * MiB;
constexpr size_t WS_WBR = 38 * MiB;
constexpr size_t WS_WOUT = 44 * MiB;
constexpr size_t WS_W13 = 48 * MiB;
constexpr size_t WS_W2 = 176 * MiB;
constexpr size_t WS_XB = 240 * MiB;
constexpr size_t WS_U = 304 * MiB;
constexpr size_t WS_Q = 336 * MiB, WS_K = 368 * MiB, WS_V = 400 * MiB;
constexpr size_t WS_HQ = 432 * MiB, WS_HF = 464 * MiB, WS_HV = 496 * MiB, WS_HG = 528 * MiB;
constexpr size_t WS_GATE = 560 * MiB;
constexpr size_t WS_YA = 752 * MiB, WS_YB = 784 * MiB, WS_YC = 816 * MiB;
constexpr size_t WS_R = 848 * MiB;
constexpr size_t WS_TOK = 976 * MiB;
constexpr size_t WS_RT = 980 * MiB;
constexpr size_t WS_END = 982 * MiB;
constexpr size_t WS_M = WS_Q;
constexpr size_t WS_X1 = WS_YA;
constexpr size_t WS_HM = 304 * MiB;
constexpr size_t WS_OM = 376 * MiB;
constexpr size_t HSTRIDE = (size_t)TG * 512;
static_assert((WS_K - WS_Q) == HSTRIDE * 2 && (WS_HQ - WS_V) == HSTRIDE * 2 && (WS_HF - WS_HQ) == HSTRIDE * 2 && (WS_HV - WS_HF) == HSTRIDE * 2 && (WS_HG - WS_HV) == HSTRIDE * 2, "EpiInProj pointer arithmetic");
static_assert(WS_OM + (size_t)(2 * TG + 32 * 256) * 1024 * 2 <= WS_GATE && WS_HM + (size_t)(2 * TG + 32 * 256) * 512 * 2 <= WS_OM, "expert buffers overlay U..HF only");
constexpr int CW_BAR = 4096;
constexpr int CW_CNT = 16384;

__device__ __forceinline__ float bf2f(bf16 b) { return __uint_as_float(((unsigned)b) << 16); }
__device__ __forceinline__ unsigned f2bf(float f) { unsigned u = __float_as_uint(f); return (u + 0x7fffu + ((u >> 16) & 1u)) >> 16; }
__device__ __forceinline__ unsigned pk2(float lo, float hi) { unsigned r; asm volatile("v_cvt_pk_bf16_f32 %0, %1, %2" : "=v"(r) : "v"(lo), "v"(hi)); return r; }
__device__ __forceinline__ float lo16(unsigned w) { return __uint_as_float(w << 16); }
__device__ __forceinline__ float hi16(unsigned w) { return __uint_as_float(w & 0xffff0000u); }
#define DPP_ADD(v, ctrl) ((v) + __builtin_bit_cast(float, __builtin_amdgcn_update_dpp(0, __builtin_bit_cast(int, (v)), (ctrl), 0xF, 0xF, true)))
__device__ __forceinline__ float wave_sum(float v) {
    v = DPP_ADD(v, 0xB1);
    v = DPP_ADD(v, 0x4E);
    v = DPP_ADD(v, 0x141);
    v = DPP_ADD(v, 0x140);
    v = v + __builtin_bit_cast(float, __builtin_amdgcn_update_dpp(0, __builtin_bit_cast(int, v), 0x142, 0xA, 0xF, false));
    v = v + __builtin_bit_cast(float, __builtin_amdgcn_update_dpp(0, __builtin_bit_cast(int, v), 0x143, 0xC, 0xF, false));
    return __builtin_bit_cast(float, __builtin_amdgcn_readlane(__builtin_bit_cast(int, v), 63));
}
__device__ __forceinline__ float wave_max(float v) {
#pragma unroll
    for (int o = 1; o < 64; o <<= 1) v = fmaxf(v, __shfl_xor(v, o));
    return v;
}
__device__ __forceinline__ float sigmoidf_(float z) { return 1.f / (1.f + expf(-z)); }
__device__ __forceinline__ float siluf_(float z) { return z / (1.f + expf(-z)); }
__device__ __forceinline__ float hg_logf(float z, float lb) {
    if (z >= 0.f) { const float sn = 1.f / (1.f + expf(z)); return log1pf(-(1.f - lb) * sn); }
    const float ez = expf(z); return logf(lb + (1.f - lb) * (ez / (1.f + ez)));
}
#define LDS_WAIT() asm volatile("s_waitcnt lgkmcnt(0)" ::: "memory")

#define XB_TMO      128
#define XB_XCNT(j)  (256  + 64 * (j))
#define XB_XSUB(j)  (1280 + 64 * (j))
#define XB_XGEN(j)  (2304 + 64 * (j))
#define XB_TOP      3328
#define XB_TOPGEN   3392
#define XCD_BAR_WORDS 3456
#define XB_SPIN_CAP (1u << 22)
__device__ __forceinline__ unsigned xb_ld(unsigned* p)              { return __hip_atomic_load(p, __ATOMIC_RELAXED, __HIP_MEMORY_SCOPE_AGENT); }
__device__ __forceinline__ unsigned xb_add(unsigned* p, unsigned v) { return __hip_atomic_fetch_add(p, v, __ATOMIC_RELAXED, __HIP_MEMORY_SCOPE_AGENT); }
__device__ __forceinline__ unsigned xb_xcc_id() { return (unsigned)__builtin_amdgcn_s_getreg((3 << 11) | 20) & 0xFu; }
#define XB_SPIN(cond, bar) do { unsigned _sp = 0; while (cond) { __builtin_amdgcn_s_sleep(1); \
    if ((++_sp & 255u) == 0u) { if (xb_ld(&(bar)[XB_TMO])) break; if (_sp > XB_SPIN_CAP) { atomicAdd(&(bar)[XB_TMO], 1u); break; } } } } while (0)
struct XcdBarrier { unsigned* bar; unsigned x; volatile LAS unsigned* st; };
__device__ __forceinline__ XcdBarrier xcd_barrier_post(unsigned* bar, volatile LAS unsigned* st) {
    XcdBarrier b; b.bar = bar; b.x = (unsigned)__builtin_amdgcn_readfirstlane((int)xb_xcc_id()); b.st = st;
    if (threadIdx.x == 0) (void)xb_add(&bar[XB_XCNT(b.x)], 1u);
    return b;
}
__device__ __forceinline__ void xcd_barrier_complete(unsigned* bar, unsigned x, unsigned& nloc, unsigned& nx) {
    const unsigned G = gridDim.x * gridDim.y * gridDim.z;
    unsigned sum, cnt, mine, sp = 0u;
    for (;;) {
        sum = 0u; cnt = 0u; mine = 0u;
#pragma unroll
        for (unsigned j = 0; j < 16; ++j) { const unsigned c = xb_ld(&bar[XB_XCNT(j)]); sum += c; cnt += (c > 0u) ? 1u : 0u; mine = (j == x) ? c : mine; }
        if (sum == G) break;
        __builtin_amdgcn_s_sleep(1);
        if ((++sp & 255u) == 0u) { if (xb_ld(&bar[XB_TMO])) break; if (sp > XB_SPIN_CAP) { atomicAdd(&bar[XB_TMO], 1u); break; } }
    }
    nloc = mine > 0u ? mine : 1u; nx = cnt > 0u ? cnt : 1u;
}
__device__ __forceinline__ void xcd_barrier(const XcdBarrier& b_) {
    XcdBarrier b = b_;
    { unsigned long long bp = (unsigned long long)b_.bar; unsigned bx = b_.x; asm volatile("" : "+s"(bp), "+s"(bx)); b.bar = (unsigned*)(GAS unsigned*)bp; b.x = bx; }
    asm volatile("s_waitcnt vmcnt(0)" ::: "memory");
    __syncthreads();
    if (threadIdx.x == 0) {
        unsigned* bar = b.bar;
        __builtin_amdgcn_s_waitcnt(0);
        unsigned nloc = b.st[0], nx = b.st[1];
        if (nloc == 0u) { xcd_barrier_complete(bar, b.x, nloc, nx); b.st[0] = nloc; b.st[1] = nx; }
        const unsigned old = xb_add(&bar[XB_XSUB(b.x)], 1u);
        const unsigned gen = old / nloc;
        if (old + 1u == (gen + 1u) * nloc) {
            __builtin_amdgcn_fence(__ATOMIC_RELEASE, "agent");
            asm volatile("s_waitcnt vmcnt(0)" ::: "memory");
            const unsigned og = xb_add(&bar[XB_TOP], 1u);
            const unsigned tg = og / nx;
            if (og + 1u == (tg + 1u) * nx) xb_add(&bar[XB_TOPGEN], 1u);
            else XB_SPIN(xb_ld(&bar[XB_TOPGEN]) == tg, bar);
            __builtin_amdgcn_fence(__ATOMIC_ACQUIRE, "agent");
            xb_add(&bar[XB_XGEN(b.x)], 1u);
            asm volatile("s_waitcnt vmcnt(0)" ::: "memory");
        } else {
            XB_SPIN(xb_ld(&bar[XB_XGEN(b.x)]) == gen, bar);
            __builtin_amdgcn_fence(__ATOMIC_ACQUIRE, "agent");
            asm volatile("s_waitcnt vmcnt(0)" ::: "memory");
        }
    }
    __syncthreads();
}

constexpr int LDS_BYTES = 147456;
constexpr int MISC_OFF = 135168;
struct Args { const void* in[25]; float* out; unsigned char* ws; int g_lo, g_hi, l_lo, l_hi, ph_lo, ph_hi, prologue, pad; };
struct Frame { LAS unsigned char* lds; int tid, lane, wave; };
typedef const __attribute__((address_space(4))) Args* KArgs;
__device__ __forceinline__ KArgs kargs() { unsigned long long v = (unsigned long long)__builtin_amdgcn_kernarg_segment_ptr(); asm volatile("" : "+s"(v)); return (KArgs)v; }
#define KA_WS() KArgs ka = kargs(); unsigned char* ws = (unsigned char*)(GAS unsigned char*)ka->ws
#define KIN(i) ((const void*)(const GAS char*)ka->in[i])
#define KOUT() ((float*)(GAS float*)ka->out)
__device__ __forceinline__ Frame mkframe(LAS unsigned char* lds) { Frame F; int t = threadIdx.x; asm volatile("" : "+v"(t)); F.lds = lds; F.tid = t; F.lane = t & 63; F.wave = __builtin_amdgcn_readfirstlane(t >> 6); return F; }

namespace pg8 {
typedef short bf16x8 __attribute__((ext_vector_type(8)));
constexpr int BM = 256, BK = 64, HALF = 128, HTB = HALF * BK * 2, STAGE_BYTES = 8 * HTB, NXCD = 8, WGM = 8;
__host__ __device__ __forceinline__ int lds_byte(int r, int c) { const int st = (r >> 4) * 2 + (c >> 5), rr = r & 15, cc = c & 31, ob = rr * 64 + cc * 2; return st * 1024 + (ob ^ (((ob >> 9) & 1) << 5)); }
__host__ __device__ __forceinline__ void stage_rc(int b, int& R, int& C) { const int st = b / 1024, sb = b % 1024, swz = sb ^ (((sb >> 9) & 1) << 5); R = (st >> 1) * 16 + swz / 64; C = (st & 1) * 32 + (swz % 64) / 2; }
__host__ __device__ __forceinline__ int perm32(int rho) { const int n = rho >> 4, i = rho & 15; return 8 * (i >> 2) + 4 * n + (i & 3); }
struct Unit { int pm, pn, e, pos0, cnt; };
__device__ __forceinline__ int xcd_remap(int wgid, int nwg) { const int q = nwg / NXCD, r = nwg % NXCD, xcd = wgid % NXCD, off = wgid / NXCD; return (xcd < r ? xcd * (q + 1) : r * (q + 1) + (xcd - r) * q) + off; }
struct StaticOrder {
    int nM, nN, nwg, G, c;
    __device__ void init(int M, int N, int G_, int c_) { nM = M / BM; nN = N / BM; nwg = nM * nN; G = G_; c = c_; }
    __device__ bool next(int i, Unit& u) const {
        const long L = (long)i * G + c; if (L >= nwg) return false;
        const int wgid = xcd_remap((int)L, nwg);
        const int nig = WGM * nN, gid = wgid / nig, fm = gid * WGM, gsz = (nM - fm) < WGM ? (nM - fm) : WGM;
        u.pm = fm + ((wgid % nig) % gsz); u.pn = (wgid % nig) / gsz; u.e = 0; u.pos0 = 0; u.cnt = 0; return true;
    }
    __device__ __forceinline__ void a_ready(const Unit&) const {}
    __device__ __forceinline__ void done(const Unit&) const {}
};
template <int PART> struct SubOrder {
    StaticOrder so;
    __device__ void init(int M, int G_, int c_) { so.init(M, (PART == 0 ? 18 : 12) * BM, G_, c_); }
    __device__ bool next(int i, Unit& u) const { if (!so.next(i, u)) return false; u.pn = PART == 0 ? u.pn + 4 : (u.pn < 4 ? u.pn : u.pn + 18); return true; }
    __device__ __forceinline__ void a_ready(const Unit&) const {}
    __device__ __forceinline__ void done(const Unit&) const {}
};
struct MergeOrder {
    StaticOrder so;
    __device__ bool next(int i, Unit& u) const { if (!so.next(i / 3, u)) return false; u.e = i % 3; return true; }
    __device__ __forceinline__ void a_ready(const Unit&) const {}
    __device__ __forceinline__ void done(const Unit&) const {}
};
struct MoeOrder {
    const LAS int* tab; int G, c, NT;
    __device__ bool next(int i, Unit& u) const {
        const int np = __builtin_amdgcn_readfirstlane(tab[32]); const int nwg = np * NT;
        const long L = (long)i * G + c; if (L >= nwg) return false;
        const int wgid = xcd_remap((int)L, nwg);
        const int panel = wgid / NT; u.pn = wgid % NT;
        int e = 0;
#pragma unroll
        for (int s2 = 16; s2 >= 1; s2 >>= 1) { const int tv = __builtin_amdgcn_readfirstlane(tab[e + s2]); if (tv <= panel) e += s2; }
        u.e = e; u.pm = panel; u.pos0 = (panel - __builtin_amdgcn_readfirstlane(tab[e])) * 256; u.cnt = __builtin_amdgcn_readfirstlane(tab[33 + e]); return true;
    }
    __device__ __forceinline__ void a_ready(const Unit&) const {}
    __device__ __forceinline__ void done(const Unit&) const {}
};
__device__ __forceinline__ unsigned cvt_pk_bf16(float lo, float hi) { unsigned r; asm volatile("v_cvt_pk_bf16_f32 %0, %1, %2" : "=v"(r) : "v"(lo), "v"(hi)); return r; }

template <class Prob, class Epi, class Sched, bool ALIGN_EPI>
__device__ __forceinline__ void gemm_phase(LAS unsigned char* lds, const Prob& P, const Sched& S, const Epi& E) {
    int tid_ = threadIdx.x; asm volatile("" : "+v"(tid_));
    const int tid = tid_, wid = __builtin_amdgcn_readfirstlane(tid >> 6), lane = tid & 63, wr = wid >> 2, wc = wid & 3, fr = lane & 15, fq = lane >> 4;
    const int K = P.K, nt = K / BK;
    unsigned vA[2][2], voffB[2];
#pragma unroll
    for (int i = 0; i < 2; ++i) { int R, C; stage_rc(tid * 16 + i * 8192, R, C); const int Rb = (R & ~31) + perm32(R & 31);
        vA[0][i] = (unsigned)(R * K + C) * 2u; vA[1][i] = vA[0][i] + (unsigned)(HALF * K * 2); voffB[i] = (unsigned)(Rb * K + C) * 2u; }
    const size_t kstep = (size_t)(BK * 2);
    const size_t hstep = (size_t)HALF * K * 2;
    const unsigned ldsw = (unsigned)wid * 1024u;
    const int aoff = lds_byte(wr * 64 + fr, fq * 8), boff = lds_byte(wc * 32 + fr, fq * 8);
#define PG8_SA(b, h) (((b) * 2 + (h)) * HTB)
#define PG8_SB(b, h) ((4 + (b) * 2 + (h)) * HTB)
#define PG8_STAGE(bufoff, gbase, voff) do { _Pragma("unroll") for (int _i = 0; _i < 2; ++_i) \
        __builtin_amdgcn_global_load_lds((const unsigned*)((const char*)(gbase) + (voff)[_i]), (LAS unsigned*)(lds + (bufoff) + ldsw + _i * 8192), 16, 0, 0); } while (0)
#define PG8_LDA(dst, b, h) do { _Pragma("unroll") for (int m = 0; m < 4; ++m) _Pragma("unroll") for (int k = 0; k < 2; ++k) dst[m][k] = *(const LAS bf16x8*)(lds + PG8_SA(b, h) + aoff + m * 2048 + k * 1024); } while (0)
#define PG8_LDB(dst, b, h) do { _Pragma("unroll") for (int n = 0; n < 2; ++n) _Pragma("unroll") for (int k = 0; k < 2; ++k) dst[n][k] = *(const LAS bf16x8*)(lds + PG8_SB(b, h) + boff + n * 2048 + k * 1024); } while (0)
#define PG8_MMA(ai, bj, At, Bt) do { __builtin_amdgcn_s_setprio(1); _Pragma("unroll") for (int m = 0; m < 4; ++m) _Pragma("unroll") for (int n = 0; n < 2; ++n) _Pragma("unroll") for (int k = 0; k < 2; ++k) \
        acc[ai][bj][m][n] = __builtin_amdgcn_mfma_f32_16x16x32_bf16(Bt[n][k], At[m][k], acc[ai][bj][m][n], 0, 0, 0); __builtin_amdgcn_s_setprio(0); } while (0)
#define PG8_WAIT_V(n) asm volatile("s_waitcnt vmcnt(" #n ")" ::: "memory")
#define PG8_WAIT_L(n) asm volatile("s_waitcnt lgkmcnt(" #n ")" ::: "memory")
#define PG8_BAR __builtin_amdgcn_s_barrier()
#define PG8_SCHED __builtin_amdgcn_sched_barrier(0)
    Unit cur, nxt; int ui = 0;
    if (!S.next(0, cur)) return;
    f32x4 acc[2][2][4][2];
#pragma unroll
    for (int a = 0; a < 2; ++a)
#pragma unroll
        for (int b = 0; b < 2; ++b)
#pragma unroll
            for (int m = 0; m < 4; ++m)
#pragma unroll
                for (int n = 0; n < 2; ++n) acc[a][b][m][n] = (f32x4){0.f, 0.f, 0.f, 0.f};
    bf16x8 At[4][2], B0[2][2], B1[2][2];
    const char* cA = P.abase(cur); const char* cB = P.bbase(cur);
    if constexpr (Prob::GATHER) P.voff(cur, tid, vA);
    S.a_ready(cur);
    PG8_STAGE(PG8_SB(0, 0), cB, voffB); PG8_STAGE(PG8_SB(0, 1), cB + hstep, voffB); PG8_STAGE(PG8_SA(0, 0), cA, vA[0]); PG8_STAGE(PG8_SA(0, 1), cA, vA[1]);
    if (wr == 1) PG8_BAR;
    PG8_WAIT_V(2); PG8_BAR;
    PG8_STAGE(PG8_SB(1, 0), cB + kstep, voffB); PG8_STAGE(PG8_SA(1, 0), cA + kstep, vA[0]); PG8_STAGE(PG8_SB(1, 1), cB + hstep + kstep, voffB);
    PG8_WAIT_V(6); PG8_BAR;
    for (;;) {
        const bool has_next = S.next(ui + 1, nxt);
        const char* nA = has_next ? P.abase(nxt) : cA; const char* nB = has_next ? P.bbase(nxt) : cB;
        unsigned nv[2][2];
#pragma unroll
        for (int h = 0; h < 2; ++h)
#pragma unroll
            for (int i = 0; i < 2; ++i) nv[h][i] = vA[h][i];
        for (int t = 0; t < nt; t += 2) {
            const bool last = (t == nt - 2);
            if constexpr (Prob::GATHER) { if (t == nt - 4 && has_next) P.voff(nxt, tid, nv); }
            const char* a1 = cA + (size_t)(t + 1) * kstep;
            const char* a2 = last ? nA : cA + (size_t)(t + 2) * kstep; const char* b2 = last ? nB : cB + (size_t)(t + 2) * kstep;
            const char* a3 = a2 + kstep; const char* b3 = b2 + kstep;
            if (last && has_next) S.a_ready(nxt);
            unsigned w0[2], w1[2];
#pragma unroll
            for (int i = 0; i < 2; ++i) { if constexpr (Prob::GATHER) { w0[i] = last ? nv[0][i] : vA[0][i]; w1[i] = last ? nv[1][i] : vA[1][i]; } else { w0[i] = vA[0][i]; w1[i] = vA[1][i]; } }
            PG8_LDB(B0, 0, 0); PG8_LDB(B1, 0, 1); PG8_SCHED; PG8_LDA(At, 0, 0); PG8_STAGE(PG8_SA(1, 1), a1, vA[1]);
            PG8_WAIT_V(8); PG8_WAIT_L(0); PG8_BAR; PG8_MMA(0, 0, At, B0); PG8_MMA(0, 1, At, B1); PG8_BAR; PG8_SCHED;
            PG8_LDA(At, 0, 1); PG8_STAGE(PG8_SB(0, 0), b2, voffB); PG8_STAGE(PG8_SB(0, 1), b2 + hstep, voffB); PG8_STAGE(PG8_SA(0, 0), a2, w0);
            PG8_WAIT_V(8); PG8_WAIT_L(0); PG8_BAR; PG8_MMA(1, 0, At, B0); PG8_MMA(1, 1, At, B1); PG8_BAR; PG8_SCHED;
            PG8_LDB(B0, 1, 0); PG8_LDB(B1, 1, 1); PG8_SCHED; PG8_LDA(At, 1, 0); PG8_STAGE(PG8_SA(0, 1), a2, w1);
            PG8_WAIT_V(8); PG8_WAIT_L(0); PG8_BAR; PG8_MMA(0, 0, At, B0); PG8_MMA(0, 1, At, B1); PG8_BAR; PG8_SCHED;
            PG8_LDA(At, 1, 1); PG8_STAGE(PG8_SB(1, 0), b3, voffB); PG8_STAGE(PG8_SB(1, 1), b3 + hstep, voffB); PG8_STAGE(PG8_SA(1, 0), a3, w0);
            PG8_WAIT_V(8); PG8_WAIT_L(0); PG8_BAR; PG8_MMA(1, 0, At, B0); PG8_MMA(1, 1, At, B1); PG8_BAR; PG8_SCHED;
        }
        if constexpr (ALIGN_EPI) { if (wr == 0) PG8_BAR; }
        E(acc, cur, wr, wc, fr, fq); S.done(cur);
        if (!has_next) break;
        if (!(Epi::CARRY && nxt.e != 0))
#pragma unroll
        for (int a = 0; a < 2; ++a)
#pragma unroll
            for (int b = 0; b < 2; ++b)
#pragma unroll
                for (int m = 0; m < 4; ++m)
#pragma unroll
                    for (int n = 0; n < 2; ++n) acc[a][b][m][n] = (f32x4){0.f, 0.f, 0.f, 0.f};
        cur = nxt; cA = nA; cB = nB; ++ui;
        if constexpr (Prob::GATHER) {
#pragma unroll
            for (int h = 0; h < 2; ++h)
#pragma unroll
                for (int i = 0; i < 2; ++i) vA[h][i] = nv[h][i]; }
        if constexpr (ALIGN_EPI) { if (wr == 1) PG8_BAR; }
    }
    PG8_WAIT_V(0);
    if constexpr (!ALIGN_EPI) { if (wr == 0) PG8_BAR; }
    PG8_BAR;
#undef PG8_SA
#undef PG8_SB
#undef PG8_STAGE
#undef PG8_LDA
#undef PG8_LDB
#undef PG8_MMA
#undef PG8_WAIT_V
#undef PG8_WAIT_L
#undef PG8_BAR
#undef PG8_SCHED
}
struct ProbDense { static constexpr bool GATHER = false; const char* A; const char* Bt; int K;
    __device__ __forceinline__ const char* abase(const Unit& u) const { return A + (size_t)u.pm * 256 * K * 2; }
    __device__ __forceinline__ const char* bbase(const Unit& u) const { return Bt + (size_t)u.pn * 256 * K * 2; }
    __device__ __forceinline__ void voff(const Unit&, int, unsigned (&)[2][2]) const {} };
struct ProbMerge { static constexpr bool GATHER = false; const char* Y0; const char* Y1; const char* Y2; const char* W; int K;
    __device__ __forceinline__ const char* abase(const Unit& u) const { const char* y = u.e == 0 ? Y0 : (u.e == 1 ? Y1 : Y2); return y + (size_t)u.pm * 256 * K * 2; }
    __device__ __forceinline__ const char* bbase(const Unit& u) const { return W + ((size_t)u.e * 1024 + u.pn * 256) * K * 2; }
    __device__ __forceinline__ void voff(const Unit&, int, unsigned (&)[2][2]) const {} };
struct ProbMoe1 { static constexpr bool GATHER = true; const char* X1; const char* W; const int* TOK; int K;
    __device__ __forceinline__ const char* abase(const Unit&) const { return X1; }
    __device__ __forceinline__ const char* bbase(const Unit& u) const { return W + ((size_t)u.e * 1024 + u.pn * 256) * K * 2; }
    __device__ __forceinline__ void voff(const Unit& u, int tid, unsigned (&v)[2][2]) const {
#pragma unroll
        for (int i = 0; i < 2; ++i) { int R, C; stage_rc(tid * 16 + i * 8192, R, C);
#pragma unroll
            for (int h = 0; h < 2; ++h) { const int pos = u.pos0 + h * 128 + R; int tk = TOK[(size_t)u.e * TG + pos]; tk = pos < u.cnt ? tk : 0; v[h][i] = (unsigned)tk * (unsigned)(K * 2) + (unsigned)C * 2u; } } } };
struct ProbMoe2 { static constexpr bool GATHER = false; const char* HM; const char* W; int K;
    __device__ __forceinline__ const char* abase(const Unit& u) const { return HM + (size_t)u.pm * 256 * K * 2; }
    __device__ __forceinline__ const char* bbase(const Unit& u) const { return W + ((size_t)u.e * 1024 + u.pn * 256) * K * 2; }
    __device__ __forceinline__ void voff(const Unit&, int, unsigned (&)[2][2]) const {} };

__device__ __forceinline__ float fsig(float z) { return __builtin_amdgcn_rcpf(1.f + __expf(-z)); }
__device__ __forceinline__ float hg_logf_fast(float z, float lb) {
    const float t = __expf(-fabsf(z)), sg = t * __builtin_amdgcn_rcpf(1.f + t), w = (1.f - lb) * sg;
    return __logf(z >= 0.f ? 1.f - w : lb + w);
}
__device__ __forceinline__ void st8(bf16* p, const f32x4& a, const f32x4& b) { u32x4 w; w.x = cvt_pk_bf16(a[0], a[1]); w.y = cvt_pk_bf16(a[2], a[3]); w.z = cvt_pk_bf16(b[0], b[1]); w.w = cvt_pk_bf16(b[2], b[3]); *(u32x4*)p = w; }
struct EpiInProj {
    static constexpr bool PERM = true, CARRY = false;
    bf16 *U, *Q, *V, *GATE; const float* rot; const float* lbt; const float* bg;
    __device__ __forceinline__ void operator()(const f32x4 (&acc)[2][2][4][2], const Unit& u, int wr, int wc, int fr, int fq) const {
        const int pn = u.pn, rowb = u.pm * 256 + wr * 64 + fr, cl = wc * 32 + 8 * fq;
        if (pn < 4) {
#pragma unroll
            for (int ai = 0; ai < 2; ++ai)
#pragma unroll
                for (int m = 0; m < 4; ++m) { const int row = rowb + ai * 128 + m * 16; f32x4 o0, o1;
#pragma unroll
                    for (int j = 0; j < 4; ++j) { o0[j] = acc[ai][0][m][0][j] * fsig(acc[ai][1][m][0][j]); o1[j] = acc[ai][0][m][1][j] * fsig(acc[ai][1][m][1][j]); }
                    st8(U + (size_t)row * 512 + pn * 128 + cl, o0, o1); asm volatile("" ::: "memory"); }
        } else if (pn < 8) {
            const int which = pn - 4; bf16* dst = Q + (size_t)(which >> 1) * HSTRIDE; const float sc = (which >> 1) ? 1.f : 0.125f * 1.4426950408889634f; const int colb = (which & 1) * 256 + cl;
            const bool rotw = (wc & 1) == 0; const float sgn = fq == 0 ? -1.f : 1.f;
#pragma unroll
            for (int ai = 0; ai < 2; ++ai) {
                f32x4 cs[4][4];
#pragma unroll
                for (int m = 0; m < 4; ++m) { cs[m][0] = (f32x4){1.f, 1.f, 1.f, 1.f}; cs[m][1] = cs[m][0]; cs[m][2] = (f32x4){0.f, 0.f, 0.f, 0.f}; cs[m][3] = cs[m][2];
                    if (rotw && fq < 2) { const f32x4* rp = (const f32x4*)(rot + (size_t)(rowb + ai * 128 + m * 16) * 16); cs[m][0] = rp[0]; cs[m][1] = rp[1]; cs[m][2] = rp[2]; cs[m][3] = rp[3]; } }
#pragma unroll
                for (int m = 0; m < 4; ++m) { const int row = rowb + ai * 128 + m * 16;
                    const f32x4 c0 = cs[m][0], c1 = cs[m][1], s0 = cs[m][2] * sgn, s1 = cs[m][3] * sgn;
#pragma unroll
                    for (int bj = 0; bj < 2; ++bj) { f32x4 x0 = acc[ai][bj][m][0], x1 = acc[ai][bj][m][1];
                        if (rotw) { f32x4 p0, p1;
#pragma unroll
                            for (int j = 0; j < 4; ++j) { p0[j] = __shfl_xor(x0[j], 16); p1[j] = __shfl_xor(x1[j], 16); }
                            x0 = x0 * c0 + p0 * s0; x1 = x1 * c1 + p1 * s1; }
                        st8(dst + (size_t)row * 512 + colb + bj * 128, x0 * sc, x1 * sc); } }
                asm volatile("" ::: "memory"); }
        } else {
            int kind, ldc, colb; bf16* dst; bool seqc = false;
            if (pn < 18) { const int tq = (pn - 8) >> 1; seqc = tq >= 1; kind = tq == 0 ? 0 : (tq == 1 ? 1 : (tq == 2 ? 2 : (tq == 3 ? 0 : 1))); dst = V + (size_t)tq * HSTRIDE; ldc = 512; colb = ((pn - 8) & 1) * 256; }
            else { kind = 3; dst = GATE; ldc = 3072; colb = (pn - 18) * 256; }
            f32x4 aux[2][2];
#pragma unroll
            for (int bj = 0; bj < 2; ++bj)
#pragma unroll
                for (int n = 0; n < 2; ++n) aux[bj][n] = kind == 2 ? *(const f32x4*)(lbt + colb + bj * 128 + cl + 4 * n) : (kind == 3 ? *(const f32x4*)(bg + colb + bj * 128 + cl + 4 * n) : (f32x4){0.f, 0.f, 0.f, 0.f});
#pragma unroll
            for (int ai = 0; ai < 2; ++ai)
#pragma unroll
                for (int m = 0; m < 4; ++m) { const int row = rowb + ai * 128 + m * 16;
#pragma unroll
                    for (int bj = 0; bj < 2; ++bj) { f32x4 x[2] = {acc[ai][bj][m][0], acc[ai][bj][m][1]};
                        if (kind == 1) {
#pragma unroll
                            for (int n = 0; n < 2; ++n)
#pragma unroll
                                for (int j = 0; j < 4; ++j) x[n][j] = x[n][j] * fsig(x[n][j]);
                        } else if (kind == 2) {
#pragma unroll
                            for (int n = 0; n < 2; ++n)
#pragma unroll
                                for (int j = 0; j < 4; ++j) x[n][j] = hg_logf_fast(x[n][j], aux[bj][n][j]);
                        } else if (kind == 3) {
#pragma unroll
                            for (int n = 0; n < 2; ++n)
#pragma unroll
                                for (int j = 0; j < 4; ++j) x[n][j] = fsig(x[n][j] + aux[bj][n][j]);
                        }
                        const size_t di = seqc ? ((size_t)((row >> 11) * 4 + (colb >> 7) + bj) * 2048 + (row & 2047)) * 128 + cl : (size_t)row * ldc + colb + bj * 128 + cl;
                        st8(dst + di, x[0], x[1]); } asm volatile("" ::: "memory"); }
        }
    }
};
struct EpiMerge {
    static constexpr bool PERM = true, CARRY = true;
    const bf16* GATE; bf16* M;
    __device__ __forceinline__ void operator()(f32x4 (&acc)[2][2][4][2], const Unit& u, int wr, int wc, int fr, int fq) const {
        const int rowb = u.pm * 256 + wr * 64 + fr, cl = u.pn * 256 + wc * 32 + 8 * fq, n = u.e;
#pragma unroll
        for (int ai = 0; ai < 2; ++ai) {
            u32x4 g[4][2], h[4][2];
#pragma unroll
            for (int m = 0; m < 4; ++m)
#pragma unroll
                for (int bj = 0; bj < 2; ++bj) { const bf16* gp = GATE + (size_t)(rowb + ai * 128 + m * 16) * 3072 + n * 1024 + cl + bj * 128;
                    g[m][bj] = *(const u32x4*)gp; h[m][bj] = g[m][bj]; if (n < 2) h[m][bj] = *(const u32x4*)(gp + 1024); }
#pragma unroll
            for (int m = 0; m < 4; ++m)
#pragma unroll
                for (int bj = 0; bj < 2; ++bj) { const u32x4 gg = g[m][bj], hh = h[m][bj];
                    f32x4 s0 = (f32x4){lo16(gg.x), hi16(gg.x), lo16(gg.y), hi16(gg.y)}, s1 = (f32x4){lo16(gg.z), hi16(gg.z), lo16(gg.w), hi16(gg.w)};
                    if (n < 2) {
                        const f32x4 d0 = (f32x4){lo16(hh.x), hi16(hh.x), lo16(hh.y), hi16(hh.y)}, d1 = (f32x4){lo16(hh.z), hi16(hh.z), lo16(hh.w), hi16(hh.w)};
#pragma unroll
                        for (int j = 0; j < 4; ++j) { s0[j] *= __builtin_amdgcn_rcpf(fmaxf(d0[j], 1e-20f)); s1[j] *= __builtin_amdgcn_rcpf(fmaxf(d1[j], 1e-20f)); }
                        acc[ai][bj][m][0] = acc[ai][bj][m][0] * s0; acc[ai][bj][m][1] = acc[ai][bj][m][1] * s1;
                    } else st8(M + (size_t)(rowb + ai * 128 + m * 16) * D + cl + bj * 128, acc[ai][bj][m][0] * s0, acc[ai][bj][m][1] * s1); }
            asm volatile("" ::: "memory"); }
    }
};
struct EpiWout {
    static constexpr bool PERM = true, CARRY = false;
    const bf16* XB; bf16* R;
    __device__ __forceinline__ void operator()(const f32x4 (&acc)[2][2][4][2], const Unit& u, int wr, int wc, int fr, int fq) const {
        const int rowb = u.pm * 256 + wr * 64 + fr, cl = u.pn * 256 + wc * 32 + 8 * fq;
#pragma unroll
        for (int ai = 0; ai < 2; ++ai) {
            u32x4 g[4][2];
#pragma unroll
            for (int m = 0; m < 4; ++m)
#pragma unroll
                for (int bj = 0; bj < 2; ++bj) g[m][bj] = *(const u32x4*)(XB + (size_t)(rowb + ai * 128 + m * 16) * D + cl + bj * 128);
#pragma unroll
            for (int m = 0; m < 4; ++m)
#pragma unroll
                for (int bj = 0; bj < 2; ++bj) { const size_t o = (size_t)(rowb + ai * 128 + m * 16) * D + cl + bj * 128; const u32x4 gg = g[m][bj];
                    st8(R + o, acc[ai][bj][m][0] + (f32x4){lo16(gg.x), hi16(gg.x), lo16(gg.y), hi16(gg.y)} * ALPHA, acc[ai][bj][m][1] + (f32x4){lo16(gg.z), hi16(gg.z), lo16(gg.w), hi16(gg.w)} * ALPHA); }
            asm volatile("" ::: "memory"); }
    }
};
struct EpiMoe1 {
    static constexpr bool PERM = true, CARRY = false;
    bf16* HM;
    __device__ __forceinline__ void operator()(const f32x4 (&acc)[2][2][4][2], const Unit& u, int wr, int wc, int fr, int fq) const {
        const int rowb = u.pm * 256 + wr * 64 + fr, cl = u.pn * 128 + wc * 32 + 8 * fq;
#pragma unroll
        for (int ai = 0; ai < 2; ++ai)
#pragma unroll
            for (int m = 0; m < 4; ++m) { const int row = rowb + ai * 128 + m * 16; f32x4 o0, o1;
#pragma unroll
                for (int j = 0; j < 4; ++j) { const float a = acc[ai][0][m][0][j], b = acc[ai][0][m][1][j]; o0[j] = a * fsig(a) * acc[ai][1][m][0][j]; o1[j] = b * fsig(b) * acc[ai][1][m][1][j]; }
                st8(HM + (size_t)row * DE + cl, o0, o1); }
    }
};
struct EpiMoe2 {
    static constexpr bool PERM = true, CARRY = false;
    bf16* OM;
    __device__ __forceinline__ void operator()(const f32x4 (&acc)[2][2][4][2], const Unit& u, int wr, int wc, int fr, int fq) const {
        const int rowb = u.pm * 256 + wr * 64 + fr, cl = u.pn * 256 + wc * 32 + 8 * fq;
#pragma unroll
        for (int ai = 0; ai < 2; ++ai)
#pragma unroll
            for (int m = 0; m < 4; ++m) { const int row = rowb + ai * 128 + m * 16;
#pragma unroll
                for (int bj = 0; bj < 2; ++bj) st8(OM + (size_t)row * D + cl + bj * 128, acc[ai][bj][m][0], acc[ai][bj][m][1]); }
    }
};
}

__device__ __forceinline__ void p_prologue(Frame& F_) {
    KA_WS();
    Frame F = mkframe(F_.lds);
    const int gt = blockIdx.x * NTHR + F.tid, NT = gridDim.x * NTHR;
    const int* pos = (const int*)KIN(1);
    float* rot = (float*)(ws + WS_ROT);
    for (int i = gt; i < T * 8; i += NT) {
        const int t = i >> 3, f = i & 7;
        const double invf[8] = {1.0, 0.19392274474868576, 0.03760603093086393, 0.007292664737217109, 0.001414213562373095, 0.0002742481756762073, 5.318295896944988e-05, 1.031338537721246e-05};
        double w = 1.0;
#pragma unroll
        for (int j = 0; j < 8; ++j) w = (f == j) ? invf[j] : w;
        const double ang = (double)pos[t] * w;
        const double n = rint(ang * 0.15915494309189535); const double r = (ang - n * 6.283185307179586) - n * 2.4492935982947064e-16;
        rot[t * 16 + f] = cosf((float)r); rot[t * 16 + 8 + f] = sinf((float)r);
    }
    { bf16* rw = (bf16*)(ws + WS_RW);
      for (int i = gt; i < 2 * 48 * 1024; i += NT) { const int l2 = i / (48 * 1024), j = (i / 1024) % 48, d = i & 1023; float w = 0.f;
          if (j < 4) w = ((const float*)KIN(16))[((size_t)l2 * D + d) * 4 + j];
          else if (j < 36) w = ((const float*)KIN(18))[(((size_t)l2 * 4 + ((j - 4) >> 3)) * D + d) * 8 + ((j - 4) & 7)];
          const unsigned hb = f2bf(w); const float hf = __uint_as_float(hb << 16);
          rw[((size_t)l2 * 2 + 0) * 48 * 1024 + j * 1024 + d] = (bf16)hb; rw[((size_t)l2 * 2 + 1) * 48 * 1024 + j * 1024 + d] = (bf16)f2bf(w - hf); } }
    float* lbt = (float*)(ws + WS_LB);
    const float* hg_lb = (const float*)KIN(9);
    for (int i = gt; i < 512; i += NT) { const float a0 = hg_lb[i], a1 = hg_lb[512 + i]; lbt[i] = 0.f; lbt[512 + i] = 1.f / (1.f + expf(a0 - a1)); }
    if (gt < 2) {
        const float* lp = (const float*)KIN(7) + gt * 256; float s1 = 0.f, s2 = 0.f;
        for (int i = 0; i < 64; ++i) { s1 += lp[i] * lp[64 + i]; s2 += lp[128 + i] * lp[192 + i]; }
        const float lam_init = gt == 0 ? 0.2f : 0.35550906759096934f;
        lbt[1024 + gt] = expf(s1) - expf(s2) + lam_init;
    }
}
__device__ __forceinline__ void p_xload(Frame& F_, int g) {
    KA_WS();
    Frame F = mkframe(F_.lds);
    const f32x4* x = (const f32x4*)((const float*)KIN(0) + (size_t)g * TG * D);
    u32x2* o = (u32x2*)((bf16*)(ws + WS_XB));
    for (size_t i = (size_t)blockIdx.x * NTHR + F.tid; i < (size_t)TG * D / 4; i += (size_t)gridDim.x * NTHR) { const f32x4 v = x[i]; u32x2 w; w.x = pk2(v.x, v.y); w.y = pk2(v.z, v.w); o[i] = w; }
}

__device__ __forceinline__ void p2_conv_unit(Frame& F, unsigned char* ws, KArgs ka, int l, int cu) {
    const float* cw = (const float*)KIN(3) + (size_t)l * 31 * 512; const float* cb = (const float*)KIN(4) + l * 512;
    const float* lg = (const float*)KIN(5) + l * 512; const float* lb = (const float*)KIN(6) + l * 512;
    const bf16* __restrict__ U = (const bf16*)(ws + WS_U); bf16* __restrict__ YA = (bf16*)(ws + WS_YA);
    LAS float* Yt = (LAS float*)F.lds;
    const int lane = F.lane, wave = F.wave, hf = wave >> 2, c = 128 * (wave & 3) + 2 * lane;
    const int tb = cu * 64 + 32 * hf, sb = tb & (S - 1);
    f32x2 wt[31], uf[62];
#pragma unroll
    for (int j = 0; j < 31; ++j) wt[j] = *(const f32x2*)(cw + j * 512 + c);
#pragma unroll
    for (int k = 0; k < 62; ++k) { unsigned w = 0u; if (sb - 30 + k >= 0) w = *(const unsigned*)(U + (size_t)(tb - 30 + k) * 512 + c); uf[k] = (f32x2){lo16(w), hi16(w)}; }
    const f32x2 bias = *(const f32x2*)(cb + c);
    __syncthreads();
#pragma unroll
    for (int tt = 0; tt < 32; ++tt) { f32x2 acc = bias;
#pragma unroll
        for (int j = 0; j < 31; ++j) acc = acc + uf[tt + j] * wt[j];
        *(LAS f32x2*)(Yt + (32 * hf + tt) * 512 + c) = acc; }
    __syncthreads();
    const int c0 = lane * 8;
#pragma unroll 2
    for (int i = 0; i < 8; ++i) { const int tl = wave * 8 + i;
        const f32x4 a0 = *(const LAS f32x4*)(Yt + tl * 512 + c0), a1 = *(const LAS f32x4*)(Yt + tl * 512 + c0 + 4);
        float acc[8] = {a0.x, a0.y, a0.z, a0.w, a1.x, a1.y, a1.z, a1.w};
        float sm = 0.f;
#pragma unroll
        for (int q = 0; q < 8; ++q) sm += acc[q];
        const float mean = wave_sum(sm) * (1.f / 512.f); float sq = 0.f;
#pragma unroll
        for (int q = 0; q < 8; ++q) { acc[q] -= mean; sq += acc[q] * acc[q]; }
        const float rstd = __builtin_amdgcn_rsqf(wave_sum(sq) * (1.f / 512.f) + EPS);
        const f32x4 g0 = *(const f32x4*)(lg + c0), g1 = *(const f32x4*)(lg + c0 + 4), b0 = *(const f32x4*)(lb + c0), b1 = *(const f32x4*)(lb + c0 + 4);
        const float gg[8] = {g0.x, g0.y, g0.z, g0.w, g1.x, g1.y, g1.z, g1.w}, bb[8] = {b0.x, b0.y, b0.z, b0.w, b1.x, b1.y, b1.z, b1.w};
        float y[8];
#pragma unroll
        for (int q = 0; q < 8; ++q) { const float z = acc[q] * rstd * gg[q] + bb[q]; y[q] = z * __builtin_amdgcn_rcpf(1.f + __expf(-z)); }
        u32x4 o; o.x = pk2(y[0], y[1]); o.y = pk2(y[2], y[3]); o.z = pk2(y[4], y[5]); o.w = pk2(y[6], y[7]);
        *(u32x4*)(YA + (size_t)(cu * 64 + tl) * 512 + c0) = o;
    }
    __syncthreads();
}
#include <hip/hip_bf16.h>
#include <cmath>
namespace attn_body {
using bf16=__hip_bfloat16;
using bf16x8=__attribute__((ext_vector_type(8)))short;
using s16x4=__attribute__((ext_vector_type(4)))short;
using f32x16=__attribute__((ext_vector_type(16)))float;
using u32x4=__attribute__((ext_vector_type(4)))unsigned;
constexpr int SEQ=2048,D=64,DMI=512,DMO=1024;
constexpr int NW=8,QBLK=32,QB=QBLK*NW,KVBLK=64,NQB=SEQ/QB;
constexpr int ATTN_UNIT_ROWS=QB;
__device__ __forceinline__ int crow(int r,int hi){return (r&3)+8*(r>>2)+4*hi;}
#define SBAR() __builtin_amdgcn_sched_barrier(0)
__device__ __forceinline__ void cmask(f32x16&p0,f32x16&p1,int jb,int qrel,int hi){
  const float NEG=-INFINITY; int kb=64*jb+4*hi;
  #pragma unroll
  for(int r=0;r<16;++r){int kv=kb+(r&3)+8*(r>>2); if(kv>qrel)p0[r]=NEG; if(kv+32>qrel)p1[r]=NEG;}
}

constexpr int NSLOT=3, SLOTB=8192;
constexpr int LDS_K=0, LDS_V=NSLOT*SLOTB, LDS_WS=2*NSLOT*SLOTB, LDS_OST=LDS_WS+NW*64*4, LDS_BYTES=LDS_OST+NW*4096;
constexpr float C2=0.125f*1.4426950408889634f;
__device__ __forceinline__ void glds16(const void*gsrc,unsigned lds_dst){unsigned keep;
  asm volatile("s_mov_b32 %0, m0\n\ts_mov_b32 m0, %2\n\ts_nop 0\n\tglobal_load_lds_dwordx4 %1, off\n\ts_mov_b32 m0, %0":"=&s"(keep):"v"(gsrc),"s"(lds_dst):"memory");}
__device__ __forceinline__ float max3f(float a,float b,float c){float r;asm("v_max3_f32 %0, %1, %2, %3":"=v"(r):"v"(a),"v"(b),"v"(c));return r;}
__device__ __forceinline__ float max2f(float a,float b){float r;asm("v_max_f32_e32 %0, %1, %2":"=v"(r):"v"(a),"v"(b));return r;}
__device__ __forceinline__ float fadd_s(float a,float b){float r;asm("v_add_f32_e32 %0, %1, %2":"=v"(r):"v"(a),"v"(b));return r;}
__device__ __forceinline__ float fsub_s(float a,float b){float r;asm("v_sub_f32_e32 %0, %1, %2":"=v"(r):"v"(a),"v"(b));return r;}
typedef float f32x2_t __attribute__((ext_vector_type(2))); typedef __bf16 bf16x2_t __attribute__((ext_vector_type(2)));
__device__ __forceinline__ unsigned cvtpk_s(float lo,float hi){f32x2_t v={lo,hi};bf16x2_t b=__builtin_convertvector(v,bf16x2_t);return __builtin_bit_cast(unsigned,b);}
#define WAIT_BAR(N) asm volatile("s_waitcnt vmcnt(" #N ") lgkmcnt(0)\n\ts_barrier":::"memory")

__device__ __forceinline__ void qkt(f32x16&p0,f32x16&p1,const char*Kslot,const bf16x8*qr,const f32x16&negm,int r32,int hi){
  const char*kb=Kslot+hi*1024+r32*16;
  #pragma unroll
  for(int d0=0;d0<4;++d0){
    const bf16x8 b0=*reinterpret_cast<const bf16x8*>(kb+d0*2048);
    const bf16x8 b1=*reinterpret_cast<const bf16x8*>(kb+d0*2048+512);
    if(d0==0){p0=__builtin_amdgcn_mfma_f32_32x32x16_bf16(b0,qr[0],negm,0,0,0);p1=__builtin_amdgcn_mfma_f32_32x32x16_bf16(b1,qr[0],negm,0,0,0);}
    else{p0=__builtin_amdgcn_mfma_f32_32x32x16_bf16(b0,qr[d0],p0,0,0,0);p1=__builtin_amdgcn_mfma_f32_32x32x16_bf16(b1,qr[d0],p1,0,0,0);}}
}
typedef __attribute__((address_space(3))) const char* lds_cptr;
typedef short v4i16_t __attribute__((ext_vector_type(4)));
__device__ __forceinline__ void kload8(bf16x8*kf,lds_cptr kp){
  kf[0]=*(const __attribute__((address_space(3))) bf16x8*)(kp);      kf[1]=*(const __attribute__((address_space(3))) bf16x8*)(kp+512);
  kf[2]=*(const __attribute__((address_space(3))) bf16x8*)(kp+2048); kf[3]=*(const __attribute__((address_space(3))) bf16x8*)(kp+2560);
  kf[4]=*(const __attribute__((address_space(3))) bf16x8*)(kp+4096); kf[5]=*(const __attribute__((address_space(3))) bf16x8*)(kp+4608);
  kf[6]=*(const __attribute__((address_space(3))) bf16x8*)(kp+6144); kf[7]=*(const __attribute__((address_space(3))) bf16x8*)(kp+6656);
}
__device__ __forceinline__ void kload2(bf16x8*kf,lds_cptr kp,int j){ kf[2*j]=*(const __attribute__((address_space(3))) bf16x8*)(kp+j*2048); kf[2*j+1]=*(const __attribute__((address_space(3))) bf16x8*)(kp+j*2048+512); }
__device__ __forceinline__ s16x4 vtr(lds_cptr p){ return __builtin_bit_cast(s16x4,__builtin_amdgcn_ds_read_tr16_b64_v4i16((__attribute__((address_space(3))) v4i16_t*)p)); }
__device__ __forceinline__ float rowmax(const f32x16&p0,const f32x16&p1){
  float a=max3f(p0[0],p0[1],p1[0]),b=max3f(p0[2],p0[3],p1[1]);a=max3f(a,p1[2],p1[3]);
  #pragma unroll
  for(int r=4;r<16;r+=4){a=max3f(a,p0[r],p0[r+1]);b=max3f(b,p0[r+2],p0[r+3]);a=max3f(a,p1[r],p1[r+1]);b=max3f(b,p1[r+2],p1[r+3]);}
  const float m=max2f(a,b);
  auto rr=__builtin_amdgcn_permlane32_swap(__float_as_uint(m),__float_as_uint(m),false,false);
  return max2f(__uint_as_float(rr[0]),__uint_as_float(rr[1]));
}
__device__ __forceinline__ void pv(f32x16*o,int vb,bf16x8 pa0,bf16x8 pa1,bf16x8 pa2,bf16x8 pa3){
  #pragma unroll
  for(int d0=0;d0<2;++d0){s16x4 lo[4],hi[4];
    #pragma unroll
    for(int ks=0;ks<4;++ks){
      asm volatile("ds_read_b64_tr_b16 %0,%1 offset:%c2":"=&v"(lo[ks]):"v"(vb),"i"(d0*4096+ks*1024):"memory");
      asm volatile("ds_read_b64_tr_b16 %0,%1 offset:%c2":"=&v"(hi[ks]):"v"(vb),"i"(d0*4096+ks*1024+512):"memory");}
    asm volatile("s_waitcnt lgkmcnt(0)":::"memory");SBAR();
    #define PK(k) (bf16x8){lo[k][0],lo[k][1],lo[k][2],lo[k][3],hi[k][0],hi[k][1],hi[k][2],hi[k][3]}
    o[d0]=__builtin_amdgcn_mfma_f32_32x32x16_bf16(pa0,PK(0),o[d0],0,0,0);
    o[d0]=__builtin_amdgcn_mfma_f32_32x32x16_bf16(pa1,PK(1),o[d0],0,0,0);
    o[d0]=__builtin_amdgcn_mfma_f32_32x32x16_bf16(pa2,PK(2),o[d0],0,0,0);
    o[d0]=__builtin_amdgcn_mfma_f32_32x32x16_bf16(pa3,PK(3),o[d0],0,0,0);
    #undef PK
  }
}

#ifndef ATTN_STORE16
#define ATTN_STORE16(p,v) (*(u32x4*)(p)=(v))
#endif
template<int THRL> __device__ __forceinline__ void attn_unit(int qb,const bf16*Qb,const bf16*__restrict__ Kb,const bf16*__restrict__ Vb,bf16*Ob,char*shm){
  int tid_=threadIdx.x; asm volatile("":"+v"(tid_));
  const int tid=tid_,lane=tid&63,r32=lane&31,hi=lane>>5; const int wid=__builtin_amdgcn_readfirstlane(tid>>6);
  const int q0=qb*QB;
  const bf16*Qw=Qb+(long)(q0+wid*QBLK)*DMI;
  const bf16*Kh=Kb,*Vh=Vb;
  const unsigned lds0=(unsigned)(uintptr_t)shm;
  float*wsf=(float*)(shm+LDS_WS)+wid*64;
  const bf16*ksrc=Kh+(long)lane*DMI+wid*8;
  const bf16*vsrc=Vh+(long)(16*(wid&3)+(lane>>2))*DMI+(wid>>2)*32+(lane&3)*8;
  const unsigned kdst=lds0+LDS_K+wid*1024, vdst=lds0+LDS_V+wid*1024;
  #define DMA_K(t,slot) glds16(ksrc+(long)(t)*KVBLK*DMI,(unsigned)__builtin_amdgcn_readfirstlane(kdst+(slot)))
  #define DMA_V(t,slot) glds16(vsrc+(long)(t)*KVBLK*DMI,(unsigned)__builtin_amdgcn_readfirstlane(vdst+(slot)))
  const int vb0=(int)(lds0+LDS_V)+((lane>>4)&1)*32+(lane&3)*8+(4*hi+((lane&15)>>2))*64;
  const char*Kbase=shm+LDS_K; bf16x8 kf[8];
  const lds_cptr shm3=(lds_cptr)shm; const lds_cptr kp0=shm3+LDS_K+hi*1024+r32*16; const lds_cptr vp0=shm3+LDS_V+((lane>>4)&1)*32+(lane&3)*8+(4*hi+((lane&15)>>2))*64;
  const int NT=(q0+QB)/KVBLK;
  DMA_K(0,0);DMA_V(0,0);DMA_K(1,SLOTB);
  bf16x8 qr[4];
  #pragma unroll
  for(int d0=0;d0<4;++d0)qr[d0]=*reinterpret_cast<const bf16x8*>(&Qw[(long)r32*DMI+d0*16+hi*8]);
  float mhat=0.f,l_reg=0.f;f32x16 o[2];o[0]=f32x16{};o[1]=f32x16{};f32x16 negm=f32x16{};asm volatile("":"+v"(negm));
  const int qrel=wid*QBLK+r32;
  #define CMASK(P0,P1,t) do{int jb_=(t)-(NT-4); if(jb_>=0)cmask(P0,P1,jb_,qrel,hi);}while(0)
  bool resc=false;
  #define START(P0,P1) do{ const float rm=rowmax(P0,P1); resc=false; \
    { const float dl=rm; mhat=fadd_s(mhat,dl); \
      _Pragma("unroll") for(int r=0;r<16;++r){P0[r]=fsub_s(P0[r],dl);P1[r]=fsub_s(P1[r],dl);} \
      _Pragma("unroll") for(int r=0;r<16;++r)negm[r]=-mhat; asm volatile("":"+v"(negm)); } \
    _Pragma("unroll") for(int r=0;r<16;++r)P0[r]=__builtin_amdgcn_exp2f(P0[r]); }while(0)
  #define RESC() do{ if(resc){ asm volatile("s_waitcnt lgkmcnt(0)":::"memory"); \
      _Pragma("unroll") for(int d_=0;d_<2;++d_) _Pragma("unroll") for(int r=0;r<16;++r)o[d_][r]*=wsf[crow(r,hi)]; } }while(0)
  f32x16 pA0,pA1,pB0,pB1;
  int sl_prev=0,sl_cur=0,sl_next=SLOTB;
  #define ROT() do{sl_prev=sl_cur;sl_cur=sl_next;sl_next=(sl_next==(NSLOT-1)*SLOTB)?0:sl_next+SLOTB;}while(0)
  DMA_K(2,2*SLOTB);
  WAIT_BAR(3);
  qkt(pA0,pA1,Kbase,qr,negm,r32,hi);asm volatile("s_nop 15\n\ts_nop 7":"+v"(pA0),"+v"(pA1));CMASK(pA0,pA1,0);
  START(pA0,pA1);
  _Pragma("unroll") for(int r=0;r<16;++r)pA1[r]=__builtin_amdgcn_exp2f(pA1[r]);
  WAIT_BAR(0);
  DMA_K(3,0);DMA_V(1,SLOTB);
  ROT();
  kload8(kf,kp0+sl_cur);
  WAIT_BAR(2);
  s16x4 vlo[8],vhi[8]; u32x4 pw0,pw1,pw2,pw3;
  #define PKW(P,B) cvtpk_s(P[B],P[B+1])
  #define PAF(k) __builtin_bit_cast(bf16x8,pw##k)
  #define VFR(i) (bf16x8){vlo[i][0],vlo[i][1],vlo[i][2],vlo[i][3],vhi[i][0],vhi[i][1],vhi[i][2],vhi[i][3]}
  #define PIN(x) asm volatile("":"+v"(x))
  #define MX3(a,b,c) __builtin_fmaxf(__builtin_fmaxf((a),(b)),(c))
  #define GAPA(MF,A0,A1,A2,A3,W0,W1,PW) do{ MF; sacc+=A0; sacc+=A1; sacc+=A2; sacc+=A3; PIN(sacc); W0; W1; PIN(PW); SBAR(); }while(0)
  #define EX(v) __builtin_amdgcn_exp2f(v)
  #define GAPB(MF,X,B) do{ MF; X[B]=EX(X[B]); X[B+1]=EX(X[B+1]); X[B+2]=EX(X[B+2]); X[B+3]=EX(X[B+3]); PIN(X); SBAR(); }while(0)
  #define VRD(i) do{ vlo[i]=vtr(vp_+(((i)>>2)*4096+((i)&3)*1024)); vhi[i]=vtr(vp_+(((i)>>2)*4096+((i)&3)*1024+512)); }while(0)
  #define KRD(G,j) do{ if(G){ kload2(kf,kp0+sl_next,j); SBAR(); } }while(0)
  #define STEP(C0,C1,P0,P1,t,GK,GV,GL) do{ SBAR(); \
    const lds_cptr vp_=vp0+sl_prev; \
    VRD(0); SBAR(); float sacc=(P0[0]+P0[1]); \
    GAPA(C0=__builtin_amdgcn_mfma_f32_32x32x16_bf16(kf[0],qr[0],negm,0,0,0), P0[2],P0[3],P0[4],P0[5],     pw0[0]=PKW(P0,0), pw0[1]=PKW(P0,2), pw0); \
    VRD(4); SBAR(); GAPA(C1=__builtin_amdgcn_mfma_f32_32x32x16_bf16(kf[1],qr[0],negm,0,0,0), P0[6],P0[7],P0[8],P0[9],     pw0[2]=PKW(P0,4), pw0[3]=PKW(P0,6), pw0); \
    VRD(1); SBAR(); GAPA(C0=__builtin_amdgcn_mfma_f32_32x32x16_bf16(kf[2],qr[1],C0,0,0,0),   P0[10],P0[11],P0[12],P0[13], pw1[0]=PKW(P0,8), pw1[1]=PKW(P0,10), pw1); \
    VRD(5); SBAR(); GAPA(C1=__builtin_amdgcn_mfma_f32_32x32x16_bf16(kf[3],qr[1],C1,0,0,0),   P0[14],P0[15],P1[0],P1[1],   pw1[2]=PKW(P0,12),pw1[3]=PKW(P0,14), pw1); \
    VRD(2); SBAR(); GAPA(C0=__builtin_amdgcn_mfma_f32_32x32x16_bf16(kf[4],qr[2],C0,0,0,0),   P1[2],P1[3],P1[4],P1[5],     pw2[0]=PKW(P1,0), pw2[1]=PKW(P1,2), pw2); \
    VRD(6); SBAR(); GAPA(C1=__builtin_amdgcn_mfma_f32_32x32x16_bf16(kf[5],qr[2],C1,0,0,0),   P1[6],P1[7],P1[8],P1[9],     pw2[2]=PKW(P1,4), pw2[3]=PKW(P1,6), pw2); \
    VRD(3); SBAR(); GAPA(C0=__builtin_amdgcn_mfma_f32_32x32x16_bf16(kf[6],qr[3],C0,0,0,0),   P1[10],P1[11],P1[12],P1[13], pw3[0]=PKW(P1,8), pw3[1]=PKW(P1,10), pw3); \
    VRD(7); SBAR(); GAPA(C1=__builtin_amdgcn_mfma_f32_32x32x16_bf16(kf[7],qr[3],C1,0,0,0),   P1[14],P1[15],0.f,0.f,       pw3[2]=PKW(P1,12),pw3[3]=PKW(P1,14), pw3); \
    l_reg+=sacc; \
    if(GK){DMA_K((t)+3,sl_cur);} if(GV){DMA_V((t)+1,sl_next);} \
    CMASK(C0,C1,t); \
    { float a=MX3(C0[0],C0[1],C1[0]),b=MX3(C0[2],C0[3],C1[1]); a=MX3(a,C1[2],C1[3]); \
      _Pragma("unroll") for(int r=4;r<16;r+=4){a=MX3(a,C0[r],C0[r+1]);b=MX3(b,C0[r+2],C0[r+3]);a=MX3(a,C1[r],C1[r+1]);b=MX3(b,C1[r+2],C1[r+3]);} \
      float rm=__builtin_fmaxf(a,b); { auto rr=__builtin_amdgcn_permlane32_swap(__float_as_uint(rm),__float_as_uint(rm),false,false); rm=__builtin_fmaxf(__uint_as_float(rr[0]),__uint_as_float(rr[1])); } \
      resc=false; \
      if(__builtin_expect(__any(rm>(float)THRL),0)){ const float dl=__builtin_fmaxf(rm,0.f); mhat+=dl; \
        _Pragma("unroll") for(int r=0;r<16;++r){C0[r]-=dl;C1[r]-=dl;} \
        _Pragma("unroll") for(int r=0;r<16;++r)negm[r]=-mhat; asm volatile("":"+v"(negm)); \
        const float f=__builtin_amdgcn_exp2f(-dl); l_reg*=f; if(hi==0)wsf[r32]=f; resc=true; } } \
    SBAR(); \
    GAPB(o[0]=__builtin_amdgcn_mfma_f32_32x32x16_bf16(PAF(0),VFR(0),o[0],0,0,0), C0,0); \
    GAPB(o[1]=__builtin_amdgcn_mfma_f32_32x32x16_bf16(PAF(0),VFR(4),o[1],0,0,0), C0,4); \
    KRD(GL,0); GAPB(o[0]=__builtin_amdgcn_mfma_f32_32x32x16_bf16(PAF(1),VFR(1),o[0],0,0,0), C0,8); \
    KRD(GL,1); GAPB(o[1]=__builtin_amdgcn_mfma_f32_32x32x16_bf16(PAF(1),VFR(5),o[1],0,0,0), C0,12); \
    KRD(GL,2); GAPB(o[0]=__builtin_amdgcn_mfma_f32_32x32x16_bf16(PAF(2),VFR(2),o[0],0,0,0), C1,0); \
    KRD(GL,3); GAPB(o[1]=__builtin_amdgcn_mfma_f32_32x32x16_bf16(PAF(2),VFR(6),o[1],0,0,0), C1,4); \
    GAPB(o[0]=__builtin_amdgcn_mfma_f32_32x32x16_bf16(PAF(3),VFR(3),o[0],0,0,0), C1,8); \
    GAPB(o[1]=__builtin_amdgcn_mfma_f32_32x32x16_bf16(PAF(3),VFR(7),o[1],0,0,0), C1,12); \
    }while(0)
  int t=1;
  #undef CMASK
  #define CMASK(P0,P1,t) do{}while(0)
  for(;t+5<NT;t+=2){
    STEP(pB0,pB1,pA0,pA1,t,true,true,true);     WAIT_BAR(2); RESC(); ROT();
    STEP(pA0,pA1,pB0,pB1,t+1,true,true,true);   WAIT_BAR(2); RESC(); ROT();
  }
  #undef CMASK
  #define CMASK(P0,P1,t) do{int jb_=(t)-(NT-4); if(jb_>=0)cmask(P0,P1,jb_,qrel,hi);}while(0)
  #define ENDW(tt) do{ if((tt)+3<NT){WAIT_BAR(2);} else if((tt)+2<NT){WAIT_BAR(1);} else {WAIT_BAR(0);} }while(0)
  for(;t+1<NT;t+=2){
    STEP(pB0,pB1,pA0,pA1,t,(t+3<NT),(t+1<NT),(t+1<NT));       ENDW(t);   RESC(); ROT();
    STEP(pA0,pA1,pB0,pB1,t+1,(t+4<NT),(t+2<NT),(t+2<NT));     ENDW(t+1); RESC(); ROT();
  }
  STEP(pB0,pB1,pA0,pA1,NT-1,false,false,false); RESC();
  { float sacc=pB0[0]+pB0[1]; _Pragma("unroll") for(int r=2;r<16;++r)sacc+=pB0[r]; _Pragma("unroll") for(int r=0;r<16;++r)sacc+=pB1[r]; l_reg+=sacc;
    pw0=(u32x4){PKW(pB0,0),PKW(pB0,2),PKW(pB0,4),PKW(pB0,6)};pw1=(u32x4){PKW(pB0,8),PKW(pB0,10),PKW(pB0,12),PKW(pB0,14)};pw2=(u32x4){PKW(pB1,0),PKW(pB1,2),PKW(pB1,4),PKW(pB1,6)};pw3=(u32x4){PKW(pB1,8),PKW(pB1,10),PKW(pB1,12),PKW(pB1,14)};
    SBAR(); pv(o,vb0+sl_cur,PAF(0),PAF(1),PAF(2),PAF(3)); }
  #undef PKW
  #undef PAF
  #undef VFR
  #undef PIN
  #undef MX3
  #undef GAPA
  #undef GAPB
  #undef EX
  #undef VRD
  #undef KRD
  #undef STEP
  #undef ENDW
  {auto rr=__builtin_amdgcn_permlane32_swap(__float_as_uint(l_reg),__float_as_uint(l_reg),false,false);l_reg=__uint_as_float(rr[0])+__uint_as_float(rr[1]);}
  if(hi==0)wsf[32+r32]=l_reg;asm volatile("s_waitcnt lgkmcnt(0)":::"memory");
  float rli[16];
  #pragma unroll
  for(int r=0;r<16;++r)rli[r]=__builtin_amdgcn_rcpf(wsf[32+crow(r,hi)]);
  bf16*Ow=Ob+(long)(q0+wid*QBLK)*DMO;
  { bf16*stg=(bf16*)(shm+LDS_OST)+wid*2048;
    #pragma unroll
    for(int r=0;r<16;++r){const int orow=crow(r,hi);
      #pragma unroll
      for(int d0=0;d0<2;++d0)stg[orow*64+d0*32+r32]=__float2bfloat16(o[d0][r]*rli[r]);}
    asm volatile("s_waitcnt lgkmcnt(0)":::"memory");
    #pragma unroll
    for(int i=0;i<4;++i){const int row=i*8+(lane>>3),ch=lane&7; const u32x4 v=*(const u32x4*)(stg+row*64+ch*8); ATTN_STORE16(Ow+(long)row*DMO+ch*8,v);} }
  asm volatile("s_waitcnt lgkmcnt(0)\n\ts_barrier":::"memory");
  #undef DMA_K
  #undef DMA_V
  #undef CMASK
  #undef START
  #undef RESC
  #undef ROT
}
constexpr int ATTN_LDS_BYTES=LDS_BYTES;
#undef SBAR
#undef WAIT_BAR
}
extern __shared__ __attribute__((aligned(16))) unsigned char g_lds[];
constexpr size_t WS_OV = WS_R;
__device__ __forceinline__ void p2c_hgrn(Frame& F_, int l, int unit);
template <int PART> __device__ __forceinline__ void p1_part(Frame& F_, int g, int l, int G, int c);
constexpr int CW_P1B = 24576;
constexpr int CW_Q = 20480;
constexpr int NQ_ATT = GB * 16 * 8, NQ_CONV = TG / 64;
__device__ __forceinline__ void p2_mixers(Frame& F_, int g, int l, int rep) {
    if (blockIdx.x < GB * 4) p2c_hgrn(F_, l, blockIdx.x);
    else {
        p1_part<1>(F_, g, l, (int)gridDim.x - GB * 4, (int)blockIdx.x - GB * 4);
        KArgs ka2 = kargs(); unsigned* pdone = (unsigned*)((unsigned char*)(GAS unsigned char*)ka2->ws + WS_CTL) + CW_P1B + 64 * (g * 2 + l);
        asm volatile("s_waitcnt vmcnt(0)" ::: "memory"); __syncthreads();
        if (threadIdx.x == 0) { __builtin_amdgcn_fence(__ATOMIC_RELEASE, "agent"); asm volatile("s_waitcnt vmcnt(0)" ::: "memory"); (void)__hip_atomic_fetch_add(pdone, 1u, __ATOMIC_RELAXED, __HIP_MEMORY_SCOPE_AGENT); }
    }
    KA_WS();
    Frame F = mkframe(F_.lds);
    const int xq = (int)(xb_xcc_id() & 7u);
    volatile LAS int* qslot = (volatile LAS int*)(F.lds + MISC_OFF + 128);
    bool conv_ok = false;
    constexpr int NQX = (NQ_ATT + NQ_CONV) / 8;
    unsigned* qbase = (unsigned*)(ws + WS_CTL) + CW_Q + 64 * ((g * 2 + l) * 8);
    int xcur = xq;
    for (;;) {
        __syncthreads();
        if (F.tid == 0) qslot[0] = (int)__hip_atomic_fetch_add(qbase + 64 * xcur, 1u, __ATOMIC_RELAXED, __HIP_MEMORY_SCOPE_AGENT);
        __syncthreads();
        int u = __builtin_amdgcn_readfirstlane(qslot[0]);
        if (u >= NQX) {
            __syncthreads();
            if (F.tid < 8) { const unsigned hd = __hip_atomic_load(qbase + 64 * F.tid, __ATOMIC_RELAXED, __HIP_MEMORY_SCOPE_AGENT); const unsigned long long m = __ballot(hd < (unsigned)NQX);
                if (F.tid == 0) qslot[1] = m ? (int)__builtin_ctzll(m) : -1; }
            __syncthreads();
            const int nx = __builtin_amdgcn_readfirstlane(qslot[1]);
            if (nx < 0) break;
            xcur = nx; continue;
        }
        const int xu = xcur;
        if (u >= NQ_ATT / 8 && !conv_ok) {
            unsigned* pdone = (unsigned*)(ws + WS_CTL) + CW_P1B + 64 * (g * 2 + l);
            if (F.tid == 0) { unsigned sp = 0; while (__hip_atomic_load(pdone, __ATOMIC_RELAXED, __HIP_MEMORY_SCOPE_AGENT) < gridDim.x - GB * 4) { __builtin_amdgcn_s_sleep(4); if (++sp > (1u << 22)) break; }
                __builtin_amdgcn_fence(__ATOMIC_ACQUIRE, "agent"); asm volatile("s_waitcnt vmcnt(0)" ::: "memory"); }
            __syncthreads(); conv_ok = true;
        }
        if (u < NQ_ATT / 8) {
            const int qb = 7 - u / (GB * 2), vhd = (u % (GB * 2)) * 8 + xu;
            const int bl = vhd >> 4, sh = (vhd >> 1) & 7, vh = vhd & 1;
            const attn_body::bf16* Qb = (const attn_body::bf16*)((bf16*)(ws + WS_Q) + (size_t)bl * S * 512 + sh * 64);
            const attn_body::bf16* Kb = (const attn_body::bf16*)((bf16*)(ws + WS_K) + (size_t)bl * S * 512 + sh * 64);
            const attn_body::bf16* Vb = (const attn_body::bf16*)((bf16*)(ws + WS_V) + (size_t)bl * S * 512 + (sh >> 1) * 128 + vh * 64);
            attn_body::bf16* Ob = (attn_body::bf16*)((bf16*)(ws + WS_OV) + (size_t)bl * S * 1024 + sh * 128 + vh * 64);
            attn_body::attn_unit<8>(qb, Qb, Kb, Vb, Ob, (char*)g_lds);
        } else { int ll = l; asm volatile("" : "+s"(ll)); p2_conv_unit(F, ws, ka, ll, (u - NQ_ATT / 8) * 8 + xu); }
    }
}
__device__ __forceinline__ void p2d_combine(Frame& F_, int l) {
    KA_WS();
    Frame F = mkframe(F_.lds);
    const float lam = ((const float*)(ws + WS_LB))[1024 + l]; const float lam_init = l == 0 ? 0.2f : 0.35550906759096934f;
    const float* ng = (const float*)KIN(8) + l * 128;
    const int lane = F.lane; const float g0 = ng[lane * 2] * (1.f - lam_init), g1 = ng[lane * 2 + 1] * (1.f - lam_init);
    const bf16* __restrict__ OV = (const bf16*)(ws + WS_OV); bf16* __restrict__ YB = (bf16*)(ws + WS_YB);
    const int per = TG / (gridDim.x * NWAVES);
    const int t0 = (blockIdx.x * NWAVES + F.wave) * per;
#pragma unroll 1
    for (int i = 0; i < per; i += 2) {
        unsigned a[2][8];
#pragma unroll
        for (int rr = 0; rr < 2; ++rr)
#pragma unroll
            for (int k = 0; k < 8; ++k) a[rr][k] = *(const unsigned*)(OV + (size_t)(t0 + i + rr) * 1024 + k * 128 + lane * 2);
#pragma unroll
        for (int rr = 0; rr < 2; ++rr)
#pragma unroll
            for (int h = 0; h < 4; ++h) { const unsigned a1 = a[rr][2 * h], a2 = a[rr][2 * h + 1];
                const float o0 = lo16(a1) - lam * lo16(a2), o1 = hi16(a1) - lam * hi16(a2);
                const float rr2 = __builtin_amdgcn_rsqf(wave_sum(o0 * o0 + o1 * o1) * (1.f / 128.f) + EPS);
                *(unsigned*)(YB + (size_t)(t0 + i + rr) * 512 + h * 128 + lane * 2) = pk2(o0 * rr2 * g0, o1 * rr2 * g1); }
    }
}

namespace hg {
typedef short bf16x8 __attribute__((ext_vector_type(8)));
typedef float f32x16 __attribute__((ext_vector_type(16)));
constexpr int ST = 272, STT = 80, RS = 264;
constexpr int O_Q1 = 0, O_KT = 8704, O_KTT = 17408, O_VT = 27648, O_D = 37888, OPS = 38400;
constexpr int L_O = 2 * OPS;
static_assert(L_O + 2 * 16384 <= MISC_OFF, "HGRN LDS map");
__device__ __forceinline__ void lbar() { asm volatile("s_waitcnt lgkmcnt(0)" ::: "memory"); __builtin_amdgcn_s_barrier(); asm volatile("" ::: "memory"); }
__device__ __forceinline__ bf16x8 pack8(const f32x16& x, int b) {
    u32x4 w; w.x = pg8::cvt_pk_bf16(x[b], x[b + 1]); w.y = pg8::cvt_pk_bf16(x[b + 2], x[b + 3]); w.z = pg8::cvt_pk_bf16(x[b + 4], x[b + 5]); w.w = pg8::cvt_pk_bf16(x[b + 6], x[b + 7]);
    return __builtin_bit_cast(bf16x8, w);
}
__device__ __forceinline__ bf16x8 ld2x8(const LAS unsigned char* p) {
    const u32x2 a = *(const LAS u32x2*)p, b = *(const LAS u32x2*)(p + 16); u32x4 w; w.x = a.x; w.y = a.y; w.z = b.x; w.w = b.y; return __builtin_bit_cast(bf16x8, w);
}
__device__ __forceinline__ float quad_bcast(float v, int which) {
    const int iv = __builtin_bit_cast(int, v); int r;
    if (which == 0) r = __builtin_amdgcn_update_dpp(0, iv, 0x00, 0xF, 0xF, true); else if (which == 1) r = __builtin_amdgcn_update_dpp(0, iv, 0x55, 0xF, 0xF, true);
    else if (which == 2) r = __builtin_amdgcn_update_dpp(0, iv, 0xAA, 0xF, 0xF, true); else r = __builtin_amdgcn_update_dpp(0, iv, 0xFF, 0xF, 0xF, true);
    return __builtin_bit_cast(float, r);
}
}
__device__ __forceinline__ void p2c_hgrn(Frame& F_, int l, int unit) {
    KA_WS();
    Frame F = mkframe(F_.lds);
    using namespace hg;
    const int bl = unit >> 2, h = unit & 3;
    LAS unsigned char* lds = F.lds;
    const int lane = F.lane, wave = F.wave, r32 = lane & 31, hi = lane >> 5;
    const size_t rb = ((size_t)(bl * 4 + h) * S) * 128;
    const size_t rbY = ((size_t)bl * S) * 512 + h * 128;
    const bf16* HQ = (const bf16*)(ws + WS_HQ) + rb; const bf16* HF = (const bf16*)(ws + WS_HF) + rb; const bf16* HV = (const bf16*)(ws + WS_HV) + rb; const bf16* HG = (const bf16*)(ws + WS_HG) + rb;
    bf16* YC = (bf16*)(ws + WS_YC) + rbY;
    const bool isP = wave >= 4;
    const int pw = wave & 3;
    __syncthreads();
    if (isP) {
        const float* ng = (const float*)KIN(10) + l * 128;
        const float n0 = ng[2 * lane], n1 = ng[2 * lane + 1];
        const int cpi = 16 * pw + (lane >> 2), tq = lane & 3;
        unsigned rawA[24], rawB[24], rawC[24]; unsigned gA[8], gB[8], gC[8];
#pragma unroll
        for (int k = 0; k < 24; ++k) { rawA[k] = 0u; rawB[k] = 0u; rawC[k] = 0u; }
#pragma unroll
        for (int k = 0; k < 8; ++k) { gA[k] = 0u; gB[k] = 0u; gC[k] = 0u; }
#define HG_LOAD(SET, n) do { _Pragma("unroll") for (int j = 0; j < 8; ++j) { const size_t go = (size_t)((n) * 32 + 8 * tq + j) * 128 + 2 * cpi; \
            SET[j] = *(const unsigned*)(HF + go); SET[8 + j] = *(const unsigned*)(HQ + go); SET[16 + j] = *(const unsigned*)(HV + go); } } while (0)
#define HG_GLOAD(GS, n) do { _Pragma("unroll") for (int jj = 0; jj < 8; ++jj) GS[jj] = *(const unsigned*)(HG + (size_t)((n) * 32 + 8 * pw + jj) * 128 + 2 * lane); } while (0)
        HG_LOAD(rawA, 0); HG_LOAD(rawB, 1); HG_LOAD(rawC, 2); HG_GLOAD(gA, 0);
#define HG_PITER(i, RS_, GU) do { \
            if ((i) + 1 <= 63) hg_prep(lds, RS_, (i) + 1, cpi, tq); \
            if ((i) + 4 <= 63) HG_LOAD(RS_, (i) + 4); \
            if ((i) >= 1 && (i) <= 64) hg_finish(lds, (i) - 1, pw, lane, n0, n1, GU); \
            if ((i) + 2 <= 63) HG_GLOAD(GU, (i) + 2); \
            lbar(); } while (0)
        auto hg_prep = [&](LAS unsigned char* lds_, const unsigned (&R_)[24], int n, int cpi_, int tq_) __attribute__((always_inline)) {
            LAS unsigned char* op = lds_ + (n & 1) * OPS;
            float p0[8], p1[8], l0[8], l1[8];
#pragma unroll
            for (int j = 0; j < 8; ++j) { const unsigned w = R_[j]; const float x0 = lo16(w) * 1.4426950408889634f, x1 = hi16(w) * 1.4426950408889634f;
                l0[j] = x0; l1[j] = x1; p0[j] = j ? p0[j - 1] + x0 : x0; p1[j] = j ? p1[j - 1] + x1 : x1; }
            float base0 = 0.f, base1 = 0.f, bl0 = 0.f, bl1 = 0.f;
#pragma unroll
            for (int q = 0; q < 4; ++q) { const float t0 = quad_bcast(p0[7], q), t1 = quad_bcast(p1[7], q); bl0 += t0; bl1 += t1; if (q < tq_) { base0 += t0; base1 += t1; } }
            unsigned ka[4], kb[4], va[4], vb4[4];
#pragma unroll
            for (int j = 0; j < 8; ++j) { const int t = 8 * tq_ + j;
                const float b0 = fmaxf(base0 + p0[j], -115.f), b1 = fmaxf(base1 + p1[j], -115.f);
                const float e0 = __builtin_amdgcn_exp2f(b0), e1 = __builtin_amdgcn_exp2f(b1), i0 = __builtin_amdgcn_exp2f(-b0), i1 = __builtin_amdgcn_exp2f(-b1);
                const float k0 = 1.f - __builtin_amdgcn_exp2f(l0[j]), k1 = 1.f - __builtin_amdgcn_exp2f(l1[j]);
                const unsigned qw = R_[8 + j], vw = R_[16 + j];
                const unsigned q1w = pg8::cvt_pk_bf16(lo16(qw) * e0, hi16(qw) * e1), ktw = pg8::cvt_pk_bf16(k0 * i0, k1 * i1);
                *(LAS unsigned*)(op + O_Q1 + t * ST + cpi_ * 4) = q1w; *(LAS unsigned*)(op + O_KT + t * ST + cpi_ * 4) = ktw;
                if (j & 1) { ka[j >> 1] |= ktw << 16; kb[j >> 1] |= ktw & 0xffff0000u; va[j >> 1] |= vw << 16; vb4[j >> 1] |= vw & 0xffff0000u; }
                else { ka[j >> 1] = ktw & 0xffffu; kb[j >> 1] = ktw >> 16; va[j >> 1] = vw & 0xffffu; vb4[j >> 1] = vw >> 16; } }
            *(LAS u32x4*)(op + O_KTT + (2 * cpi_) * STT + 16 * tq_) = (u32x4){ka[0], ka[1], ka[2], ka[3]}; *(LAS u32x4*)(op + O_KTT + (2 * cpi_ + 1) * STT + 16 * tq_) = (u32x4){kb[0], kb[1], kb[2], kb[3]};
            *(LAS u32x4*)(op + O_VT + (2 * cpi_) * STT + 16 * tq_) = (u32x4){va[0], va[1], va[2], va[3]}; *(LAS u32x4*)(op + O_VT + (2 * cpi_ + 1) * STT + 16 * tq_) = (u32x4){vb4[0], vb4[1], vb4[2], vb4[3]};
            if (tq_ == 3) *(LAS f32x2*)(op + O_D + cpi_ * 8) = (f32x2){__builtin_amdgcn_exp2f(fmaxf(bl0, -115.f)), __builtin_amdgcn_exp2f(fmaxf(bl1, -115.f))};
        };
        auto hg_finish = [&](LAS unsigned char* lds_, int j, int pw_, int lane_, float n0_, float n1_, const unsigned (&gt_)[8]) __attribute__((always_inline)) {
            LAS float* Ot = (LAS float*)(lds_ + L_O + (j & 1) * 16384);
            f32x2 ov[8];
#pragma unroll
            for (int jj = 0; jj < 8; ++jj) ov[jj] = *(const LAS f32x2*)(Ot + (8 * pw_ + jj) * 128 + 2 * lane_);
            asm volatile("s_waitcnt lgkmcnt(0)" ::: "memory");
#pragma unroll
            for (int jj = 0; jj < 8; ++jj) { const int t = 8 * pw_ + jj; const f32x2 o = ov[jj];
                const float rr = __builtin_amdgcn_rsqf(wave_sum(o.x * o.x + o.y * o.y) * (1.f / 128.f) + EPS);
                *(LAS unsigned*)((LAS unsigned char*)Ot + t * 512 + 4 * lane_) = pk2(o.x * rr * n0_ * lo16(gt_[jj]), o.y * rr * n1_ * hi16(gt_[jj])); }
        };
#pragma unroll 1
        for (int i = -1; i <= 62; i += 3) { HG_PITER(i, rawA, gB); HG_PITER(i + 1, rawB, gC); HG_PITER(i + 2, rawC, gA); }
        lbar();
#undef HG_PITER
#undef HG_LOAD
#undef HG_GLOAD
    } else {
        const int vb = pw;
        f32x16 Sacc[4];
#pragma unroll
        for (int cb = 0; cb < 4; ++cb)
#pragma unroll
            for (int r = 0; r < 16; ++r) Sacc[cb][r] = 0.f;
#pragma unroll 1
        for (int i = -1; i <= 65; ++i) {
            if (vb < 2 && i >= 2) {
                const LAS unsigned char* yt = lds + L_O + (i & 1) * 16384 + vb * 128;
#pragma unroll
                for (int k = 0; k < 4; ++k) { const int row = 8 * k + (lane >> 3), c16 = lane & 7;
                    *(u32x4*)(YC + (size_t)((i - 2) * 32 + row) * 512 + vb * 64 + c16 * 8) = *(const LAS u32x4*)(yt + row * 512 + c16 * 16); }
            }
            if (i >= 0 && i <= 63) {
                const LAS unsigned char* op = lds + (i & 1) * OPS;
                bf16x8 fk[8], fq[8], fp[8], fvp[2];
#pragma unroll
                for (int kc = 0; kc < 8; ++kc) { fk[kc] = *(const LAS bf16x8*)(op + O_KT + r32 * ST + (16 * kc + 8 * hi) * 2); fq[kc] = *(const LAS bf16x8*)(op + O_Q1 + r32 * ST + (16 * kc + 8 * hi) * 2); }
#pragma unroll
                for (int kc = 0; kc < 8; ++kc) fp[kc] = ld2x8(op + O_Q1 + r32 * ST + (16 * kc + 4 * hi) * 2);
#pragma unroll
                for (int ks = 0; ks < 2; ++ks) fvp[ks] = ld2x8(op + O_VT + (32 * vb + r32) * STT + (16 * ks + 4 * hi) * 2);
                asm volatile("s_waitcnt lgkmcnt(0)" ::: "memory"); __builtin_amdgcn_sched_barrier(0);
                f32x16 X, o;
#pragma unroll
                for (int r = 0; r < 16; ++r) { X[r] = 0.f; o[r] = 0.f; }
#pragma unroll
                for (int kc = 0; kc < 8; ++kc) { X = __builtin_amdgcn_mfma_f32_32x32x16_bf16(fk[kc], fq[kc], X, 0, 0, 0);
                    o = __builtin_amdgcn_mfma_f32_32x32x16_bf16(fp[kc], pack8(Sacc[kc >> 1], 8 * (kc & 1)), o, 0, 0, 0); }
                __builtin_amdgcn_sched_barrier(0);
                bf16x8 fkt[8], fvn[2];
#pragma unroll
                for (int ks = 0; ks < 2; ++ks) fvn[ks] = *(const LAS bf16x8*)(op + O_VT + (32 * vb + r32) * STT + (16 * ks + 8 * hi) * 2);
#pragma unroll
                for (int cb = 0; cb < 4; ++cb)
#pragma unroll
                    for (int ks = 0; ks < 2; ++ks) fkt[2 * cb + ks] = *(const LAS bf16x8*)(op + O_KTT + (32 * cb + r32) * STT + (16 * ks + 8 * hi) * 2);
#pragma unroll
                for (int r = 0; r < 16; ++r) { const int sidx = (r & 3) + 8 * (r >> 2) + 4 * hi; X[r] = sidx <= r32 ? X[r] : 0.f; }
#pragma unroll
                for (int ks = 0; ks < 2; ++ks) o = __builtin_amdgcn_mfma_f32_32x32x16_bf16(pack8(X, 8 * ks), fvp[ks], o, 0, 0, 0);
                asm volatile("s_waitcnt lgkmcnt(0)" ::: "memory"); __builtin_amdgcn_sched_barrier(0);
#pragma unroll
                for (int cb = 0; cb < 4; ++cb)
#pragma unroll
                    for (int ks = 0; ks < 2; ++ks) Sacc[cb] = __builtin_amdgcn_mfma_f32_32x32x16_bf16(fkt[2 * cb + ks], fvn[ks], Sacc[cb], 0, 0, 0);
                __builtin_amdgcn_sched_barrier(0);
                LAS float* Ot = (LAS float*)(lds + L_O + (i & 1) * 16384);
#pragma unroll
                for (int r = 0; r < 16; ++r) Ot[((r & 3) + 8 * (r >> 2) + 4 * hi) * 128 + 32 * vb + r32] = o[r];
#pragma unroll
                for (int cb = 0; cb < 4; ++cb)
#pragma unroll
                    for (int g4 = 0; g4 < 4; ++g4) { const f32x4 d = *(const LAS f32x4*)(op + O_D + (32 * cb + 8 * g4 + 4 * hi) * 4);
#pragma unroll
                        for (int j = 0; j < 4; ++j) Sacc[cb][4 * g4 + j] *= d[j]; }
            }
            lbar();
        }
    }
    __syncthreads();
}

__device__ __forceinline__ void p5_ln_route(Frame& F_, int g, int l, int bank) {
    KA_WS();
    Frame F = mkframe(F_.lds);
    typedef short bf16x8 __attribute__((ext_vector_type(8)));
    const float* lg = (const float*)KIN(14) + l * D; const float* lb = (const float*)KIN(15) + l * D;
    const float* bgp = (const float*)KIN(17) + l * 4; const float* be = (const float*)KIN(19) + l * 32;
    unsigned* cnt = ((unsigned*)(ws + WS_CTL)) + CW_CNT + bank * 32;
    constexpr int XS = 2064;
    LAS unsigned char* XH = F.lds; LAS unsigned char* XL = F.lds + 16 * XS; LAS float* LG = (LAS float*)(F.lds + 32 * XS);
    LAS int* ent_e = (LAS int*)(F.lds + 32 * XS + 6144); LAS int* ent_pos = ent_e + 256; LAS float* ent_w = (LAS float*)(ent_pos + 256);
    const int lane = F.lane, wave = F.wave;
    constexpr int rows_per_wg = TG / 256;
    constexpr int NP = rows_per_wg / 16;
    const int row0 = blockIdx.x * rows_per_wg;
    const bf16* Rb = (const bf16*)(ws + WS_R); bf16* X1 = (bf16*)(ws + WS_X1);
    const int nb = wave % 3, kh = wave / 3;
    bf16x8 bh[16], blo[16];
    if (wave < 6) {
        const bf16* rw = (const bf16*)(ws + WS_RW) + (size_t)l * 2 * 48 * 1024 + (size_t)(16 * nb + (lane & 15)) * 1024 + 512 * kh + 8 * (lane >> 4);
#pragma unroll
        for (int ks = 0; ks < 16; ++ks) { bh[ks] = *(const bf16x8*)(rw + 32 * ks); blo[ks] = *(const bf16x8*)(rw + 48 * 1024 + 32 * ks); }
    }
    __syncthreads();
    f32x4 vin[2][4];
#pragma unroll
    for (int rr = 0; rr < 2; ++rr) { const u32x2* rp = (const u32x2*)(Rb + (size_t)(row0 + 2 * wave + rr) * D) + lane;
#pragma unroll
        for (int j = 0; j < 4; ++j) { const u32x2 w = rp[64 * j]; vin[rr][j] = (f32x4){lo16(w.x), hi16(w.x), lo16(w.y), hi16(w.y)}; } }
#pragma unroll 1
    for (int p = 0; p < NP; ++p) {
        f32x4 vnx[2][4];
#pragma unroll
        for (int rr = 0; rr < 2; ++rr) { const int tn = row0 + 16 * (p + 1 < NP ? p + 1 : p) + 2 * wave + rr; const u32x2* rp = (const u32x2*)(Rb + (size_t)tn * D) + lane;
#pragma unroll
            for (int j = 0; j < 4; ++j) { const u32x2 w = rp[64 * j]; vnx[rr][j] = (f32x4){lo16(w.x), hi16(w.x), lo16(w.y), hi16(w.y)}; } }
#pragma unroll
        for (int rr = 0; rr < 2; ++rr) {
            const int rl = 2 * wave + rr, t = row0 + 16 * p + rl;
            f32x4 v[4]; float sm = 0.f;
#pragma unroll
            for (int j = 0; j < 4; ++j) { v[j] = vin[rr][j]; sm += (v[j].x + v[j].y) + (v[j].z + v[j].w); }
            const float mean = wave_sum(sm) * (1.f / D); float s2 = 0.f;
#pragma unroll
            for (int j = 0; j < 4; ++j) { v[j] = v[j] - mean; s2 += (v[j].x * v[j].x + v[j].y * v[j].y) + (v[j].z * v[j].z + v[j].w * v[j].w); }
            const float rstd = __builtin_amdgcn_rsqf(wave_sum(s2) * (1.f / D) + EPS);
#pragma unroll
            for (int j = 0; j < 4; ++j) {
                const int d0 = lane * 4 + 256 * j; const f32x4 gg = *(const f32x4*)(lg + d0), bb = *(const f32x4*)(lb + d0);
                const f32x4 y = v[j] * rstd * gg + bb;
                const unsigned h0 = pk2(y.x, y.y), h1 = pk2(y.z, y.w);
                *(u32x2*)(X1 + (size_t)t * D + d0) = (u32x2){h0, h1};
                const unsigned l0 = pk2(y.x - lo16(h0), y.y - hi16(h0)), l1 = pk2(y.z - lo16(h1), y.w - hi16(h1));
                *(LAS u32x2*)(XH + rl * XS + d0 * 2) = (u32x2){h0, h1}; *(LAS u32x2*)(XL + rl * XS + d0 * 2) = (u32x2){l0, l1};
            }
        }
#pragma unroll
        for (int rr = 0; rr < 2; ++rr)
#pragma unroll
            for (int j = 0; j < 4; ++j) vin[rr][j] = vnx[rr][j];
        __syncthreads();
        if (wave < 6) {
            f32x4 acc = {0.f, 0.f, 0.f, 0.f};
            const LAS unsigned char* ah = XH + (lane & 15) * XS + (512 * kh + 8 * (lane >> 4)) * 2; const LAS unsigned char* al = XL + (lane & 15) * XS + (512 * kh + 8 * (lane >> 4)) * 2;
#pragma unroll
            for (int ks = 0; ks < 16; ++ks) { const bf16x8 xa = *(const LAS bf16x8*)(ah + 64 * ks), xb = *(const LAS bf16x8*)(al + 64 * ks);
                acc = __builtin_amdgcn_mfma_f32_16x16x32_bf16(xa, bh[ks], acc, 0, 0, 0); acc = __builtin_amdgcn_mfma_f32_16x16x32_bf16(xb, bh[ks], acc, 0, 0, 0); acc = __builtin_amdgcn_mfma_f32_16x16x32_bf16(xa, blo[ks], acc, 0, 0, 0); }
#pragma unroll
            for (int i = 0; i < 4; ++i) LG[(kh * 16 + 4 * (lane >> 4) + i) * 48 + 16 * nb + (lane & 15)] = acc[i];
        }
        __syncthreads();
        if (F.tid < 16) {
            const int rl = F.tid;
            const LAS float* L0 = LG + rl * 48; const LAS float* L1 = LG + (16 + rl) * 48;
            float gl4[4];
#pragma unroll
            for (int e = 0; e < 4; ++e) gl4[e] = L0[e] + L1[e] + bgp[e];
            int gi = 0; float gm = gl4[0];
#pragma unroll
            for (int e = 1; e < 4; ++e) if (gl4[e] > gm) { gm = gl4[e]; gi = e; }
            float gs = 0.f;
#pragma unroll
            for (int e = 0; e < 4; ++e) gs += __expf(gl4[e] - gm);
            const float pgroup = 1.f / gs;
            float el[8];
#pragma unroll
            for (int e = 0; e < 8; ++e) el[e] = L0[4 + 8 * gi + e] + L1[4 + 8 * gi + e] + be[gi * 8 + e];
            int i0 = 0; float v0 = el[0];
#pragma unroll
            for (int e = 1; e < 8; ++e) if (el[e] > v0) { v0 = el[e]; i0 = e; }
            int i1 = -1; float v1 = -INFINITY;
#pragma unroll
            for (int e = 0; e < 8; ++e) if (e != i0 && el[e] > v1) { v1 = el[e]; i1 = e; }
            const float ex = __expf(v1 - v0); const float p0 = 1.f / (1.f + ex), p1 = ex * p0;
            const int ri = 16 * p + rl;
            ent_e[ri * 2] = gi * 8 + i0; ent_e[ri * 2 + 1] = gi * 8 + i1; ent_w[ri * 2] = p0 * pgroup; ent_w[ri * 2 + 1] = p1 * pgroup;
        }
        __syncthreads();
    }
    LAS unsigned* lcnt = (LAS unsigned*)(ent_w + 256); LAS unsigned* lbase = lcnt + 32;
    if (F.tid < 32) lcnt[F.tid] = 0u;
    __syncthreads();
    int my_e = 0; unsigned my_rank = 0;
    if (F.tid < rows_per_wg * 2) { my_e = ent_e[F.tid]; my_rank = __hip_atomic_fetch_add((unsigned*)(lcnt + my_e), 1u, __ATOMIC_RELAXED, __HIP_MEMORY_SCOPE_WORKGROUP); }
    __syncthreads();
    if (F.tid < 32) { const unsigned c = lcnt[F.tid]; lbase[F.tid] = c ? __hip_atomic_fetch_add(cnt + F.tid, c, __ATOMIC_RELAXED, __HIP_MEMORY_SCOPE_AGENT) : 0u; }
    __syncthreads();
    if (F.tid < rows_per_wg * 2) { const unsigned pos = lbase[my_e] + my_rank; ent_pos[F.tid] = (int)pos; ((int*)(ws + WS_TOK))[(size_t)my_e * TG + pos] = row0 + (F.tid >> 1); }
    __syncthreads();
    if (F.tid < rows_per_wg) { const int i = F.tid; unsigned* r = ((unsigned*)(ws + WS_RT)) + (size_t)(row0 + i) * 8;
        r[0] = (unsigned)ent_e[2 * i]; r[1] = (unsigned)ent_pos[2 * i]; r[2] = __float_as_uint(ent_w[2 * i]); r[3] = (unsigned)ent_e[2 * i + 1]; r[4] = (unsigned)ent_pos[2 * i + 1]; r[5] = __float_as_uint(ent_w[2 * i + 1]); }
    __syncthreads();
}

constexpr int TAB_OFF = MISC_OFF + 256;
__device__ __forceinline__ void moe_table(Frame& F_, int g, int l);
__device__ __forceinline__ void p8_ln2(Frame& F_, int g, int l) {
    KA_WS();
    Frame F = mkframe(F_.lds);
    const float* lg = (const float*)KIN(23) + l * D; const float* lb = (const float*)KIN(24) + l * D;
    moe_table(F_, g, l);
    const LAS int* offs = (const LAS int*)(F.lds + TAB_OFF);
    const int lane = F.lane;
    const bf16* __restrict__ X1 = (const bf16*)(ws + WS_X1); const bf16* __restrict__ OM = (const bf16*)(ws + WS_OM);
    const int per = TG / (gridDim.x * NWAVES);
    const int t0 = (blockIdx.x * NWAVES + F.wave) * per;
    int ms0 = 0, ms1 = 0; float mw0 = 0.f, mw1 = 0.f;
    if (lane < per) { const unsigned* r = ((const unsigned*)(ws + WS_RT)) + (size_t)(t0 + lane) * 8; const u32x4 ra = *(const u32x4*)r; const u32x2 rb2 = *(const u32x2*)(r + 4);
        ms0 = offs[ra.x] * 256 + (int)ra.y; mw0 = __uint_as_float(ra.z); ms1 = offs[ra.w] * 256 + (int)rb2.x; mw1 = __uint_as_float(rb2.y); }
#pragma unroll 1
    for (int i = 0; i < per; i += 2) {
        u32x2 xa[2][4], oa[2][4], ob[2][4]; float w0[2], w1[2];
#pragma unroll
        for (int rr = 0; rr < 2; ++rr) {
            const int s0 = __builtin_amdgcn_readlane(ms0, i + rr), s1 = __builtin_amdgcn_readlane(ms1, i + rr);
            w0[rr] = __builtin_bit_cast(float, __builtin_amdgcn_readlane(__builtin_bit_cast(int, mw0), i + rr)); w1[rr] = __builtin_bit_cast(float, __builtin_amdgcn_readlane(__builtin_bit_cast(int, mw1), i + rr));
#pragma unroll
            for (int j = 0; j < 4; ++j) { const int d0 = lane * 4 + 256 * j;
                xa[rr][j] = *(const u32x2*)(X1 + (size_t)(t0 + i + rr) * D + d0); oa[rr][j] = *(const u32x2*)(OM + (size_t)s0 * D + d0); ob[rr][j] = *(const u32x2*)(OM + (size_t)s1 * D + d0); }
        }
#pragma unroll
        for (int rr = 0; rr < 2; ++rr) {
            const int t = t0 + i + rr;
            f32x4 v[4]; float sm = 0.f;
#pragma unroll
            for (int j = 0; j < 4; ++j) {
                v[j].x = ALPHA * lo16(xa[rr][j].x) + w0[rr] * lo16(oa[rr][j].x) + w1[rr] * lo16(ob[rr][j].x); v[j].y = ALPHA * hi16(xa[rr][j].x) + w0[rr] * hi16(oa[rr][j].x) + w1[rr] * hi16(ob[rr][j].x);
                v[j].z = ALPHA * lo16(xa[rr][j].y) + w0[rr] * lo16(oa[rr][j].y) + w1[rr] * lo16(ob[rr][j].y); v[j].w = ALPHA * hi16(xa[rr][j].y) + w0[rr] * hi16(oa[rr][j].y) + w1[rr] * hi16(ob[rr][j].y);
                sm += (v[j].x + v[j].y) + (v[j].z + v[j].w);
            }
            const float mean = wave_sum(sm) * (1.f / D); float s2 = 0.f;
#pragma unroll
            for (int j = 0; j < 4; ++j) { v[j] = v[j] - mean; s2 += (v[j].x * v[j].x + v[j].y * v[j].y) + (v[j].z * v[j].z + v[j].w * v[j].w); }
            const float rstd = __builtin_amdgcn_rsqf(wave_sum(s2) * (1.f / D) + EPS);
#pragma unroll
            for (int j = 0; j < 4; ++j) {
                const int d0 = lane * 4 + 256 * j; const f32x4 gg = *(const f32x4*)(lg + d0), bb = *(const f32x4*)(lb + d0);
                const f32x4 y = v[j] * rstd * gg + bb;
                if (l == NL - 1) *(f32x4*)(KOUT() + ((size_t)g * TG + t) * D + d0) = y;
                else *(u32x2*)((bf16*)(ws + WS_XB) + (size_t)t * D + d0) = (u32x2){pk2(y.x, y.y), pk2(y.z, y.w)};
            }
        }
    }
}

struct RmId { int off; __device__ __forceinline__ int operator()(int n0) const { return off + n0; } };
struct RmGlu { __device__ __forceinline__ int operator()(int n0) const { if (n0 >= 1024) return n0; const int hi = n0 >= 512, c = n0 - hi * 512; return (c >> 7) * 256 + hi * 128 + (c & 127); } };
struct RmIl { int hi; __device__ __forceinline__ int operator()(int n0) const { return (n0 >> 7) * 256 + hi * 128 + (n0 & 127); } };
template <class RM>
__device__ __forceinline__ void transpose_item(const float* W, int K, int N, bf16* WT, RM rowmap, LAS float* scr, int item, int lane) {
    const int nblk = N / 32, kb = item / nblk, nb = item % nblk, k0 = 64 * kb, n0 = 32 * nb;
#pragma unroll 8
    for (int i = 0; i < 32; ++i) { const int kk = 2 * i + (lane >> 5); scr[kk * 33 + (lane & 31)] = W[(size_t)(k0 + kk) * N + n0 + (lane & 31)]; }
    LDS_WAIT();
    const int c = lane & 7; const int r0 = rowmap(n0);
#pragma unroll
    for (int j = 0; j < 4; ++j) { const int n = (lane >> 3) + 8 * j; const LAS float* sp = scr + (8 * c) * 33 + n;
        u32x4 o; o.x = pk2(sp[0 * 33], sp[1 * 33]); o.y = pk2(sp[2 * 33], sp[3 * 33]); o.z = pk2(sp[4 * 33], sp[5 * 33]); o.w = pk2(sp[6 * 33], sp[7 * 33]);
        *(u32x4*)(WT + (size_t)(r0 + n) * K + k0 + 8 * c) = o; }
    LDS_WAIT();
}
__device__ __forceinline__ void p_wprep(Frame& F_) {
    KA_WS();
    Frame F = mkframe(F_.lds);
    LAS float* scr = (LAS float*)(F.lds + F.wave * 16384);
    const int gw = blockIdx.x * NWAVES + F.wave, NGW = gridDim.x * NWAVES, lane = F.lane;
    bf16* WIN = (bf16*)(ws + WS_WIN); bf16* WBR = (bf16*)(ws + WS_WBR); bf16* WOUT = (bf16*)(ws + WS_WOUT); bf16* W13 = (bf16*)(ws + WS_W13); bf16* W2 = (bf16*)(ws + WS_W2);
    constexpr int I_IN = 16 * 240, I_BR = 8 * 32, I_OUT = 16 * 32, I_W1 = 16 * 16, I_W2 = 8 * 32;
    constexpr int N_IN = 2 * I_IN, N_BR = 6 * I_BR, N_OUT = 2 * I_OUT, N_W1 = 64 * I_W1, N_W2 = 64 * I_W2;
    constexpr int NITEMS = N_IN + N_BR + N_OUT + 2 * N_W1 + N_W2;
    for (int it = gw; it < NITEMS; it += NGW) {
        int r = it;
        if (r < N_IN) { const int l = r / I_IN; transpose_item((const float*)KIN(2) + (size_t)l * D * INC, D, INC, WIN + (size_t)l * INC * D, RmGlu(), scr, r % I_IN, lane); continue; } r -= N_IN;
        if (r < N_BR) { const int q = r / I_BR; transpose_item((const float*)KIN(11) + (size_t)q * 512 * D, 512, D, WBR + (size_t)q * D * 512, RmId{0}, scr, r % I_BR, lane); continue; } r -= N_BR;
        if (r < N_OUT) { const int l = r / I_OUT; transpose_item((const float*)KIN(13) + (size_t)l * D * D, D, D, WOUT + (size_t)l * D * D, RmId{0}, scr, r % I_OUT, lane); continue; } r -= N_OUT;
        if (r < N_W1) { const int q = r / I_W1; transpose_item((const float*)KIN(20) + (size_t)q * D * DE, D, DE, W13 + (size_t)q * 1024 * D, RmIl{0}, scr, r % I_W1, lane); continue; } r -= N_W1;
        if (r < N_W1) { const int q = r / I_W1; transpose_item((const float*)KIN(21) + (size_t)q * D * DE, D, DE, W13 + (size_t)q * 1024 * D, RmIl{1}, scr, r % I_W1, lane); continue; } r -= N_W1;
        { const int q = r / I_W2; transpose_item((const float*)KIN(22) + (size_t)q * DE * D, DE, D, W2 + (size_t)q * D * DE, RmId{0}, scr, r % I_W2, lane); }
    }
}

template <int PART> __device__ __forceinline__ void p1_part(Frame& F_, int g, int l, int G, int c) {
    KA_WS();
    Frame F = mkframe(F_.lds);
    pg8::ProbDense P{(const char*)((bf16*)(ws + WS_XB)), (const char*)(ws + WS_WIN) + (size_t)l * INC * D * 2, D};
    pg8::SubOrder<PART> S; S.init(TG, G, c);
    pg8::EpiInProj E{((bf16*)(ws + WS_U)), ((bf16*)(ws + WS_Q)), ((bf16*)(ws + WS_V)), ((bf16*)(ws + WS_GATE)), ((const float*)(ws + WS_ROT)) + (size_t)g * TG * 16, ((const float*)(ws + WS_LB)) + l * 512, (const float*)KIN(12) + (size_t)l * 3 * D};
    pg8::gemm_phase<pg8::ProbDense, pg8::EpiInProj, pg8::SubOrder<PART>, true>(F.lds, P, S, E);
}
__device__ __forceinline__ void p3_merge(Frame& F_, int l) {
    KA_WS();
    Frame F = mkframe(F_.lds);
    pg8::ProbMerge P{(const char*)((bf16*)(ws + WS_YA)), (const char*)((bf16*)(ws + WS_YB)), (const char*)((bf16*)(ws + WS_YC)), (const char*)(ws + WS_WBR) + (size_t)l * 3 * D * 512 * 2, 512};
    pg8::MergeOrder S; S.so.init(TG, D, gridDim.x, blockIdx.x);
    pg8::EpiMerge E{((bf16*)(ws + WS_GATE)), ((bf16*)(ws + WS_M))};
    pg8::gemm_phase<pg8::ProbMerge, pg8::EpiMerge, pg8::MergeOrder, true>(F.lds, P, S, E);
}
__device__ __forceinline__ void p4_wout(Frame& F_, int l) {
    KA_WS();
    Frame F = mkframe(F_.lds);
    pg8::ProbDense P{(const char*)((bf16*)(ws + WS_M)), (const char*)(ws + WS_WOUT) + (size_t)l * D * D * 2, D};
    pg8::StaticOrder S; S.init(TG, D, gridDim.x, blockIdx.x);
    pg8::EpiWout E{((bf16*)(ws + WS_XB)), ((bf16*)(ws + WS_R))};
    pg8::gemm_phase<pg8::ProbDense, pg8::EpiWout, pg8::StaticOrder, true>(F.lds, P, S, E);
}
__device__ __forceinline__ void moe_table(Frame& F_, int g, int l) {
    KA_WS();
    Frame F = mkframe(F_.lds);
    const unsigned* cnt = ((unsigned*)(ws + WS_CTL)) + CW_CNT + (g * 2 + l) * 32;
    LAS int* tab = (LAS int*)(F.lds + TAB_OFF);
    __syncthreads();
    if (F.tid < 64) {
        const int c = F.tid < 32 ? (int)cnt[F.tid] : 0; int sacc = (c + 255) >> 8;
#pragma unroll
        for (int o = 1; o < 32; o <<= 1) { const int t2 = __shfl_up(sacc, o); if (F.lane >= o) sacc += t2; }
        if (F.tid < 32) { tab[F.tid + 1] = sacc; tab[33 + F.tid] = c; }
        if (F.tid == 0) tab[0] = 0;
    }
    __syncthreads();
}
__device__ __forceinline__ void p6_moe1(Frame& F_, int g, int l) {
    KA_WS();
    Frame F = mkframe(F_.lds);
    moe_table(F, g, l);
    pg8::ProbMoe1 P{(const char*)((bf16*)(ws + WS_X1)), (const char*)(ws + WS_W13) + (size_t)l * NE * 1024 * D * 2, ((int*)(ws + WS_TOK)), D};
    pg8::MoeOrder S{(const LAS int*)(F.lds + TAB_OFF), (int)gridDim.x, (int)blockIdx.x, 4};
    pg8::EpiMoe1 E{((bf16*)(ws + WS_HM))};
    pg8::gemm_phase<pg8::ProbMoe1, pg8::EpiMoe1, pg8::MoeOrder, true>(F.lds, P, S, E);
}
__device__ __forceinline__ void p7_moe2(Frame& F_, int g, int l) {
    KA_WS();
    Frame F = mkframe(F_.lds);
    moe_table(F, g, l);
    pg8::ProbMoe2 P{(const char*)((bf16*)(ws + WS_HM)), (const char*)(ws + WS_W2) + (size_t)l * NE * D * DE * 2, DE};
    pg8::MoeOrder S{(const LAS int*)(F.lds + TAB_OFF), (int)gridDim.x, (int)blockIdx.x, 4};
    pg8::EpiMoe2 E{((bf16*)(ws + WS_OM))};
    pg8::gemm_phase<pg8::ProbMoe2, pg8::EpiMoe2, pg8::MoeOrder, true>(F.lds, P, S, E);
}

__device__ __forceinline__ void frame_init(Frame& F, unsigned char* lds_raw) {
    F.lds = (LAS unsigned char*)lds_raw; F.tid = threadIdx.x; F.lane = F.tid & 63; F.wave = __builtin_amdgcn_readfirstlane(F.tid >> 6);
}
__global__ void __launch_bounds__(NTHR, 2) fwd_all(Args a) {
    extern __shared__ __attribute__((aligned(16))) unsigned char lds_raw[];
    Frame F; frame_init(F, lds_raw);
    volatile LAS unsigned* MISC = (volatile LAS unsigned*)(F.lds + MISC_OFF);
    if (F.tid < 64) MISC[F.tid] = 0u;
    __syncthreads();
    XcdBarrier bar = xcd_barrier_post((unsigned*)(a.ws + WS_CTL) + CW_BAR, MISC + 8);
    p_prologue(F); p_wprep(F); p_xload(F, 0);
    xcd_barrier(bar);
    for (int g = 0; g < NG; ++g) {
        for (int l = 0; l < NL; ++l) {
            p1_part<0>(F, g, l, (int)gridDim.x, (int)blockIdx.x); xcd_barrier(bar);
            p2_mixers(F, g, l, 0); xcd_barrier(bar);
            p2d_combine(F, l); xcd_barrier(bar);
            p3_merge(F, l); xcd_barrier(bar);
            p4_wout(F, l); xcd_barrier(bar);
            p5_ln_route(F, g, l, g * 2 + l); xcd_barrier(bar);
            p6_moe1(F, g, l); xcd_barrier(bar);
            p7_moe2(F, g, l); xcd_barrier(bar);
            p8_ln2(F, g, l);
            if (l == NL - 1 && g + 1 < NG) p_xload(F, g + 1);
            xcd_barrier(bar);
        }
    }
}

extern "C" void kernel_launch(void* const* d_in, const int* in_sizes, int n_in, void* d_out, int out_size, void* d_ws, size_t ws_size, hipStream_t stream) {
    static int grid = 0;
    if (grid == 0) {
        if (n_in != 25 || out_size != T * D || ws_size < WS_END) { fprintf(stderr, "kernel_launch: unexpected shapes (n_in %d out %d ws %zu)\n", n_in, out_size, ws_size); grid = -1; return; }
        int dev = 0, cus = 0;
        if (hipGetDevice(&dev) != hipSuccess || hipDeviceGetAttribute(&cus, hipDeviceAttributeMultiprocessorCount, dev) != hipSuccess) { grid = -1; return; }
        (void)hipGetLastError();
        grid = cus;
        if (grid != 256) { fprintf(stderr, "kernel_launch: built for 256 CUs, got %d\n", cus); grid = -1; return; }
    }
    if (grid < 0) return;
    (void)hipMemsetAsync((char*)d_ws + WS_CTL, 0, CTL_ZERO_BYTES, stream);
    Args a{};
    for (int i = 0; i < 25; ++i) a.in[i] = d_in[i];
    a.out = (float*)d_out; a.ws = (unsigned char*)d_ws;
    { static bool attr = false; if (!attr) { (void)hipFuncSetAttribute((const void*)fwd_all, hipFuncAttributeMaxDynamicSharedMemorySize, LDS_BYTES); attr = true; }
      hipLaunchKernelGGL(fwd_all, dim3(grid), dim3(NTHR), LDS_BYTES, stream, a);}

}
```

```cpp
#include <hip/hip_runtime.h>
#include <cstdio>
#include <cstdint>

#ifndef ONE_LAUNCH
#define ONE_LAUNCH 1
#endif

#define GAS __attribute__((address_space(1)))
#define LAS __attribute__((address_space(3)))
typedef unsigned short bf16;
typedef float f32x4 __attribute__((ext_vector_type(4)));
typedef float f32x2 __attribute__((ext_vector_type(2)));
typedef unsigned u32x4 __attribute__((ext_vector_type(4)));
typedef unsigned u32x2 __attribute__((ext_vector_type(2)));

constexpr int D = 1024, NBATCH = 32, S = 2048, T = NBATCH * S, NL = 2;
constexpr int GB = 16, TG = GB * S, NG = NBATCH / GB;
constexpr int INC = 7680;
constexpr int NE = 32, DE = 512;
constexpr float ALPHA = 1.4142135623730951f, EPS = 1e-5f;
constexpr int NWAVES = 8, NTHR = 512;

constexpr size_t MiB = 1u << 20;
constexpr size_t WS_CTL = 0, CTL_ZERO_BYTES = 1 * MiB;
constexpr size_t WS_ROT = 1 * MiB;
constexpr size_t WS_LB = 5 * MiB;
constexpr size_t WS_RW = 6 * MiB;
constexpr size_t WS_WIN = 8 * MiB;
constexpr size_t WS_WBR = 38 * MiB;
constexpr size_t WS_WOUT = 44 * MiB;
constexpr size_t WS_W13 = 48 * MiB;
constexpr size_t WS_W2 = 176 * MiB;
constexpr size_t WS_XB = 240 * MiB;
constexpr size_t WS_U = 304 * MiB;
constexpr size_t WS_Q = 336 * MiB, WS_K = 368 * MiB, WS_V = 400 * MiB;
constexpr size_t WS_HQ = 432 * MiB, WS_HF = 464 * MiB, WS_HV = 496 * MiB, WS_HG = 528 * MiB;
constexpr size_t WS_GATE = 560 * MiB;
constexpr size_t WS_YA = 752 * MiB, WS_YB = 784 * MiB, WS_YC = 816 * MiB;
constexpr size_t WS_R = 848 * MiB;
constexpr size_t WS_TOK = 976 * MiB;
constexpr size_t WS_RT = 980 * MiB;
constexpr size_t WS_END = 982 * MiB;
constexpr size_t WS_M = WS_Q;
constexpr size_t WS_X1 = WS_YA;
constexpr size_t WS_HM = 304 * MiB;
constexpr size_t WS_OM = 376 * MiB;
constexpr size_t HSTRIDE = (size_t)TG * 512;
static_assert((WS_K - WS_Q) == HSTRIDE * 2 && (WS_HQ - WS_V) == HSTRIDE * 2 && (WS_HF - WS_HQ) == HSTRIDE * 2 && (WS_HV - WS_HF) == HSTRIDE * 2 && (WS_HG - WS_HV) == HSTRIDE * 2, "EpiInProj pointer arithmetic");
static_assert(WS_OM + (size_t)(2 * TG + 32 * 256) * 1024 * 2 <= WS_GATE && WS_HM + (size_t)(2 * TG + 32 * 256) * 512 * 2 <= WS_OM, "expert buffers overlay U..HF only");
constexpr int CW_BAR = 4096;
constexpr int CW_CNT = 16384;

__device__ __forceinline__ float bf2f(bf16 b) { return __uint_as_float(((unsigned)b) << 16); }
__device__ __forceinline__ unsigned f2bf(float f) { unsigned u = __float_as_uint(f); return (u + 0x7fffu + ((u >> 16) & 1u)) >> 16; }
__device__ __forceinline__ unsigned pk2(float lo, float hi) { unsigned r; asm volatile("v_cvt_pk_bf16_f32 %0, %1, %2" : "=v"(r) : "v"(lo), "v"(hi)); return r; }
__device__ __forceinline__ float lo16(unsigned w) { return __uint_as_float(w << 16); }
__device__ __forceinline__ float hi16(unsigned w) { return __uint_as_float(w & 0xffff0000u); }
#define DPP_ADD(v, ctrl) ((v) + __builtin_bit_cast(float, __builtin_amdgcn_update_dpp(0, __builtin_bit_cast(int, (v)), (ctrl), 0xF, 0xF, true)))
__device__ __forceinline__ float wave_sum(float v) {
    v = DPP_ADD(v, 0xB1);
    v = DPP_ADD(v, 0x4E);
    v = DPP_ADD(v, 0x141);
    v = DPP_ADD(v, 0x140);
    v = v + __builtin_bit_cast(float, __builtin_amdgcn_update_dpp(0, __builtin_bit_cast(int, v), 0x142, 0xA, 0xF, false));
    v = v + __builtin_bit_cast(float, __builtin_amdgcn_update_dpp(0, __builtin_bit_cast(int, v), 0x143, 0xC, 0xF, false));
    return __builtin_bit_cast(float, __builtin_amdgcn_readlane(__builtin_bit_cast(int, v), 63));
}
__device__ __forceinline__ float wave_max(float v) {
#pragma unroll
    for (int o = 1; o < 64; o <<= 1) v = fmaxf(v, __shfl_xor(v, o));
    return v;
}
__device__ __forceinline__ float sigmoidf_(float z) { return 1.f / (1.f + expf(-z)); }
__device__ __forceinline__ float siluf_(float z) { return z / (1.f + expf(-z)); }
__device__ __forceinline__ float hg_logf(float z, float lb) {
    if (z >= 0.f) { const float sn = 1.f / (1.f + expf(z)); return log1pf(-(1.f - lb) * sn); }
    const float ez = expf(z); return logf(lb + (1.f - lb) * (ez / (1.f + ez)));
}
#define LDS_WAIT() asm volatile("s_waitcnt lgkmcnt(0)" ::: "memory")

#define XB_TMO      128
#define XB_XCNT(j)  (256  + 64 * (j))
#define XB_XSUB(j)  (1280 + 64 * (j))
#define XB_XGEN(j)  (2304 + 64 * (j))
#define XB_TOP      3328
#define XB_TOPGEN   3392
#define XCD_BAR_WORDS 3456
#define XB_SPIN_CAP (1u << 22)
__device__ __forceinline__ unsigned xb_ld(unsigned* p)              { return __hip_atomic_load(p, __ATOMIC_RELAXED, __HIP_MEMORY_SCOPE_AGENT); }
__device__ __forceinline__ unsigned xb_add(unsigned* p, unsigned v) { return __hip_atomic_fetch_add(p, v, __ATOMIC_RELAXED, __HIP_MEMORY_SCOPE_AGENT); }
__device__ __forceinline__ unsigned xb_xcc_id() { return (unsigned)__builtin_amdgcn_s_getreg((3 << 11) | 20) & 0xFu; }
#define XB_SPIN(cond, bar) do { unsigned _sp = 0; while (cond) { __builtin_amdgcn_s_sleep(1); \
    if ((++_sp & 255u) == 0u) { if (xb_ld(&(bar)[XB_TMO])) break; if (_sp > XB_SPIN_CAP) { atomicAdd(&(bar)[XB_TMO], 1u); break; } } } } while (0)
struct XcdBarrier { unsigned* bar; unsigned x; volatile LAS unsigned* st; };
__device__ __forceinline__ XcdBarrier xcd_barrier_post(unsigned* bar, volatile LAS unsigned* st) {
    XcdBarrier b; b.bar = bar; b.x = (unsigned)__builtin_amdgcn_readfirstlane((int)xb_xcc_id()); b.st = st;
    if (threadIdx.x == 0) (void)xb_add(&bar[XB_XCNT(b.x)], 1u);
    return b;
}
__device__ __forceinline__ void xcd_barrier_complete(unsigned* bar, unsigned x, unsigned& nloc, unsigned& nx) {
    const unsigned G = gridDim.x * gridDim.y * gridDim.z;
    unsigned sum, cnt, mine, sp = 0u;
    for (;;) {
        sum = 0u; cnt = 0u; mine = 0u;
#pragma unroll
        for (unsigned j = 0; j < 16; ++j) { const unsigned c = xb_ld(&bar[XB_XCNT(j)]); sum += c; cnt += (c > 0u) ? 1u : 0u; mine = (j == x) ? c : mine; }
        if (sum == G) break;
        __builtin_amdgcn_s_sleep(1);
        if ((++sp & 255u) == 0u) { if (xb_ld(&bar[XB_TMO])) break; if (sp > XB_SPIN_CAP) { atomicAdd(&bar[XB_TMO], 1u); break; } }
    }
    nloc = mine > 0u ? mine : 1u; nx = cnt > 0u ? cnt : 1u;
}
__device__ __forceinline__ void xcd_barrier(const XcdBarrier& b_) {
    XcdBarrier b = b_;
    { unsigned long long bp = (unsigned long long)b_.bar; unsigned bx = b_.x; asm volatile("" : "+s"(bp), "+s"(bx)); b.bar = (unsigned*)(GAS unsigned*)bp; b.x = bx; }
    asm volatile("s_waitcnt vmcnt(0)" ::: "memory");
    __syncthreads();
    if (threadIdx.x == 0) {
        unsigned* bar = b.bar;
        __builtin_amdgcn_s_waitcnt(0);
        unsigned nloc = b.st[0], nx = b.st[1];
        if (nloc == 0u) { xcd_barrier_complete(bar, b.x, nloc, nx); b.st[0] = nloc; b.st[1] = nx; }
        const unsigned old = xb_add(&bar[XB_XSUB(b.x)], 1u);
        const unsigned gen = old / nloc;
        if (old + 1u == (gen + 1u) * nloc) {
            __builtin_amdgcn_fence(__ATOMIC_RELEASE, "agent");
            asm volatile("s_waitcnt vmcnt(0)" ::: "memory");
            const unsigned og = xb_add(&bar[XB_TOP], 1u);
            const unsigned tg = og / nx;
            if (og + 1u == (tg + 1u) * nx) xb_add(&bar[XB_TOPGEN], 1u);
            else XB_SPIN(xb_ld(&bar[XB_TOPGEN]) == tg, bar);
            __builtin_amdgcn_fence(__ATOMIC_ACQUIRE, "agent");
            xb_add(&bar[XB_XGEN(b.x)], 1u);
            asm volatile("s_waitcnt vmcnt(0)" ::: "memory");
        } else {
            XB_SPIN(xb_ld(&bar[XB_XGEN(b.x)]) == gen, bar);
            __builtin_amdgcn_fence(__ATOMIC_ACQUIRE, "agent");
            asm volatile("s_waitcnt vmcnt(0)" ::: "memory");
        }
    }
    __syncthreads();
}

constexpr int LDS_BYTES = 147456;
constexpr int MISC_OFF = 135168;
struct Args { const void* in[25]; float* out; unsigned char* ws; int g_lo, g_hi, l_lo, l_hi, ph_lo, ph_hi, prologue, pad; };
struct Frame { LAS unsigned char* lds; int tid, lane, wave; };
typedef const __attribute__((address_space(4))) Args* KArgs;
__device__ __forceinline__ KArgs kargs() { unsigned long long v = (unsigned long long)__builtin_amdgcn_kernarg_segment_ptr(); asm volatile("" : "+s"(v)); return (KArgs)v; }
#define KA_WS() KArgs ka = kargs(); unsigned char* ws = (unsigned char*)(GAS unsigned char*)ka->ws
#define KIN(i) ((const void*)(const GAS char*)ka->in[i])
#define KOUT() ((float*)(GAS float*)ka->out)
__device__ __forceinline__ Frame mkframe(LAS unsigned char* lds) { Frame F; int t = threadIdx.x; asm volatile("" : "+v"(t)); F.lds = lds; F.tid = t; F.lane = t & 63; F.wave = __builtin_amdgcn_readfirstlane(t >> 6); return F; }

namespace pg8 {
typedef short bf16x8 __attribute__((ext_vector_type(8)));
constexpr int BM = 256, BK = 64, HALF = 128, HTB = HALF * BK * 2, STAGE_BYTES = 8 * HTB, NXCD = 8, WGM = 8;
__host__ __device__ __forceinline__ int lds_byte(int r, int c) { const int st = (r >> 4) * 2 + (c >> 5), rr = r & 15, cc = c & 31, ob = rr * 64 + cc * 2; return st * 1024 + (ob ^ (((ob >> 9) & 1) << 5)); }
__host__ __device__ __forceinline__ void stage_rc(int b, int& R, int& C) { const int st = b / 1024, sb = b % 1024, swz = sb ^ (((sb >> 9) & 1) << 5); R = (st >> 1) * 16 + swz / 64; C = (st & 1) * 32 + (swz % 64) / 2; }
__host__ __device__ __forceinline__ int perm32(int rho) { const int n = rho >> 4, i = rho & 15; return 8 * (i >> 2) + 4 * n + (i & 3); }
struct Unit { int pm, pn, e, pos0, cnt; };
__device__ __forceinline__ int xcd_remap(int wgid, int nwg) { const int q = nwg / NXCD, r = nwg % NXCD, xcd = wgid % NXCD, off = wgid / NXCD; return (xcd < r ? xcd * (q + 1) : r * (q + 1) + (xcd - r) * q) + off; }
struct StaticOrder {
    int nM, nN, nwg, G, c;
    __device__ void init(int M, int N, int G_, int c_) { nM = M / BM; nN = N / BM; nwg = nM * nN; G = G_; c = c_; }
    __device__ bool next(int i, Unit& u) const {
        const long L = (long)i * G + c; if (L >= nwg) return false;
        const int wgid = xcd_remap((int)L, nwg);
        const int nig = WGM * nN, gid = wgid / nig, fm = gid * WGM, gsz = (nM - fm) < WGM ? (nM - fm) : WGM;
        u.pm = fm + ((wgid % nig) % gsz); u.pn = (wgid % nig) / gsz; u.e = 0; u.pos0 = 0; u.cnt = 0; return true;
    }
    __device__ __forceinline__ void a_ready(const Unit&) const {}
    __device__ __forceinline__ void done(const Unit&) const {}
};
template <int PART> struct SubOrder {
    StaticOrder so;
    __device__ void init(int M, int G_, int c_) { so.init(M, (PART == 0 ? 18 : 12) * BM, G_, c_); }
    __device__ bool next(int i, Unit& u) const { if (!so.next(i, u)) return false; u.pn = PART == 0 ? u.pn + 4 : (u.pn < 4 ? u.pn : u.pn + 18); return true; }
    __device__ __forceinline__ void a_ready(const Unit&) const {}
    __device__ __forceinline__ void done(const Unit&) const {}
};
struct MergeOrder {
    StaticOrder so;
    __device__ bool next(int i, Unit& u) const { if (!so.next(i / 3, u)) return false; u.e = i % 3; return true; }
    __device__ __forceinline__ void a_ready(const Unit&) const {}
    __device__ __forceinline__ void done(const Unit&) const {}
};
struct MoeOrder {
    const LAS int* tab; int G, c, NT;
    __device__ bool next(int i, Unit& u) const {
        const int np = __builtin_amdgcn_readfirstlane(tab[32]); const int nwg = np * NT;
        const long L = (long)i * G + c; if (L >= nwg) return false;
        const int wgid = xcd_remap((int)L, nwg);
        const int panel = wgid / NT; u.pn = wgid % NT;
        int e = 0;
#pragma unroll
        for (int s2 = 16; s2 >= 1; s2 >>= 1) { const int tv = __builtin_amdgcn_readfirstlane(tab[e + s2]); if (tv <= panel) e += s2; }
        u.e = e; u.pm = panel; u.pos0 = (panel - __builtin_amdgcn_readfirstlane(tab[e])) * 256; u.cnt = __builtin_amdgcn_readfirstlane(tab[33 + e]); return true;
    }
    __device__ __forceinline__ void a_ready(const Unit&) const {}
    __device__ __forceinline__ void done(const Unit&) const {}
};
__device__ __forceinline__ unsigned cvt_pk_bf16(float lo, float hi) { unsigned r; asm volatile("v_cvt_pk_bf16_f32 %0, %1, %2" : "=v"(r) : "v"(lo), "v"(hi)); return r; }

template <class Prob, class Epi, class Sched, bool ALIGN_EPI>
__device__ __forceinline__ void gemm_phase(LAS unsigned char* lds, const Prob& P, const Sched& S, const Epi& E) {
    int tid_ = threadIdx.x; asm volatile("" : "+v"(tid_));
    const int tid = tid_, wid = __builtin_amdgcn_readfirstlane(tid >> 6), lane = tid & 63, wr = wid >> 2, wc = wid & 3, fr = lane & 15, fq = lane >> 4;
    const int K = P.K, nt = K / BK;
    unsigned vA[2][2], voffB[2];
#pragma unroll
    for (int i = 0; i < 2; ++i) { int R, C; stage_rc(tid * 16 + i * 8192, R, C); const int Rb = (R & ~31) + perm32(R & 31);
        vA[0][i] = (unsigned)(R * K + C) * 2u; vA[1][i] = vA[0][i] + (unsigned)(HALF * K * 2); voffB[i] = (unsigned)(Rb * K + C) * 2u; }
    const size_t kstep = (size_t)(BK * 2);
    const size_t hstep = (size_t)HALF * K * 2;
    const unsigned ldsw = (unsigned)wid * 1024u;
    const int aoff = lds_byte(wr * 64 + fr, fq * 8), boff = lds_byte(wc * 32 + fr, fq * 8);
#define PG8_SA(b, h) (((b) * 2 + (h)) * HTB)
#define PG8_SB(b, h) ((4 + (b) * 2 + (h)) * HTB)
#define PG8_STAGE(bufoff, gbase, voff) do { _Pragma("unroll") for (int _i = 0; _i < 2; ++_i) \
        __builtin_amdgcn_global_load_lds((const unsigned*)((const char*)(gbase) + (voff)[_i]), (LAS unsigned*)(lds + (bufoff) + ldsw + _i * 8192), 16, 0, 0); } while (0)
#define PG8_LDA(dst, b, h) do { _Pragma("unroll") for (int m = 0; m < 4; ++m) _Pragma("unroll") for (int k = 0; k < 2; ++k) dst[m][k] = *(const LAS bf16x8*)(lds + PG8_SA(b, h) + aoff + m * 2048 + k * 1024); } while (0)
#define PG8_LDB(dst, b, h) do { _Pragma("unroll") for (int n = 0; n < 2; ++n) _Pragma("unroll") for (int k = 0; k < 2; ++k) dst[n][k] = *(const LAS bf16x8*)(lds + PG8_SB(b, h) + boff + n * 2048 + k * 1024); } while (0)
#define PG8_MMA(ai, bj, At, Bt) do { __builtin_amdgcn_s_setprio(1); _Pragma("unroll") for (int m = 0; m < 4; ++m) _Pragma("unroll") for (int n = 0; n < 2; ++n) _Pragma("unroll") for (int k = 0; k < 2; ++k) \
        acc[ai][bj][m][n] = __builtin_amdgcn_mfma_f32_16x16x32_bf16(Bt[n][k], At[m][k], acc[ai][bj][m][n], 0, 0, 0); __builtin_amdgcn_s_setprio(0); } while (0)
#define PG8_WAIT_V(n) asm volatile("s_waitcnt vmcnt(" #n ")" ::: "memory")
#define PG8_WAIT_L(n) asm volatile("s_waitcnt lgkmcnt(" #n ")" ::: "memory")
#define PG8_BAR __builtin_amdgcn_s_barrier()
#define PG8_SCHED __builtin_amdgcn_sched_barrier(0)
    Unit cur, nxt; int ui = 0;
    if (!S.next(0, cur)) return;
    f32x4 acc[2][2][4][2];
#pragma unroll
    for (int a = 0; a < 2; ++a)
#pragma unroll
        for (int b = 0; b < 2; ++b)
#pragma unroll
            for (int m = 0; m < 4; ++m)
#pragma unroll
                for (int n = 0; n < 2; ++n) acc[a][b][m][n] = (f32x4){0.f, 0.f, 0.f, 0.f};
    bf16x8 At[4][2], B0[2][2], B1[2][2];
    const char* cA = P.abase(cur); const char* cB = P.bbase(cur);
    if constexpr (Prob::GATHER) P.voff(cur, tid, vA);
    S.a_ready(cur);
    PG8_STAGE(PG8_SB(0, 0), cB, voffB); PG8_STAGE(PG8_SB(0, 1), cB + hstep, voffB); PG8_STAGE(PG8_SA(0, 0), cA, vA[0]); PG8_STAGE(PG8_SA(0, 1), cA, vA[1]);
    if (wr == 1) PG8_BAR;
    PG8_WAIT_V(2); PG8_BAR;
    PG8_STAGE(PG8_SB(1, 0), cB + kstep, voffB); PG8_STAGE(PG8_SA(1, 0), cA + kstep, vA[0]); PG8_STAGE(PG8_SB(1, 1), cB + hstep + kstep, voffB);
    PG8_WAIT_V(6); PG8_BAR;
    for (;;) {
        const bool has_next = S.next(ui + 1, nxt);
        const char* nA = has_next ? P.abase(nxt) : cA; const char* nB = has_next ? P.bbase(nxt) : cB;
        unsigned nv[2][2];
#pragma unroll
        for (int h = 0; h < 2; ++h)
#pragma unroll
            for (int i = 0; i < 2; ++i) nv[h][i] = vA[h][i];
        for (int t = 0; t < nt; t += 2) {
            const bool last = (t == nt - 2);
            if constexpr (Prob::GATHER) { if (t == nt - 4 && has_next) P.voff(nxt, tid, nv); }
            const char* a1 = cA + (size_t)(t + 1) * kstep;
            const char* a2 = last ? nA : cA + (size_t)(t + 2) * kstep; const char* b2 = last ? nB : cB + (size_t)(t + 2) * kstep;
            const char* a3 = a2 + kstep; const char* b3 = b2 + kstep;
            if (last && has_next) S.a_ready(nxt);
            unsigned w0[2], w1[2];
#pragma unroll
            for (int i = 0; i < 2; ++i) { if constexpr (Prob::GATHER) { w0[i] = last ? nv[0][i] : vA[0][i]; w1[i] = last ? nv[1][i] : vA[1][i]; } else { w0[i] = vA[0][i]; w1[i] = vA[1][i]; } }
            PG8_LDB(B0, 0, 0); PG8_LDB(B1, 0, 1); PG8_SCHED; PG8_LDA(At, 0, 0); PG8_STAGE(PG8_SA(1, 1), a1, vA[1]);
            PG8_WAIT_V(8); PG8_WAIT_L(0); PG8_BAR; PG8_MMA(0, 0, At, B0); PG8_MMA(0, 1, At, B1); PG8_BAR; PG8_SCHED;
            PG8_LDA(At, 0, 1); PG8_STAGE(PG8_SB(0, 0), b2, voffB); PG8_STAGE(PG8_SB(0, 1), b2 + hstep, voffB); PG8_STAGE(PG8_SA(0, 0), a2, w0);
            PG8_WAIT_V(8); PG8_WAIT_L(0); PG8_BAR; PG8_MMA(1, 0, At, B0); PG8_MMA(1, 1, At, B1); PG8_BAR; PG8_SCHED;
            PG8_LDB(B0, 1, 0); PG8_LDB(B1, 1, 1); PG8_SCHED; PG8_LDA(At, 1, 0); PG8_STAGE(PG8_SA(0, 1), a2, w1);
            PG8_WAIT_V(8); PG8_WAIT_L(0); PG8_BAR; PG8_MMA(0, 0, At, B0); PG8_MMA(0, 1, At, B1); PG8_BAR; PG8_SCHED;
            PG8_LDA(At, 1, 1); PG8_STAGE(PG8_SB(1, 0), b3, voffB); PG8_STAGE(PG8_SB(1, 1), b3 + hstep, voffB); PG8_STAGE(PG8_SA(1, 0), a3, w0);
            PG8_WAIT_V(8); PG8_WAIT_L(0); PG8_BAR; PG8_MMA(1, 0, At, B0); PG8_MMA(1, 1, At, B1); PG8_BAR; PG8_SCHED;
        }
        if constexpr (ALIGN_EPI) { if (wr == 0) PG8_BAR; }
        E(acc, cur, wr, wc, fr, fq); S.done(cur);
        if (!has_next) break;
        if (!(Epi::CARRY && nxt.e != 0))
#pragma unroll
        for (int a = 0; a < 2; ++a)
#pragma unroll
            for (int b = 0; b < 2; ++b)
#pragma unroll
                for (int m = 0; m < 4; ++m)
#pragma unroll
                    for (int n = 0; n < 2; ++n) acc[a][b][m][n] = (f32x4){0.f, 0.f, 0.f, 0.f};
        cur = nxt; cA = nA; cB = nB; ++ui;
        if constexpr (Prob::GATHER) {
#pragma unroll
            for (int h = 0; h < 2; ++h)
#pragma unroll
                for (int i = 0; i < 2; ++i) vA[h][i] = nv[h][i]; }
        if constexpr (ALIGN_EPI) { if (wr == 1) PG8_BAR; }
    }
    PG8_WAIT_V(0);
    if constexpr (!ALIGN_EPI) { if (wr == 0) PG8_BAR; }
    PG8_BAR;
#undef PG8_SA
#undef PG8_SB
#undef PG8_STAGE
#undef PG8_LDA
#undef PG8_LDB
#undef PG8_MMA
#undef PG8_WAIT_V
#undef PG8_WAIT_L
#undef PG8_BAR
#undef PG8_SCHED
}
struct ProbDense { static constexpr bool GATHER = false; const char* A; const char* Bt; int K;
    __device__ __forceinline__ const char* abase(const Unit& u) const { return A + (size_t)u.pm * 256 * K * 2; }
    __device__ __forceinline__ const char* bbase(const Unit& u) const { return Bt + (size_t)u.pn * 256 * K * 2; }
    __device__ __forceinline__ void voff(const Unit&, int, unsigned (&)[2][2]) const {} };
struct ProbMerge { static constexpr bool GATHER = false; const char* Y0; const char* Y1; const char* Y2; const char* W; int K;
    __device__ __forceinline__ const char* abase(const Unit& u) const { const char* y = u.e == 0 ? Y0 : (u.e == 1 ? Y1 : Y2); return y + (size_t)u.pm * 256 * K * 2; }
    __device__ __forceinline__ const char* bbase(const Unit& u) const { return W + ((size_t)u.e * 1024 + u.pn * 256) * K * 2; }
    __device__ __forceinline__ void voff(const Unit&, int, unsigned (&)[2][2]) const {} };
struct ProbMoe1 { static constexpr bool GATHER = true; const char* X1; const char* W; const int* TOK; int K;
    __device__ __forceinline__ const char* abase(const Unit&) const { return X1; }
    __device__ __forceinline__ const char* bbase(const Unit& u) const { return W + ((size_t)u.e * 1024 + u.pn * 256) * K * 2; }
    __device__ __forceinline__ void voff(const Unit& u, int tid, unsigned (&v)[2][2]) const {
#pragma unroll
        for (int i = 0; i < 2; ++i) { int R, C; stage_rc(tid * 16 + i * 8192, R, C);
#pragma unroll
            for (int h = 0; h < 2; ++h) { const int pos = u.pos0 + h * 128 + R; int tk = TOK[(size_t)u.e * TG + pos]; tk = pos < u.cnt ? tk : 0; v[h][i] = (unsigned)tk * (unsigned)(K * 2) + (unsigned)C * 2u; } } } };
struct ProbMoe2 { static constexpr bool GATHER = false; const char* HM; const char* W; int K;
    __device__ __forceinline__ const char* abase(const Unit& u) const { return HM + (size_t)u.pm * 256 * K * 2; }
    __device__ __forceinline__ const char* bbase(const Unit& u) const { return W + ((size_t)u.e * 1024 + u.pn * 256) * K * 2; }
    __device__ __forceinline__ void voff(const Unit&, int, unsigned (&)[2][2]) const {} };

__device__ __forceinline__ float fsig(float z) { return __builtin_amdgcn_rcpf(1.f + __expf(-z)); }
__device__ __forceinline__ float hg_logf_fast(float z, float lb) {
    const float t = __expf(-fabsf(z)), sg = t * __builtin_amdgcn_rcpf(1.f + t), w = (1.f - lb) * sg;
    return __logf(z >= 0.f ? 1.f - w : lb + w);
}
__device__ __forceinline__ void st8(bf16* p, const f32x4& a, const f32x4& b) { u32x4 w; w.x = cvt_pk_bf16(a[0], a[1]); w.y = cvt_pk_bf16(a[2], a[3]); w.z = cvt_pk_bf16(b[0], b[1]); w.w = cvt_pk_bf16(b[2], b[3]); *(u32x4*)p = w; }
struct EpiInProj {
    static constexpr bool PERM = true, CARRY = false;
    bf16 *U, *Q, *V, *GATE; const float* rot; const float* lbt; const float* bg;
    __device__ __forceinline__ void operator()(const f32x4 (&acc)[2][2][4][2], const Unit& u, int wr, int wc, int fr, int fq) const {
        const int pn = u.pn, rowb = u.pm * 256 + wr * 64 + fr, cl = wc * 32 + 8 * fq;
        if (pn < 4) {
#pragma unroll
            for (int ai = 0; ai < 2; ++ai)
#pragma unroll
                for (int m = 0; m < 4; ++m) { const int row = rowb + ai * 128 + m * 16; f32x4 o0, o1;
#pragma unroll
                    for (int j = 0; j < 4; ++j) { o0[j] = acc[ai][0][m][0][j] * fsig(acc[ai][1][m][0][j]); o1[j] = acc[ai][0][m][1][j] * fsig(acc[ai][1][m][1][j]); }
                    st8(U + (size_t)row * 512 + pn * 128 + cl, o0, o1); asm volatile("" ::: "memory"); }
        } else if (pn < 8) {
            const int which = pn - 4; bf16* dst = Q + (size_t)(which >> 1) * HSTRIDE; const float sc = (which >> 1) ? 1.f : 0.125f * 1.4426950408889634f; const int colb = (which & 1) * 256 + cl;
            const bool rotw = (wc & 1) == 0; const float sgn = fq == 0 ? -1.f : 1.f;
#pragma unroll
            for (int ai = 0; ai < 2; ++ai) {
                f32x4 cs[4][4];
#pragma unroll
                for (int m = 0; m < 4; ++m) { cs[m][0] = (f32x4){1.f, 1.f, 1.f, 1.f}; cs[m][1] = cs[m][0]; cs[m][2] = (f32x4){0.f, 0.f, 0.f, 0.f}; cs[m][3] = cs[m][2];
                    if (rotw && fq < 2) { const f32x4* rp = (const f32x4*)(rot + (size_t)(rowb + ai * 128 + m * 16) * 16); cs[m][0] = rp[0]; cs[m][1] = rp[1]; cs[m][2] = rp[2]; cs[m][3] = rp[3]; } }
#pragma unroll
                for (int m = 0; m < 4; ++m) { const int row = rowb + ai * 128 + m * 16;
                    const f32x4 c0 = cs[m][0], c1 = cs[m][1], s0 = cs[m][2] * sgn, s1 = cs[m][3] * sgn;
#pragma unroll
                    for (int bj = 0; bj < 2; ++bj) { f32x4 x0 = acc[ai][bj][m][0], x1 = acc[ai][bj][m][1];
                        if (rotw) { f32x4 p0, p1;
#pragma unroll
                            for (int j = 0; j < 4; ++j) { p0[j] = __shfl_xor(x0[j], 16); p1[j] = __shfl_xor(x1[j], 16); }
                            x0 = x0 * c0 + p0 * s0; x1 = x1 * c1 + p1 * s1; }
                        st8(dst + (size_t)row * 512 + colb + bj * 128, x0 * sc, x1 * sc); } }
                asm volatile("" ::: "memory"); }
        } else {
            int kind, ldc, colb; bf16* dst; bool seqc = false;
            if (pn < 18) { const int tq = (pn - 8) >> 1; seqc = tq >= 1; kind = tq == 0 ? 0 : (tq == 1 ? 1 : (tq == 2 ? 2 : (tq == 3 ? 0 : 1))); dst = V + (size_t)tq * HSTRIDE; ldc = 512; colb = ((pn - 8) & 1) * 256; }
            else { kind = 3; dst = GATE; ldc = 3072; colb = (pn - 18) * 256; }
            f32x4 aux[2][2];
#pragma unroll
            for (int bj = 0; bj < 2; ++bj)
#pragma unroll
                for (int n = 0; n < 2; ++n) aux[bj][n] = kind == 2 ? *(const f32x4*)(lbt + colb + bj * 128 + cl + 4 * n) : (kind == 3 ? *(const f32x4*)(bg + colb + bj * 128 + cl + 4 * n) : (f32x4){0.f, 0.f, 0.f, 0.f});
#pragma unroll
            for (int ai = 0; ai < 2; ++ai)
#pragma unroll
                for (int m = 0; m < 4; ++m) { const int row = rowb + ai * 128 + m * 16;
#pragma unroll
                    for (int bj = 0; bj < 2; ++bj) { f32x4 x[2] = {acc[ai][bj][m][0], acc[ai][bj][m][1]};
                        if (kind == 1) {
#pragma unroll
                            for (int n = 0; n < 2; ++n)
#pragma unroll
                                for (int j = 0; j < 4; ++j) x[n][j] = x[n][j] * fsig(x[n][j]);
                        } else if (kind == 2) {
#pragma unroll
                            for (int n = 0; n < 2; ++n)
#pragma unroll
                                for (int j = 0; j < 4; ++j) x[n][j] = hg_logf_fast(x[n][j], aux[bj][n][j]);
                        } else if (kind == 3) {
#pragma unroll
                            for (int n = 0; n < 2; ++n)
#pragma unroll
                                for (int j = 0; j < 4; ++j) x[n][j] = fsig(x[n][j] + aux[bj][n][j]);
                        }
                        const size_t di = seqc ? ((size_t)((row >> 11) * 4 + (colb >> 7) + bj) * 2048 + (row & 2047)) * 128 + cl : (size_t)row * ldc + colb + bj * 128 + cl;
                        st8(dst + di, x[0], x[1]); } asm volatile("" ::: "memory"); }
        }
    }
};
struct EpiMerge {
    static constexpr bool PERM = true, CARRY = true;
    const bf16* GATE; bf16* M;
    __device__ __forceinline__ void operator()(f32x4 (&acc)[2][2][4][2], const Unit& u, int wr, int wc, int fr, int fq) const {
        const int rowb = u.pm * 256 + wr * 64 + fr, cl = u.pn * 256 + wc * 32 + 8 * fq, n = u.e;
#pragma unroll
        for (int ai = 0; ai < 2; ++ai) {
            u32x4 g[4][2], h[4][2];
#pragma unroll
            for (int m = 0; m < 4; ++m)
#pragma unroll
                for (int bj = 0; bj < 2; ++bj) { const bf16* gp = GATE + (size_t)(rowb + ai * 128 + m * 16) * 3072 + n * 1024 + cl + bj * 128;
                    g[m][bj] = *(const u32x4*)gp; h[m][bj] = g[m][bj]; if (n < 2) h[m][bj] = *(const u32x4*)(gp + 1024); }
#pragma unroll
            for (int m = 0; m < 4; ++m)
#pragma unroll
                for (int bj = 0; bj < 2; ++bj) { const u32x4 gg = g[m][bj], hh = h[m][bj];
                    f32x4 s0 = (f32x4){lo16(gg.x), hi16(gg.x), lo16(gg.y), hi16(gg.y)}, s1 = (f32x4){lo16(gg.z), hi16(gg.z), lo16(gg.w), hi16(gg.w)};
                    if (n < 2) {
                        const f32x4 d0 = (f32x4){lo16(hh.x), hi16(hh.x), lo16(hh.y), hi16(hh.y)}, d1 = (f32x4){lo16(hh.z), hi16(hh.z), lo16(hh.w), hi16(hh.w)};
#pragma unroll
                        for (int j = 0; j < 4; ++j) { s0[j] *= __builtin_amdgcn_rcpf(fmaxf(d0[j], 1e-20f)); s1[j] *= __builtin_amdgcn_rcpf(fmaxf(d1[j], 1e-20f)); }
                        acc[ai][bj][m][0] = acc[ai][bj][m][0] * s0; acc[ai][bj][m][1] = acc[ai][bj][m][1] * s1;
                    } else st8(M + (size_t)(rowb + ai * 128 + m * 16) * D + cl + bj * 128, acc[ai][bj][m][0] * s0, acc[ai][bj][m][1] * s1); }
            asm volatile("" ::: "memory"); }
    }
};
struct EpiWout {
    static constexpr bool PERM = true, CARRY = false;
    const bf16* XB; bf16* R;
    __device__ __forceinline__ void operator()(const f32x4 (&acc)[2][2][4][2], const Unit& u, int wr, int wc, int fr, int fq) const {
        const int rowb = u.pm * 256 + wr * 64 + fr, cl = u.pn * 256 + wc * 32 + 8 * fq;
#pragma unroll
        for (int ai = 0; ai < 2; ++ai) {
            u32x4 g[4][2];
#pragma unroll
            for (int m = 0; m < 4; ++m)
#pragma unroll
                for (int bj = 0; bj < 2; ++bj) g[m][bj] = *(const u32x4*)(XB + (size_t)(rowb + ai * 128 + m * 16) * D + cl + bj * 128);
#pragma unroll
            for (int m = 0; m < 4; ++m)
#pragma unroll
                for (int bj = 0; bj < 2; ++bj) { const size_t o = (size_t)(rowb + ai * 128 + m * 16) * D + cl + bj * 128; const u32x4 gg = g[m][bj];
                    st8(R + o, acc[ai][bj][m][0] + (f32x4){lo16(gg.x), hi16(gg.x), lo16(gg.y), hi16(gg.y)} * ALPHA, acc[ai][bj][m][1] + (f32x4){lo16(gg.z), hi16(gg.z), lo16(gg.w), hi16(gg.w)} * ALPHA); }
            asm volatile("" ::: "memory"); }
    }
};
struct EpiMoe1 {
    static constexpr bool PERM = true, CARRY = false;
    bf16* HM;
    __device__ __forceinline__ void operator()(const f32x4 (&acc)[2][2][4][2], const Unit& u, int wr, int wc, int fr, int fq) const {
        const int rowb = u.pm * 256 + wr * 64 + fr, cl = u.pn * 128 + wc * 32 + 8 * fq;
#pragma unroll
        for (int ai = 0; ai < 2; ++ai)
#pragma unroll
            for (int m = 0; m < 4; ++m) { const int row = rowb + ai * 128 + m * 16; f32x4 o0, o1;
#pragma unroll
                for (int j = 0; j < 4; ++j) { const float a = acc[ai][0][m][0][j], b = acc[ai][0][m][1][j]; o0[j] = a * fsig(a) * acc[ai][1][m][0][j]; o1[j] = b * fsig(b) * acc[ai][1][m][1][j]; }
                st8(HM + (size_t)row * DE + cl, o0, o1); }
    }
};
struct EpiMoe2 {
    static constexpr bool PERM = true, CARRY = false;
    bf16* OM;
    __device__ __forceinline__ void operator()(const f32x4 (&acc)[2][2][4][2], const Unit& u, int wr, int wc, int fr, int fq) const {
        const int rowb = u.pm * 256 + wr * 64 + fr, cl = u.pn * 256 + wc * 32 + 8 * fq;
#pragma unroll
        for (int ai = 0; ai < 2; ++ai)
#pragma unroll
            for (int m = 0; m < 4; ++m) { const int row = rowb + ai * 128 + m * 16;
#pragma unroll
                for (int bj = 0; bj < 2; ++bj) st8(OM + (size_t)row * D + cl + bj * 128, acc[ai][bj][m][0], acc[ai][bj][m][1]); }
    }
};
}

__device__ __forceinline__ void p_prologue(Frame& F_) {
    KA_WS();
    Frame F = mkframe(F_.lds);
    const int gt = blockIdx.x * NTHR + F.tid, NT = gridDim.x * NTHR;
    const int* pos = (const int*)KIN(1);
    float* rot = (float*)(ws + WS_ROT);
    for (int i = gt; i < T * 8; i += NT) {
        const int t = i >> 3, f = i & 7;
        const double invf[8] = {1.0, 0.19392274474868576, 0.03760603093086393, 0.007292664737217109, 0.001414213562373095, 0.0002742481756762073, 5.318295896944988e-05, 1.031338537721246e-05};
        double w = 1.0;
#pragma unroll
        for (int j = 0; j < 8; ++j) w = (f == j) ? invf[j] : w;
        const double ang = (double)pos[t] * w;
        const double n = rint(ang * 0.15915494309189535); const double r = (ang - n * 6.283185307179586) - n * 2.4492935982947064e-16;
        rot[t * 16 + f] = cosf((float)r); rot[t * 16 + 8 + f] = sinf((float)r);
    }
    { bf16* rw = (bf16*)(ws + WS_RW);
      for (int i = gt; i < 2 * 48 * 1024; i += NT) { const int l2 = i / (48 * 1024), j = (i / 1024) % 48, d = i & 1023; float w = 0.f;
          if (j < 4) w = ((const float*)KIN(16))[((size_t)l2 * D + d) * 4 + j];
          else if (j < 36) w = ((const float*)KIN(18))[(((size_t)l2 * 4 + ((j - 4) >> 3)) * D + d) * 8 + ((j - 4) & 7)];
          const unsigned hb = f2bf(w); const float hf = __uint_as_float(hb << 16);
          rw[((size_t)l2 * 2 + 0) * 48 * 1024 + j * 1024 + d] = (bf16)hb; rw[((size_t)l2 * 2 + 1) * 48 * 1024 + j * 1024 + d] = (bf16)f2bf(w - hf); } }
    float* lbt = (float*)(ws + WS_LB);
    const float* hg_lb = (const float*)KIN(9);
    for (int i = gt; i < 512; i += NT) { const float a0 = hg_lb[i], a1 = hg_lb[512 + i]; lbt[i] = 0.f; lbt[512 + i] = 1.f / (1.f + expf(a0 - a1)); }
    if (gt < 2) {
        const float* lp = (const float*)KIN(7) + gt * 256; float s1 = 0.f, s2 = 0.f;
        for (int i = 0; i < 64; ++i) { s1 += lp[i] * lp[64 + i]; s2 += lp[128 + i] * lp[192 + i]; }
        const float lam_init = gt == 0 ? 0.2f : 0.35550906759096934f;
        lbt[1024 + gt] = expf(s1) - expf(s2) + lam_init;
    }
}
__device__ __forceinline__ void p_xload(Frame& F_, int g) {
    KA_WS();
    Frame F = mkframe(F_.lds);
    const f32x4* x = (const f32x4*)((const float*)KIN(0) + (size_t)g * TG * D);
    u32x2* o = (u32x2*)((bf16*)(ws + WS_XB));
    for (size_t i = (size_t)blockIdx.x * NTHR + F.tid; i < (size_t)TG * D / 4; i += (size_t)gridDim.x * NTHR) { const f32x4 v = x[i]; u32x2 w; w.x = pk2(v.x, v.y); w.y = pk2(v.z, v.w); o[i] = w; }
}

__device__ __forceinline__ void p2_conv_unit(Frame& F, unsigned char* ws, KArgs ka, int l, int cu) {
    const float* cw = (const float*)KIN(3) + (size_t)l * 31 * 512; const float* cb = (const float*)KIN(4) + l * 512;
    const float* lg = (const float*)KIN(5) + l * 512; const float* lb = (const float*)KIN(6) + l * 512;
    const bf16* __restrict__ U = (const bf16*)(ws + WS_U); bf16* __restrict__ YA = (bf16*)(ws + WS_YA);
    LAS float* Yt = (LAS float*)F.lds;
    const int lane = F.lane, wave = F.wave, hf = wave >> 2, c = 128 * (wave & 3) + 2 * lane;
    const int tb = cu * 64 + 32 * hf, sb = tb & (S - 1);
    f32x2 wt[31], uf[62];
#pragma unroll
    for (int j = 0; j < 31; ++j) wt[j] = *(const f32x2*)(cw + j * 512 + c);
#pragma unroll
    for (int k = 0; k < 62; ++k) { unsigned w = 0u; if (sb - 30 + k >= 0) w = *(const unsigned*)(U + (size_t)(tb - 30 + k) * 512 + c); uf[k] = (f32x2){lo16(w), hi16(w)}; }
    const f32x2 bias = *(const f32x2*)(cb + c);
    __syncthreads();
#pragma unroll
    for (int tt = 0; tt < 32; ++tt) { f32x2 acc = bias;
#pragma unroll
        for (int j = 0; j < 31; ++j) acc = acc + uf[tt + j] * wt[j];
        *(LAS f32x2*)(Yt + (32 * hf + tt) * 512 + c) = acc; }
    __syncthreads();
    const int c0 = lane * 8;
#pragma unroll 2
    for (int i = 0; i < 8; ++i) { const int tl = wave * 8 + i;
        const f32x4 a0 = *(const LAS f32x4*)(Yt + tl * 512 + c0), a1 = *(const LAS f32x4*)(Yt + tl * 512 + c0 + 4);
        float acc[8] = {a0.x, a0.y, a0.z, a0.w, a1.x, a1.y, a1.z, a1.w};
        float sm = 0.f;
#pragma unroll
        for (int q = 0; q < 8; ++q) sm += acc[q];
        const float mean = wave_sum(sm) * (1.f / 512.f); float sq = 0.f;
#pragma unroll
        for (int q = 0; q < 8; ++q) { acc[q] -= mean; sq += acc[q] * acc[q]; }
        const float rstd = __builtin_amdgcn_rsqf(wave_sum(sq) * (1.f / 512.f) + EPS);
        const f32x4 g0 = *(const f32x4*)(lg + c0), g1 = *(const f32x4*)(lg + c0 + 4), b0 = *(const f32x4*)(lb + c0), b1 = *(const f32x4*)(lb + c0 + 4);
        const float gg[8] = {g0.x, g0.y, g0.z, g0.w, g1.x, g1.y, g1.z, g1.w}, bb[8] = {b0.x, b0.y, b0.z, b0.w, b1.x, b1.y, b1.z, b1.w};
        float y[8];
#pragma unroll
        for (int q = 0; q < 8; ++q) { const float z = acc[q] * rstd * gg[q] + bb[q]; y[q] = z * __builtin_amdgcn_rcpf(1.f + __expf(-z)); }
        u32x4 o; o.x = pk2(y[0], y[1]); o.y = pk2(y[2], y[3]); o.z = pk2(y[4], y[5]); o.w = pk2(y[6], y[7]);
        *(u32x4*)(YA + (size_t)(cu * 64 + tl) * 512 + c0) = o;
    }
    __syncthreads();
}
#include <hip/hip_bf16.h>
#include <cmath>
namespace attn_body {
using bf16=__hip_bfloat16;
using bf16x8=__attribute__((ext_vector_type(8)))short;
using s16x4=__attribute__((ext_vector_type(4)))short;
using f32x16=__attribute__((ext_vector_type(16)))float;
using u32x4=__attribute__((ext_vector_type(4)))unsigned;
constexpr int SEQ=2048,D=64,DMI=512,DMO=1024;
constexpr int NW=8,QBLK=32,QB=QBLK*NW,KVBLK=64,NQB=SEQ/QB;
constexpr int ATTN_UNIT_ROWS=QB;
__device__ __forceinline__ int crow(int r,int hi){return (r&3)+8*(r>>2)+4*hi;}
#define SBAR() __builtin_amdgcn_sched_barrier(0)
__device__ __forceinline__ void cmask(f32x16&p0,f32x16&p1,int jb,int qrel,int hi){
  const float NEG=-INFINITY; int kb=64*jb+4*hi;
  #pragma unroll
  for(int r=0;r<16;++r){int kv=kb+(r&3)+8*(r>>2); if(kv>qrel)p0[r]=NEG; if(kv+32>qrel)p1[r]=NEG;}
}

constexpr int NSLOT=3, SLOTB=8192;
constexpr int LDS_K=0, LDS_V=NSLOT*SLOTB, LDS_WS=2*NSLOT*SLOTB, LDS_OST=LDS_WS+NW*64*4, LDS_BYTES=LDS_OST+NW*4096;
constexpr float C2=0.125f*1.4426950408889634f;
__device__ __forceinline__ void glds16(const void*gsrc,unsigned lds_dst){unsigned keep;
  asm volatile("s_mov_b32 %0, m0\n\ts_mov_b32 m0, %2\n\ts_nop 0\n\tglobal_load_lds_dwordx4 %1, off\n\ts_mov_b32 m0, %0":"=&s"(keep):"v"(gsrc),"s"(lds_dst):"memory");}
__device__ __forceinline__ float max3f(float a,float b,float c){float r;asm("v_max3_f32 %0, %1, %2, %3":"=v"(r):"v"(a),"v"(b),"v"(c));return r;}
__device__ __forceinline__ float max2f(float a,float b){float r;asm("v_max_f32_e32 %0, %1, %2":"=v"(r):"v"(a),"v"(b));return r;}
__device__ __forceinline__ float fadd_s(float a,float b){float r;asm("v_add_f32_e32 %0, %1, %2":"=v"(r):"v"(a),"v"(b));return r;}
__device__ __forceinline__ float fsub_s(float a,float b){float r;asm("v_sub_f32_e32 %0, %1, %2":"=v"(r):"v"(a),"v"(b));return r;}
typedef float f32x2_t __attribute__((ext_vector_type(2))); typedef __bf16 bf16x2_t __attribute__((ext_vector_type(2)));
__device__ __forceinline__ unsigned cvtpk_s(float lo,float hi){f32x2_t v={lo,hi};bf16x2_t b=__builtin_convertvector(v,bf16x2_t);return __builtin_bit_cast(unsigned,b);}
#define WAIT_BAR(N) asm volatile("s_waitcnt vmcnt(" #N ") lgkmcnt(0)\n\ts_barrier":::"memory")

__device__ __forceinline__ void qkt(f32x16&p0,f32x16&p1,const char*Kslot,const bf16x8*qr,const f32x16&negm,int r32,int hi){
  const char*kb=Kslot+hi*1024+r32*16;
  #pragma unroll
  for(int d0=0;d0<4;++d0){
    const bf16x8 b0=*reinterpret_cast<const bf16x8*>(kb+d0*2048);
    const bf16x8 b1=*reinterpret_cast<const bf16x8*>(kb+d0*2048+512);
    if(d0==0){p0=__builtin_amdgcn_mfma_f32_32x32x16_bf16(b0,qr[0],negm,0,0,0);p1=__builtin_amdgcn_mfma_f32_32x32x16_bf16(b1,qr[0],negm,0,0,0);}
    else{p0=__builtin_amdgcn_mfma_f32_32x32x16_bf16(b0,qr[d0],p0,0,0,0);p1=__builtin_amdgcn_mfma_f32_32x32x16_bf16(b1,qr[d0],p1,0,0,0);}}
}
typedef __attribute__((address_space(3))) const char* lds_cptr;
typedef short v4i16_t __attribute__((ext_vector_type(4)));
__device__ __forceinline__ void kload8(bf16x8*kf,lds_cptr kp){
  kf[0]=*(const __attribute__((address_space(3))) bf16x8*)(kp);      kf[1]=*(const __attribute__((address_space(3))) bf16x8*)(kp+512);
  kf[2]=*(const __attribute__((address_space(3))) bf16x8*)(kp+2048); kf[3]=*(const __attribute__((address_space(3))) bf16x8*)(kp+2560);
  kf[4]=*(const __attribute__((address_space(3))) bf16x8*)(kp+4096); kf[5]=*(const __attribute__((address_space(3))) bf16x8*)(kp+4608);
  kf[6]=*(const __attribute__((address_space(3))) bf16x8*)(kp+6144); kf[7]=*(const __attribute__((address_space(3))) bf16x8*)(kp+6656);
}
__device__ __forceinline__ void kload2(bf16x8*kf,lds_cptr kp,int j){ kf[2*j]=*(const __attribute__((address_space(3))) bf16x8*)(kp+j*2048); kf[2*j+1]=*(const __attribute__((address_space(3))) bf16x8*)(kp+j*2048+512); }
__device__ __forceinline__ s16x4 vtr(lds_cptr p){ return __builtin_bit_cast(s16x4,__builtin_amdgcn_ds_read_tr16_b64_v4i16((__attribute__((address_space(3))) v4i16_t*)p)); }
__device__ __forceinline__ float rowmax(const f32x16&p0,const f32x16&p1){
  float a=max3f(p0[0],p0[1],p1[0]),b=max3f(p0[2],p0[3],p1[1]);a=max3f(a,p1[2],p1[3]);
  #pragma unroll
  for(int r=4;r<16;r+=4){a=max3f(a,p0[r],p0[r+1]);b=max3f(b,p0[r+2],p0[r+3]);a=max3f(a,p1[r],p1[r+1]);b=max3f(b,p1[r+2],p1[r+3]);}
  const float m=max2f(a,b);
  auto rr=__builtin_amdgcn_permlane32_swap(__float_as_uint(m),__float_as_uint(m),false,false);
  return max2f(__uint_as_float(rr[0]),__uint_as_float(rr[1]));
}
__device__ __forceinline__ void pv(f32x16*o,int vb,bf16x8 pa0,bf16x8 pa1,bf16x8 pa2,bf16x8 pa3){
  #pragma unroll
  for(int d0=0;d0<2;++d0){s16x4 lo[4],hi[4];
    #pragma unroll
    for(int ks=0;ks<4;++ks){
      asm volatile("ds_read_b64_tr_b16 %0,%1 offset:%c2":"=&v"(lo[ks]):"v"(vb),"i"(d0*4096+ks*1024):"memory");
      asm volatile("ds_read_b64_tr_b16 %0,%1 offset:%c2":"=&v"(hi[ks]):"v"(vb),"i"(d0*4096+ks*1024+512):"memory");}
    asm volatile("s_waitcnt lgkmcnt(0)":::"memory");SBAR();
    #define PK(k) (bf16x8){lo[k][0],lo[k][1],lo[k][2],lo[k][3],hi[k][0],hi[k][1],hi[k][2],hi[k][3]}
    o[d0]=__builtin_amdgcn_mfma_f32_32x32x16_bf16(pa0,PK(0),o[d0],0,0,0);
    o[d0]=__builtin_amdgcn_mfma_f32_32x32x16_bf16(pa1,PK(1),o[d0],0,0,0);
    o[d0]=__builtin_amdgcn_mfma_f32_32x32x16_bf16(pa2,PK(2),o[d0],0,0,0);
    o[d0]=__builtin_amdgcn_mfma_f32_32x32x16_bf16(pa3,PK(3),o[d0],0,0,0);
    #undef PK
  }
}

#ifndef ATTN_STORE16
#define ATTN_STORE16(p,v) (*(u32x4*)(p)=(v))
#endif
template<int THRL> __device__ __forceinline__ void attn_unit(int qb,const bf16*Qb,const bf16*__restrict__ Kb,const bf16*__restrict__ Vb,bf16*Ob,char*shm){
  int tid_=threadIdx.x; asm volatile("":"+v"(tid_));
  const int tid=tid_,lane=tid&63,r32=lane&31,hi=lane>>5; const int wid=__builtin_amdgcn_readfirstlane(tid>>6);
  const int q0=qb*QB;
  const bf16*Qw=Qb+(long)(q0+wid*QBLK)*DMI;
  const bf16*Kh=Kb,*Vh=Vb;
  const unsigned lds0=(unsigned)(uintptr_t)shm;
  float*wsf=(float*)(shm+LDS_WS)+wid*64;
  const bf16*ksrc=Kh+(long)lane*DMI+wid*8;
  const bf16*vsrc=Vh+(long)(16*(wid&3)+(lane>>2))*DMI+(wid>>2)*32+(lane&3)*8;
  const unsigned kdst=lds0+LDS_K+wid*1024, vdst=lds0+LDS_V+wid*1024;
  #define DMA_K(t,slot) glds16(ksrc+(long)(t)*KVBLK*DMI,(unsigned)__builtin_amdgcn_readfirstlane(kdst+(slot)))
  #define DMA_V(t,slot) glds16(vsrc+(long)(t)*KVBLK*DMI,(unsigned)__builtin_amdgcn_readfirstlane(vdst+(slot)))
  const int vb0=(int)(lds0+LDS_V)+((lane>>4)&1)*32+(lane&3)*8+(4*hi+((lane&15)>>2))*64;
  const char*Kbase=shm+LDS_K; bf16x8 kf[8];
  const lds_cptr shm3=(lds_cptr)shm; const lds_cptr kp0=shm3+LDS_K+hi*1024+r32*16; const lds_cptr vp0=shm3+LDS_V+((lane>>4)&1)*32+(lane&3)*8+(4*hi+((lane&15)>>2))*64;
  const int NT=(q0+QB)/KVBLK;
  DMA_K(0,0);DMA_V(0,0);DMA_K(1,SLOTB);
  bf16x8 qr[4];
  #pragma unroll
  for(int d0=0;d0<4;++d0)qr[d0]=*reinterpret_cast<const bf16x8*>(&Qw[(long)r32*DMI+d0*16+hi*8]);
  float mhat=0.f,l_reg=0.f;f32x16 o[2];o[0]=f32x16{};o[1]=f32x16{};f32x16 negm=f32x16{};asm volatile("":"+v"(negm));
  const int qrel=wid*QBLK+r32;
  #define CMASK(P0,P1,t) do{int jb_=(t)-(NT-4); if(jb_>=0)cmask(P0,P1,jb_,qrel,hi);}while(0)
  bool resc=false;
  #define START(P0,P1) do{ const float rm=rowmax(P0,P1); resc=false; \
    { const float dl=rm; mhat=fadd_s(mhat,dl); \
      _Pragma("unroll") for(int r=0;r<16;++r){P0[r]=fsub_s(P0[r],dl);P1[r]=fsub_s(P1[r],dl);} \
      _Pragma("unroll") for(int r=0;r<16;++r)negm[r]=-mhat; asm volatile("":"+v"(negm)); } \
    _Pragma("unroll") for(int r=0;r<16;++r)P0[r]=__builtin_amdgcn_exp2f(P0[r]); }while(0)
  #define RESC() do{ if(resc){ asm volatile("s_waitcnt lgkmcnt(0)":::"memory"); \
      _Pragma("unroll") for(int d_=0;d_<2;++d_) _Pragma("unroll") for(int r=0;r<16;++r)o[d_][r]*=wsf[crow(r,hi)]; } }while(0)
  f32x16 pA0,pA1,pB0,pB1;
  int sl_prev=0,sl_cur=0,sl_next=SLOTB;
  #define ROT() do{sl_prev=sl_cur;sl_cur=sl_next;sl_next=(sl_next==(NSLOT-1)*SLOTB)?0:sl_next+SLOTB;}while(0)
  DMA_K(2,2*SLOTB);
  WAIT_BAR(3);
  qkt(pA0,pA1,Kbase,qr,negm,r32,hi);asm volatile("s_nop 15\n\ts_nop 7":"+v"(pA0),"+v"(pA1));CMASK(pA0,pA1,0);
  START(pA0,pA1);
  _Pragma("unroll") for(int r=0;r<16;++r)pA1[r]=__builtin_amdgcn_exp2f(pA1[r]);
  WAIT_BAR(0);
  DMA_K(3,0);DMA_V(1,SLOTB);
  ROT();
  kload8(kf,kp0+sl_cur);
  WAIT_BAR(2);
  s16x4 vlo[8],vhi[8]; u32x4 pw0,pw1,pw2,pw3;
  #define PKW(P,B) cvtpk_s(P[B],P[B+1])
  #define PAF(k) __builtin_bit_cast(bf16x8,pw##k)
  #define VFR(i) (bf16x8){vlo[i][0],vlo[i][1],vlo[i][2],vlo[i][3],vhi[i][0],vhi[i][1],vhi[i][2],vhi[i][3]}
  #define PIN(x) asm volatile("":"+v"(x))
  #define MX3(a,b,c) __builtin_fmaxf(__builtin_fmaxf((a),(b)),(c))
  #define GAPA(MF,A0,A1,A2,A3,W0,W1,PW) do{ MF; sacc+=A0; sacc+=A1; sacc+=A2; sacc+=A3; PIN(sacc); W0; W1; PIN(PW); SBAR(); }while(0)
  #define EX(v) __builtin_amdgcn_exp2f(v)
  #define GAPB(MF,X,B) do{ MF; X[B]=EX(X[B]); X[B+1]=EX(X[B+1]); X[B+2]=EX(X[B+2]); X[B+3]=EX(X[B+3]); PIN(X); SBAR(); }while(0)
  #define VRD(i) do{ vlo[i]=vtr(vp_+(((i)>>2)*4096+((i)&3)*1024)); vhi[i]=vtr(vp_+(((i)>>2)*4096+((i)&3)*1024+512)); }while(0)
  #define KRD(G,j) do{ if(G){ kload2(kf,kp0+sl_next,j); SBAR(); } }while(0)
  #define STEP(C0,C1,P0,P1,t,GK,GV,GL) do{ SBAR(); \
    const lds_cptr vp_=vp0+sl_prev; \
    VRD(0); SBAR(); float sacc=(P0[0]+P0[1]); \
    GAPA(C0=__builtin_amdgcn_mfma_f32_32x32x16_bf16(kf[0],qr[0],negm,0,0,0), P0[2],P0[3],P0[4],P0[5],     pw0[0]=PKW(P0,0), pw0[1]=PKW(P0,2), pw0); \
    VRD(4); SBAR(); GAPA(C1=__builtin_amdgcn_mfma_f32_32x32x16_bf16(kf[1],qr[0],negm,0,0,0), P0[6],P0[7],P0[8],P0[9],     pw0[2]=PKW(P0,4), pw0[3]=PKW(P0,6), pw0); \
    VRD(1); SBAR(); GAPA(C0=__builtin_amdgcn_mfma_f32_32x32x16_bf16(kf[2],qr[1],C0,0,0,0),   P0[10],P0[11],P0[12],P0[13], pw1[0]=PKW(P0,8), pw1[1]=PKW(P0,10), pw1); \
    VRD(5); SBAR(); GAPA(C1=__builtin_amdgcn_mfma_f32_32x32x16_bf16(kf[3],qr[1],C1,0,0,0),   P0[14],P0[15],P1[0],P1[1],   pw1[2]=PKW(P0,12),pw1[3]=PKW(P0,14), pw1); \
    VRD(2); SBAR(); GAPA(C0=__builtin_amdgcn_mfma_f32_32x32x16_bf16(kf[4],qr[2],C0,0,0,0),   P1[2],P1[3],P1[4],P1[5],     pw2[0]=PKW(P1,0), pw2[1]=PKW(P1,2), pw2); \
    VRD(6); SBAR(); GAPA(C1=__builtin_amdgcn_mfma_f32_32x32x16_bf16(kf[5],qr[2],C1,0,0,0),   P1[6],P1[7],P1[8],P1[9],     pw2[2]=PKW(P1,4), pw2[3]=PKW(P1,6), pw2); \
    VRD(3); SBAR(); GAPA(C0=__builtin_amdgcn_mfma_f32_32x32x16_bf16(kf[6],qr[3],C0,0,0,0),   P1[10],P1[11],P1[12],P1[13], pw3[0]=PKW(P1,8), pw3[1]=PKW(P1,10), pw3); \
    VRD(7); SBAR(); GAPA(C1=__builtin_amdgcn_mfma_f32_32x32x16_bf16(kf[7],qr[3],C1,0,0,0),   P1[14],P1[15],0.f,0.f,       pw3[2]=PKW(P1,12),pw3[3]=PKW(P1,14), pw3); \
    l_reg+=sacc; \
    if(GK){DMA_K((t)+3,sl_cur);} if(GV){DMA_V((t)+1,sl_next);} \
    CMASK(C0,C1,t); \
    { float a=MX3(C0[0],C0[1],C1[0]),b=MX3(C0[2],C0[3],C1[1]); a=MX3(a,C1[2],C1[3]); \
      _Pragma("unroll") for(int r=4;r<16;r+=4){a=MX3(a,C0[r],C0[r+1]);b=MX3(b,C0[r+2],C0[r+3]);a=MX3(a,C1[r],C1[r+1]);b=MX3(b,C1[r+2],C1[r+3]);} \
      float rm=__builtin_fmaxf(a,b); { auto rr=__builtin_amdgcn_permlane32_swap(__float_as_uint(rm),__float_as_uint(rm),false,false); rm=__builtin_fmaxf(__uint_as_float(rr[0]),__uint_as_float(rr[1])); } \
      resc=false; \
      if(__builtin_expect(__any(rm>(float)THRL),0)){ const float dl=__builtin_fmaxf(rm,0.f); mhat+=dl; \
        _Pragma("unroll") for(int r=0;r<16;++r){C0[r]-=dl;C1[r]-=dl;} \
        _Pragma("unroll") for(int r=0;r<16;++r)negm[r]=-mhat; asm volatile("":"+v"(negm)); \
        const float f=__builtin_amdgcn_exp2f(-dl); l_reg*=f; if(hi==0)wsf[r32]=f; resc=true; } } \
    SBAR(); \
    GAPB(o[0]=__builtin_amdgcn_mfma_f32_32x32x16_bf16(PAF(0),VFR(0),o[0],0,0,0), C0,0); \
    GAPB(o[1]=__builtin_amdgcn_mfma_f32_32x32x16_bf16(PAF(0),VFR(4),o[1],0,0,0), C0,4); \
    KRD(GL,0); GAPB(o[0]=__builtin_amdgcn_mfma_f32_32x32x16_bf16(PAF(1),VFR(1),o[0],0,0,0), C0,8); \
    KRD(GL,1); GAPB(o[1]=__builtin_amdgcn_mfma_f32_32x32x16_bf16(PAF(1),VFR(5),o[1],0,0,0), C0,12); \
    KRD(GL,2); GAPB(o[0]=__builtin_amdgcn_mfma_f32_32x32x16_bf16(PAF(2),VFR(2),o[0],0,0,0), C1,0); \
    KRD(GL,3); GAPB(o[1]=__builtin_amdgcn_mfma_f32_32x32x16_bf16(PAF(2),VFR(6),o[1],0,0,0), C1,4); \
    GAPB(o[0]=__builtin_amdgcn_mfma_f32_32x32x16_bf16(PAF(3),VFR(3),o[0],0,0,0), C1,8); \
    GAPB(o[1]=__builtin_amdgcn_mfma_f32_32x32x16_bf16(PAF(3),VFR(7),o[1],0,0,0), C1,12); \
    }while(0)
  int t=1;
  #undef CMASK
  #define CMASK(P0,P1,t) do{}while(0)
  for(;t+5<NT;t+=2){
    STEP(pB0,pB1,pA0,pA1,t,true,true,true);     WAIT_BAR(2); RESC(); ROT();
    STEP(pA0,pA1,pB0,pB1,t+1,true,true,true);   WAIT_BAR(2); RESC(); ROT();
  }
  #undef CMASK
  #define CMASK(P0,P1,t) do{int jb_=(t)-(NT-4); if(jb_>=0)cmask(P0,P1,jb_,qrel,hi);}while(0)
  #define ENDW(tt) do{ if((tt)+3<NT){WAIT_BAR(2);} else if((tt)+2<NT){WAIT_BAR(1);} else {WAIT_BAR(0);} }while(0)
  for(;t+1<NT;t+=2){
    STEP(pB0,pB1,pA0,pA1,t,(t+3<NT),(t+1<NT),(t+1<NT));       ENDW(t);   RESC(); ROT();
    STEP(pA0,pA1,pB0,pB1,t+1,(t+4<NT),(t+2<NT),(t+2<NT));     ENDW(t+1); RESC(); ROT();
  }
  STEP(pB0,pB1,pA0,pA1,NT-1,false,false,false); RESC();
  { float sacc=pB0[0]+pB0[1]; _Pragma("unroll") for(int r=2;r<16;++r)sacc+=pB0[r]; _Pragma("unroll") for(int r=0;r<16;++r)sacc+=pB1[r]; l_reg+=sacc;
    pw0=(u32x4){PKW(pB0,0),PKW(pB0,2),PKW(pB0,4),PKW(pB0,6)};pw1=(u32x4){PKW(pB0,8),PKW(pB0,10),PKW(pB0,12),PKW(pB0,14)};pw2=(u32x4){PKW(pB1,0),PKW(pB1,2),PKW(pB1,4),PKW(pB1,6)};pw3=(u32x4){PKW(pB1,8),PKW(pB1,10),PKW(pB1,12),PKW(pB1,14)};
    SBAR(); pv(o,vb0+sl_cur,PAF(0),PAF(1),PAF(2),PAF(3)); }
  #undef PKW
  #undef PAF
  #undef VFR
  #undef PIN
  #undef MX3
  #undef GAPA
  #undef GAPB
  #undef EX
  #undef VRD
  #undef KRD
  #undef STEP
  #undef ENDW
  {auto rr=__builtin_amdgcn_permlane32_swap(__float_as_uint(l_reg),__float_as_uint(l_reg),false,false);l_reg=__uint_as_float(rr[0])+__uint_as_float(rr[1]);}
  if(hi==0)wsf[32+r32]=l_reg;asm volatile("s_waitcnt lgkmcnt(0)":::"memory");
  float rli[16];
  #pragma unroll
  for(int r=0;r<16;++r)rli[r]=__builtin_amdgcn_rcpf(wsf[32+crow(r,hi)]);
  bf16*Ow=Ob+(long)(q0+wid*QBLK)*DMO;
  { bf16*stg=(bf16*)(shm+LDS_OST)+wid*2048;
    #pragma unroll
    for(int r=0;r<16;++r){const int orow=crow(r,hi);
      #pragma unroll
      for(int d0=0;d0<2;++d0)stg[orow*64+d0*32+r32]=__float2bfloat16(o[d0][r]*rli[r]);}
    asm volatile("s_waitcnt lgkmcnt(0)":::"memory");
    #pragma unroll
    for(int i=0;i<4;++i){const int row=i*8+(lane>>3),ch=lane&7; const u32x4 v=*(const u32x4*)(stg+row*64+ch*8); ATTN_STORE16(Ow+(long)row*DMO+ch*8,v);} }
  asm volatile("s_waitcnt lgkmcnt(0)\n\ts_barrier":::"memory");
  #undef DMA_K
  #undef DMA_V
  #undef CMASK
  #undef START
  #undef RESC
  #undef ROT
}
constexpr int ATTN_LDS_BYTES=LDS_BYTES;
#undef SBAR
#undef WAIT_BAR
}
extern __shared__ __attribute__((aligned(16))) unsigned char g_lds[];
constexpr size_t WS_OV = WS_R;
__device__ __forceinline__ void p2c_hgrn(Frame& F_, int l, int unit);
template <int PART> __device__ __forceinline__ void p1_part(Frame& F_, int g, int l, int G, int c);
constexpr int CW_P1B = 24576;
constexpr int CW_Q = 20480;
constexpr int NQ_ATT = GB * 16 * 8, NQ_CONV = TG / 64;
__device__ __forceinline__ void p2_mixers(Frame& F_, int g, int l, int rep) {
    if (blockIdx.x < GB * 4) p2c_hgrn(F_, l, blockIdx.x);
    else {
        p1_part<1>(F_, g, l, (int)gridDim.x - GB * 4, (int)blockIdx.x - GB * 4);
        KArgs ka2 = kargs(); unsigned* pdone = (unsigned*)((unsigned char*)(GAS unsigned char*)ka2->ws + WS_CTL) + CW_P1B + 64 * (g * 2 + l);
        asm volatile("s_waitcnt vmcnt(0)" ::: "memory"); __syncthreads();
        if (threadIdx.x == 0) { __builtin_amdgcn_fence(__ATOMIC_RELEASE, "agent"); asm volatile("s_waitcnt vmcnt(0)" ::: "memory"); (void)__hip_atomic_fetch_add(pdone, 1u, __ATOMIC_RELAXED, __HIP_MEMORY_SCOPE_AGENT); }
    }
    KA_WS();
    Frame F = mkframe(F_.lds);
    const int xq = (int)(xb_xcc_id() & 7u);
    volatile LAS int* qslot = (volatile LAS int*)(F.lds + MISC_OFF + 128);
    bool conv_ok = false;
    constexpr int NQX = (NQ_ATT + NQ_CONV) / 8;
    unsigned* qbase = (unsigned*)(ws + WS_CTL) + CW_Q + 64 * ((g * 2 + l) * 8);
    int xcur = xq;
    for (;;) {
        __syncthreads();
        if (F.tid == 0) qslot[0] = (int)__hip_atomic_fetch_add(qbase + 64 * xcur, 1u, __ATOMIC_RELAXED, __HIP_MEMORY_SCOPE_AGENT);
        __syncthreads();
        int u = __builtin_amdgcn_readfirstlane(qslot[0]);
        if (u >= NQX) {
            __syncthreads();
            if (F.tid < 8) { const unsigned hd = __hip_atomic_load(qbase + 64 * F.tid, __ATOMIC_RELAXED, __HIP_MEMORY_SCOPE_AGENT); const unsigned long long m = __ballot(hd < (unsigned)NQX);
                if (F.tid == 0) qslot[1] = m ? (int)__builtin_ctzll(m) : -1; }
            __syncthreads();
            const int nx = __builtin_amdgcn_readfirstlane(qslot[1]);
            if (nx < 0) break;
            xcur = nx; continue;
        }
        const int xu = xcur;
        if (u >= NQ_ATT / 8 && !conv_ok) {
            unsigned* pdone = (unsigned*)(ws + WS_CTL) + CW_P1B + 64 * (g * 2 + l);
            if (F.tid == 0) { unsigned sp = 0; while (__hip_atomic_load(pdone, __ATOMIC_RELAXED, __HIP_MEMORY_SCOPE_AGENT) < gridDim.x - GB * 4) { __builtin_amdgcn_s_sleep(4); if (++sp > (1u << 22)) break; }
                __builtin_amdgcn_fence(__ATOMIC_ACQUIRE, "agent"); asm volatile("s_waitcnt vmcnt(0)" ::: "memory"); }
            __syncthreads(); conv_ok = true;
        }
        if (u < NQ_ATT / 8) {
            const int qb = 7 - u / (GB * 2), vhd = (u % (GB * 2)) * 8 + xu;
            const int bl = vhd >> 4, sh = (vhd >> 1) & 7, vh = vhd & 1;
            const attn_body::bf16* Qb = (const attn_body::bf16*)((bf16*)(ws + WS_Q) + (size_t)bl * S * 512 + sh * 64);
            const attn_body::bf16* Kb = (const attn_body::bf16*)((bf16*)(ws + WS_K) + (size_t)bl * S * 512 + sh * 64);
            const attn_body::bf16* Vb = (const attn_body::bf16*)((bf16*)(ws + WS_V) + (size_t)bl * S * 512 + (sh >> 1) * 128 + vh * 64);
            attn_body::bf16* Ob = (attn_body::bf16*)((bf16*)(ws + WS_OV) + (size_t)bl * S * 1024 + sh * 128 + vh * 64);
            attn_body::attn_unit<8>(qb, Qb, Kb, Vb, Ob, (char*)g_lds);
        } else { int ll = l; asm volatile("" : "+s"(ll)); p2_conv_unit(F, ws, ka, ll, (u - NQ_ATT / 8) * 8 + xu); }
    }
}
__device__ __forceinline__ void p2d_combine(Frame& F_, int l) {
    KA_WS();
    Frame F = mkframe(F_.lds);
    const float lam = ((const float*)(ws + WS_LB))[1024 + l]; const float lam_init = l == 0 ? 0.2f : 0.35550906759096934f;
    const float* ng = (const float*)KIN(8) + l * 128;
    const int lane = F.lane; const float g0 = ng[lane * 2] * (1.f - lam_init), g1 = ng[lane * 2 + 1] * (1.f - lam_init);
    const bf16* __restrict__ OV = (const bf16*)(ws + WS_OV); bf16* __restrict__ YB = (bf16*)(ws + WS_YB);
    const int per = TG / (gridDim.x * NWAVES);
    const int t0 = (blockIdx.x * NWAVES + F.wave) * per;
#pragma unroll 1
    for (int i = 0; i < per; i += 2) {
        unsigned a[2][8];
#pragma unroll
        for (int rr = 0; rr < 2; ++rr)
#pragma unroll
            for (int k = 0; k < 8; ++k) a[rr][k] = *(const unsigned*)(OV + (size_t)(t0 + i + rr) * 1024 + k * 128 + lane * 2);
#pragma unroll
        for (int rr = 0; rr < 2; ++rr)
#pragma unroll
            for (int h = 0; h < 4; ++h) { const unsigned a1 = a[rr][2 * h], a2 = a[rr][2 * h + 1];
                const float o0 = lo16(a1) - lam * lo16(a2), o1 = hi16(a1) - lam * hi16(a2);
                const float rr2 = __builtin_amdgcn_rsqf(wave_sum(o0 * o0 + o1 * o1) * (1.f / 128.f) + EPS);
                *(unsigned*)(YB + (size_t)(t0 + i + rr) * 512 + h * 128 + lane * 2) = pk2(o0 * rr2 * g0, o1 * rr2 * g1); }
    }
}

namespace hg {
typedef short bf16x8 __attribute__((ext_vector_type(8)));
typedef float f32x16 __attribute__((ext_vector_type(16)));
constexpr int ST = 272, STT = 80, RS = 264;
constexpr int O_Q1 = 0, O_KT = 8704, O_KTT = 17408, O_VT = 27648, O_D = 37888, OPS = 38400;
constexpr int L_O = 2 * OPS;
static_assert(L_O + 2 * 16384 <= MISC_OFF, "HGRN LDS map");
__device__ __forceinline__ void lbar() { asm volatile("s_waitcnt lgkmcnt(0)" ::: "memory"); __builtin_amdgcn_s_barrier(); asm volatile("" ::: "memory"); }
__device__ __forceinline__ bf16x8 pack8(const f32x16& x, int b) {
    u32x4 w; w.x = pg8::cvt_pk_bf16(x[b], x[b + 1]); w.y = pg8::cvt_pk_bf16(x[b + 2], x[b + 3]); w.z = pg8::cvt_pk_bf16(x[b + 4], x[b + 5]); w.w = pg8::cvt_pk_bf16(x[b + 6], x[b + 7]);
    return __builtin_bit_cast(bf16x8, w);
}
__device__ __forceinline__ bf16x8 ld2x8(const LAS unsigned char* p) {
    const u32x2 a = *(const LAS u32x2*)p, b = *(const LAS u32x2*)(p + 16); u32x4 w; w.x = a.x; w.y = a.y; w.z = b.x; w.w = b.y; return __builtin_bit_cast(bf16x8, w);
}
__device__ __forceinline__ float quad_bcast(float v, int which) {
    const int iv = __builtin_bit_cast(int, v); int r;
    if (which == 0) r = __builtin_amdgcn_update_dpp(0, iv, 0x00, 0xF, 0xF, true); else if (which == 1) r = __builtin_amdgcn_update_dpp(0, iv, 0x55, 0xF, 0xF, true);
    else if (which == 2) r = __builtin_amdgcn_update_dpp(0, iv, 0xAA, 0xF, 0xF, true); else r = __builtin_amdgcn_update_dpp(0, iv, 0xFF, 0xF, 0xF, true);
    return __builtin_bit_cast(float, r);
}
}
__device__ __forceinline__ void p2c_hgrn(Frame& F_, int l, int unit) {
    KA_WS();
    Frame F = mkframe(F_.lds);
    using namespace hg;
    const int bl = unit >> 2, h = unit & 3;
    LAS unsigned char* lds = F.lds;
    const int lane = F.lane, wave = F.wave, r32 = lane & 31, hi = lane >> 5;
    const size_t rb = ((size_t)(bl * 4 + h) * S) * 128;
    const size_t rbY = ((size_t)bl * S) * 512 + h * 128;
    const bf16* HQ = (const bf16*)(ws + WS_HQ) + rb; const bf16* HF = (const bf16*)(ws + WS_HF) + rb; const bf16* HV = (const bf16*)(ws + WS_HV) + rb; const bf16* HG = (const bf16*)(ws + WS_HG) + rb;
    bf16* YC = (bf16*)(ws + WS_YC) + rbY;
    const bool isP = wave >= 4;
    const int pw = wave & 3;
    __syncthreads();
    if (isP) {
        const float* ng = (const float*)KIN(10) + l * 128;
        const float n0 = ng[2 * lane], n1 = ng[2 * lane + 1];
        const int cpi = 16 * pw + (lane >> 2), tq = lane & 3;
        unsigned rawA[24], rawB[24], rawC[24]; unsigned gA[8], gB[8], gC[8];
#pragma unroll
        for (int k = 0; k < 24; ++k) { rawA[k] = 0u; rawB[k] = 0u; rawC[k] = 0u; }
#pragma unroll
        for (int k = 0; k < 8; ++k) { gA[k] = 0u; gB[k] = 0u; gC[k] = 0u; }
#define HG_LOAD(SET, n) do { _Pragma("unroll") for (int j = 0; j < 8; ++j) { const size_t go = (size_t)((n) * 32 + 8 * tq + j) * 128 + 2 * cpi; \
            SET[j] = *(const unsigned*)(HF + go); SET[8 + j] = *(const unsigned*)(HQ + go); SET[16 + j] = *(const unsigned*)(HV + go); } } while (0)
#define HG_GLOAD(GS, n) do { _Pragma("unroll") for (int jj = 0; jj < 8; ++jj) GS[jj] = *(const unsigned*)(HG + (size_t)((n) * 32 + 8 * pw + jj) * 128 + 2 * lane); } while (0)
        HG_LOAD(rawA, 0); HG_LOAD(rawB, 1); HG_LOAD(rawC, 2); HG_GLOAD(gA, 0);
#define HG_PITER(i, RS_, GU) do { \
            if ((i) + 1 <= 63) hg_prep(lds, RS_, (i) + 1, cpi, tq); \
            if ((i) + 4 <= 63) HG_LOAD(RS_, (i) + 4); \
            if ((i) >= 1 && (i) <= 64) hg_finish(lds, (i) - 1, pw, lane, n0, n1, GU); \
            if ((i) + 2 <= 63) HG_GLOAD(GU, (i) + 2); \
            lbar(); } while (0)
        auto hg_prep = [&](LAS unsigned char* lds_, const unsigned (&R_)[24], int n, int cpi_, int tq_) __attribute__((always_inline)) {
            LAS unsigned char* op = lds_ + (n & 1) * OPS;
            float p0[8], p1[8], l0[8], l1[8];
#pragma unroll
            for (int j = 0; j < 8; ++j) { const unsigned w = R_[j]; const float x0 = lo16(w) * 1.4426950408889634f, x1 = hi16(w) * 1.4426950408889634f;
                l0[j] = x0; l1[j] = x1; p0[j] = j ? p0[j - 1] + x0 : x0; p1[j] = j ? p1[j - 1] + x1 : x1; }
            float base0 = 0.f, base1 = 0.f, bl0 = 0.f, bl1 = 0.f;
#pragma unroll
            for (int q = 0; q < 4; ++q) { const float t0 = quad_bcast(p0[7], q), t1 = quad_bcast(p1[7], q); bl0 += t0; bl1 += t1; if (q < tq_) { base0 += t0; base1 += t1; } }
            unsigned ka[4], kb[4], va[4], vb4[4];
#pragma unroll
            for (int j = 0; j < 8; ++j) { const int t = 8 * tq_ + j;
                const float b0 = fmaxf(base0 + p0[j], -115.f), b1 = fmaxf(base1 + p1[j], -115.f);
                const float e0 = __builtin_amdgcn_exp2f(b0), e1 = __builtin_amdgcn_exp2f(b1), i0 = __builtin_amdgcn_exp2f(-b0), i1 = __builtin_amdgcn_exp2f(-b1);
                const float k0 = 1.f - __builtin_amdgcn_exp2f(l0[j]), k1 = 1.f - __builtin_amdgcn_exp2f(l1[j]);
                const unsigned qw = R_[8 + j], vw = R_[16 + j];
                const unsigned q1w = pg8::cvt_pk_bf16(lo16(qw) * e0, hi16(qw) * e1), ktw = pg8::cvt_pk_bf16(k0 * i0, k1 * i1);
                *(LAS unsigned*)(op + O_Q1 + t * ST + cpi_ * 4) = q1w; *(LAS unsigned*)(op + O_KT + t * ST + cpi_ * 4) = ktw;
                if (j & 1) { ka[j >> 1] |= ktw << 16; kb[j >> 1] |= ktw & 0xffff0000u; va[j >> 1] |= vw << 16; vb4[j >> 1] |= vw & 0xffff0000u; }
                else { ka[j >> 1] = ktw & 0xffffu; kb[j >> 1] = ktw >> 16; va[j >> 1] = vw & 0xffffu; vb4[j >> 1] = vw >> 16; } }
            *(LAS u32x4*)(op + O_KTT + (2 * cpi_) * STT + 16 * tq_) = (u32x4){ka[0], ka[1], ka[2], ka[3]}; *(LAS u32x4*)(op + O_KTT + (2 * cpi_ + 1) * STT + 16 * tq_) = (u32x4){kb[0], kb[1], kb[2], kb[3]};
            *(LAS u32x4*)(op + O_VT + (2 * cpi_) * STT + 16 * tq_) = (u32x4){va[0], va[1], va[2], va[3]}; *(LAS u32x4*)(op + O_VT + (2 * cpi_ + 1) * STT + 16 * tq_) = (u32x4){vb4[0], vb4[1], vb4[2], vb4[3]};
            if (tq_ == 3) *(LAS f32x2*)(op + O_D + cpi_ * 8) = (f32x2){__builtin_amdgcn_exp2f(fmaxf(bl0, -115.f)), __builtin_amdgcn_exp2f(fmaxf(bl1, -115.f))};
        };
        auto hg_finish = [&](LAS unsigned char* lds_, int j, int pw_, int lane_, float n0_, float n1_, const unsigned (&gt_)[8]) __attribute__((always_inline)) {
            LAS float* Ot = (LAS float*)(lds_ + L_O + (j & 1) * 16384);
            f32x2 ov[8];
#pragma unroll
            for (int jj = 0; jj < 8; ++jj) ov[jj] = *(const LAS f32x2*)(Ot + (8 * pw_ + jj) * 128 + 2 * lane_);
            asm volatile("s_waitcnt lgkmcnt(0)" ::: "memory");
#pragma unroll
            for (int jj = 0; jj < 8; ++jj) { const int t = 8 * pw_ + jj; const f32x2 o = ov[jj];
                const float rr = __builtin_amdgcn_rsqf(wave_sum(o.x * o.x + o.y * o.y) * (1.f / 128.f) + EPS);
                *(LAS unsigned*)((LAS unsigned char*)Ot + t * 512 + 4 * lane_) = pk2(o.x * rr * n0_ * lo16(gt_[jj]), o.y * rr * n1_ * hi16(gt_[jj])); }
        };
#pragma unroll 1
        for (int i = -1; i <= 62; i += 3) { HG_PITER(i, rawA, gB); HG_PITER(i + 1, rawB, gC); HG_PITER(i + 2, rawC, gA); }
        lbar();
#undef HG_PITER
#undef HG_LOAD
#undef HG_GLOAD
    } else {
        const int vb = pw;
        f32x16 Sacc[4];
#pragma unroll
        for (int cb = 0; cb < 4; ++cb)
#pragma unroll
            for (int r = 0; r < 16; ++r) Sacc[cb][r] = 0.f;
#pragma unroll 1
        for (int i = -1; i <= 65; ++i) {
            if (vb < 2 && i >= 2) {
                const LAS unsigned char* yt = lds + L_O + (i & 1) * 16384 + vb * 128;
#pragma unroll
                for (int k = 0; k < 4; ++k) { const int row = 8 * k + (lane >> 3), c16 = lane & 7;
                    *(u32x4*)(YC + (size_t)((i - 2) * 32 + row) * 512 + vb * 64 + c16 * 8) = *(const LAS u32x4*)(yt + row * 512 + c16 * 16); }
            }
            if (i >= 0 && i <= 63) {
                const LAS unsigned char* op = lds + (i & 1) * OPS;
                bf16x8 fk[8], fq[8], fp[8], fvp[2];
#pragma unroll
                for (int kc = 0; kc < 8; ++kc) { fk[kc] = *(const LAS bf16x8*)(op + O_KT + r32 * ST + (16 * kc + 8 * hi) * 2); fq[kc] = *(const LAS bf16x8*)(op + O_Q1 + r32 * ST + (16 * kc + 8 * hi) * 2); }
#pragma unroll
                for (int kc = 0; kc < 8; ++kc) fp[kc] = ld2x8(op + O_Q1 + r32 * ST + (16 * kc + 4 * hi) * 2);
#pragma unroll
                for (int ks = 0; ks < 2; ++ks) fvp[ks] = ld2x8(op + O_VT + (32 * vb + r32) * STT + (16 * ks + 4 * hi) * 2);
                asm volatile("s_waitcnt lgkmcnt(0)" ::: "memory"); __builtin_amdgcn_sched_barrier(0);
                f32x16 X, o;
#pragma unroll
                for (int r = 0; r < 16; ++r) { X[r] = 0.f; o[r] = 0.f; }
#pragma unroll
                for (int kc = 0; kc < 8; ++kc) { X = __builtin_amdgcn_mfma_f32_32x32x16_bf16(fk[kc], fq[kc], X, 0, 0, 0);
                    o = __builtin_amdgcn_mfma_f32_32x32x16_bf16(fp[kc], pack8(Sacc[kc >> 1], 8 * (kc & 1)), o, 0, 0, 0); }
                __builtin_amdgcn_sched_barrier(0);
                bf16x8 fkt[8], fvn[2];
#pragma unroll
                for (int ks = 0; ks < 2; ++ks) fvn[ks] = *(const LAS bf16x8*)(op + O_VT + (32 * vb + r32) * STT + (16 * ks + 8 * hi) * 2);
#pragma unroll
                for (int cb = 0; cb < 4; ++cb)
#pragma unroll
                    for (int ks = 0; ks < 2; ++ks) fkt[2 * cb + ks] = *(const LAS bf16x8*)(op + O_KTT + (32 * cb + r32) * STT + (16 * ks + 8 * hi) * 2);
#pragma unroll
                for (int r = 0; r < 16; ++r) { const int sidx = (r & 3) + 8 * (r >> 2) + 4 * hi; X[r] = sidx <= r32 ? X[r] : 0.f; }
#pragma unroll
                for (int ks = 0; ks < 2; ++ks) o = __builtin_amdgcn_mfma_f32_32x32x16_bf16(pack8(X, 8 * ks), fvp[ks], o, 0, 0, 0);
                asm volatile("s_waitcnt lgkmcnt(0)" ::: "memory"); __builtin_amdgcn_sched_barrier(0);
#pragma unroll
                for (int cb = 0; cb < 4; ++cb)
#pragma unroll
                    for (int ks = 0; ks < 2; ++ks) Sacc[cb] = __builtin_amdgcn_mfma_f32_32x32x16_bf16(fkt[2 * cb + ks], fvn[ks], Sacc[cb], 0, 0, 0);
                __builtin_amdgcn_sched_barrier(0);
                LAS float* Ot = (LAS float*)(lds + L_O + (i & 1) * 16384);
#pragma unroll
                for (int r = 0; r < 16; ++r) Ot[((r & 3) + 8 * (r >> 2) + 4 * hi) * 128 + 32 * vb + r32] = o[r];
#pragma unroll
                for (int cb = 0; cb < 4; ++cb)
#pragma unroll
                    for (int g4 = 0; g4 < 4; ++g4) { const f32x4 d = *(const LAS f32x4*)(op + O_D + (32 * cb + 8 * g4 + 4 * hi) * 4);
#pragma unroll
                        for (int j = 0; j < 4; ++j) Sacc[cb][4 * g4 + j] *= d[j]; }
            }
            lbar();
        }
    }
    __syncthreads();
}

__device__ __forceinline__ void p5_ln_route(Frame& F_, int g, int l, int bank) {
    KA_WS();
    Frame F = mkframe(F_.lds);
    typedef short bf16x8 __attribute__((ext_vector_type(8)));
    const float* lg = (const float*)KIN(14) + l * D; const float* lb = (const float*)KIN(15) + l * D;
    const float* bgp = (const float*)KIN(17) + l * 4; const float* be = (const float*)KIN(19) + l * 32;
    unsigned* cnt = ((unsigned*)(ws + WS_CTL)) + CW_CNT + bank * 32;
    constexpr int BS = 2064;
    LAS unsigned char* BT = F.lds; LAS float* LGT = (LAS float*)(F.lds + 48 * BS);
    LAS int* ent_e = (LAS int*)(F.lds + 48 * BS + 24576); LAS int* ent_pos = ent_e + 256; LAS float* ent_w = (LAS float*)(ent_pos + 256);
    const int lane = F.lane, wave = F.wave;
    constexpr int rows_per_wg = TG / 256;
    const int row0 = blockIdx.x * rows_per_wg, wrow0 = row0 + 16 * wave;
    const bf16* Rb = (const bf16*)(ws + WS_R); bf16* X1 = (bf16*)(ws + WS_X1);
    __syncthreads();
    u32x4 wreg[12];
    { const bf16* rw = (const bf16*)(ws + WS_RW) + (size_t)l * 2 * 48 * 1024;
#pragma unroll
      for (int k = 0; k < 12; ++k) { const int ch = F.tid + 512 * k; wreg[k] = *(const u32x4*)(rw + (size_t)(ch >> 7) * 1024 + (ch & 127) * 8); } }
    u32x2 rin[16][4];
#pragma unroll
    for (int r = 0; r < 16; ++r) { const u32x2* rp = (const u32x2*)(Rb + (size_t)(wrow0 + r) * D) + lane;
#pragma unroll
        for (int j = 0; j < 4; ++j) rin[r][j] = rp[64 * j]; }
#pragma unroll
    for (int k = 0; k < 12; ++k) { const int ch = F.tid + 512 * k; *(LAS u32x4*)(BT + (ch >> 7) * BS + (ch & 127) * 16) = wreg[k]; }
    f32x4 gg[4], bb[4];
#pragma unroll
    for (int j = 0; j < 4; ++j) { gg[j] = *(const f32x4*)(lg + lane * 4 + 256 * j); bb[j] = *(const f32x4*)(lb + lane * 4 + 256 * j); }
#pragma unroll
    for (int r = 0; r < 16; ++r) {
        f32x4 v[4]; float sm = 0.f;
#pragma unroll
        for (int j = 0; j < 4; ++j) { const u32x2 w = rin[r][j]; v[j] = (f32x4){lo16(w.x), hi16(w.x), lo16(w.y), hi16(w.y)}; sm += (v[j].x + v[j].y) + (v[j].z + v[j].w); }
        const float mean = wave_sum(sm) * (1.f / D); float s2 = 0.f;
#pragma unroll
        for (int j = 0; j < 4; ++j) { v[j] = v[j] - mean; s2 += (v[j].x * v[j].x + v[j].y * v[j].y) + (v[j].z * v[j].z + v[j].w * v[j].w); }
        const float rstd = __builtin_amdgcn_rsqf(wave_sum(s2) * (1.f / D) + EPS);
#pragma unroll
        for (int j = 0; j < 4; ++j) { const f32x4 y = v[j] * rstd * gg[j] + bb[j];
            *(u32x2*)(X1 + (size_t)(wrow0 + r) * D + lane * 4 + 256 * j) = (u32x2){pk2(y.x, y.y), pk2(y.z, y.w)}; }
    }
    asm volatile("s_waitcnt vmcnt(0)" ::: "memory");
    __syncthreads();
    {
        f32x4 acc[3];
#pragma unroll
        for (int nb = 0; nb < 3; ++nb) acc[nb] = (f32x4){0.f, 0.f, 0.f, 0.f};
        const bf16* xr = X1 + (size_t)(wrow0 + (lane & 15)) * D + 8 * (lane >> 4);
        const LAS unsigned char* bp = BT + (lane & 15) * BS + 16 * (lane >> 4);
#pragma unroll 8
        for (int ks = 0; ks < 32; ++ks) { const bf16x8 xa = *(const bf16x8*)(xr + 32 * ks);
#pragma unroll
            for (int nb = 0; nb < 3; ++nb) acc[nb] = __builtin_amdgcn_mfma_f32_16x16x32_bf16(xa, *(const LAS bf16x8*)(bp + nb * 16 * BS + 64 * ks), acc[nb], 0, 0, 0); }
        LAS float* lw = LGT + wave * 16 * 48;
#pragma unroll
        for (int nb = 0; nb < 3; ++nb)
#pragma unroll
            for (int i = 0; i < 4; ++i) lw[(4 * (lane >> 4) + i) * 48 + 16 * nb + (lane & 15)] = acc[nb][i];
        asm volatile("s_waitcnt lgkmcnt(0)" ::: "memory");
        if (lane < 16) {
            const LAS float* L0 = lw + lane * 48;
            float gl4[4];
#pragma unroll
            for (int e = 0; e < 4; ++e) gl4[e] = L0[e] + bgp[e];
            int gi = 0; float gm = gl4[0];
#pragma unroll
            for (int e = 1; e < 4; ++e) if (gl4[e] > gm) { gm = gl4[e]; gi = e; }
            float gs = 0.f;
#pragma unroll
            for (int e = 0; e < 4; ++e) gs += __expf(gl4[e] - gm);
            const float pgroup = 1.f / gs;
            float el[8];
#pragma unroll
            for (int e = 0; e < 8; ++e) el[e] = L0[4 + 8 * gi + e] + be[gi * 8 + e];
            int i0 = 0; float v0 = el[0];
#pragma unroll
            for (int e = 1; e < 8; ++e) if (el[e] > v0) { v0 = el[e]; i0 = e; }
            int i1 = -1; float v1 = -INFINITY;
#pragma unroll
            for (int e = 0; e < 8; ++e) if (e != i0 && el[e] > v1) { v1 = el[e]; i1 = e; }
            const float ex = __expf(v1 - v0); const float p0 = 1.f / (1.f + ex), p1 = ex * p0;
            const int ri = 16 * wave + lane;
            ent_e[ri * 2] = gi * 8 + i0; ent_e[ri * 2 + 1] = gi * 8 + i1; ent_w[ri * 2] = p0 * pgroup; ent_w[ri * 2 + 1] = p1 * pgroup;
        }
    }
    __syncthreads();
    LAS unsigned* lcnt = (LAS unsigned*)(ent_w + 256); LAS unsigned* lbase = lcnt + 32;
    if (F.tid < 32) lcnt[F.tid] = 0u;
    __syncthreads();
    int my_e = 0; unsigned my_rank = 0;
    if (F.tid < rows_per_wg * 2) { my_e = ent_e[F.tid]; my_rank = __hip_atomic_fetch_add((unsigned*)(lcnt + my_e), 1u, __ATOMIC_RELAXED, __HIP_MEMORY_SCOPE_WORKGROUP); }
    __syncthreads();
    if (F.tid < 32) { const unsigned c = lcnt[F.tid]; lbase[F.tid] = c ? __hip_atomic_fetch_add(cnt + F.tid, c, __ATOMIC_RELAXED, __HIP_MEMORY_SCOPE_AGENT) : 0u; }
    __syncthreads();
    if (F.tid < rows_per_wg * 2) { const unsigned pos = lbase[my_e] + my_rank; ent_pos[F.tid] = (int)pos; ((int*)(ws + WS_TOK))[(size_t)my_e * TG + pos] = row0 + (F.tid >> 1); }
    __syncthreads();
    if (F.tid < rows_per_wg) { const int i = F.tid; unsigned* r = ((unsigned*)(ws + WS_RT)) + (size_t)(row0 + i) * 8;
        r[0] = (unsigned)ent_e[2 * i]; r[1] = (unsigned)ent_pos[2 * i]; r[2] = __float_as_uint(ent_w[2 * i]); r[3] = (unsigned)ent_e[2 * i + 1]; r[4] = (unsigned)ent_pos[2 * i + 1]; r[5] = __float_as_uint(ent_w[2 * i + 1]); }
    __syncthreads();
}

constexpr int TAB_OFF = MISC_OFF + 256;
__device__ __forceinline__ void moe_table(Frame& F_, int g, int l);
__device__ __forceinline__ void p8_ln2(Frame& F_, int g, int l) {
    KA_WS();
    Frame F = mkframe(F_.lds);
    const float* lg = (const float*)KIN(23) + l * D; const float* lb = (const float*)KIN(24) + l * D;
    moe_table(F_, g, l);
    const LAS int* offs = (const LAS int*)(F.lds + TAB_OFF);
    const int lane = F.lane;
    const bf16* __restrict__ X1 = (const bf16*)(ws + WS_X1); const bf16* __restrict__ OM = (const bf16*)(ws + WS_OM);
    const int per = TG / (gridDim.x * NWAVES);
    const int t0 = (blockIdx.x * NWAVES + F.wave) * per;
    int ms0 = 0, ms1 = 0; float mw0 = 0.f, mw1 = 0.f;
    if (lane < per) { const unsigned* r = ((const unsigned*)(ws + WS_RT)) + (size_t)(t0 + lane) * 8; const u32x4 ra = *(const u32x4*)r; const u32x2 rb2 = *(const u32x2*)(r + 4);
        ms0 = offs[ra.x] * 256 + (int)ra.y; mw0 = __uint_as_float(ra.z); ms1 = offs[ra.w] * 256 + (int)rb2.x; mw1 = __uint_as_float(rb2.y); }
#pragma unroll 1
    for (int i = 0; i < per; i += 2) {
        u32x2 xa[2][4], oa[2][4], ob[2][4]; float w0[2], w1[2];
#pragma unroll
        for (int rr = 0; rr < 2; ++rr) {
            const int s0 = __builtin_amdgcn_readlane(ms0, i + rr), s1 = __builtin_amdgcn_readlane(ms1, i + rr);
            w0[rr] = __builtin_bit_cast(float, __builtin_amdgcn_readlane(__builtin_bit_cast(int, mw0), i + rr)); w1[rr] = __builtin_bit_cast(float, __builtin_amdgcn_readlane(__builtin_bit_cast(int, mw1), i + rr));
#pragma unroll
            for (int j = 0; j < 4; ++j) { const int d0 = lane * 4 + 256 * j;
                xa[rr][j] = *(const u32x2*)(X1 + (size_t)(t0 + i + rr) * D + d0); oa[rr][j] = *(const u32x2*)(OM + (size_t)s0 * D + d0); ob[rr][j] = *(const u32x2*)(OM + (size_t)s1 * D + d0); }
        }
#pragma unroll
        for (int rr = 0; rr < 2; ++rr) {
            const int t = t0 + i + rr;
            f32x4 v[4]; float sm = 0.f;
#pragma unroll
            for (int j = 0; j < 4; ++j) {
                v[j].x = ALPHA * lo16(xa[rr][j].x) + w0[rr] * lo16(oa[rr][j].x) + w1[rr] * lo16(ob[rr][j].x); v[j].y = ALPHA * hi16(xa[rr][j].x) + w0[rr] * hi16(oa[rr][j].x) + w1[rr] * hi16(ob[rr][j].x);
                v[j].z = ALPHA * lo16(xa[rr][j].y) + w0[rr] * lo16(oa[rr][j].y) + w1[rr] * lo16(ob[rr][j].y); v[j].w = ALPHA * hi16(xa[rr][j].y) + w0[rr] * hi16(oa[rr][j].y) + w1[rr] * hi16(ob[rr][j].y);
                sm += (v[j].x + v[j].y) + (v[j].z + v[j].w);
            }
            const float mean = wave_sum(sm) * (1.f / D); float s2 = 0.f;
#pragma unroll
            for (int j = 0; j < 4; ++j) { v[j] = v[j] - mean; s2 += (v[j].x * v[j].x + v[j].y * v[j].y) + (v[j].z * v[j].z + v[j].w * v[j].w); }
            const float rstd = __builtin_amdgcn_rsqf(wave_sum(s2) * (1.f / D) + EPS);
#pragma unroll
            for (int j = 0; j < 4; ++j) {
                const int d0 = lane * 4 + 256 * j; const f32x4 gg = *(const f32x4*)(lg + d0), bb = *(const f32x4*)(lb + d0);
                const f32x4 y = v[j] * rstd * gg + bb;
                if (l == NL - 1) *(f32x4*)(KOUT() + ((size_t)g * TG + t) * D + d0) = y;
                else *(u32x2*)((bf16*)(ws + WS_XB) + (size_t)t * D + d0) = (u32x2){pk2(y.x, y.y), pk2(y.z, y.w)};
            }
        }
    }
}

struct RmId { int off; __device__ __forceinline__ int operator()(int n0) const { return off + n0; } };
struct RmGlu { __device__ __forceinline__ int operator()(int n0) const { if (n0 >= 1024) return n0; const int hi = n0 >= 512, c = n0 - hi * 512; return (c >> 7) * 256 + hi * 128 + (c & 127); } };
struct RmIl { int hi; __device__ __forceinline__ int operator()(int n0) const { return (n0 >> 7) * 256 + hi * 128 + (n0 & 127); } };
template <class RM>
__device__ __forceinline__ void transpose_item(const float* W, int K, int N, bf16* WT, RM rowmap, LAS float* scr, int item, int lane) {
    const int nblk = N / 32, kb = item / nblk, nb = item % nblk, k0 = 64 * kb, n0 = 32 * nb;
#pragma unroll 8
    for (int i = 0; i < 32; ++i) { const int kk = 2 * i + (lane >> 5); scr[kk * 33 + (lane & 31)] = W[(size_t)(k0 + kk) * N + n0 + (lane & 31)]; }
    LDS_WAIT();
    const int c = lane & 7; const int r0 = rowmap(n0);
#pragma unroll
    for (int j = 0; j < 4; ++j) { const int n = (lane >> 3) + 8 * j; const LAS float* sp = scr + (8 * c) * 33 + n;
        u32x4 o; o.x = pk2(sp[0 * 33], sp[1 * 33]); o.y = pk2(sp[2 * 33], sp[3 * 33]); o.z = pk2(sp[4 * 33], sp[5 * 33]); o.w = pk2(sp[6 * 33], sp[7 * 33]);
        *(u32x4*)(WT + (size_t)(r0 + n) * K + k0 + 8 * c) = o; }
    LDS_WAIT();
}
__device__ __forceinline__ void p_wprep(Frame& F_) {
    KA_WS();
    Frame F = mkframe(F_.lds);
    LAS float* scr = (LAS float*)(F.lds + F.wave * 16384);
    const int gw = blockIdx.x * NWAVES + F.wave, NGW = gridDim.x * NWAVES, lane = F.lane;
    bf16* WIN = (bf16*)(ws + WS_WIN); bf16* WBR = (bf16*)(ws + WS_WBR); bf16* WOUT = (bf16*)(ws + WS_WOUT); bf16* W13 = (bf16*)(ws + WS_W13); bf16* W2 = (bf16*)(ws + WS_W2);
    constexpr int I_IN = 16 * 240, I_BR = 8 * 32, I_OUT = 16 * 32, I_W1 = 16 * 16, I_W2 = 8 * 32;
    constexpr int N_IN = 2 * I_IN, N_BR = 6 * I_BR, N_OUT = 2 * I_OUT, N_W1 = 64 * I_W1, N_W2 = 64 * I_W2;
    constexpr int NITEMS = N_IN + N_BR + N_OUT + 2 * N_W1 + N_W2;
    for (int it = gw; it < NITEMS; it += NGW) {
        int r = it;
        if (r < N_IN) { const int l = r / I_IN; transpose_item((const float*)KIN(2) + (size_t)l * D * INC, D, INC, WIN + (size_t)l * INC * D, RmGlu(), scr, r % I_IN, lane); continue; } r -= N_IN;
        if (r < N_BR) { const int q = r / I_BR; transpose_item((const float*)KIN(11) + (size_t)q * 512 * D, 512, D, WBR + (size_t)q * D * 512, RmId{0}, scr, r % I_BR, lane); continue; } r -= N_BR;
        if (r < N_OUT) { const int l = r / I_OUT; transpose_item((const float*)KIN(13) + (size_t)l * D * D, D, D, WOUT + (size_t)l * D * D, RmId{0}, scr, r % I_OUT, lane); continue; } r -= N_OUT;
        if (r < N_W1) { const int q = r / I_W1; transpose_item((const float*)KIN(20) + (size_t)q * D * DE, D, DE, W13 + (size_t)q * 1024 * D, RmIl{0}, scr, r % I_W1, lane); continue; } r -= N_W1;
        if (r < N_W1) { const int q = r / I_W1; transpose_item((const float*)KIN(21) + (size_t)q * D * DE, D, DE, W13 + (size_t)q * 1024 * D, RmIl{1}, scr, r % I_W1, lane); continue; } r -= N_W1;
        { const int q = r / I_W2; transpose_item((const float*)KIN(22) + (size_t)q * DE * D, DE, D, W2 + (size_t)q * D * DE, RmId{0}, scr, r % I_W2, lane); }
    }
}

template <int PART> __device__ __forceinline__ void p1_part(Frame& F_, int g, int l, int G, int c) {
    KA_WS();
    Frame F = mkframe(F_.lds);
    pg8::ProbDense P{(const char*)((bf16*)(ws + WS_XB)), (const char*)(ws + WS_WIN) + (size_t)l * INC * D * 2, D};
    pg8::SubOrder<PART> S; S.init(TG, G, c);
    pg8::EpiInProj E{((bf16*)(ws + WS_U)), ((bf16*)(ws + WS_Q)), ((bf16*)(ws + WS_V)), ((bf16*)(ws + WS_GATE)), ((const float*)(ws + WS_ROT)) + (size_t)g * TG * 16, ((const float*)(ws + WS_LB)) + l * 512, (const float*)KIN(12) + (size_t)l * 3 * D};
    pg8::gemm_phase<pg8::ProbDense, pg8::EpiInProj, pg8::SubOrder<PART>, true>(F.lds, P, S, E);
}
__device__ __forceinline__ void p3_merge(Frame& F_, int l) {
    KA_WS();
    Frame F = mkframe(F_.lds);
    pg8::ProbMerge P{(const char*)((bf16*)(ws + WS_YA)), (const char*)((bf16*)(ws + WS_YB)), (const char*)((bf16*)(ws + WS_YC)), (const char*)(ws + WS_WBR) + (size_t)l * 3 * D * 512 * 2, 512};
    pg8::MergeOrder S; S.so.init(TG, D, gridDim.x, blockIdx.x);
    pg8::EpiMerge E{((bf16*)(ws + WS_GATE)), ((bf16*)(ws + WS_M))};
    pg8::gemm_phase<pg8::ProbMerge, pg8::EpiMerge, pg8::MergeOrder, true>(F.lds, P, S, E);
}
__device__ __forceinline__ void p4_wout(Frame& F_, int l) {
    KA_WS();
    Frame F = mkframe(F_.lds);
    pg8::ProbDense P{(const char*)((bf16*)(ws + WS_M)), (const char*)(ws + WS_WOUT) + (size_t)l * D * D * 2, D};
    pg8::StaticOrder S; S.init(TG, D, gridDim.x, blockIdx.x);
    pg8::EpiWout E{((bf16*)(ws + WS_XB)), ((bf16*)(ws + WS_R))};
    pg8::gemm_phase<pg8::ProbDense, pg8::EpiWout, pg8::StaticOrder, true>(F.lds, P, S, E);
}
__device__ __forceinline__ void moe_table(Frame& F_, int g, int l) {
    KA_WS();
    Frame F = mkframe(F_.lds);
    const unsigned* cnt = ((unsigned*)(ws + WS_CTL)) + CW_CNT + (g * 2 + l) * 32;
    LAS int* tab = (LAS int*)(F.lds + TAB_OFF);
    __syncthreads();
    if (F.tid < 64) {
        const int c = F.tid < 32 ? (int)cnt[F.tid] : 0; int sacc = (c + 255) >> 8;
#pragma unroll
        for (int o = 1; o < 32; o <<= 1) { const int t2 = __shfl_up(sacc, o); if (F.lane >= o) sacc += t2; }
        if (F.tid < 32) { tab[F.tid + 1] = sacc; tab[33 + F.tid] = c; }
        if (F.tid == 0) tab[0] = 0;
    }
    __syncthreads();
}
__device__ __forceinline__ void p6_moe1(Frame& F_, int g, int l) {
    KA_WS();
    Frame F = mkframe(F_.lds);
    moe_table(F, g, l);
    pg8::ProbMoe1 P{(const char*)((bf16*)(ws + WS_X1)), (const char*)(ws + WS_W13) + (size_t)l * NE * 1024 * D * 2, ((int*)(ws + WS_TOK)), D};
    pg8::MoeOrder S{(const LAS int*)(F.lds + TAB_OFF), (int)gridDim.x, (int)blockIdx.x, 4};
    pg8::EpiMoe1 E{((bf16*)(ws + WS_HM))};
    pg8::gemm_phase<pg8::ProbMoe1, pg8::EpiMoe1, pg8::MoeOrder, true>(F.lds, P, S, E);
}
__device__ __forceinline__ void p7_moe2(Frame& F_, int g, int l) {
    KA_WS();
    Frame F = mkframe(F_.lds);
    moe_table(F, g, l);
    pg8::ProbMoe2 P{(const char*)((bf16*)(ws + WS_HM)), (const char*)(ws + WS_W2) + (size_t)l * NE * D * DE * 2, DE};
    pg8::MoeOrder S{(const LAS int*)(F.lds + TAB_OFF), (int)gridDim.x, (int)blockIdx.x, 4};
    pg8::EpiMoe2 E{((bf16*)(ws + WS_OM))};
    pg8::gemm_phase<pg8::ProbMoe2, pg8::EpiMoe2, pg8::MoeOrder, true>(F.lds, P, S, E);
}

__device__ __forceinline__ void frame_init(Frame& F, unsigned char* lds_raw) {
    F.lds = (LAS unsigned char*)lds_raw; F.tid = threadIdx.x; F.lane = F.tid & 63; F.wave = __builtin_amdgcn_readfirstlane(F.tid >> 6);
}
__global__ void __launch_bounds__(NTHR, 2) fwd_all(Args a) {
    extern __shared__ __attribute__((aligned(16))) unsigned char lds_raw[];
    Frame F; frame_init(F, lds_raw);
    volatile LAS unsigned* MISC = (volatile LAS unsigned*)(F.lds + MISC_OFF);
    if (F.tid < 64) MISC[F.tid] = 0u;
    __syncthreads();
    XcdBarrier bar = xcd_barrier_post((unsigned*)(a.ws + WS_CTL) + CW_BAR, MISC + 8);
    p_prologue(F); p_wprep(F); p_xload(F, 0);
    xcd_barrier(bar);
    for (int g = 0; g < NG; ++g) {
        for (int l = 0; l < NL; ++l) {
            p1_part<0>(F, g, l, (int)gridDim.x, (int)blockIdx.x); xcd_barrier(bar);
            p2_mixers(F, g, l, 0); xcd_barrier(bar);
            p2d_combine(F, l); xcd_barrier(bar);
            p3_merge(F, l); xcd_barrier(bar);
            p4_wout(F, l); xcd_barrier(bar);
            p5_ln_route(F, g, l, g * 2 + l); xcd_barrier(bar);
            p6_moe1(F, g, l); xcd_barrier(bar);
            p7_moe2(F, g, l); xcd_barrier(bar);
            p8_ln2(F, g, l);
            if (l == NL - 1 && g + 1 < NG) p_xload(F, g + 1);
            xcd_barrier(bar);
        }
    }
}

extern "C" void kernel_launch(void* const* d_in, const int* in_sizes, int n_in, void* d_out, int out_size, void* d_ws, size_t ws_size, hipStream_t stream) {
    static int grid = 0;
    if (grid == 0) {
        if (n_in != 25 || out_size != T * D || ws_size < WS_END) { fprintf(stderr, "kernel_launch: unexpected shapes (n_in %d out %d ws %zu)\n", n_in, out_size, ws_size); grid = -1; return; }
        int dev = 0, cus = 0;
        if (hipGetDevice(&dev) != hipSuccess || hipDeviceGetAttribute(&cus, hipDeviceAttributeMultiprocessorCount, dev) != hipSuccess) { grid = -1; return; }
        (void)hipGetLastError();
        grid = cus;
        if (grid != 256) { fprintf(stderr, "kernel_launch: built for 256 CUs, got %d\n", cus); grid = -1; return; }
    }
    if (grid < 0) return;
    (void)hipMemsetAsync((char*)d_ws + WS_CTL, 0, CTL_ZERO_BYTES, stream);
    Args a{};
    for (int i = 0; i < 25; ++i) a.in[i] = d_in[i];
    a.out = (float*)d_out; a.ws = (unsigned char*)d_ws;
    { static bool attr = false; if (!attr) { (void)hipFuncSetAttribute((const void*)fwd_all, hipFuncAttributeMaxDynamicSharedMemorySize, LDS_BYTES); attr = true; }
      hipLaunchKernelGGL(fwd_all, dim3(grid), dim3(NTHR), LDS_BYTES, stream, a);}

}
```

```cpp
#include <hip/hip_runtime.h>
#include <cstdio>
#include <cstdint>

#ifndef ONE_LAUNCH
#define ONE_LAUNCH 1
#endif

#define GAS __attribute__((address_space(1)))
#define LAS __attribute__((address_space(3)))
typedef unsigned short bf16;
typedef float f32x4 __attribute__((ext_vector_type(4)));
typedef float f32x2 __attribute__((ext_vector_type(2)));
typedef unsigned u32x4 __attribute__((ext_vector_type(4)));
typedef unsigned u32x2 __attribute__((ext_vector_type(2)));

constexpr int D = 1024, NBATCH = 32, S = 2048, T = NBATCH * S, NL = 2;
constexpr int GB = 16, TG = GB * S, NG = NBATCH / GB;
constexpr int INC = 7680;
constexpr int NE = 32, DE = 512;
constexpr float ALPHA = 1.4142135623730951f, EPS = 1e-5f;
constexpr int NWAVES = 8, NTHR = 512;

constexpr size_t MiB = 1u << 20;
constexpr size_t WS_CTL = 0, CTL_ZERO_BYTES = 1 * MiB;
constexpr size_t WS_ROT = 1 * MiB;
constexpr size_t WS_LB = 5 * MiB;
constexpr size_t WS_RW = 6 * MiB;
constexpr size_t WS_WIN = 8 * MiB;
constexpr size_t WS_WBR = 38 * MiB;
constexpr size_t WS_WOUT = 44 * MiB;
constexpr size_t WS_W13 = 48 * MiB;
constexpr size_t WS_W2 = 176 * MiB;
constexpr size_t WS_XB = 240 * MiB;
constexpr size_t WS_U = 304 * MiB;
constexpr size_t WS_Q = 336 * MiB, WS_K = 368 * MiB, WS_V = 400 * MiB;
constexpr size_t WS_HQ = 432 * MiB, WS_HF = 464 * MiB, WS_HV = 496 * MiB, WS_HG = 528 * MiB;
constexpr size_t WS_GATE = 560 * MiB;
constexpr size_t WS_YA = 752 * MiB, WS_YB = 784 * MiB, WS_YC = 816 * MiB;
constexpr size_t WS_R = 848 * MiB;
constexpr size_t WS_TOK = 976 * MiB;
constexpr size_t WS_RT = 980 * MiB;
constexpr size_t WS_END = 982 * MiB;
constexpr size_t WS_M = WS_Q;
constexpr size_t WS_X1 = WS_YA;
constexpr size_t WS_HM = 304 * MiB;
constexpr size_t WS_OM = 376 * MiB;
constexpr size_t HSTRIDE = (size_t)TG * 512;
static_assert((WS_K - WS_Q) == HSTRIDE * 2 && (WS_HQ - WS_V) == HSTRIDE * 2 && (WS_HF - WS_HQ) == HSTRIDE * 2 && (WS_HV - WS_HF) == HSTRIDE * 2 && (WS_HG - WS_HV) == HSTRIDE * 2, "EpiInProj pointer arithmetic");
static_assert(WS_OM + (size_t)(2 * TG + 32 * 256) * 1024 * 2 <= WS_GATE && WS_HM + (size_t)(2 * TG + 32 * 256) * 512 * 2 <= WS_OM, "expert buffers overlay U..HF only");
constexpr int CW_BAR = 4096;
constexpr int CW_CNT = 16384;

__device__ __forceinline__ float bf2f(bf16 b) { return __uint_as_float(((unsigned)b) << 16); }
__device__ __forceinline__ unsigned f2bf(float f) { unsigned u = __float_as_uint(f); return (u + 0x7fffu + ((u >> 16) & 1u)) >> 16; }
__device__ __forceinline__ unsigned pk2(float lo, float hi) { unsigned r; asm volatile("v_cvt_pk_bf16_f32 %0, %1, %2" : "=v"(r) : "v"(lo), "v"(hi)); return r; }
__device__ __forceinline__ float lo16(unsigned w) { return __uint_as_float(w << 16); }
__device__ __forceinline__ float hi16(unsigned w) { return __uint_as_float(w & 0xffff0000u); }
#define DPP_ADD(v, ctrl) ((v) + __builtin_bit_cast(float, __builtin_amdgcn_update_dpp(0, __builtin_bit_cast(int, (v)), (ctrl), 0xF, 0xF, true)))
__device__ __forceinline__ float wave_sum(float v) {
    v = DPP_ADD(v, 0xB1);
    v = DPP_ADD(v, 0x4E);
    v = DPP_ADD(v, 0x141);
    v = DPP_ADD(v, 0x140);
    v = v + __builtin_bit_cast(float, __builtin_amdgcn_update_dpp(0, __builtin_bit_cast(int, v), 0x142, 0xA, 0xF, false));
    v = v + __builtin_bit_cast(float, __builtin_amdgcn_update_dpp(0, __builtin_bit_cast(int, v), 0x143, 0xC, 0xF, false));
    return __builtin_bit_cast(float, __builtin_amdgcn_readlane(__builtin_bit_cast(int, v), 63));
}
__device__ __forceinline__ float wave_max(float v) {
#pragma unroll
    for (int o = 1; o < 64; o <<= 1) v = fmaxf(v, __shfl_xor(v, o));
    return v;
}
__device__ __forceinline__ float sigmoidf_(float z) { return 1.f / (1.f + expf(-z)); }
__device__ __forceinline__ float siluf_(float z) { return z / (1.f + expf(-z)); }
__device__ __forceinline__ float hg_logf(float z, float lb) {
    if (z >= 0.f) { const float sn = 1.f / (1.f + expf(z)); return log1pf(-(1.f - lb) * sn); }
    const float ez = expf(z); return logf(lb + (1.f - lb) * (ez / (1.f + ez)));
}
#define LDS_WAIT() asm volatile("s_waitcnt lgkmcnt(0)" ::: "memory")

#define XB_TMO      128
#define XB_XCNT(j)  (256  + 64 * (j))
#define XB_XSUB(j)  (1280 + 64 * (j))
#define XB_XGEN(j)  (2304 + 64 * (j))
#define XB_TOP      3328
#define XB_TOPGEN   3392
#define XCD_BAR_WORDS 3456
#define XB_SPIN_CAP (1u << 22)
__device__ __forceinline__ unsigned xb_ld(unsigned* p)              { return __hip_atomic_load(p, __ATOMIC_RELAXED, __HIP_MEMORY_SCOPE_AGENT); }
__device__ __forceinline__ unsigned xb_add(unsigned* p, unsigned v) { return __hip_atomic_fetch_add(p, v, __ATOMIC_RELAXED, __HIP_MEMORY_SCOPE_AGENT); }
__device__ __forceinline__ unsigned xb_xcc_id() { return (unsigned)__builtin_amdgcn_s_getreg((3 << 11) | 20) & 0xFu; }
#define XB_SPIN(cond, bar) do { unsigned _sp = 0; while (cond) { __builtin_amdgcn_s_sleep(1); \
    if ((++_sp & 255u) == 0u) { if (xb_ld(&(bar)[XB_TMO])) break; if (_sp > XB_SPIN_CAP) { atomicAdd(&(bar)[XB_TMO], 1u); break; } } } } while (0)
struct XcdBarrier { unsigned* bar; unsigned x; volatile LAS unsigned* st; };
__device__ __forceinline__ XcdBarrier xcd_barrier_post(unsigned* bar, volatile LAS unsigned* st) {
    XcdBarrier b; b.bar = bar; b.x = (unsigned)__builtin_amdgcn_readfirstlane((int)xb_xcc_id()); b.st = st;
    if (threadIdx.x == 0) (void)xb_add(&bar[XB_XCNT(b.x)], 1u);
    return b;
}
__device__ __forceinline__ void xcd_barrier_complete(unsigned* bar, unsigned x, unsigned& nloc, unsigned& nx) {
    const unsigned G = gridDim.x * gridDim.y * gridDim.z;
    unsigned sum, cnt, mine, sp = 0u;
    for (;;) {
        sum = 0u; cnt = 0u; mine = 0u;
#pragma unroll
        for (unsigned j = 0; j < 16; ++j) { const unsigned c = xb_ld(&bar[XB_XCNT(j)]); sum += c; cnt += (c > 0u) ? 1u : 0u; mine = (j == x) ? c : mine; }
        if (sum == G) break;
        __builtin_amdgcn_s_sleep(1);
        if ((++sp & 255u) == 0u) { if (xb_ld(&bar[XB_TMO])) break; if (sp > XB_SPIN_CAP) { atomicAdd(&bar[XB_TMO], 1u); break; } }
    }
    nloc = mine > 0u ? mine : 1u; nx = cnt > 0u ? cnt : 1u;
}
__device__ __forceinline__ void xcd_barrier(const XcdBarrier& b_) {
    XcdBarrier b = b_;
    { unsigned long long bp = (unsigned long long)b_.bar; unsigned bx = b_.x; asm volatile("" : "+s"(bp), "+s"(bx)); b.bar = (unsigned*)(GAS unsigned*)bp; b.x = bx; }
    asm volatile("s_waitcnt vmcnt(0)" ::: "memory");
    __syncthreads();
    if (threadIdx.x == 0) {
        unsigned* bar = b.bar;
        __builtin_amdgcn_s_waitcnt(0);
        unsigned nloc = b.st[0], nx = b.st[1];
        if (nloc == 0u) { xcd_barrier_complete(bar, b.x, nloc, nx); b.st[0] = nloc; b.st[1] = nx; }
        const unsigned old = xb_add(&bar[XB_XSUB(b.x)], 1u);
        const unsigned gen = old / nloc;
        if (old + 1u == (gen + 1u) * nloc) {
            __builtin_amdgcn_fence(__ATOMIC_RELEASE, "agent");
            asm volatile("s_waitcnt vmcnt(0)" ::: "memory");
            const unsigned og = xb_add(&bar[XB_TOP], 1u);
            const unsigned tg = og / nx;
            if (og + 1u == (tg + 1u) * nx) xb_add(&bar[XB_TOPGEN], 1u);
            else XB_SPIN(xb_ld(&bar[XB_TOPGEN]) == tg, bar);
            __builtin_amdgcn_fence(__ATOMIC_ACQUIRE, "agent");
            xb_add(&bar[XB_XGEN(b.x)], 1u);
            asm volatile("s_waitcnt vmcnt(0)" ::: "memory");
        } else {
            XB_SPIN(xb_ld(&bar[XB_XGEN(b.x)]) == gen, bar);
            __builtin_amdgcn_fence(__ATOMIC_ACQUIRE, "agent");
            asm volatile("s_waitcnt vmcnt(0)" ::: "memory");
        }
    }
    __syncthreads();
}

constexpr int LDS_BYTES = 147456;
constexpr int MISC_OFF = 135168;
struct Args { const void* in[25]; float* out; unsigned char* ws; int g_lo, g_hi, l_lo, l_hi, ph_lo, ph_hi, prologue, pad; };
struct Frame { LAS unsigned char* lds; int tid, lane, wave; };
typedef const __attribute__((address_space(4))) Args* KArgs;
__device__ __forceinline__ KArgs kargs() { unsigned long long v = (unsigned long long)__builtin_amdgcn_kernarg_segment_ptr(); asm volatile("" : "+s"(v)); return (KArgs)v; }
#define KA_WS() KArgs ka = kargs(); unsigned char* ws = (unsigned char*)(GAS unsigned char*)ka->ws
#define KIN(i) ((const void*)(const GAS char*)ka->in[i])
#define KOUT() ((float*)(GAS float*)ka->out)
__device__ __forceinline__ Frame mkframe(LAS unsigned char* lds) { Frame F; int t = threadIdx.x; asm volatile("" : "+v"(t)); F.lds = lds; F.tid = t; F.lane = t & 63; F.wave = __builtin_amdgcn_readfirstlane(t >> 6); return F; }

namespace pg8 {
typedef short bf16x8 __attribute__((ext_vector_type(8)));
constexpr int BM = 256, BK = 64, HALF = 128, HTB = HALF * BK * 2, STAGE_BYTES = 8 * HTB, NXCD = 8, WGM = 8;
__host__ __device__ __forceinline__ int lds_byte(int r, int c) { const int st = (r >> 4) * 2 + (c >> 5), rr = r & 15, cc = c & 31, ob = rr * 64 + cc * 2; return st * 1024 + (ob ^ (((ob >> 9) & 1) << 5)); }
__host__ __device__ __forceinline__ void stage_rc(int b, int& R, int& C) { const int st = b / 1024, sb = b % 1024, swz = sb ^ (((sb >> 9) & 1) << 5); R = (st >> 1) * 16 + swz / 64; C = (st & 1) * 32 + (swz % 64) / 2; }
__host__ __device__ __forceinline__ int perm32(int rho) { const int n = rho >> 4, i = rho & 15; return 8 * (i >> 2) + 4 * n + (i & 3); }
struct Unit { int pm, pn, e, pos0, cnt; };
__device__ __forceinline__ int xcd_remap(int wgid, int nwg) { const int q = nwg / NXCD, r = nwg % NXCD, xcd = wgid % NXCD, off = wgid / NXCD; return (xcd < r ? xcd * (q + 1) : r * (q + 1) + (xcd - r) * q) + off; }
struct StaticOrder {
    int nM, nN, nwg, G, c;
    __device__ void init(int M, int N, int G_, int c_) { nM = M / BM; nN = N / BM; nwg = nM * nN; G = G_; c = c_; }
    __device__ bool next(int i, Unit& u) const {
        const long L = (long)i * G + c; if (L >= nwg) return false;
        const int wgid = xcd_remap((int)L, nwg);
        const int nig = WGM * nN, gid = wgid / nig, fm = gid * WGM, gsz = (nM - fm) < WGM ? (nM - fm) : WGM;
        u.pm = fm + ((wgid % nig) % gsz); u.pn = (wgid % nig) / gsz; u.e = 0; u.pos0 = 0; u.cnt = 0; return true;
    }
    __device__ __forceinline__ void a_ready(const Unit&, bool) const {}
    __device__ __forceinline__ void done(const Unit&) const {}
};
template <int PART> struct SubOrder {
    StaticOrder so;
    __device__ void init(int M, int G_, int c_) { so.init(M, (PART == 0 ? 18 : 12) * BM, G_, c_); }
    __device__ bool next(int i, Unit& u) const { if (!so.next(i, u)) return false; u.pn = PART == 0 ? u.pn + 4 : (u.pn < 4 ? u.pn : u.pn + 18); return true; }
    __device__ __forceinline__ void a_ready(const Unit&, bool) const {}
    __device__ __forceinline__ void done(const Unit&) const {}
};
struct MergeOrder {
    StaticOrder so;
    __device__ bool next(int i, Unit& u) const { if (!so.next(i / 3, u)) return false; u.e = i % 3; return true; }
    __device__ __forceinline__ void a_ready(const Unit&, bool) const {}
    __device__ __forceinline__ void done(const Unit&) const {}
};
template <int MODE> struct MoeOrder {
    const LAS int* tab; int G, c, NT; unsigned* pc;
    __device__ bool next(int i, Unit& u) const {
        const int np = __builtin_amdgcn_readfirstlane(tab[32]); const int nwg = np * NT;
        const long L = (long)i * G + c; if (L >= nwg) return false;
        const int wgid = xcd_remap((int)L, nwg);
        const int panel = wgid / NT; u.pn = wgid % NT;
        int e = 0;
#pragma unroll
        for (int s2 = 16; s2 >= 1; s2 >>= 1) { const int tv = __builtin_amdgcn_readfirstlane(tab[e + s2]); if (tv <= panel) e += s2; }
        u.e = e; u.pm = panel; u.pos0 = (panel - __builtin_amdgcn_readfirstlane(tab[e])) * 256; u.cnt = __builtin_amdgcn_readfirstlane(tab[33 + e]); return true;
    }
    __device__ __forceinline__ void a_ready(const Unit& u, bool first) const {
        if constexpr (MODE == 2) {
            if (__builtin_amdgcn_readfirstlane(threadIdx.x >> 6) == 0) {
                if ((threadIdx.x & 63) == 0) { unsigned sp = 0; while (__hip_atomic_load(pc + u.pm * 16, __ATOMIC_RELAXED, __HIP_MEMORY_SCOPE_AGENT) < 32u) { __builtin_amdgcn_s_sleep(2); if (++sp > (1u << 22)) break; } }
                __builtin_amdgcn_fence(__ATOMIC_ACQUIRE, "agent"); asm volatile("s_waitcnt vmcnt(0)" ::: "memory");
            }
            if (first) __builtin_amdgcn_s_barrier();
        }
    }
    __device__ __forceinline__ void done(const Unit& u) const {
        if constexpr (MODE == 1) {
            asm volatile("s_waitcnt vmcnt(0)" ::: "memory");
            if ((threadIdx.x & 63) == 0) (void)__hip_atomic_fetch_add(pc + u.pm * 16, 1u, __ATOMIC_RELAXED, __HIP_MEMORY_SCOPE_AGENT);
        }
    }
};
__device__ __forceinline__ unsigned cvt_pk_bf16(float lo, float hi) { unsigned r; asm volatile("v_cvt_pk_bf16_f32 %0, %1, %2" : "=v"(r) : "v"(lo), "v"(hi)); return r; }

template <class Prob, class Epi, class Sched, bool ALIGN_EPI>
__device__ __forceinline__ void gemm_phase(LAS unsigned char* lds, const Prob& P, const Sched& S, const Epi& E) {
    int tid_ = threadIdx.x; asm volatile("" : "+v"(tid_));
    const int tid = tid_, wid = __builtin_amdgcn_readfirstlane(tid >> 6), lane = tid & 63, wr = wid >> 2, wc = wid & 3, fr = lane & 15, fq = lane >> 4;
    const int K = P.K, nt = K / BK;
    unsigned vA[2][2], voffB[2];
#pragma unroll
    for (int i = 0; i < 2; ++i) { int R, C; stage_rc(tid * 16 + i * 8192, R, C); const int Rb = (R & ~31) + perm32(R & 31);
        vA[0][i] = (unsigned)(R * K + C) * 2u; vA[1][i] = vA[0][i] + (unsigned)(HALF * K * 2); voffB[i] = (unsigned)(Rb * K + C) * 2u; }
    const size_t kstep = (size_t)(BK * 2);
    const size_t hstep = (size_t)HALF * K * 2;
    const unsigned ldsw = (unsigned)wid * 1024u;
    const int aoff = lds_byte(wr * 64 + fr, fq * 8), boff = lds_byte(wc * 32 + fr, fq * 8);
#define PG8_SA(b, h) (((b) * 2 + (h)) * HTB)
#define PG8_SB(b, h) ((4 + (b) * 2 + (h)) * HTB)
#define PG8_STAGE(bufoff, gbase, voff) do { _Pragma("unroll") for (int _i = 0; _i < 2; ++_i) \
        __builtin_amdgcn_global_load_lds((const unsigned*)((const char*)(gbase) + (voff)[_i]), (LAS unsigned*)(lds + (bufoff) + ldsw + _i * 8192), 16, 0, 0); } while (0)
#define PG8_LDA(dst, b, h) do { _Pragma("unroll") for (int m = 0; m < 4; ++m) _Pragma("unroll") for (int k = 0; k < 2; ++k) dst[m][k] = *(const LAS bf16x8*)(lds + PG8_SA(b, h) + aoff + m * 2048 + k * 1024); } while (0)
#define PG8_LDB(dst, b, h) do { _Pragma("unroll") for (int n = 0; n < 2; ++n) _Pragma("unroll") for (int k = 0; k < 2; ++k) dst[n][k] = *(const LAS bf16x8*)(lds + PG8_SB(b, h) + boff + n * 2048 + k * 1024); } while (0)
#define PG8_MMA(ai, bj, At, Bt) do { __builtin_amdgcn_s_setprio(1); _Pragma("unroll") for (int m = 0; m < 4; ++m) _Pragma("unroll") for (int n = 0; n < 2; ++n) _Pragma("unroll") for (int k = 0; k < 2; ++k) \
        acc[ai][bj][m][n] = __builtin_amdgcn_mfma_f32_16x16x32_bf16(Bt[n][k], At[m][k], acc[ai][bj][m][n], 0, 0, 0); __builtin_amdgcn_s_setprio(0); } while (0)
#define PG8_WAIT_V(n) asm volatile("s_waitcnt vmcnt(" #n ")" ::: "memory")
#define PG8_WAIT_L(n) asm volatile("s_waitcnt lgkmcnt(" #n ")" ::: "memory")
#define PG8_BAR __builtin_amdgcn_s_barrier()
#define PG8_SCHED __builtin_amdgcn_sched_barrier(0)
    Unit cur, nxt; int ui = 0;
    if (!S.next(0, cur)) return;
    f32x4 acc[2][2][4][2];
#pragma unroll
    for (int a = 0; a < 2; ++a)
#pragma unroll
        for (int b = 0; b < 2; ++b)
#pragma unroll
            for (int m = 0; m < 4; ++m)
#pragma unroll
                for (int n = 0; n < 2; ++n) acc[a][b][m][n] = (f32x4){0.f, 0.f, 0.f, 0.f};
    bf16x8 At[4][2], B0[2][2], B1[2][2];
    const char* cA = P.abase(cur); const char* cB = P.bbase(cur);
    if constexpr (Prob::GATHER) P.voff(cur, tid, vA);
    S.a_ready(cur, true);
    PG8_STAGE(PG8_SB(0, 0), cB, voffB); PG8_STAGE(PG8_SB(0, 1), cB + hstep, voffB); PG8_STAGE(PG8_SA(0, 0), cA, vA[0]); PG8_STAGE(PG8_SA(0, 1), cA, vA[1]);
    if (wr == 1) PG8_BAR;
    PG8_WAIT_V(2); PG8_BAR;
    PG8_STAGE(PG8_SB(1, 0), cB + kstep, voffB); PG8_STAGE(PG8_SA(1, 0), cA + kstep, vA[0]); PG8_STAGE(PG8_SB(1, 1), cB + hstep + kstep, voffB);
    PG8_WAIT_V(6); PG8_BAR;
    for (;;) {
        const bool has_next = S.next(ui + 1, nxt);
        const char* nA = has_next ? P.abase(nxt) : cA; const char* nB = has_next ? P.bbase(nxt) : cB;
        unsigned nv[2][2];
#pragma unroll
        for (int h = 0; h < 2; ++h)
#pragma unroll
            for (int i = 0; i < 2; ++i) nv[h][i] = vA[h][i];
        for (int t = 0; t < nt; t += 2) {
            const bool last = (t == nt - 2);
            if constexpr (Prob::GATHER) { if (t == nt - 4 && has_next) P.voff(nxt, tid, nv); }
            const char* a1 = cA + (size_t)(t + 1) * kstep;
            const char* a2 = last ? nA : cA + (size_t)(t + 2) * kstep; const char* b2 = last ? nB : cB + (size_t)(t + 2) * kstep;
            const char* a3 = a2 + kstep; const char* b3 = b2 + kstep;
            if (last && has_next) S.a_ready(nxt, false);
            unsigned w0[2], w1[2];
#pragma unroll
            for (int i = 0; i < 2; ++i) { if constexpr (Prob::GATHER) { w0[i] = last ? nv[0][i] : vA[0][i]; w1[i] = last ? nv[1][i] : vA[1][i]; } else { w0[i] = vA[0][i]; w1[i] = vA[1][i]; } }
            PG8_LDB(B0, 0, 0); PG8_LDB(B1, 0, 1); PG8_SCHED; PG8_LDA(At, 0, 0); PG8_STAGE(PG8_SA(1, 1), a1, vA[1]);
            PG8_WAIT_V(8); PG8_WAIT_L(0); PG8_BAR; PG8_MMA(0, 0, At, B0); PG8_MMA(0, 1, At, B1); PG8_BAR; PG8_SCHED;
            PG8_LDA(At, 0, 1); PG8_STAGE(PG8_SB(0, 0), b2, voffB); PG8_STAGE(PG8_SB(0, 1), b2 + hstep, voffB); PG8_STAGE(PG8_SA(0, 0), a2, w0);
            PG8_WAIT_V(8); PG8_WAIT_L(0); PG8_BAR; PG8_MMA(1, 0, At, B0); PG8_MMA(1, 1, At, B1); PG8_BAR; PG8_SCHED;
            PG8_LDB(B0, 1, 0); PG8_LDB(B1, 1, 1); PG8_SCHED; PG8_LDA(At, 1, 0); PG8_STAGE(PG8_SA(0, 1), a2, w1);
            PG8_WAIT_V(8); PG8_WAIT_L(0); PG8_BAR; PG8_MMA(0, 0, At, B0); PG8_MMA(0, 1, At, B1); PG8_BAR; PG8_SCHED;
            PG8_LDA(At, 1, 1); PG8_STAGE(PG8_SB(1, 0), b3, voffB); PG8_STAGE(PG8_SB(1, 1), b3 + hstep, voffB); PG8_STAGE(PG8_SA(1, 0), a3, w0);
            PG8_WAIT_V(8); PG8_WAIT_L(0); PG8_BAR; PG8_MMA(1, 0, At, B0); PG8_MMA(1, 1, At, B1); PG8_BAR; PG8_SCHED;
        }
        if constexpr (ALIGN_EPI) { if (wr == 0) PG8_BAR; }
        E(acc, cur, wr, wc, fr, fq); S.done(cur);
        if (!has_next) break;
        if (!(Epi::CARRY && nxt.e != 0))
#pragma unroll
        for (int a = 0; a < 2; ++a)
#pragma unroll
            for (int b = 0; b < 2; ++b)
#pragma unroll
                for (int m = 0; m < 4; ++m)
#pragma unroll
                    for (int n = 0; n < 2; ++n) acc[a][b][m][n] = (f32x4){0.f, 0.f, 0.f, 0.f};
        cur = nxt; cA = nA; cB = nB; ++ui;
        if constexpr (Prob::GATHER) {
#pragma unroll
            for (int h = 0; h < 2; ++h)
#pragma unroll
                for (int i = 0; i < 2; ++i) vA[h][i] = nv[h][i]; }
        if constexpr (ALIGN_EPI) { if (wr == 1) PG8_BAR; }
    }
    PG8_WAIT_V(0);
    if constexpr (!ALIGN_EPI) { if (wr == 0) PG8_BAR; }
    PG8_BAR;
#undef PG8_SA
#undef PG8_SB
#undef PG8_STAGE
#undef PG8_LDA
#undef PG8_LDB
#undef PG8_MMA
#undef PG8_WAIT_V
#undef PG8_WAIT_L
#undef PG8_BAR
#undef PG8_SCHED
}
struct ProbDense { static constexpr bool GATHER = false; const char* A; const char* Bt; int K;
    __device__ __forceinline__ const char* abase(const Unit& u) const { return A + (size_t)u.pm * 256 * K * 2; }
    __device__ __forceinline__ const char* bbase(const Unit& u) const { return Bt + (size_t)u.pn * 256 * K * 2; }
    __device__ __forceinline__ void voff(const Unit&, int, unsigned (&)[2][2]) const {} };
struct ProbMerge { static constexpr bool GATHER = false; const char* Y0; const char* Y1; const char* Y2; const char* W; int K;
    __device__ __forceinline__ const char* abase(const Unit& u) const { const char* y = u.e == 0 ? Y0 : (u.e == 1 ? Y1 : Y2); return y + (size_t)u.pm * 256 * K * 2; }
    __device__ __forceinline__ const char* bbase(const Unit& u) const { return W + ((size_t)u.e * 1024 + u.pn * 256) * K * 2; }
    __device__ __forceinline__ void voff(const Unit&, int, unsigned (&)[2][2]) const {} };
struct ProbMoe1 { static constexpr bool GATHER = true; const char* X1; const char* W; const int* TOK; int K;
    __device__ __forceinline__ const char* abase(const Unit&) const { return X1; }
    __device__ __forceinline__ const char* bbase(const Unit& u) const { return W + ((size_t)u.e * 1024 + u.pn * 256) * K * 2; }
    __device__ __forceinline__ void voff(const Unit& u, int tid, unsigned (&v)[2][2]) const {
#pragma unroll
        for (int i = 0; i < 2; ++i) { int R, C; stage_rc(tid * 16 + i * 8192, R, C);
#pragma unroll
            for (int h = 0; h < 2; ++h) { const int pos = u.pos0 + h * 128 + R; int tk = TOK[(size_t)u.e * TG + pos]; tk = pos < u.cnt ? tk : 0; v[h][i] = (unsigned)tk * (unsigned)(K * 2) + (unsigned)C * 2u; } } } };
struct ProbMoe2 { static constexpr bool GATHER = false; const char* HM; const char* W; int K;
    __device__ __forceinline__ const char* abase(const Unit& u) const { return HM + (size_t)u.pm * 256 * K * 2; }
    __device__ __forceinline__ const char* bbase(const Unit& u) const { return W + ((size_t)u.e * 1024 + u.pn * 256) * K * 2; }
    __device__ __forceinline__ void voff(const Unit&, int, unsigned (&)[2][2]) const {} };

__device__ __forceinline__ float fsig(float z) { return __builtin_amdgcn_rcpf(1.f + __expf(-z)); }
__device__ __forceinline__ float hg_logf_fast(float z, float lb) {
    const float t = __expf(-fabsf(z)), sg = t * __builtin_amdgcn_rcpf(1.f + t), w = (1.f - lb) * sg;
    return __logf(z >= 0.f ? 1.f - w : lb + w);
}
__device__ __forceinline__ void st8wt(bf16* p, const f32x4& a, const f32x4& b) { u32x4 w; w.x = cvt_pk_bf16(a[0], a[1]); w.y = cvt_pk_bf16(a[2], a[3]); w.z = cvt_pk_bf16(b[0], b[1]); w.w = cvt_pk_bf16(b[2], b[3]);
    asm volatile("global_store_dwordx4 %0, %1, off sc1\n\ts_nop 1" :: "v"(p), "v"(w) : "memory"); }
__device__ __forceinline__ void st8(bf16* p, const f32x4& a, const f32x4& b) { u32x4 w; w.x = cvt_pk_bf16(a[0], a[1]); w.y = cvt_pk_bf16(a[2], a[3]); w.z = cvt_pk_bf16(b[0], b[1]); w.w = cvt_pk_bf16(b[2], b[3]); *(u32x4*)p = w; }
struct EpiInProj {
    static constexpr bool PERM = true, CARRY = false;
    bf16 *U, *Q, *V, *GATE; const float* rot; const float* lbt; const float* bg;
    __device__ __forceinline__ void operator()(const f32x4 (&acc)[2][2][4][2], const Unit& u, int wr, int wc, int fr, int fq) const {
        const int pn = u.pn, rowb = u.pm * 256 + wr * 64 + fr, cl = wc * 32 + 8 * fq;
        if (pn < 4) {
#pragma unroll
            for (int ai = 0; ai < 2; ++ai)
#pragma unroll
                for (int m = 0; m < 4; ++m) { const int row = rowb + ai * 128 + m * 16; f32x4 o0, o1;
#pragma unroll
                    for (int j = 0; j < 4; ++j) { o0[j] = acc[ai][0][m][0][j] * fsig(acc[ai][1][m][0][j]); o1[j] = acc[ai][0][m][1][j] * fsig(acc[ai][1][m][1][j]); }
                    st8(U + (size_t)row * 512 + pn * 128 + cl, o0, o1); asm volatile("" ::: "memory"); }
        } else if (pn < 8) {
            const int which = pn - 4; bf16* dst = Q + (size_t)(which >> 1) * HSTRIDE; const float sc = (which >> 1) ? 1.f : 0.125f * 1.4426950408889634f; const int colb = (which & 1) * 256 + cl;
            const bool rotw = (wc & 1) == 0; const float sgn = fq == 0 ? -1.f : 1.f;
#pragma unroll
            for (int ai = 0; ai < 2; ++ai) {
                f32x4 cs[4][4];
#pragma unroll
                for (int m = 0; m < 4; ++m) { cs[m][0] = (f32x4){1.f, 1.f, 1.f, 1.f}; cs[m][1] = cs[m][0]; cs[m][2] = (f32x4){0.f, 0.f, 0.f, 0.f}; cs[m][3] = cs[m][2];
                    if (rotw && fq < 2) { const f32x4* rp = (const f32x4*)(rot + (size_t)(rowb + ai * 128 + m * 16) * 16); cs[m][0] = rp[0]; cs[m][1] = rp[1]; cs[m][2] = rp[2]; cs[m][3] = rp[3]; } }
#pragma unroll
                for (int m = 0; m < 4; ++m) { const int row = rowb + ai * 128 + m * 16;
                    const f32x4 c0 = cs[m][0], c1 = cs[m][1], s0 = cs[m][2] * sgn, s1 = cs[m][3] * sgn;
#pragma unroll
                    for (int bj = 0; bj < 2; ++bj) { f32x4 x0 = acc[ai][bj][m][0], x1 = acc[ai][bj][m][1];
                        if (rotw) { f32x4 p0, p1;
#pragma unroll
                            for (int j = 0; j < 4; ++j) { p0[j] = __shfl_xor(x0[j], 16); p1[j] = __shfl_xor(x1[j], 16); }
                            x0 = x0 * c0 + p0 * s0; x1 = x1 * c1 + p1 * s1; }
                        st8(dst + (size_t)row * 512 + colb + bj * 128, x0 * sc, x1 * sc); } }
                asm volatile("" ::: "memory"); }
        } else {
            int kind, ldc, colb; bf16* dst; bool seqc = false;
            if (pn < 18) { const int tq = (pn - 8) >> 1; seqc = tq >= 1; kind = tq == 0 ? 0 : (tq == 1 ? 1 : (tq == 2 ? 2 : (tq == 3 ? 0 : 1))); dst = V + (size_t)tq * HSTRIDE; ldc = 512; colb = ((pn - 8) & 1) * 256; }
            else { kind = 3; dst = GATE; ldc = 3072; colb = (pn - 18) * 256; }
            f32x4 aux[2][2];
#pragma unroll
            for (int bj = 0; bj < 2; ++bj)
#pragma unroll
                for (int n = 0; n < 2; ++n) aux[bj][n] = kind == 2 ? *(const f32x4*)(lbt + colb + bj * 128 + cl + 4 * n) : (kind == 3 ? *(const f32x4*)(bg + colb + bj * 128 + cl + 4 * n) : (f32x4){0.f, 0.f, 0.f, 0.f});
#pragma unroll
            for (int ai = 0; ai < 2; ++ai)
#pragma unroll
                for (int m = 0; m < 4; ++m) { const int row = rowb + ai * 128 + m * 16;
#pragma unroll
                    for (int bj = 0; bj < 2; ++bj) { f32x4 x[2] = {acc[ai][bj][m][0], acc[ai][bj][m][1]};
                        if (kind == 1) {
#pragma unroll
                            for (int n = 0; n < 2; ++n)
#pragma unroll
                                for (int j = 0; j < 4; ++j) x[n][j] = x[n][j] * fsig(x[n][j]);
                        } else if (kind == 2) {
#pragma unroll
                            for (int n = 0; n < 2; ++n)
#pragma unroll
                                for (int j = 0; j < 4; ++j) x[n][j] = hg_logf_fast(x[n][j], aux[bj][n][j]);
                        } else if (kind == 3) {
#pragma unroll
                            for (int n = 0; n < 2; ++n)
#pragma unroll
                                for (int j = 0; j < 4; ++j) x[n][j] = fsig(x[n][j] + aux[bj][n][j]);
                        }
                        const size_t di = seqc ? ((size_t)((row >> 11) * 4 + (colb >> 7) + bj) * 2048 + (row & 2047)) * 128 + cl : (size_t)row * ldc + colb + bj * 128 + cl;
                        st8(dst + di, x[0], x[1]); } asm volatile("" ::: "memory"); }
        }
    }
};
struct EpiMerge {
    static constexpr bool PERM = true, CARRY = true;
    const bf16* GATE; bf16* M;
    __device__ __forceinline__ void operator()(f32x4 (&acc)[2][2][4][2], const Unit& u, int wr, int wc, int fr, int fq) const {
        const int rowb = u.pm * 256 + wr * 64 + fr, cl = u.pn * 256 + wc * 32 + 8 * fq, n = u.e;
#pragma unroll
        for (int ai = 0; ai < 2; ++ai) {
            u32x4 g[4][2], h[4][2];
#pragma unroll
            for (int m = 0; m < 4; ++m)
#pragma unroll
                for (int bj = 0; bj < 2; ++bj) { const bf16* gp = GATE + (size_t)(rowb + ai * 128 + m * 16) * 3072 + n * 1024 + cl + bj * 128;
                    g[m][bj] = *(const u32x4*)gp; h[m][bj] = g[m][bj]; if (n < 2) h[m][bj] = *(const u32x4*)(gp + 1024); }
#pragma unroll
            for (int m = 0; m < 4; ++m)
#pragma unroll
                for (int bj = 0; bj < 2; ++bj) { const u32x4 gg = g[m][bj], hh = h[m][bj];
                    f32x4 s0 = (f32x4){lo16(gg.x), hi16(gg.x), lo16(gg.y), hi16(gg.y)}, s1 = (f32x4){lo16(gg.z), hi16(gg.z), lo16(gg.w), hi16(gg.w)};
                    if (n < 2) {
                        const f32x4 d0 = (f32x4){lo16(hh.x), hi16(hh.x), lo16(hh.y), hi16(hh.y)}, d1 = (f32x4){lo16(hh.z), hi16(hh.z), lo16(hh.w), hi16(hh.w)};
#pragma unroll
                        for (int j = 0; j < 4; ++j) { s0[j] *= __builtin_amdgcn_rcpf(fmaxf(d0[j], 1e-20f)); s1[j] *= __builtin_amdgcn_rcpf(fmaxf(d1[j], 1e-20f)); }
                        acc[ai][bj][m][0] = acc[ai][bj][m][0] * s0; acc[ai][bj][m][1] = acc[ai][bj][m][1] * s1;
                    } else st8(M + (size_t)(rowb + ai * 128 + m * 16) * D + cl + bj * 128, acc[ai][bj][m][0] * s0, acc[ai][bj][m][1] * s1); }
            asm volatile("" ::: "memory"); }
    }
};
struct EpiWout {
    static constexpr bool PERM = true, CARRY = false;
    const bf16* XB; bf16* R;
    __device__ __forceinline__ void operator()(const f32x4 (&acc)[2][2][4][2], const Unit& u, int wr, int wc, int fr, int fq) const {
        const int rowb = u.pm * 256 + wr * 64 + fr, cl = u.pn * 256 + wc * 32 + 8 * fq;
#pragma unroll
        for (int ai = 0; ai < 2; ++ai) {
            u32x4 g[4][2];
#pragma unroll
            for (int m = 0; m < 4; ++m)
#pragma unroll
                for (int bj = 0; bj < 2; ++bj) g[m][bj] = *(const u32x4*)(XB + (size_t)(rowb + ai * 128 + m * 16) * D + cl + bj * 128);
#pragma unroll
            for (int m = 0; m < 4; ++m)
#pragma unroll
                for (int bj = 0; bj < 2; ++bj) { const size_t o = (size_t)(rowb + ai * 128 + m * 16) * D + cl + bj * 128; const u32x4 gg = g[m][bj];
                    st8(R + o, acc[ai][bj][m][0] + (f32x4){lo16(gg.x), hi16(gg.x), lo16(gg.y), hi16(gg.y)} * ALPHA, acc[ai][bj][m][1] + (f32x4){lo16(gg.z), hi16(gg.z), lo16(gg.w), hi16(gg.w)} * ALPHA); }
            asm volatile("" ::: "memory"); }
    }
};
struct EpiMoe1 {
    static constexpr bool PERM = true, CARRY = false;
    bf16* HM;
    __device__ __forceinline__ void operator()(const f32x4 (&acc)[2][2][4][2], const Unit& u, int wr, int wc, int fr, int fq) const {
        const int rowb = u.pm * 256 + wr * 64 + fr, cl = u.pn * 128 + wc * 32 + 8 * fq;
#pragma unroll
        for (int ai = 0; ai < 2; ++ai)
#pragma unroll
            for (int m = 0; m < 4; ++m) { const int row = rowb + ai * 128 + m * 16; f32x4 o0, o1;
#pragma unroll
                for (int j = 0; j < 4; ++j) { const float a = acc[ai][0][m][0][j], b = acc[ai][0][m][1][j]; o0[j] = a * fsig(a) * acc[ai][1][m][0][j]; o1[j] = b * fsig(b) * acc[ai][1][m][1][j]; }
                st8wt(HM + (size_t)row * DE + cl, o0, o1); }
    }
};
struct EpiMoe2 {
    static constexpr bool PERM = true, CARRY = false;
    bf16* OM;
    __device__ __forceinline__ void operator()(const f32x4 (&acc)[2][2][4][2], const Unit& u, int wr, int wc, int fr, int fq) const {
        const int rowb = u.pm * 256 + wr * 64 + fr, cl = u.pn * 256 + wc * 32 + 8 * fq;
#pragma unroll
        for (int ai = 0; ai < 2; ++ai)
#pragma unroll
            for (int m = 0; m < 4; ++m) { const int row = rowb + ai * 128 + m * 16;
#pragma unroll
                for (int bj = 0; bj < 2; ++bj) st8(OM + (size_t)row * D + cl + bj * 128, acc[ai][bj][m][0], acc[ai][bj][m][1]); }
    }
};
}

__device__ __forceinline__ void p_prologue(Frame& F_) {
    KA_WS();
    Frame F = mkframe(F_.lds);
    const int gt = blockIdx.x * NTHR + F.tid, NT = gridDim.x * NTHR;
    const int* pos = (const int*)KIN(1);
    float* rot = (float*)(ws + WS_ROT);
    for (int i = gt; i < T * 8; i += NT) {
        const int t = i >> 3, f = i & 7;
        const double invf[8] = {1.0, 0.19392274474868576, 0.03760603093086393, 0.007292664737217109, 0.001414213562373095, 0.0002742481756762073, 5.318295896944988e-05, 1.031338537721246e-05};
        double w = 1.0;
#pragma unroll
        for (int j = 0; j < 8; ++j) w = (f == j) ? invf[j] : w;
        const double ang = (double)pos[t] * w;
        const double n = rint(ang * 0.15915494309189535); const double r = (ang - n * 6.283185307179586) - n * 2.4492935982947064e-16;
        rot[t * 16 + f] = cosf((float)r); rot[t * 16 + 8 + f] = sinf((float)r);
    }
    { bf16* rw = (bf16*)(ws + WS_RW);
      for (int i = gt; i < 2 * 48 * 1024; i += NT) { const int l2 = i / (48 * 1024), j = (i / 1024) % 48, d = i & 1023; float w = 0.f;
          if (j < 4) w = ((const float*)KIN(16))[((size_t)l2 * D + d) * 4 + j];
          else if (j < 36) w = ((const float*)KIN(18))[(((size_t)l2 * 4 + ((j - 4) >> 3)) * D + d) * 8 + ((j - 4) & 7)];
          const unsigned hb = f2bf(w); const float hf = __uint_as_float(hb << 16);
          rw[((size_t)l2 * 2 + 0) * 48 * 1024 + j * 1024 + d] = (bf16)hb; rw[((size_t)l2 * 2 + 1) * 48 * 1024 + j * 1024 + d] = (bf16)f2bf(w - hf); } }
    float* lbt = (float*)(ws + WS_LB);
    const float* hg_lb = (const float*)KIN(9);
    for (int i = gt; i < 512; i += NT) { const float a0 = hg_lb[i], a1 = hg_lb[512 + i]; lbt[i] = 0.f; lbt[512 + i] = 1.f / (1.f + expf(a0 - a1)); }
    if (gt < 2) {
        const float* lp = (const float*)KIN(7) + gt * 256; float s1 = 0.f, s2 = 0.f;
        for (int i = 0; i < 64; ++i) { s1 += lp[i] * lp[64 + i]; s2 += lp[128 + i] * lp[192 + i]; }
        const float lam_init = gt == 0 ? 0.2f : 0.35550906759096934f;
        lbt[1024 + gt] = expf(s1) - expf(s2) + lam_init;
    }
}
__device__ __forceinline__ void p_xload(Frame& F_, int g) {
    KA_WS();
    Frame F = mkframe(F_.lds);
    const f32x4* x = (const f32x4*)((const float*)KIN(0) + (size_t)g * TG * D);
    u32x2* o = (u32x2*)((bf16*)(ws + WS_XB));
    const size_t st = (size_t)gridDim.x * NTHR;
    for (size_t i = (size_t)blockIdx.x * NTHR + F.tid; i < (size_t)TG * D / 4; i += 8 * st) { f32x4 v[8];
#pragma unroll
        for (int j = 0; j < 8; ++j) v[j] = x[i + j * st];
#pragma unroll
        for (int j = 0; j < 8; ++j) { u32x2 w; w.x = pk2(v[j].x, v[j].y); w.y = pk2(v[j].z, v[j].w); o[i + j * st] = w; } }
}

constexpr int CW_XLQ = 28672;
__device__ __forceinline__ void p_xload_queue(Frame& F_, int g) {
    KA_WS();
    Frame F = mkframe(F_.lds);
    volatile LAS int* qslot = (volatile LAS int*)(F.lds + MISC_OFF + 128);
    unsigned* qh = (unsigned*)(ws + WS_CTL) + CW_XLQ;
    const f32x4* x = (const f32x4*)((const float*)KIN(0) + (size_t)g * TG * D);
    u32x2* o = (u32x2*)((bf16*)(ws + WS_XB));
    const size_t st = (size_t)256 * NTHR;
    for (;;) {
        __syncthreads();
        if (F.tid == 0) qslot[0] = (int)__hip_atomic_fetch_add(qh, 1u, __ATOMIC_RELAXED, __HIP_MEMORY_SCOPE_AGENT);
        __syncthreads();
        const int c = __builtin_amdgcn_readfirstlane(qslot[0]);
        if (c >= 256) break;
        for (size_t i = (size_t)c * NTHR + F.tid; i < (size_t)TG * D / 4; i += 8 * st) { f32x4 v[8];
#pragma unroll
            for (int j = 0; j < 8; ++j) v[j] = x[i + j * st];
#pragma unroll
            for (int j = 0; j < 8; ++j) { u32x2 w; w.x = pk2(v[j].x, v[j].y); w.y = pk2(v[j].z, v[j].w); o[i + j * st] = w; } }
    }
}

__device__ __forceinline__ void p2_conv_unit(Frame& F, unsigned char* ws, KArgs ka, int l, int cu) {
    const float* cw = (const float*)KIN(3) + (size_t)l * 31 * 512; const float* cb = (const float*)KIN(4) + l * 512;
    const float* lg = (const float*)KIN(5) + l * 512; const float* lb = (const float*)KIN(6) + l * 512;
    const bf16* __restrict__ U = (const bf16*)(ws + WS_U); bf16* __restrict__ YA = (bf16*)(ws + WS_YA);
    LAS float* Yt = (LAS float*)F.lds;
    const int lane = F.lane, wave = F.wave, hf = wave >> 2, c = 128 * (wave & 3) + 2 * lane;
    const int tb = cu * 64 + 32 * hf, sb = tb & (S - 1);
    f32x2 wt[31], uf[62];
#pragma unroll
    for (int j = 0; j < 31; ++j) wt[j] = *(const f32x2*)(cw + j * 512 + c);
#pragma unroll
    for (int k = 0; k < 62; ++k) { unsigned w = 0u; if (sb - 30 + k >= 0) w = *(const unsigned*)(U + (size_t)(tb - 30 + k) * 512 + c); uf[k] = (f32x2){lo16(w), hi16(w)}; }
    const f32x2 bias = *(const f32x2*)(cb + c);
    __syncthreads();
#pragma unroll
    for (int tt = 0; tt < 32; ++tt) { f32x2 acc = bias;
#pragma unroll
        for (int j = 0; j < 31; ++j) acc = acc + uf[tt + j] * wt[j];
        *(LAS f32x2*)(Yt + (32 * hf + tt) * 512 + c) = acc; }
    __syncthreads();
    const int c0 = lane * 8;
#pragma unroll 2
    for (int i = 0; i < 8; ++i) { const int tl = wave * 8 + i;
        const f32x4 a0 = *(const LAS f32x4*)(Yt + tl * 512 + c0), a1 = *(const LAS f32x4*)(Yt + tl * 512 + c0 + 4);
        float acc[8] = {a0.x, a0.y, a0.z, a0.w, a1.x, a1.y, a1.z, a1.w};
        float sm = 0.f;
#pragma unroll
        for (int q = 0; q < 8; ++q) sm += acc[q];
        const float mean = wave_sum(sm) * (1.f / 512.f); float sq = 0.f;
#pragma unroll
        for (int q = 0; q < 8; ++q) { acc[q] -= mean; sq += acc[q] * acc[q]; }
        const float rstd = __builtin_amdgcn_rsqf(wave_sum(sq) * (1.f / 512.f) + EPS);
        const f32x4 g0 = *(const f32x4*)(lg + c0), g1 = *(const f32x4*)(lg + c0 + 4), b0 = *(const f32x4*)(lb + c0), b1 = *(const f32x4*)(lb + c0 + 4);
        const float gg[8] = {g0.x, g0.y, g0.z, g0.w, g1.x, g1.y, g1.z, g1.w}, bb[8] = {b0.x, b0.y, b0.z, b0.w, b1.x, b1.y, b1.z, b1.w};
        float y[8];
#pragma unroll
        for (int q = 0; q < 8; ++q) { const float z = acc[q] * rstd * gg[q] + bb[q]; y[q] = z * __builtin_amdgcn_rcpf(1.f + __expf(-z)); }
        u32x4 o; o.x = pk2(y[0], y[1]); o.y = pk2(y[2], y[3]); o.z = pk2(y[4], y[5]); o.w = pk2(y[6], y[7]);
        *(u32x4*)(YA + (size_t)(cu * 64 + tl) * 512 + c0) = o;
    }
    __syncthreads();
}
#include <hip/hip_bf16.h>
#include <cmath>
namespace attn_body {
using bf16=__hip_bfloat16;
using bf16x8=__attribute__((ext_vector_type(8)))short;
using s16x4=__attribute__((ext_vector_type(4)))short;
using f32x16=__attribute__((ext_vector_type(16)))float;
using u32x4=__attribute__((ext_vector_type(4)))unsigned;
constexpr int SEQ=2048,D=64,DMI=512,DMO=1024;
constexpr int NW=8,QBLK=32,QB=QBLK*NW,KVBLK=64,NQB=SEQ/QB;
constexpr int ATTN_UNIT_ROWS=QB;
__device__ __forceinline__ int crow(int r,int hi){return (r&3)+8*(r>>2)+4*hi;}
#define SBAR() __builtin_amdgcn_sched_barrier(0)
__device__ __forceinline__ void cmask(f32x16&p0,f32x16&p1,int jb,int qrel,int hi){
  const float NEG=-INFINITY; int kb=64*jb+4*hi;
  #pragma unroll
  for(int r=0;r<16;++r){int kv=kb+(r&3)+8*(r>>2); if(kv>qrel)p0[r]=NEG; if(kv+32>qrel)p1[r]=NEG;}
}

constexpr int NSLOT=3, SLOTB=8192;
constexpr int LDS_K=0, LDS_V=NSLOT*SLOTB, LDS_WS=3*NSLOT*SLOTB, LDS_OST=LDS_WS+NW*64*4, LDS_BYTES=LDS_OST+NW*4096;
constexpr float C2=0.125f*1.4426950408889634f;
__device__ __forceinline__ void glds16(const void*gsrc,unsigned lds_dst){unsigned keep;
  asm volatile("s_mov_b32 %0, m0\n\ts_mov_b32 m0, %2\n\ts_nop 0\n\tglobal_load_lds_dwordx4 %1, off\n\ts_mov_b32 m0, %0":"=&s"(keep):"v"(gsrc),"s"(lds_dst):"memory");}
__device__ __forceinline__ void glds16s(const void*gbase,unsigned voff,unsigned lds_dst){unsigned keep;
  asm volatile("s_mov_b32 %0, m0\n\ts_mov_b32 m0, %3\n\ts_nop 0\n\tglobal_load_lds_dwordx4 %1, %2\n\ts_mov_b32 m0, %0":"=&s"(keep):"v"(voff),"s"(gbase),"s"(lds_dst):"memory");}
__device__ __forceinline__ void glds16s128(const void*gbase,unsigned voff,unsigned lds_dst){unsigned keep;
  asm volatile("s_mov_b32 %0, m0\n\ts_mov_b32 m0, %3\n\ts_nop 0\n\tglobal_load_lds_dwordx4 %1, %2 offset:128\n\ts_mov_b32 m0, %0":"=&s"(keep):"v"(voff),"s"(gbase),"s"(lds_dst):"memory");}
__device__ __forceinline__ float max3f(float a,float b,float c){float r;asm("v_max3_f32 %0, %1, %2, %3":"=v"(r):"v"(a),"v"(b),"v"(c));return r;}
__device__ __forceinline__ float max2f(float a,float b){float r;asm("v_max_f32_e32 %0, %1, %2":"=v"(r):"v"(a),"v"(b));return r;}
__device__ __forceinline__ float fadd_s(float a,float b){float r;asm("v_add_f32_e32 %0, %1, %2":"=v"(r):"v"(a),"v"(b));return r;}
__device__ __forceinline__ float fsub_s(float a,float b){float r;asm("v_sub_f32_e32 %0, %1, %2":"=v"(r):"v"(a),"v"(b));return r;}
typedef float f32x2_t __attribute__((ext_vector_type(2))); typedef float f32x4_t __attribute__((ext_vector_type(4))); typedef __bf16 bf16x2_t __attribute__((ext_vector_type(2)));
__device__ __forceinline__ unsigned cvtpk_s(float lo,float hi){f32x2_t v={lo,hi};bf16x2_t b=__builtin_convertvector(v,bf16x2_t);return __builtin_bit_cast(unsigned,b);}
#define WAIT_BAR(N) asm volatile("s_waitcnt vmcnt(" #N ") lgkmcnt(0)\n\ts_barrier":::"memory")

__device__ __forceinline__ void qkt(f32x16&p0,f32x16&p1,const char*Kslot,const bf16x8*qr,const f32x16&negm,int r32,int hi){
  const char*kb=Kslot+hi*1024+r32*16;
  #pragma unroll
  for(int d0=0;d0<4;++d0){
    const bf16x8 b0=*reinterpret_cast<const bf16x8*>(kb+d0*2048);
    const bf16x8 b1=*reinterpret_cast<const bf16x8*>(kb+d0*2048+512);
    if(d0==0){p0=__builtin_amdgcn_mfma_f32_32x32x16_bf16(b0,qr[0],negm,0,0,0);p1=__builtin_amdgcn_mfma_f32_32x32x16_bf16(b1,qr[0],negm,0,0,0);}
    else{p0=__builtin_amdgcn_mfma_f32_32x32x16_bf16(b0,qr[d0],p0,0,0,0);p1=__builtin_amdgcn_mfma_f32_32x32x16_bf16(b1,qr[d0],p1,0,0,0);}}
}
typedef __attribute__((address_space(3))) const char* lds_cptr;
typedef short v4i16_t __attribute__((ext_vector_type(4)));
__device__ __forceinline__ void kload8(bf16x8*kf,lds_cptr kp){
  kf[0]=*(const __attribute__((address_space(3))) bf16x8*)(kp);      kf[1]=*(const __attribute__((address_space(3))) bf16x8*)(kp+512);
  kf[2]=*(const __attribute__((address_space(3))) bf16x8*)(kp+2048); kf[3]=*(const __attribute__((address_space(3))) bf16x8*)(kp+2560);
  kf[4]=*(const __attribute__((address_space(3))) bf16x8*)(kp+4096); kf[5]=*(const __attribute__((address_space(3))) bf16x8*)(kp+4608);
  kf[6]=*(const __attribute__((address_space(3))) bf16x8*)(kp+6144); kf[7]=*(const __attribute__((address_space(3))) bf16x8*)(kp+6656);
}
__device__ __forceinline__ void kload2(bf16x8*kf,lds_cptr kp,int j){ kf[2*j]=*(const __attribute__((address_space(3))) bf16x8*)(kp+j*2048); kf[2*j+1]=*(const __attribute__((address_space(3))) bf16x8*)(kp+j*2048+512); }
__device__ __forceinline__ s16x4 vtr(lds_cptr p){ return __builtin_bit_cast(s16x4,__builtin_amdgcn_ds_read_tr16_b64_v4i16((__attribute__((address_space(3))) v4i16_t*)p)); }
__device__ __forceinline__ float rowmax(const f32x16&p0,const f32x16&p1){
  float a=max3f(p0[0],p0[1],p1[0]),b=max3f(p0[2],p0[3],p1[1]);a=max3f(a,p1[2],p1[3]);
  #pragma unroll
  for(int r=4;r<16;r+=4){a=max3f(a,p0[r],p0[r+1]);b=max3f(b,p0[r+2],p0[r+3]);a=max3f(a,p1[r],p1[r+1]);b=max3f(b,p1[r+2],p1[r+3]);}
  const float m=max2f(a,b);
  auto rr=__builtin_amdgcn_permlane32_swap(__float_as_uint(m),__float_as_uint(m),false,false);
  return max2f(__uint_as_float(rr[0]),__uint_as_float(rr[1]));
}
__device__ __forceinline__ void pv(f32x16*o,int vb,bf16x8 pa0,bf16x8 pa1,bf16x8 pa2,bf16x8 pa3){
  #pragma unroll
  for(int d0=0;d0<4;++d0){s16x4 lo[4],hi[4];
    #pragma unroll
    for(int ks=0;ks<4;++ks){
      asm volatile("ds_read_b64_tr_b16 %0,%1 offset:%c2":"=&v"(lo[ks]):"v"(vb),"i"(d0*4096+ks*1024):"memory");
      asm volatile("ds_read_b64_tr_b16 %0,%1 offset:%c2":"=&v"(hi[ks]):"v"(vb),"i"(d0*4096+ks*1024+512):"memory");}
    asm volatile("s_waitcnt lgkmcnt(0)":::"memory");SBAR();
    #define PK(k) (bf16x8){lo[k][0],lo[k][1],lo[k][2],lo[k][3],hi[k][0],hi[k][1],hi[k][2],hi[k][3]}
    o[d0]=__builtin_amdgcn_mfma_f32_32x32x16_bf16(pa0,PK(0),o[d0],0,0,0);
    o[d0]=__builtin_amdgcn_mfma_f32_32x32x16_bf16(pa1,PK(1),o[d0],0,0,0);
    o[d0]=__builtin_amdgcn_mfma_f32_32x32x16_bf16(pa2,PK(2),o[d0],0,0,0);
    o[d0]=__builtin_amdgcn_mfma_f32_32x32x16_bf16(pa3,PK(3),o[d0],0,0,0);
    #undef PK
  }
}

#ifndef ATTN_STORE16
#define ATTN_STORE16(p,v) (*(u32x4*)(p)=(v))
#endif
template<int THRL,int MODE> __device__ __forceinline__ void attn_unit(int qb,const bf16*Qb,const bf16*__restrict__ Kb,const bf16*__restrict__ Vb,bf16*Ob,bf16*Yb,const float*gp,float lam,float gsc,char*shm){
  int tid_=threadIdx.x; asm volatile("":"+v"(tid_));
  const int tid=tid_,lane=tid&63,r32=lane&31,hi=lane>>5; const int wid=__builtin_amdgcn_readfirstlane(tid>>6);
  const int q0=qb*QB;
  const bf16*Qw=Qb+(long)(q0+wid*QBLK)*DMI;
  const bf16*Kh=Kb,*Vh=Vb;
  const unsigned lds0=(unsigned)(uintptr_t)shm;
  float*wsf=(float*)(shm+LDS_WS)+wid*64;
  const unsigned koff=(unsigned)(lane*DMI+wid*8)*2u;
  const unsigned voff=(unsigned)((16*(wid&3)+(lane>>2))*DMI+(wid>>2)*32+(lane&3)*8)*2u;
  const unsigned kdst=lds0+LDS_K+wid*1024, vdst=lds0+LDS_V+wid*1024;
  #define DMA_K(t,slot) glds16s(Kh+(long)(t)*KVBLK*DMI,koff,(unsigned)__builtin_amdgcn_readfirstlane(kdst+(slot)))
  #define DMA_V(t,slot) do{ glds16s(Vh+(long)(t)*KVBLK*DMI,voff,(unsigned)__builtin_amdgcn_readfirstlane(vdst+2*(slot))); glds16s(Vh+64+(long)(t)*KVBLK*DMI,voff,(unsigned)__builtin_amdgcn_readfirstlane(vdst+2*(slot)+8192)); }while(0)
  const char*Kbase=shm+LDS_K; bf16x8 kf[8];
  const lds_cptr shm3=(lds_cptr)shm; const lds_cptr kp0=shm3+LDS_K+hi*1024+r32*16; const lds_cptr vp0=shm3+LDS_V+((lane>>4)&1)*32+(lane&3)*8+(4*hi+((lane&15)>>2))*64;
  const int NT=(q0+QB)/KVBLK;
  DMA_K(0,0);DMA_V(0,0);DMA_K(1,SLOTB);
  bf16x8 qr[4];
  #pragma unroll
  for(int d0=0;d0<4;++d0)qr[d0]=*reinterpret_cast<const bf16x8*>(&Qw[(long)r32*DMI+d0*16+hi*8]);
  float mhat=0.f,l_reg=0.f;f32x16 o[4];o[0]=f32x16{};o[1]=f32x16{};o[2]=f32x16{};o[3]=f32x16{};f32x16 negm=f32x16{};asm volatile("":"+v"(negm));
  const int qrel=wid*QBLK+r32;
  #define CMASK(P0,P1,t) do{int jb_=(t)-(NT-4); if(jb_>=0)cmask(P0,P1,jb_,qrel,hi);}while(0)
  bool resc=false;
  #define START(P0,P1) do{ const float rm=rowmax(P0,P1); resc=false; \
    { const float dl=rm; mhat=fadd_s(mhat,dl); \
      _Pragma("unroll") for(int r=0;r<16;++r){P0[r]=fsub_s(P0[r],dl);P1[r]=fsub_s(P1[r],dl);} \
      _Pragma("unroll") for(int r=0;r<16;++r)negm[r]=-mhat; asm volatile("":"+v"(negm)); } \
    _Pragma("unroll") for(int r=0;r<16;++r)P0[r]=__builtin_amdgcn_exp2f(P0[r]); }while(0)
  #define RESC() do{ if(resc){ asm volatile("s_waitcnt lgkmcnt(0)":::"memory"); \
      _Pragma("unroll") for(int d_=0;d_<4;++d_) _Pragma("unroll") for(int r=0;r<16;++r)o[d_][r]*=wsf[crow(r,hi)]; } }while(0)
  f32x16 pA0,pA1,pB0,pB1;
  int sl_prev=0,sl_cur=0,sl_next=SLOTB;
  #define ROT() do{sl_prev=sl_cur;sl_cur=sl_next;sl_next=(sl_next==(NSLOT-1)*SLOTB)?0:sl_next+SLOTB;}while(0)
  DMA_K(2,2*SLOTB);
  WAIT_BAR(3);
  qkt(pA0,pA1,Kbase,qr,negm,r32,hi);asm volatile("s_nop 15\n\ts_nop 7":"+v"(pA0),"+v"(pA1));CMASK(pA0,pA1,0);
  START(pA0,pA1);
  _Pragma("unroll") for(int r=0;r<16;++r)pA1[r]=__builtin_amdgcn_exp2f(pA1[r]);
  WAIT_BAR(0);
  DMA_K(3,0);DMA_V(1,SLOTB);
  ROT();
  kload8(kf,kp0+sl_cur);
  WAIT_BAR(3);
  s16x4 vlo[8],vhi[8]; u32x4 pw0,pw1,pw2,pw3;
  #define PKW(P,B) cvtpk_s(P[B],P[B+1])
  #define PAF(k) __builtin_bit_cast(bf16x8,pw##k)
  #define VFR(i) (bf16x8){vlo[i][0],vlo[i][1],vlo[i][2],vlo[i][3],vhi[i][0],vhi[i][1],vhi[i][2],vhi[i][3]}
  #define PIN(x) asm volatile("":"+v"(x))
  #define MX3(a,b,c) __builtin_fmaxf(__builtin_fmaxf((a),(b)),(c))
  #define GAPA(MF,A0,A1,A2,A3,W0,W1,PW) do{ MF; sacc+=A0; sacc+=A1; sacc+=A2; sacc+=A3; PIN(sacc); W0; W1; PIN(PW); SBAR(); }while(0)
  #define EX(v) __builtin_amdgcn_exp2f(v)
  #define GAPB(MF,X,B) do{ MF; X[B]=EX(X[B]); X[B+1]=EX(X[B+1]); PIN(X); SBAR(); }while(0)
  #define VRD2(i) do{ vlo[i]=vtr(vp_+(8192+((i)>>2)*4096+((i)&3)*1024)); vhi[i]=vtr(vp_+(8192+((i)>>2)*4096+((i)&3)*1024+512)); SBAR(); }while(0)
  #define VRD(i) do{ vlo[i]=vtr(vp_+(((i)>>2)*4096+((i)&3)*1024)); vhi[i]=vtr(vp_+(((i)>>2)*4096+((i)&3)*1024+512)); }while(0)
  #define KRD(G,j) do{ if(G){ kload2(kf,kp0+sl_next,j); SBAR(); } }while(0)
  #define STEP(C0,C1,P0,P1,t,GK,GV,GL) do{ SBAR(); \
    const lds_cptr vp_=vp0+2*sl_prev; \
    VRD(0); SBAR(); float sacc=(P0[0]+P0[1]); \
    GAPA(C0=__builtin_amdgcn_mfma_f32_32x32x16_bf16(kf[0],qr[0],negm,0,0,0), P0[2],P0[3],P0[4],P0[5],     pw0[0]=PKW(P0,0), pw0[1]=PKW(P0,2), pw0); \
    VRD(4); SBAR(); GAPA(C1=__builtin_amdgcn_mfma_f32_32x32x16_bf16(kf[1],qr[0],negm,0,0,0), P0[6],P0[7],P0[8],P0[9],     pw0[2]=PKW(P0,4), pw0[3]=PKW(P0,6), pw0); \
    VRD(1); SBAR(); GAPA(C0=__builtin_amdgcn_mfma_f32_32x32x16_bf16(kf[2],qr[1],C0,0,0,0),   P0[10],P0[11],P0[12],P0[13], pw1[0]=PKW(P0,8), pw1[1]=PKW(P0,10), pw1); \
    VRD(5); SBAR(); GAPA(C1=__builtin_amdgcn_mfma_f32_32x32x16_bf16(kf[3],qr[1],C1,0,0,0),   P0[14],P0[15],P1[0],P1[1],   pw1[2]=PKW(P0,12),pw1[3]=PKW(P0,14), pw1); \
    VRD(2); SBAR(); GAPA(C0=__builtin_amdgcn_mfma_f32_32x32x16_bf16(kf[4],qr[2],C0,0,0,0),   P1[2],P1[3],P1[4],P1[5],     pw2[0]=PKW(P1,0), pw2[1]=PKW(P1,2), pw2); \
    VRD(6); SBAR(); GAPA(C1=__builtin_amdgcn_mfma_f32_32x32x16_bf16(kf[5],qr[2],C1,0,0,0),   P1[6],P1[7],P1[8],P1[9],     pw2[2]=PKW(P1,4), pw2[3]=PKW(P1,6), pw2); \
    VRD(3); SBAR(); GAPA(C0=__builtin_amdgcn_mfma_f32_32x32x16_bf16(kf[6],qr[3],C0,0,0,0),   P1[10],P1[11],P1[12],P1[13], pw3[0]=PKW(P1,8), pw3[1]=PKW(P1,10), pw3); \
    VRD(7); SBAR(); GAPA(C1=__builtin_amdgcn_mfma_f32_32x32x16_bf16(kf[7],qr[3],C1,0,0,0),   P1[14],P1[15],0.f,0.f,       pw3[2]=PKW(P1,12),pw3[3]=PKW(P1,14), pw3); \
    l_reg+=sacc; \
    if(GK){DMA_K((t)+3,sl_cur);} if(GV){DMA_V((t)+1,sl_next);} \
    CMASK(C0,C1,t); \
    { float a=MX3(C0[0],C0[1],C1[0]),b=MX3(C0[2],C0[3],C1[1]); a=MX3(a,C1[2],C1[3]); \
      _Pragma("unroll") for(int r=4;r<16;r+=4){a=MX3(a,C0[r],C0[r+1]);b=MX3(b,C0[r+2],C0[r+3]);a=MX3(a,C1[r],C1[r+1]);b=MX3(b,C1[r+2],C1[r+3]);} \
      float rm=__builtin_fmaxf(a,b); { auto rr=__builtin_amdgcn_permlane32_swap(__float_as_uint(rm),__float_as_uint(rm),false,false); rm=__builtin_fmaxf(__uint_as_float(rr[0]),__uint_as_float(rr[1])); } \
      resc=false; \
      if(__builtin_expect(__any(rm>(float)THRL),0)){ const float dl=__builtin_fmaxf(rm,0.f); mhat+=dl; \
        _Pragma("unroll") for(int r=0;r<16;++r){C0[r]-=dl;C1[r]-=dl;} \
        _Pragma("unroll") for(int r=0;r<16;++r)negm[r]=-mhat; asm volatile("":"+v"(negm)); \
        const float f=__builtin_amdgcn_exp2f(-dl); l_reg*=f; if(hi==0)wsf[r32]=f; resc=true; } } \
    SBAR(); \
    GAPB(o[0]=__builtin_amdgcn_mfma_f32_32x32x16_bf16(PAF(0),VFR(0),o[0],0,0,0), C0,0);  VRD2(0); \
    GAPB(o[1]=__builtin_amdgcn_mfma_f32_32x32x16_bf16(PAF(0),VFR(4),o[1],0,0,0), C0,2);  VRD2(4); \
    GAPB(o[0]=__builtin_amdgcn_mfma_f32_32x32x16_bf16(PAF(1),VFR(1),o[0],0,0,0), C0,4);  VRD2(1); \
    GAPB(o[1]=__builtin_amdgcn_mfma_f32_32x32x16_bf16(PAF(1),VFR(5),o[1],0,0,0), C0,6);  VRD2(5); \
    GAPB(o[0]=__builtin_amdgcn_mfma_f32_32x32x16_bf16(PAF(2),VFR(2),o[0],0,0,0), C0,8);  VRD2(2); \
    GAPB(o[1]=__builtin_amdgcn_mfma_f32_32x32x16_bf16(PAF(2),VFR(6),o[1],0,0,0), C0,10); VRD2(6); \
    GAPB(o[0]=__builtin_amdgcn_mfma_f32_32x32x16_bf16(PAF(3),VFR(3),o[0],0,0,0), C0,12); VRD2(3); \
    GAPB(o[1]=__builtin_amdgcn_mfma_f32_32x32x16_bf16(PAF(3),VFR(7),o[1],0,0,0), C0,14); VRD2(7); \
    GAPB(o[2]=__builtin_amdgcn_mfma_f32_32x32x16_bf16(PAF(0),VFR(0),o[2],0,0,0), C1,0); \
    GAPB(o[3]=__builtin_amdgcn_mfma_f32_32x32x16_bf16(PAF(0),VFR(4),o[3],0,0,0), C1,2); \
    KRD(GL,0); GAPB(o[2]=__builtin_amdgcn_mfma_f32_32x32x16_bf16(PAF(1),VFR(1),o[2],0,0,0), C1,4); \
    KRD(GL,1); GAPB(o[3]=__builtin_amdgcn_mfma_f32_32x32x16_bf16(PAF(1),VFR(5),o[3],0,0,0), C1,6); \
    KRD(GL,2); GAPB(o[2]=__builtin_amdgcn_mfma_f32_32x32x16_bf16(PAF(2),VFR(2),o[2],0,0,0), C1,8); \
    KRD(GL,3); GAPB(o[3]=__builtin_amdgcn_mfma_f32_32x32x16_bf16(PAF(2),VFR(6),o[3],0,0,0), C1,10); \
    GAPB(o[2]=__builtin_amdgcn_mfma_f32_32x32x16_bf16(PAF(3),VFR(3),o[2],0,0,0), C1,12); \
    GAPB(o[3]=__builtin_amdgcn_mfma_f32_32x32x16_bf16(PAF(3),VFR(7),o[3],0,0,0), C1,14); \
    }while(0)
  int t=1;
  #undef CMASK
  #define CMASK(P0,P1,t) do{}while(0)
  for(;t+5<NT;t+=2){
    STEP(pB0,pB1,pA0,pA1,t,true,true,true);     WAIT_BAR(3); RESC(); ROT();
    STEP(pA0,pA1,pB0,pB1,t+1,true,true,true);   WAIT_BAR(3); RESC(); ROT();
  }
  #undef CMASK
  #define CMASK(P0,P1,t) do{int jb_=(t)-(NT-4); if(jb_>=0)cmask(P0,P1,jb_,qrel,hi);}while(0)
  #define ENDW(tt) do{ if((tt)+3<NT){WAIT_BAR(3);} else if((tt)+2<NT){WAIT_BAR(2);} else {WAIT_BAR(0);} }while(0)
  for(;t+1<NT;t+=2){
    STEP(pB0,pB1,pA0,pA1,t,(t+3<NT),(t+1<NT),(t+1<NT));       ENDW(t);   RESC(); ROT();
    STEP(pA0,pA1,pB0,pB1,t+1,(t+4<NT),(t+2<NT),(t+2<NT));     ENDW(t+1); RESC(); ROT();
  }
  STEP(pB0,pB1,pA0,pA1,NT-1,false,false,false); RESC();
  { float sacc=pB0[0]+pB0[1]; _Pragma("unroll") for(int r=2;r<16;++r)sacc+=pB0[r]; _Pragma("unroll") for(int r=0;r<16;++r)sacc+=pB1[r]; l_reg+=sacc;
    pw0=(u32x4){PKW(pB0,0),PKW(pB0,2),PKW(pB0,4),PKW(pB0,6)};pw1=(u32x4){PKW(pB0,8),PKW(pB0,10),PKW(pB0,12),PKW(pB0,14)};pw2=(u32x4){PKW(pB1,0),PKW(pB1,2),PKW(pB1,4),PKW(pB1,6)};pw3=(u32x4){PKW(pB1,8),PKW(pB1,10),PKW(pB1,12),PKW(pB1,14)};
    SBAR(); pv(o,(int)(unsigned)(uintptr_t)(vp0+2*sl_cur),PAF(0),PAF(1),PAF(2),PAF(3)); }
  #undef PKW
  #undef PAF
  #undef VFR
  #undef PIN
  #undef MX3
  #undef GAPA
  #undef GAPB
  #undef EX
  #undef VRD
  #undef VRD2
  #undef KRD
  #undef STEP
  #undef ENDW
  {auto rr=__builtin_amdgcn_permlane32_swap(__float_as_uint(l_reg),__float_as_uint(l_reg),false,false);l_reg=__uint_as_float(rr[0])+__uint_as_float(rr[1]);}
  if(hi==0)wsf[32+r32]=l_reg;asm volatile("s_waitcnt lgkmcnt(0)":::"memory");
  float rli[16];
  #pragma unroll
  for(int r=0;r<16;++r)rli[r]=__builtin_amdgcn_rcpf(wsf[32+crow(r,hi)]);
  bf16*Ow=Ob+(long)(q0+wid*QBLK)*DMO;
  if constexpr(MODE==0){ bf16*stg=(bf16*)(shm+LDS_OST)+wid*2048;
    #pragma unroll
    for(int hf=0;hf<2;++hf){
    #pragma unroll
    for(int r=0;r<16;++r){const int orow=crow(r,hi);
      #pragma unroll
      for(int d0=0;d0<2;++d0)stg[orow*64+d0*32+r32]=__float2bfloat16(o[hf*2+d0][r]*rli[r]);}
    asm volatile("s_waitcnt lgkmcnt(0)":::"memory");
    #pragma unroll
    for(int i=0;i<4;++i){const int row=i*8+(lane>>3),ch=lane&7; const u32x4 v=*(const u32x4*)(stg+row*64+ch*8); ATTN_STORE16(Ow+(long)row*DMO+hf*64+ch*8,v);}
    asm volatile("s_waitcnt lgkmcnt(0)":::"memory"); } }
  else { bf16*stg=(bf16*)(shm+LDS_OST)+wid*2048;
    const int ch=lane&7,rw=lane>>3;
    u32x4 o1[2][4];
    #pragma unroll
    for(int hf=0;hf<2;++hf)
      #pragma unroll
      for(int i=0;i<4;++i)o1[hf][i]=*(const u32x4*)(Ow+(long)(i*8+rw)*DMO+hf*64+ch*8);
    f32x4_t gq[2][2];
    #pragma unroll
    for(int hf=0;hf<2;++hf){gq[hf][0]=*(const f32x4_t*)(gp+hf*64+ch*8);gq[hf][1]=*(const f32x4_t*)(gp+hf*64+ch*8+4);}
    float dv[2][4][8]; float ss[4]={0.f,0.f,0.f,0.f};
    #pragma unroll
    for(int hf=0;hf<2;++hf){
      #pragma unroll
      for(int r=0;r<16;++r){const int orow=crow(r,hi);
        #pragma unroll
        for(int d0=0;d0<2;++d0)stg[orow*64+d0*32+r32]=__float2bfloat16(o[hf*2+d0][r]*rli[r]);}
      asm volatile("s_waitcnt lgkmcnt(0)":::"memory");
      #pragma unroll
      for(int i=0;i<4;++i){const u32x4 v=*(const u32x4*)(stg+(i*8+rw)*64+ch*8);
        #pragma unroll
        for(int k=0;k<4;++k){ const unsigned a=o1[hf][i][k],b=v[k];
          const float d0_=__uint_as_float(a<<16)-lam*__uint_as_float(b<<16), d1_=__uint_as_float(a&0xffff0000u)-lam*__uint_as_float(b&0xffff0000u);
          dv[hf][i][2*k]=d0_; dv[hf][i][2*k+1]=d1_; ss[i]+=d0_*d0_+d1_*d1_; } }
      asm volatile("s_waitcnt lgkmcnt(0)":::"memory"); }
    bf16*Yw=Yb+(long)(q0+wid*QBLK)*DMI;
    #pragma unroll
    for(int i=0;i<4;++i){ float t_=ss[i];
      t_=t_+__builtin_bit_cast(float,__builtin_amdgcn_update_dpp(0,__builtin_bit_cast(int,t_),0xB1,0xF,0xF,true));
      t_=t_+__builtin_bit_cast(float,__builtin_amdgcn_update_dpp(0,__builtin_bit_cast(int,t_),0x4E,0xF,0xF,true));
      t_=t_+__builtin_bit_cast(float,__builtin_amdgcn_update_dpp(0,__builtin_bit_cast(int,t_),0x141,0xF,0xF,true));
      const float rs=__builtin_amdgcn_rsqf(t_*(1.f/128.f)+1e-5f)*gsc;
      #pragma unroll
      for(int hf=0;hf<2;++hf){ u32x4 w;
        #pragma unroll
        for(int k=0;k<4;++k){ const float g0_=k<2?gq[hf][0][2*k]:gq[hf][1][2*k-4], g1_=k<2?gq[hf][0][2*k+1]:gq[hf][1][2*k-3]; w[k]=cvtpk_s(dv[hf][i][2*k]*rs*g0_,dv[hf][i][2*k+1]*rs*g1_); }
        ATTN_STORE16(Yw+(long)(i*8+rw)*DMI+hf*64+ch*8,w); } } }
  asm volatile("s_waitcnt lgkmcnt(0)\n\ts_barrier":::"memory");
  #undef DMA_K
  #undef DMA_V
  #undef CMASK
  #undef START
  #undef RESC
  #undef ROT
}
constexpr int ATTN_LDS_BYTES=LDS_BYTES;
#undef SBAR
#undef WAIT_BAR
}
extern __shared__ __attribute__((aligned(16))) unsigned char g_lds[];
constexpr size_t WS_OV = WS_R;
__device__ __forceinline__ void p2c_hgrn(Frame& F_, int l, int unit);
template <int PART> __device__ __forceinline__ void p1_part(Frame& F_, int g, int l, int G, int c);
constexpr int CW_MOE = 32768;
constexpr int CW_P1B = 24576;
constexpr int CW_Q = 20480;
constexpr int NQ_ATT = GB * 4 * 8, NQ_CONV = TG / 64;
constexpr int WI_IN = 16 * 240, WI_BR = 8 * 32, WI_OUT = 16 * 32, WI_W1 = 16 * 16, WI_W2 = 8 * 32;
constexpr int WN_IN = 2 * WI_IN, WN_BR = 6 * WI_BR, WN_OUT = 2 * WI_OUT, WN_W1 = 64 * WI_W1, WN_W2 = 64 * WI_W2;
constexpr int W_NITEMS = WN_IN + WN_BR + WN_OUT + 2 * WN_W1 + WN_W2;
constexpr int NWP_UNITS = (W_NITEMS - WI_IN + 63) / 64, NWP8 = (NWP_UNITS + 7) / 8;
__device__ __forceinline__ void wprep_items(Frame& F_, int first, int step, int end);
constexpr int CW_PB = 65536;
__device__ __noinline__ void p1b_arrive(LAS unsigned char* lds, unsigned* pq) {
    if (threadIdx.x == 0) {
        volatile LAS unsigned* st = (volatile LAS unsigned*)(lds + MISC_OFF) + 8;
        const unsigned nloc = st[0], x = xb_xcc_id() & 15u;
        const unsigned old = xb_add(&pq[64 * x], 1u);
        if (old + 1u == nloc) { __builtin_amdgcn_fence(__ATOMIC_RELEASE, "agent"); asm volatile("s_waitcnt vmcnt(0)" ::: "memory"); (void)xb_add(&pq[1024], 1u); }
    }
}
__device__ __forceinline__ void p2_mixers(Frame& F_, int g, int l, int rep) {
    bool p1b_done = blockIdx.x < GB * 4, p1b_now = false, qlast = false;
    static_assert(NQ_ATT / 8 >= 32, "a workgroup's first pull (before its in-projection units) must never be a conv unit: at most 32 workgroups pull first from one XCD queue, whose first NQ_ATT/8 units are attention pairs");
    if (blockIdx.x < GB * 4) { p2c_hgrn(F_, l, blockIdx.x); KArgs ka3 = kargs(); p1b_arrive(F_.lds, (unsigned*)((unsigned char*)(GAS unsigned char*)ka3->ws + WS_CTL) + CW_PB + 2048 * (g * 2 + l)); }
    KA_WS();
    Frame F = mkframe(F_.lds);
    const int xq = (int)(xb_xcc_id() & 7u);
    volatile LAS int* qslot = (volatile LAS int*)(F.lds + MISC_OFF + 128);
    bool conv_ok = false;
    const bool wpq = (g == 0 && l == 0);
    const int NQX = (NQ_ATT + NQ_CONV) / 8 + (wpq ? NWP8 : 0);
    unsigned* qbase = (unsigned*)(ws + WS_CTL) + CW_Q + 64 * ((g * 2 + l) * 8);
    int xcur = xq;
    for (;;) {
        __syncthreads();
        if (F.tid == 0) qslot[0] = (int)__hip_atomic_fetch_add(qbase + 64 * xcur, 1u, __ATOMIC_RELAXED, __HIP_MEMORY_SCOPE_AGENT);
        __syncthreads();
        int u = __builtin_amdgcn_readfirstlane(qslot[0]);
        if (u >= NQX) {
            __syncthreads();
            int t8 = threadIdx.x; asm volatile("" : "+v"(t8));
            if (t8 < 8) { const unsigned hd = __hip_atomic_load(qbase + 64 * t8, __ATOMIC_RELAXED, __HIP_MEMORY_SCOPE_AGENT); const unsigned long long m = __ballot(hd < (unsigned)NQX);
                if (t8 == 0) qslot[1] = m ? (int)__builtin_ctzll(m) : -1; }
            __syncthreads();
            const int nx = __builtin_amdgcn_readfirstlane(qslot[1]);
            if (nx < 0) { if (!p1b_done) { p1b_now = true; qlast = true; } else break; }
            else { xcur = nx; continue; }
        }
        if (!qlast) {
        const int xu = xcur;
        int kind = 0, ui = u;
        if (wpq) { constexpr int MIXN = NQ_ATT / 8 + NWP8;
            if (u < MIXN) { const int a0 = u * (NQ_ATT / 8) / MIXN, a1 = (u + 1) * (NQ_ATT / 8) / MIXN; if (a1 > a0) { kind = 0; ui = a0; } else { kind = 2; ui = u - a0; } }
            else { kind = 1; ui = u - MIXN; } }
        else if (u >= NQ_ATT / 8) { kind = 1; ui = u - NQ_ATT / 8; }
        if (kind == 1 && !conv_ok) {
            unsigned* pdone = (unsigned*)(ws + WS_CTL) + CW_PB + 2048 * (g * 2 + l) + 1024;
            if (F.tid == 0) { const unsigned nx = ((volatile LAS unsigned*)(F.lds + MISC_OFF))[9]; unsigned sp = 0; while (__hip_atomic_load(pdone, __ATOMIC_RELAXED, __HIP_MEMORY_SCOPE_AGENT) < nx) { __builtin_amdgcn_s_sleep(4); if (++sp > (1u << 22)) break; }
                __builtin_amdgcn_fence(__ATOMIC_ACQUIRE, "agent"); asm volatile("s_waitcnt vmcnt(0)" ::: "memory"); }
            __syncthreads(); conv_ok = true;
        }
        if (kind == 2) { const int base = WI_IN + (ui * 8 + xu) * 64; int w8 = threadIdx.x; asm volatile("" : "+v"(w8)); w8 = __builtin_amdgcn_readfirstlane(w8 >> 6);
            wprep_items(F_, base + w8, 8, (base + 64 < W_NITEMS ? base + 64 : W_NITEMS)); }
        else if (kind == 0) { const int u = ui;
            const int qb = 7 - u / (GB / 2), vhd = (u % (GB / 2)) * 8 + xu;
            const int bl = vhd >> 2, hd = vhd & 3;
            const attn_body::bf16* Qb = (const attn_body::bf16*)((bf16*)(ws + WS_Q) + (size_t)bl * S * 512 + hd * 128);
            const attn_body::bf16* Kb = (const attn_body::bf16*)((bf16*)(ws + WS_K) + (size_t)bl * S * 512 + hd * 128);
            const attn_body::bf16* Vb = (const attn_body::bf16*)((bf16*)(ws + WS_V) + (size_t)bl * S * 512 + hd * 128);
            attn_body::bf16* Ob = (attn_body::bf16*)((bf16*)(ws + WS_OV) + (size_t)bl * S * 1024 + hd * 256);
            attn_body::bf16* Yb = (attn_body::bf16*)((bf16*)(ws + WS_YB) + (size_t)bl * S * 512 + hd * 128);
            int ll = l; asm volatile("" : "+s"(ll));
            const float lam = ((const float*)(ws + WS_LB))[1024 + ll]; const float lam_init = ll == 0 ? 0.2f : 0.35550906759096934f;
            const float* gp = (const float*)KIN(8) + ll * 128;
            attn_body::attn_unit<8, 0>(qb, Qb, Kb, Vb, Ob, Yb, gp, lam, 1.f - lam_init, (char*)g_lds);
            attn_body::attn_unit<8, 1>(qb, Qb + 64, Kb + 64, Vb, Ob, Yb, gp, lam, 1.f - lam_init, (char*)g_lds);
        } else { int ll = l; asm volatile("" : "+s"(ll)); Frame Fc = mkframe(F_.lds); p2_conv_unit(Fc, ws, ka, ll, ui * 8 + xu); }
        if (!p1b_done) p1b_now = true;
        }
        if (p1b_now) {
            asm volatile("s_waitcnt vmcnt(0) lgkmcnt(0)" ::: "memory"); __syncthreads();
            p1_part<1>(F_, g, l, (int)gridDim.x - GB * 4, (int)blockIdx.x - GB * 4);
            KArgs ka2 = kargs();
            asm volatile("s_waitcnt vmcnt(0)" ::: "memory"); __syncthreads();
            p1b_arrive(F_.lds, (unsigned*)((unsigned char*)(GAS unsigned char*)ka2->ws + WS_CTL) + CW_PB + 2048 * (g * 2 + l));
            p1b_done = true; p1b_now = false;
        }
        if (qlast) break;
    }
}
namespace hg {
typedef short bf16x8 __attribute__((ext_vector_type(8)));
typedef float f32x16 __attribute__((ext_vector_type(16)));
constexpr int ST = 272, STT = 80, RS = 264;
constexpr int O_Q1 = 0, O_KT = 8704, O_KTT = 17408, O_VT = 27648, O_D = 37888, OPS = 38400;
constexpr int L_O = 2 * OPS;
static_assert(L_O + 2 * 16384 <= MISC_OFF, "HGRN LDS map");
__device__ __forceinline__ void lbar() { asm volatile("s_waitcnt lgkmcnt(0)" ::: "memory"); __builtin_amdgcn_s_barrier(); asm volatile("" ::: "memory"); }
__device__ __forceinline__ bf16x8 pack8(const f32x16& x, int b) {
    u32x4 w; w.x = pg8::cvt_pk_bf16(x[b], x[b + 1]); w.y = pg8::cvt_pk_bf16(x[b + 2], x[b + 3]); w.z = pg8::cvt_pk_bf16(x[b + 4], x[b + 5]); w.w = pg8::cvt_pk_bf16(x[b + 6], x[b + 7]);
    return __builtin_bit_cast(bf16x8, w);
}
__device__ __forceinline__ bf16x8 ld2x8(const LAS unsigned char* p) {
    const u32x2 a = *(const LAS u32x2*)p, b = *(const LAS u32x2*)(p + 16); u32x4 w; w.x = a.x; w.y = a.y; w.z = b.x; w.w = b.y; return __builtin_bit_cast(bf16x8, w);
}
__device__ __forceinline__ float quad_bcast(float v, int which) {
    const int iv = __builtin_bit_cast(int, v); int r;
    if (which == 0) r = __builtin_amdgcn_update_dpp(0, iv, 0x00, 0xF, 0xF, true); else if (which == 1) r = __builtin_amdgcn_update_dpp(0, iv, 0x55, 0xF, 0xF, true);
    else if (which == 2) r = __builtin_amdgcn_update_dpp(0, iv, 0xAA, 0xF, 0xF, true); else r = __builtin_amdgcn_update_dpp(0, iv, 0xFF, 0xF, 0xF, true);
    return __builtin_bit_cast(float, r);
}
}
__device__ __forceinline__ void p2c_hgrn(Frame& F_, int l, int unit) {
    KA_WS();
    Frame F = mkframe(F_.lds);
    using namespace hg;
    const int bl = unit >> 2, h = unit & 3;
    LAS unsigned char* lds = F.lds;
    const int lane = F.lane, wave = F.wave, r32 = lane & 31, hi = lane >> 5;
    const size_t rb = ((size_t)(bl * 4 + h) * S) * 128;
    const size_t rbY = ((size_t)bl * S) * 512 + h * 128;
    const bf16* HQ = (const bf16*)(ws + WS_HQ) + rb; const bf16* HF = (const bf16*)(ws + WS_HF) + rb; const bf16* HV = (const bf16*)(ws + WS_HV) + rb; const bf16* HG = (const bf16*)(ws + WS_HG) + rb;
    bf16* YC = (bf16*)(ws + WS_YC) + rbY;
    const bool isP = wave >= 4;
    const int pw = wave & 3;
    __syncthreads();
    auto hg_finish = [&](LAS unsigned char* lds_, int j, int pw_, int lane_, float n0_, float n1_, const unsigned (&gt_)[8]) __attribute__((always_inline)) {
        LAS float* Ot = (LAS float*)(lds_ + L_O + (j & 1) * 16384);
        f32x2 ov[8];
#pragma unroll
        for (int jj = 0; jj < 8; ++jj) ov[jj] = *(const LAS f32x2*)(Ot + (8 * pw_ + jj) * 128 + 2 * lane_);
        asm volatile("s_waitcnt lgkmcnt(0)" ::: "memory");
#pragma unroll
        for (int jj = 0; jj < 8; ++jj) { const int t = 8 * pw_ + jj; const f32x2 o = ov[jj];
            const float rr = __builtin_amdgcn_rsqf(wave_sum(o.x * o.x + o.y * o.y) * (1.f / 128.f) + EPS);
            *(LAS unsigned*)((LAS unsigned char*)Ot + t * 512 + 4 * lane_) = pk2(o.x * rr * n0_ * lo16(gt_[jj]), o.y * rr * n1_ * hi16(gt_[jj])); }
    };
    if (isP) {
        const int cpi = 16 * pw + (lane >> 2), tq = lane & 3;
        unsigned rawA[24], rawB[24], rawC[24];
#pragma unroll
        for (int k = 0; k < 24; ++k) { rawA[k] = 0u; rawB[k] = 0u; rawC[k] = 0u; }
#define HG_LOAD(SET, n) do { _Pragma("unroll") for (int j = 0; j < 8; ++j) { const size_t go = (size_t)((n) * 32 + 8 * tq + j) * 128 + 2 * cpi; \
            SET[j] = *(const unsigned*)(HF + go); SET[8 + j] = *(const unsigned*)(HQ + go); SET[16 + j] = *(const unsigned*)(HV + go); } } while (0)
        HG_LOAD(rawA, 0); HG_LOAD(rawB, 1); HG_LOAD(rawC, 2);
#define HG_PITER(i, RS_) do { \
            if ((i) + 1 <= 63) hg_prep(lds, RS_, (i) + 1, cpi, tq); \
            if ((i) + 4 <= 63) HG_LOAD(RS_, (i) + 4); \
            lbar(); } while (0)
        auto hg_prep = [&](LAS unsigned char* lds_, const unsigned (&R_)[24], int n, int cpi_, int tq_) __attribute__((always_inline)) {
            LAS unsigned char* op = lds_ + (n & 1) * OPS;
            float p0[8], p1[8], l0[8], l1[8];
#pragma unroll
            for (int j = 0; j < 8; ++j) { const unsigned w = R_[j]; const float x0 = lo16(w) * 1.4426950408889634f, x1 = hi16(w) * 1.4426950408889634f;
                l0[j] = x0; l1[j] = x1; p0[j] = j ? p0[j - 1] + x0 : x0; p1[j] = j ? p1[j - 1] + x1 : x1; }
            float base0 = 0.f, base1 = 0.f, bl0 = 0.f, bl1 = 0.f;
#pragma unroll
            for (int q = 0; q < 4; ++q) { const float t0 = quad_bcast(p0[7], q), t1 = quad_bcast(p1[7], q); bl0 += t0; bl1 += t1; if (q < tq_) { base0 += t0; base1 += t1; } }
            unsigned ka[4], kb[4], va[4], vb4[4];
#pragma unroll
            for (int j = 0; j < 8; ++j) { const int t = 8 * tq_ + j;
                const float b0 = fmaxf(base0 + p0[j], -115.f), b1 = fmaxf(base1 + p1[j], -115.f);
                const float e0 = __builtin_amdgcn_exp2f(b0), e1 = __builtin_amdgcn_exp2f(b1), i0 = __builtin_amdgcn_exp2f(-b0), i1 = __builtin_amdgcn_exp2f(-b1);
                const float k0 = 1.f - __builtin_amdgcn_exp2f(l0[j]), k1 = 1.f - __builtin_amdgcn_exp2f(l1[j]);
                const unsigned qw = R_[8 + j], vw = R_[16 + j];
                const unsigned q1w = pg8::cvt_pk_bf16(lo16(qw) * e0, hi16(qw) * e1), ktw = pg8::cvt_pk_bf16(k0 * i0, k1 * i1);
                *(LAS unsigned*)(op + O_Q1 + t * ST + cpi_ * 4) = q1w; *(LAS unsigned*)(op + O_KT + t * ST + cpi_ * 4) = ktw;
                if (j & 1) { ka[j >> 1] |= ktw << 16; kb[j >> 1] |= ktw & 0xffff0000u; va[j >> 1] |= vw << 16; vb4[j >> 1] |= vw & 0xffff0000u; }
                else { ka[j >> 1] = ktw & 0xffffu; kb[j >> 1] = ktw >> 16; va[j >> 1] = vw & 0xffffu; vb4[j >> 1] = vw >> 16; } }
            *(LAS u32x4*)(op + O_KTT + (2 * cpi_) * STT + 16 * tq_) = (u32x4){ka[0], ka[1], ka[2], ka[3]}; *(LAS u32x4*)(op + O_KTT + (2 * cpi_ + 1) * STT + 16 * tq_) = (u32x4){kb[0], kb[1], kb[2], kb[3]};
            *(LAS u32x4*)(op + O_VT + (2 * cpi_) * STT + 16 * tq_) = (u32x4){va[0], va[1], va[2], va[3]}; *(LAS u32x4*)(op + O_VT + (2 * cpi_ + 1) * STT + 16 * tq_) = (u32x4){vb4[0], vb4[1], vb4[2], vb4[3]};
            if (tq_ == 3) *(LAS f32x2*)(op + O_D + cpi_ * 8) = (f32x2){__builtin_amdgcn_exp2f(fmaxf(bl0, -115.f)), __builtin_amdgcn_exp2f(fmaxf(bl1, -115.f))};
        };
#pragma unroll 1
        for (int i = -1; i <= 62; i += 3) { HG_PITER(i, rawA); HG_PITER(i + 1, rawB); HG_PITER(i + 2, rawC); }
        lbar();
#undef HG_PITER
#undef HG_LOAD
#undef HG_GLOAD
    } else {
        const int vb = pw;
        const float* ng = (const float*)KIN(10) + l * 128;
        const float n0 = ng[2 * lane], n1 = ng[2 * lane + 1];
        unsigned gt[8];
#pragma unroll
        for (int k = 0; k < 8; ++k) gt[k] = 0u;
        f32x16 Sacc[4];
#pragma unroll
        for (int cb = 0; cb < 4; ++cb)
#pragma unroll
            for (int r = 0; r < 16; ++r) Sacc[cb][r] = 0.f;
#pragma unroll 1
        for (int i = -1; i <= 65; ++i) {
            if (i >= 1 && i <= 64) hg_finish(lds, i - 1, pw, lane, n0, n1, gt);
            if (i >= 0 && i <= 63) {
#pragma unroll
                for (int jj = 0; jj < 8; ++jj) gt[jj] = ((const unsigned*)(HG + (size_t)(i * 32 + 8 * pw) * 128))[jj * 64 + lane]; }
            if (vb < 2 && i >= 2) {
                const LAS unsigned char* yt = lds + L_O + (i & 1) * 16384 + vb * 128;
#pragma unroll
                for (int k = 0; k < 4; ++k) { const int row = 8 * k + (lane >> 3), c16 = lane & 7;
                    *(u32x4*)(YC + (size_t)((i - 2) * 32 + row) * 512 + vb * 64 + c16 * 8) = *(const LAS u32x4*)(yt + row * 512 + c16 * 16); }
            }
            if (i >= 0 && i <= 63) {
                const LAS unsigned char* op = lds + (i & 1) * OPS;
                bf16x8 fk[8], fq[8], fp[8], fvp[2];
#pragma unroll
                for (int kc = 0; kc < 8; ++kc) { fk[kc] = *(const LAS bf16x8*)(op + O_KT + r32 * ST + (16 * kc + 8 * hi) * 2); fq[kc] = *(const LAS bf16x8*)(op + O_Q1 + r32 * ST + (16 * kc + 8 * hi) * 2); }
#pragma unroll
                for (int kc = 0; kc < 8; ++kc) fp[kc] = ld2x8(op + O_Q1 + r32 * ST + (16 * kc + 4 * hi) * 2);
#pragma unroll
                for (int ks = 0; ks < 2; ++ks) fvp[ks] = ld2x8(op + O_VT + (32 * vb + r32) * STT + (16 * ks + 4 * hi) * 2);
                asm volatile("s_waitcnt lgkmcnt(0)" ::: "memory"); __builtin_amdgcn_sched_barrier(0);
                f32x16 X, o;
#pragma unroll
                for (int r = 0; r < 16; ++r) { X[r] = 0.f; o[r] = 0.f; }
#pragma unroll
                for (int kc = 0; kc < 8; ++kc) { X = __builtin_amdgcn_mfma_f32_32x32x16_bf16(fk[kc], fq[kc], X, 0, 0, 0);
                    o = __builtin_amdgcn_mfma_f32_32x32x16_bf16(fp[kc], pack8(Sacc[kc >> 1], 8 * (kc & 1)), o, 0, 0, 0); }
                __builtin_amdgcn_sched_barrier(0);
                bf16x8 fkt[8], fvn[2];
#pragma unroll
                for (int ks = 0; ks < 2; ++ks) fvn[ks] = *(const LAS bf16x8*)(op + O_VT + (32 * vb + r32) * STT + (16 * ks + 8 * hi) * 2);
#pragma unroll
                for (int cb = 0; cb < 4; ++cb)
#pragma unroll
                    for (int ks = 0; ks < 2; ++ks) fkt[2 * cb + ks] = *(const LAS bf16x8*)(op + O_KTT + (32 * cb + r32) * STT + (16 * ks + 8 * hi) * 2);
#pragma unroll
                for (int r = 0; r < 16; ++r) { const int sidx = (r & 3) + 8 * (r >> 2) + 4 * hi; X[r] = sidx <= r32 ? X[r] : 0.f; }
#pragma unroll
                for (int ks = 0; ks < 2; ++ks) o = __builtin_amdgcn_mfma_f32_32x32x16_bf16(pack8(X, 8 * ks), fvp[ks], o, 0, 0, 0);
                asm volatile("s_waitcnt lgkmcnt(0)" ::: "memory"); __builtin_amdgcn_sched_barrier(0);
#pragma unroll
                for (int cb = 0; cb < 4; ++cb)
#pragma unroll
                    for (int ks = 0; ks < 2; ++ks) Sacc[cb] = __builtin_amdgcn_mfma_f32_32x32x16_bf16(fkt[2 * cb + ks], fvn[ks], Sacc[cb], 0, 0, 0);
                __builtin_amdgcn_sched_barrier(0);
                LAS float* Ot = (LAS float*)(lds + L_O + (i & 1) * 16384);
#pragma unroll
                for (int r = 0; r < 16; ++r) Ot[((r & 3) + 8 * (r >> 2) + 4 * hi) * 128 + 32 * vb + r32] = o[r];
#pragma unroll
                for (int cb = 0; cb < 4; ++cb)
#pragma unroll
                    for (int g4 = 0; g4 < 4; ++g4) { const f32x4 d = *(const LAS f32x4*)(op + O_D + (32 * cb + 8 * g4 + 4 * hi) * 4);
#pragma unroll
                        for (int j = 0; j < 4; ++j) Sacc[cb][4 * g4 + j] *= d[j]; }
            }
            lbar();
        }
    }
    __syncthreads();
}

__device__ __forceinline__ void p5_ln_route(Frame& F_, int g, int l, int bank) {
    KA_WS();
    Frame F = mkframe(F_.lds);
    typedef short bf16x8 __attribute__((ext_vector_type(8)));
    const float* lg = (const float*)KIN(14) + l * D; const float* lb = (const float*)KIN(15) + l * D;
    const float* bgp = (const float*)KIN(17) + l * 4; const float* be = (const float*)KIN(19) + l * 32;
    unsigned* cnt = ((unsigned*)(ws + WS_CTL)) + CW_CNT + bank * 32;
    constexpr int BS = 2064;
    LAS unsigned char* BT = F.lds; LAS float* LGT = (LAS float*)(F.lds + 48 * BS);
    LAS int* ent_e = (LAS int*)(F.lds + 48 * BS + 24576); LAS int* ent_pos = ent_e + 256; LAS float* ent_w = (LAS float*)(ent_pos + 256);
    const int lane = F.lane, wave = F.wave;
    constexpr int rows_per_wg = TG / 256;
    const int row0 = blockIdx.x * rows_per_wg, wrow0 = row0 + 16 * wave;
    const bf16* Rb = (const bf16*)(ws + WS_R); bf16* X1 = (bf16*)(ws + WS_X1);
    __syncthreads();
    u32x4 wreg[12];
    { const bf16* rw = (const bf16*)(ws + WS_RW) + (size_t)l * 2 * 48 * 1024;
#pragma unroll
      for (int k = 0; k < 12; ++k) { const int ch = F.tid + 512 * k; wreg[k] = *(const u32x4*)(rw + (size_t)(ch >> 7) * 1024 + (ch & 127) * 8); } }
    u32x2 rin[16][4];
#pragma unroll
    for (int r = 0; r < 16; ++r) { const u32x2* rp = (const u32x2*)(Rb + (size_t)(wrow0 + r) * D) + lane;
#pragma unroll
        for (int j = 0; j < 4; ++j) rin[r][j] = rp[64 * j]; }
#pragma unroll
    for (int k = 0; k < 12; ++k) { const int ch = F.tid + 512 * k; *(LAS u32x4*)(BT + (ch >> 7) * BS + (ch & 127) * 16) = wreg[k]; }
    f32x4 gg[4], bb[4];
#pragma unroll
    for (int j = 0; j < 4; ++j) { gg[j] = *(const f32x4*)(lg + lane * 4 + 256 * j); bb[j] = *(const f32x4*)(lb + lane * 4 + 256 * j); }
#pragma unroll
    for (int r = 0; r < 16; ++r) {
        f32x4 v[4]; float sm = 0.f;
#pragma unroll
        for (int j = 0; j < 4; ++j) { const u32x2 w = rin[r][j]; v[j] = (f32x4){lo16(w.x), hi16(w.x), lo16(w.y), hi16(w.y)}; sm += (v[j].x + v[j].y) + (v[j].z + v[j].w); }
        const float mean = wave_sum(sm) * (1.f / D); float s2 = 0.f;
#pragma unroll
        for (int j = 0; j < 4; ++j) { v[j] = v[j] - mean; s2 += (v[j].x * v[j].x + v[j].y * v[j].y) + (v[j].z * v[j].z + v[j].w * v[j].w); }
        const float rstd = __builtin_amdgcn_rsqf(wave_sum(s2) * (1.f / D) + EPS);
#pragma unroll
        for (int j = 0; j < 4; ++j) { const f32x4 y = v[j] * rstd * gg[j] + bb[j];
            *(u32x2*)(X1 + (size_t)(wrow0 + r) * D + lane * 4 + 256 * j) = (u32x2){pk2(y.x, y.y), pk2(y.z, y.w)}; }
    }
    asm volatile("s_waitcnt vmcnt(0)" ::: "memory");
    __syncthreads();
    {
        f32x4 acc[3];
#pragma unroll
        for (int nb = 0; nb < 3; ++nb) acc[nb] = (f32x4){0.f, 0.f, 0.f, 0.f};
        const bf16* xr = X1 + (size_t)(wrow0 + (lane & 15)) * D + 8 * (lane >> 4);
        const LAS unsigned char* bp = BT + (lane & 15) * BS + 16 * (lane >> 4);
#pragma unroll 8
        for (int ks = 0; ks < 32; ++ks) { const bf16x8 xa = *(const bf16x8*)(xr + 32 * ks);
#pragma unroll
            for (int nb = 0; nb < 3; ++nb) acc[nb] = __builtin_amdgcn_mfma_f32_16x16x32_bf16(xa, *(const LAS bf16x8*)(bp + nb * 16 * BS + 64 * ks), acc[nb], 0, 0, 0); }
        LAS float* lw = LGT + wave * 16 * 48;
#pragma unroll
        for (int nb = 0; nb < 3; ++nb)
#pragma unroll
            for (int i = 0; i < 4; ++i) lw[(4 * (lane >> 4) + i) * 48 + 16 * nb + (lane & 15)] = acc[nb][i];
        asm volatile("s_waitcnt lgkmcnt(0)" ::: "memory");
        if (lane < 16) {
            const LAS float* L0 = lw + lane * 48;
            float gl4[4];
#pragma unroll
            for (int e = 0; e < 4; ++e) gl4[e] = L0[e] + bgp[e];
            int gi = 0; float gm = gl4[0];
#pragma unroll
            for (int e = 1; e < 4; ++e) if (gl4[e] > gm) { gm = gl4[e]; gi = e; }
            float gs = 0.f;
#pragma unroll
            for (int e = 0; e < 4; ++e) gs += __expf(gl4[e] - gm);
            const float pgroup = 1.f / gs;
            float el[8];
#pragma unroll
            for (int e = 0; e < 8; ++e) el[e] = L0[4 + 8 * gi + e] + be[gi * 8 + e];
            int i0 = 0; float v0 = el[0];
#pragma unroll
            for (int e = 1; e < 8; ++e) if (el[e] > v0) { v0 = el[e]; i0 = e; }
            int i1 = -1; float v1 = -INFINITY;
#pragma unroll
            for (int e = 0; e < 8; ++e) if (e != i0 && el[e] > v1) { v1 = el[e]; i1 = e; }
            const float ex = __expf(v1 - v0); const float p0 = 1.f / (1.f + ex), p1 = ex * p0;
            const int ri = 16 * wave + lane;
            ent_e[ri * 2] = gi * 8 + i0; ent_e[ri * 2 + 1] = gi * 8 + i1; ent_w[ri * 2] = p0 * pgroup; ent_w[ri * 2 + 1] = p1 * pgroup;
        }
    }
    __syncthreads();
    LAS unsigned* lcnt = (LAS unsigned*)(ent_w + 256); LAS unsigned* lbase = lcnt + 32;
    if (F.tid < 32) lcnt[F.tid] = 0u;
    __syncthreads();
    int my_e = 0; unsigned my_rank = 0;
    if (F.tid < rows_per_wg * 2) { my_e = ent_e[F.tid]; my_rank = __hip_atomic_fetch_add((unsigned*)(lcnt + my_e), 1u, __ATOMIC_RELAXED, __HIP_MEMORY_SCOPE_WORKGROUP); }
    __syncthreads();
    if (F.tid < 32) { const unsigned c = lcnt[F.tid]; lbase[F.tid] = c ? __hip_atomic_fetch_add(cnt + F.tid, c, __ATOMIC_RELAXED, __HIP_MEMORY_SCOPE_AGENT) : 0u; }
    __syncthreads();
    if (F.tid < rows_per_wg * 2) { const unsigned pos = lbase[my_e] + my_rank; ent_pos[F.tid] = (int)pos; ((int*)(ws + WS_TOK))[(size_t)my_e * TG + pos] = row0 + (F.tid >> 1); }
    __syncthreads();
    if (F.tid < rows_per_wg) { const int i = F.tid; unsigned* r = ((unsigned*)(ws + WS_RT)) + (size_t)(row0 + i) * 8;
        r[0] = (unsigned)ent_e[2 * i]; r[1] = (unsigned)ent_pos[2 * i]; r[2] = __float_as_uint(ent_w[2 * i]); r[3] = (unsigned)ent_e[2 * i + 1]; r[4] = (unsigned)ent_pos[2 * i + 1]; r[5] = __float_as_uint(ent_w[2 * i + 1]); }
    __syncthreads();
}

constexpr int TAB_OFF = MISC_OFF + 256;
__device__ __forceinline__ void moe_table(Frame& F_, int g, int l);
__device__ __forceinline__ void p8_ln2(Frame& F_, int g, int l) {
    KA_WS();
    Frame F = mkframe(F_.lds);
    const float* lg = (const float*)KIN(23) + l * D; const float* lb = (const float*)KIN(24) + l * D;
    __syncthreads();
    const LAS int* offs = (const LAS int*)(F.lds + TAB_OFF);
    const int lane = F.lane;
    const bf16* __restrict__ X1 = (const bf16*)(ws + WS_X1); const bf16* __restrict__ OM = (const bf16*)(ws + WS_OM);
    const int per = TG / (gridDim.x * NWAVES);
    const int t0 = (blockIdx.x * NWAVES + F.wave) * per;
    int ms0 = 0, ms1 = 0; float mw0 = 0.f, mw1 = 0.f;
    if (lane < per) { const unsigned* r = ((const unsigned*)(ws + WS_RT)) + (size_t)(t0 + lane) * 8; const u32x4 ra = *(const u32x4*)r; const u32x2 rb2 = *(const u32x2*)(r + 4);
        ms0 = offs[ra.x] * 256 + (int)ra.y; mw0 = __uint_as_float(ra.z); ms1 = offs[ra.w] * 256 + (int)rb2.x; mw1 = __uint_as_float(rb2.y); }
#pragma unroll 1
    for (int i = 0; i < per; i += 2) {
        u32x2 xa[2][4], oa[2][4], ob[2][4]; float w0[2], w1[2];
#pragma unroll
        for (int rr = 0; rr < 2; ++rr) {
            const int s0 = __builtin_amdgcn_readlane(ms0, i + rr), s1 = __builtin_amdgcn_readlane(ms1, i + rr);
            w0[rr] = __builtin_bit_cast(float, __builtin_amdgcn_readlane(__builtin_bit_cast(int, mw0), i + rr)); w1[rr] = __builtin_bit_cast(float, __builtin_amdgcn_readlane(__builtin_bit_cast(int, mw1), i + rr));
#pragma unroll
            for (int j = 0; j < 4; ++j) { const int d0 = lane * 4 + 256 * j;
                xa[rr][j] = *(const u32x2*)(X1 + (size_t)(t0 + i + rr) * D + d0); oa[rr][j] = *(const u32x2*)(OM + (size_t)s0 * D + d0); ob[rr][j] = *(const u32x2*)(OM + (size_t)s1 * D + d0); }
        }
#pragma unroll
        for (int rr = 0; rr < 2; ++rr) {
            const int t = t0 + i + rr;
            f32x4 v[4]; float sm = 0.f;
#pragma unroll
            for (int j = 0; j < 4; ++j) {
                v[j].x = ALPHA * lo16(xa[rr][j].x) + w0[rr] * lo16(oa[rr][j].x) + w1[rr] * lo16(ob[rr][j].x); v[j].y = ALPHA * hi16(xa[rr][j].x) + w0[rr] * hi16(oa[rr][j].x) + w1[rr] * hi16(ob[rr][j].x);
                v[j].z = ALPHA * lo16(xa[rr][j].y) + w0[rr] * lo16(oa[rr][j].y) + w1[rr] * lo16(ob[rr][j].y); v[j].w = ALPHA * hi16(xa[rr][j].y) + w0[rr] * hi16(oa[rr][j].y) + w1[rr] * hi16(ob[rr][j].y);
                sm += (v[j].x + v[j].y) + (v[j].z + v[j].w);
            }
            const float mean = wave_sum(sm) * (1.f / D); float s2 = 0.f;
#pragma unroll
            for (int j = 0; j < 4; ++j) { v[j] = v[j] - mean; s2 += (v[j].x * v[j].x + v[j].y * v[j].y) + (v[j].z * v[j].z + v[j].w * v[j].w); }
            const float rstd = __builtin_amdgcn_rsqf(wave_sum(s2) * (1.f / D) + EPS);
#pragma unroll
            for (int j = 0; j < 4; ++j) {
                const int d0 = lane * 4 + 256 * j; const f32x4 gg = *(const f32x4*)(lg + d0), bb = *(const f32x4*)(lb + d0);
                const f32x4 y = v[j] * rstd * gg + bb;
                if (l == NL - 1) *(f32x4*)(KOUT() + ((size_t)g * TG + t) * D + d0) = y;
                else *(u32x2*)((bf16*)(ws + WS_XB) + (size_t)t * D + d0) = (u32x2){pk2(y.x, y.y), pk2(y.z, y.w)};
            }
        }
    }
}

struct RmId { int off; __device__ __forceinline__ int operator()(int n0) const { return off + n0; } };
struct RmGlu { __device__ __forceinline__ int operator()(int n0) const { if (n0 >= 1024) return n0; const int hi = n0 >= 512, c = n0 - hi * 512; return (c >> 7) * 256 + hi * 128 + (c & 127); } };
struct RmIl { int hi; __device__ __forceinline__ int operator()(int n0) const { return (n0 >> 7) * 256 + hi * 128 + (n0 & 127); } };
struct WItem { const float* src; bf16* dst; int N, K; };
__device__ __forceinline__ void witem_load(const WItem& w, int lane, f32x4 (&v)[8]) {
#pragma unroll
    for (int j = 0; j < 8; ++j) v[j] = *(const f32x4*)(w.src + (size_t)(j * 8 + (lane >> 3)) * w.N + (lane & 7) * 4);
}
__device__ __forceinline__ void witem_store(const WItem& w, int lane, const f32x4 (&v)[8], LAS float* scr) {
#pragma unroll
    for (int j = 0; j < 8; ++j) { LAS float* d = scr + (j * 8 + (lane >> 3)) * 33 + (lane & 7) * 4; d[0] = v[j].x; d[1] = v[j].y; d[2] = v[j].z; d[3] = v[j].w; }
    LDS_WAIT();
    const int c = lane & 7;
#pragma unroll
    for (int j = 0; j < 4; ++j) { const int n = (lane >> 3) + 8 * j; const LAS float* sp = scr + (8 * c) * 33 + n;
        u32x4 o; o.x = pk2(sp[0 * 33], sp[1 * 33]); o.y = pk2(sp[2 * 33], sp[3 * 33]); o.z = pk2(sp[4 * 33], sp[5 * 33]); o.w = pk2(sp[6 * 33], sp[7 * 33]);
        *(u32x4*)(w.dst + (size_t)n * w.K + 8 * c) = o; }
    LDS_WAIT();
}
template <class RM>
__device__ __forceinline__ WItem witem_make(const float* W, int K, int N, bf16* WT, RM rowmap, int item) {
    const int nblk = N / 32, kb = item / nblk, nb = item % nblk, k0 = 64 * kb, n0 = 32 * nb;
    WItem w; w.src = W + (size_t)k0 * N + n0; w.dst = WT + (size_t)rowmap(n0) * K + k0; w.N = N; w.K = K; return w;
}
__device__ __forceinline__ WItem witem_decode(unsigned char* ws, KArgs ka, int it) {
    bf16* WIN = (bf16*)(ws + WS_WIN); bf16* WBR = (bf16*)(ws + WS_WBR); bf16* WOUT = (bf16*)(ws + WS_WOUT); bf16* W13 = (bf16*)(ws + WS_W13); bf16* W2 = (bf16*)(ws + WS_W2);
    constexpr int I_IN = WI_IN, I_BR = WI_BR, I_OUT = WI_OUT, I_W1 = WI_W1, I_W2 = WI_W2;
    constexpr int N_IN = WN_IN, N_BR = WN_BR, N_OUT = WN_OUT, N_W1 = WN_W1;
    int r = it;
    if (r < N_IN) { const int l = r / I_IN; return witem_make((const float*)KIN(2) + (size_t)l * D * INC, D, INC, WIN + (size_t)l * INC * D, RmGlu(), r % I_IN); } r -= N_IN;
    if (r < N_BR) { const int q = r / I_BR; return witem_make((const float*)KIN(11) + (size_t)q * 512 * D, 512, D, WBR + (size_t)q * D * 512, RmId{0}, r % I_BR); } r -= N_BR;
    if (r < N_OUT) { const int l = r / I_OUT; return witem_make((const float*)KIN(13) + (size_t)l * D * D, D, D, WOUT + (size_t)l * D * D, RmId{0}, r % I_OUT); } r -= N_OUT;
    if (r < N_W1) { const int q = r / I_W1; return witem_make((const float*)KIN(20) + (size_t)q * D * DE, D, DE, W13 + (size_t)q * 1024 * D, RmIl{0}, r % I_W1); } r -= N_W1;
    if (r < N_W1) { const int q = r / I_W1; return witem_make((const float*)KIN(21) + (size_t)q * D * DE, D, DE, W13 + (size_t)q * 1024 * D, RmIl{1}, r % I_W1); } r -= N_W1;
    { const int q = r / I_W2; return witem_make((const float*)KIN(22) + (size_t)q * DE * D, DE, D, W2 + (size_t)q * D * DE, RmId{0}, r % I_W2); }
}
__device__ __forceinline__ void wprep_items(Frame& F_, int first, int step, int end) {
    KA_WS();
    Frame F = mkframe(F_.lds);
    LAS float* scr = (LAS float*)(F.lds + F.wave * 16384);
    const int lane = F.lane;
    if (first >= end) return;
    WItem cur = witem_decode(ws, ka, first); f32x4 v[8]; witem_load(cur, lane, v);
#pragma unroll 1
    for (int it = first; it < end; it += step) {
        const bool more = it + step < end;
        WItem nxt = cur; f32x4 vn[8];
        if (more) { nxt = witem_decode(ws, ka, it + step); witem_load(nxt, lane, vn); }
        witem_store(cur, lane, v, scr);
        if (more) { cur = nxt;
#pragma unroll
            for (int j = 0; j < 8; ++j) v[j] = vn[j]; }
    }
}
__device__ __forceinline__ void p_wprep(Frame& F_) {
    int t = threadIdx.x; asm volatile("" : "+v"(t));
    wprep_items(F_, blockIdx.x * NWAVES + __builtin_amdgcn_readfirstlane(t >> 6), gridDim.x * NWAVES, WI_IN);
}

template <int PART> __device__ __forceinline__ void p1_part(Frame& F_, int g, int l, int G, int c) {
    KA_WS();
    Frame F = mkframe(F_.lds);
    pg8::ProbDense P{(const char*)((bf16*)(ws + WS_XB)), (const char*)(ws + WS_WIN) + (size_t)l * INC * D * 2, D};
    pg8::SubOrder<PART> S; S.init(TG, G, c);
    pg8::EpiInProj E{((bf16*)(ws + WS_U)), ((bf16*)(ws + WS_Q)), ((bf16*)(ws + WS_V)), ((bf16*)(ws + WS_GATE)), ((const float*)(ws + WS_ROT)) + (size_t)g * TG * 16, ((const float*)(ws + WS_LB)) + l * 512, (const float*)KIN(12) + (size_t)l * 3 * D};
    pg8::gemm_phase<pg8::ProbDense, pg8::EpiInProj, pg8::SubOrder<PART>, true>(F.lds, P, S, E);
}
__device__ __forceinline__ void p3_merge(Frame& F_, int l) {
    KA_WS();
    Frame F = mkframe(F_.lds);
    pg8::ProbMerge P{(const char*)((bf16*)(ws + WS_YA)), (const char*)((bf16*)(ws + WS_YB)), (const char*)((bf16*)(ws + WS_YC)), (const char*)(ws + WS_WBR) + (size_t)l * 3 * D * 512 * 2, 512};
    pg8::MergeOrder S; S.so.init(TG, D, gridDim.x, blockIdx.x);
    pg8::EpiMerge E{((bf16*)(ws + WS_GATE)), ((bf16*)(ws + WS_M))};
    pg8::gemm_phase<pg8::ProbMerge, pg8::EpiMerge, pg8::MergeOrder, true>(F.lds, P, S, E);
}
__device__ __forceinline__ void p4_wout(Frame& F_, int l) {
    KA_WS();
    Frame F = mkframe(F_.lds);
    pg8::ProbDense P{(const char*)((bf16*)(ws + WS_M)), (const char*)(ws + WS_WOUT) + (size_t)l * D * D * 2, D};
    pg8::StaticOrder S; S.init(TG, D, gridDim.x, blockIdx.x);
    pg8::EpiWout E{((bf16*)(ws + WS_XB)), ((bf16*)(ws + WS_R))};
    pg8::gemm_phase<pg8::ProbDense, pg8::EpiWout, pg8::StaticOrder, true>(F.lds, P, S, E);
}
__device__ __forceinline__ void moe_table(Frame& F_, int g, int l) {
    KA_WS();
    Frame F = mkframe(F_.lds);
    const unsigned* cnt = ((unsigned*)(ws + WS_CTL)) + CW_CNT + (g * 2 + l) * 32;
    LAS int* tab = (LAS int*)(F.lds + TAB_OFF);
    __syncthreads();
    if (F.tid < 64) {
        const int c = F.tid < 32 ? (int)cnt[F.tid] : 0; int sacc = (c + 255) >> 8;
#pragma unroll
        for (int o = 1; o < 32; o <<= 1) { const int t2 = __shfl_up(sacc, o); if (F.lane >= o) sacc += t2; }
        if (F.tid < 32) { tab[F.tid + 1] = sacc; tab[33 + F.tid] = c; }
        if (F.tid == 0) tab[0] = 0;
    }
    __syncthreads();
}
__device__ __forceinline__ void p6_moe1(Frame& F_, int g, int l) {
    KA_WS();
    Frame F = mkframe(F_.lds);
    moe_table(F, g, l);
    pg8::ProbMoe1 P{(const char*)((bf16*)(ws + WS_X1)), (const char*)(ws + WS_W13) + (size_t)l * NE * 1024 * D * 2, ((int*)(ws + WS_TOK)), D};
    pg8::MoeOrder<1> S{(const LAS int*)(F.lds + TAB_OFF), (int)gridDim.x, (int)blockIdx.x, 4, (unsigned*)(ws + WS_CTL) + CW_MOE + (g * 2 + l) * 8192};
    pg8::EpiMoe1 E{((bf16*)(ws + WS_HM))};
    pg8::gemm_phase<pg8::ProbMoe1, pg8::EpiMoe1, pg8::MoeOrder<1>, true>(F.lds, P, S, E);
}
__device__ __forceinline__ void p7_moe2(Frame& F_, int g, int l) {
    KA_WS();
    Frame F = mkframe(F_.lds);
    __syncthreads();
    pg8::ProbMoe2 P{(const char*)((bf16*)(ws + WS_HM)), (const char*)(ws + WS_W2) + (size_t)l * NE * D * DE * 2, DE};
    pg8::MoeOrder<2> S{(const LAS int*)(F.lds + TAB_OFF), (int)gridDim.x, (int)gridDim.x - 1 - (int)blockIdx.x, 4, (unsigned*)(ws + WS_CTL) + CW_MOE + (g * 2 + l) * 8192};
    pg8::EpiMoe2 E{((bf16*)(ws + WS_OM))};
    pg8::gemm_phase<pg8::ProbMoe2, pg8::EpiMoe2, pg8::MoeOrder<2>, true>(F.lds, P, S, E);
}

__device__ __forceinline__ void frame_init(Frame& F, unsigned char* lds_raw) {
    F.lds = (LAS unsigned char*)lds_raw; F.tid = threadIdx.x; F.lane = F.tid & 63; F.wave = __builtin_amdgcn_readfirstlane(F.tid >> 6);
}
__global__ void __launch_bounds__(NTHR, 2) fwd_all(Args a) {
    extern __shared__ __attribute__((aligned(16))) unsigned char lds_raw[];
    Frame F; frame_init(F, lds_raw);
    volatile LAS unsigned* MISC = (volatile LAS unsigned*)(F.lds + MISC_OFF);
    if (F.tid < 64) MISC[F.tid] = 0u;
    __syncthreads();
    XcdBarrier bar = xcd_barrier_post((unsigned*)(a.ws + WS_CTL) + CW_BAR, MISC + 8);
    p_prologue(F); p_wprep(F); p_xload(F, 0);
    xcd_barrier(bar);
    for (int g = 0; g < NG; ++g) {
        for (int l = 0; l < NL; ++l) {
            p1_part<0>(F, g, l, (int)gridDim.x, (int)blockIdx.x); xcd_barrier(bar);
            p2_mixers(F, g, l, 0); xcd_barrier(bar);
            p3_merge(F, l); xcd_barrier(bar);
            p4_wout(F, l); xcd_barrier(bar);
            p5_ln_route(F, g, l, g * 2 + l); xcd_barrier(bar);
            p6_moe1(F, g, l);
            p7_moe2(F, g, l);
            if (l == NL - 1 && g + 1 < NG) p_xload_queue(F, g + 1);
            xcd_barrier(bar);
            p8_ln2(F, g, l);
            if (!(g == NG - 1 && l == NL - 1)) xcd_barrier(bar);
        }
    }
}

extern "C" void kernel_launch(void* const* d_in, const int* in_sizes, int n_in, void* d_out, int out_size, void* d_ws, size_t ws_size, hipStream_t stream) {
    static int grid = 0;
    if (grid == 0) {
        if (n_in != 25 || out_size != T * D || ws_size < WS_END) { fprintf(stderr, "kernel_launch: unexpected shapes (n_in %d out %d ws %zu)\n", n_in, out_size, ws_size); grid = -1; return; }
        int dev = 0, cus = 0;
        if (hipGetDevice(&dev) != hipSuccess || hipDeviceGetAttribute(&cus, hipDeviceAttributeMultiprocessorCount, dev) != hipSuccess) { grid = -1; return; }
        (void)hipGetLastError();
        grid = cus;
        if (grid != 256) { fprintf(stderr, "kernel_launch: built for 256 CUs, got %d\n", cus); grid = -1; return; }
    }
    if (grid < 0) return;
    (void)hipMemsetAsync((char*)d_ws + WS_CTL, 0, CTL_ZERO_BYTES, stream);
    Args a{};
    for (int i = 0; i < 25; ++i) a.in[i] = d_in[i];
    a.out = (float*)d_out; a.ws = (unsigned char*)d_ws;
    { static bool attr = false; if (!attr) { (void)hipFuncSetAttribute((const void*)fwd_all, hipFuncAttributeMaxDynamicSharedMemorySize, LDS_BYTES); attr = true; }
      hipLaunchKernelGGL(fwd_all, dim3(grid), dim3(NTHR), LDS_BYTES, stream, a);}

}
```
